# Optimizing an MI355X kernel written in HIP

```python
import math
import functools
import jax
import jax.numpy as jnp
from jax import lax
import numpy as np

D_MODEL = 1024
BATCH = 8
SEQ = 2048
DEPTH = 2

GRID_W = 64
CTX_LEN = 256
EPS = 1e-6
HEAD_DIM = 64
GROUP_WIDTH = D_MODEL // 2
MIX_WIDTH = 2 * GROUP_WIDTH

HY_CH = GROUP_WIDTH
HY_BANDS = 16
HY_EMB = 2 * HY_BANDS + 1
HY_FILT_HID = 64
HY_FAST_DECAY = 0.3
HY_SLOW_DECAY = 1.5
HY_DECAY_TARGET = 1e-2
SHORT_CONV = 3

SSM_INNER = GROUP_WIDTH
SSM_HEADDIM = 64
SSM_HEADS = SSM_INNER // SSM_HEADDIM
SSM_GROUPS = 2
SSM_STATE = 128
SSM_CHUNK = 128
SSM_CONV_CH = SSM_INNER + 2 * SSM_GROUPS * SSM_STATE
EVEN_IN = 3 * HY_CH + SSM_INNER + SSM_CONV_CH + 2 * SSM_HEADS

MLA_HEADS = GROUP_WIDTH // HEAD_DIM
MLA_NOPE = 64
MLA_ROPE = 32
MLA_V = 64
MLA_Q_LORA = D_MODEL // 4
MLA_KV_LORA = D_MODEL // 8

GQA_HEADS = GROUP_WIDTH // HEAD_DIM
GQA_KV = GQA_HEADS // 4
WINDOW = 128
ODD_IN = MLA_Q_LORA + MLA_KV_LORA + MLA_ROPE + (GQA_HEADS + 2 * GQA_KV) * HEAD_DIM

ROPE_BASE = 10000.0
ATTN_BLOCK = 128

D_FF = ((8 * D_MODEL // 3 + 127) // 128) * 128
N_EXPERTS = 8
TOP_K = 2
D_FF_EXPERT = 7 * D_MODEL // 2

N_EVEN = (DEPTH + 1) // 2
N_ODD = DEPTH // 2

kernel_name = 'hybrid_flow_prefix_block'


def rmsnorm(x, g):
    xf = x.astype(jnp.float32)
    y = xf * lax.rsqrt(jnp.mean(xf * xf, axis=-1, keepdims=True) + EPS)
    return (y * g.astype(jnp.float32)).astype(x.dtype)


def ada_params(cond, w, b):
    m = jax.nn.silu(cond) @ w + b
    return [t[:, None, :] for t in jnp.split(m, 6, axis=-1)]


def modulate(h, shift, scale):
    return h * (1 + scale) + shift


def split_last(x, sizes):
    out, start = [], 0
    for s in sizes:
        out.append(x[..., start:start + s])
        start += s
    return out


def flip_seq(t):
    return jnp.flip(t, axis=1)


def dwconv_centred(x, w, b):
    k_w, ch = w.shape
    pad = k_w // 2
    y = lax.conv_general_dilated(x, w[:, None, :].astype(x.dtype), window_strides=(1,), padding=[(pad, pad)],
                                 dimension_numbers=('NWC', 'WIO', 'NWC'), feature_group_count=ch)
    return y + b


def hyena_filters(n, w1, b1, w2, b2, w3, freq):
    pos = jnp.arange(n, dtype=jnp.float32)
    t = pos / (n - 1)
    omega = 2.0 * math.pi * pos / n
    bands = jnp.linspace(1e-4, HY_BANDS - 1, HY_BANDS, dtype=jnp.float32)
    z = jnp.concatenate([t[:, None], jnp.cos(omega[:, None] * bands), -jnp.sin(omega[:, None] * bands)], axis=-1)
    f = freq.astype(jnp.float32)
    h = jnp.sin(f * (z @ w1.astype(jnp.float32) + b1.astype(jnp.float32)))
    h = jnp.sin(f * (h @ w2.astype(jnp.float32) + b2.astype(jnp.float32)))
    h = (h @ w3.astype(jnp.float32)).reshape(n, 2, HY_CH)
    deltas = jnp.abs(jnp.linspace(math.log(HY_DECAY_TARGET) / HY_SLOW_DECAY, math.log(HY_DECAY_TARGET) / HY_FAST_DECAY,
                                  HY_CH, dtype=jnp.float32))
    decay = jnp.exp(-t[:, None] * deltas[None, :])
    return h[:, 0] * decay, h[:, 1] * decay


def long_conv_bidir(u, h_fwd, h_bwd, bias):
    n, ch = h_fwd.shape
    filt = jnp.concatenate([h_fwd, jnp.zeros((1, ch), jnp.float32), h_bwd[1:][::-1]], axis=0)
    uf = jnp.fft.rfft(u, n=2 * n, axis=1)
    ff = jnp.fft.rfft(filt, n=2 * n, axis=0)
    y = jnp.fft.irfft(uf * ff[None], n=2 * n, axis=1)[:, :n]
    return y + u * bias


def hyena_mixer(proj, conv_w, conv_b, w1, b1, w2, b2, w3, freq, bias):
    n = proj.shape[1]
    x0, x1, v = jnp.split(dwconv_centred(proj, conv_w, conv_b).astype(jnp.float32), 3, axis=-1)
    h_fwd, h_bwd = hyena_filters(n, w1, b1, w2, b2, w3, freq)
    y = x0 * long_conv_bidir(x1 * v, h_fwd, h_bwd, bias.astype(jnp.float32))
    return y.astype(proj.dtype)


def segsum(a):
    t_len = a.shape[-1]
    cs = jnp.cumsum(a, axis=-1)
    seg = cs[..., :, None] - cs[..., None, :]
    mask = jnp.tril(jnp.ones((t_len, t_len), dtype=bool))
    return jnp.where(mask, seg, -jnp.inf)


def ssd_scan(x, dt, a_head, b_in, c_in, init_state):
    bsz, n, nh, hp = x.shape
    ns = b_in.shape[-1]
    nc = n // SSM_CHUNK
    xd = (x * dt[..., None]).reshape(bsz, nc, SSM_CHUNK, nh, hp)
    a = (dt * a_head).reshape(bsz, nc, SSM_CHUNK, nh).transpose(0, 3, 1, 2)
    bc = b_in.reshape(bsz, nc, SSM_CHUNK, nh, ns)
    cc = c_in.reshape(bsz, nc, SSM_CHUNK, nh, ns)
    a_cs = jnp.cumsum(a, axis=-1)
    lmat = jnp.exp(segsum(a))
    scores = jnp.einsum('bcqhn,bcshn->bhcqs', cc, bc) * lmat
    y_diag = jnp.einsum('bhcqs,bcshp->bcqhp', scores, xd)
    decay_states = jnp.exp(a_cs[..., -1:] - a_cs).transpose(0, 2, 3, 1)
    states = jnp.einsum('bcqhn,bcqhp->bchpn', bc * decay_states[..., None], xd)
    states = jnp.concatenate([init_state[:, None], states], axis=1)
    chunk_a = jnp.pad(a_cs[..., -1], ((0, 0), (0, 0), (1, 0)))
    decay_chunk = jnp.exp(segsum(chunk_a))
    new_states = jnp.einsum('bhzc,bchpn->bzhpn', decay_chunk, states)
    states_in, final_state = new_states[:, :-1], new_states[:, -1]
    out_decay = jnp.exp(a_cs).transpose(0, 2, 3, 1)
    y_off = jnp.einsum('bcqhn,bchpn->bcqhp', cc * out_decay[..., None], states_in)
    return (y_diag + y_off).reshape(bsz, n, nh, hp), final_state


def ssd_mixer(proj, init_f, init_b, conv_w, conv_b, dt_bias, a_log, d_skip, norm_g):
    bsz, n, _ = proj.shape
    f32 = jnp.float32
    z, xbc, dt_raw = split_last(proj, [SSM_INNER, SSM_CONV_CH, 2 * SSM_HEADS])
    xbc = jax.nn.silu(dwconv_centred(xbc, conv_w, conv_b)).astype(f32)
    xs, b_in, c_in = split_last(xbc, [SSM_INNER, SSM_GROUPS * SSM_STATE, SSM_GROUPS * SSM_STATE])
    xs = xs.reshape(bsz, n, SSM_HEADS, SSM_HEADDIM)
    rep = SSM_HEADS // SSM_GROUPS
    b_in = jnp.repeat(b_in.reshape(bsz, n, SSM_GROUPS, SSM_STATE), rep, axis=2)
    c_in = jnp.repeat(c_in.reshape(bsz, n, SSM_GROUPS, SSM_STATE), rep, axis=2)
    dt = jax.nn.softplus(dt_raw.astype(f32).reshape(bsz, n, 2, SSM_HEADS) + dt_bias.astype(f32))
    a = -jnp.exp(a_log.astype(f32))
    y_f, s_f = ssd_scan(xs, dt[:, :, 0], a[0], b_in, c_in, init_f)
    y_b, s_b = ssd_scan(flip_seq(xs), flip_seq(dt[:, :, 1]), a[1], flip_seq(b_in), flip_seq(c_in), init_b)
    y = y_f + flip_seq(y_b) + xs * d_skip.astype(f32)[:, None]
    y = y.reshape(bsz, n, SSM_INNER) * jax.nn.silu(z.astype(f32))
    yg = y.reshape(bsz, n, SSM_GROUPS, SSM_INNER // SSM_GROUPS)
    yg = yg * lax.rsqrt(jnp.mean(yg * yg, axis=-1, keepdims=True) + EPS)
    y = yg.reshape(bsz, n, SSM_INNER) * norm_g.astype(f32)
    return y.astype(proj.dtype), s_f, s_b


def even_mix(h, init_f, init_b, w_in, hy_conv_w, hy_conv_b, f_w1, f_b1, f_w2, f_b2, f_w3, hy_freq, hy_bias,
             ssm_conv_w, ssm_conv_b, dt_bias, a_log, d_skip, ssm_norm_g, w_out):
    proj = h @ w_in
    y_hy = hyena_mixer(proj[..., :3 * HY_CH], hy_conv_w, hy_conv_b, f_w1, f_b1, f_w2, f_b2, f_w3, hy_freq, hy_bias)
    y_ssm, s_f, s_b = ssd_mixer(proj[..., 3 * HY_CH:], init_f, init_b, ssm_conv_w, ssm_conv_b, dt_bias, a_log,
                                d_skip, ssm_norm_g)
    out = jnp.concatenate([y_hy, y_ssm], axis=-1) @ w_out
    return out, s_f, s_b


def axial_rope_tables(n_tokens, rot_dim):
    n_rows = n_tokens // GRID_W
    rows, cols = jnp.meshgrid(jnp.arange(n_rows), jnp.arange(GRID_W), indexing='ij')
    rows = rows.reshape(-1).astype(jnp.float32)
    cols = cols.reshape(-1).astype(jnp.float32)
    nf = rot_dim // 4
    inv = ROPE_BASE ** (-jnp.arange(nf, dtype=jnp.float32) / nf)
    ang = jnp.concatenate([rows[:, None] * inv, cols[:, None] * inv], axis=-1)
    return jnp.cos(ang), jnp.sin(ang)


def apply_rope(x, rope):
    cos, sin = rope
    half = x.shape[-1] // 2
    x1, x2 = x[..., :half], x[..., half:]
    c, s = cos[None, :, None, :], sin[None, :, None, :]
    return jnp.concatenate([x1 * c - x2 * s, x2 * c + x1 * s], axis=-1).astype(x.dtype)


def dense_attention_blocked(q, k, v, scale):
    bsz, n, nh, d = q.shape
    nb = n // ATTN_BLOCK
    qb = q.reshape(bsz, nb, ATTN_BLOCK, nh, d).transpose(1, 0, 2, 3, 4)

    def one_block(qi):
        s = jnp.einsum('bqhd,bkhd->bhqk', qi, k).astype(jnp.float32) * scale
        p = jax.nn.softmax(s, axis=-1).astype(v.dtype)
        return jnp.einsum('bhqk,bkhd->bqhd', p, v)

    o = lax.map(one_block, qb)
    return o.transpose(1, 0, 2, 3, 4).reshape(bsz, n, nh, v.shape[-1])


def window_gqa_sink(q, k, v, k_ctx, v_ctx, sink):
    bsz, n, gh, d = q.shape
    n_kv = k.shape[2]
    g = gh // n_kv
    w = WINDOW
    nb = n // w
    c_len = k_ctx.shape[1]
    scale = d ** -0.5
    qb = q.reshape(bsz, nb, w, n_kv, g, d)

    def band(t):
        tp = jnp.pad(t, ((0, 0), (w, w), (0, 0), (0, 0))).reshape(bsz, nb + 2, w, n_kv, d)
        return jnp.concatenate([tp[:, :-2], tp[:, 1:-1], tp[:, 2:]], axis=2)

    kb, vb = band(k), band(v)
    qpos = jnp.arange(nb)[:, None] * w + jnp.arange(w)[None, :]
    kpos = (jnp.arange(nb)[:, None] - 1) * w + jnp.arange(3 * w)[None, :]
    rel = kpos[:, None, :] - qpos[:, :, None]
    valid = (jnp.abs(rel) <= w) & (kpos[:, None, :] >= 0) & (kpos[:, None, :] < n)
    s_loc = jnp.einsum('bnqkgd,bnrkd->bnkgqr', qb, kb).astype(jnp.float32) * scale
    s_loc = jnp.where(valid[None, :, None, None], s_loc, -jnp.inf)
    s_ctx = jnp.einsum('bnqkgd,bckd->bnkgqc', qb, k_ctx).astype(jnp.float32) * scale
    s_sink = jnp.broadcast_to(sink.astype(jnp.float32).reshape(1, 1, n_kv, g, 1, 1), s_loc.shape[:-1] + (1,))
    p = jax.nn.softmax(jnp.concatenate([s_loc, s_ctx, s_sink], axis=-1), axis=-1).astype(v.dtype)
    o = (jnp.einsum('bnkgqr,bnrkd->bnqkgd', p[..., :3 * w], vb)
         + jnp.einsum('bnkgqc,bckd->bnqkgd', p[..., 3 * w:3 * w + c_len], v_ctx))
    return o.reshape(bsz, n, gh, d)


def ctx_gqa_sink(q, k, v, sink):
    bsz, c_len, gh, d = q.shape
    n_kv = k.shape[2]
    g = gh // n_kv
    qg = q.reshape(bsz, c_len, n_kv, g, d)
    s = jnp.einsum('bqkgd,bckd->bkgqc', qg, k).astype(jnp.float32) * d ** -0.5
    s_sink = jnp.broadcast_to(sink.astype(jnp.float32).reshape(1, n_kv, g, 1, 1), s.shape[:-1] + (1,))
    p = jax.nn.softmax(jnp.concatenate([s, s_sink], axis=-1), axis=-1)[..., :-1].astype(v.dtype)
    return jnp.einsum('bkgqc,bckd->bqkgd', p, v).reshape(bsz, c_len, gh, d)


def odd_project(h, w_in, q_norm_g, w_q_up, kv_norm_g, w_kv_up):
    bsz, n, _ = h.shape
    q_lat, kv_lat, k_rope, q_g, k_g, v_g = split_last(
        h @ w_in, [MLA_Q_LORA, MLA_KV_LORA, MLA_ROPE, GQA_HEADS * HEAD_DIM, GQA_KV * HEAD_DIM, GQA_KV * HEAD_DIM])
    q = (rmsnorm(q_lat, q_norm_g) @ w_q_up).reshape(bsz, n, MLA_HEADS, MLA_NOPE + MLA_ROPE)
    kv = (rmsnorm(kv_lat, kv_norm_g) @ w_kv_up).reshape(bsz, n, MLA_HEADS, MLA_NOPE + MLA_V)
    return (q[..., :MLA_NOPE], q[..., MLA_NOPE:], kv[..., :MLA_NOPE], k_rope[:, :, None, :], kv[..., MLA_NOPE:],
            q_g.reshape(bsz, n, GQA_HEADS, HEAD_DIM), k_g.reshape(bsz, n, GQA_KV, HEAD_DIM),
            v_g.reshape(bsz, n, GQA_KV, HEAD_DIM))


def mla_keys(k_nope, k_rope):
    return jnp.concatenate([k_nope, jnp.broadcast_to(k_rope, k_nope.shape[:-1] + (MLA_ROPE,))], axis=-1)


def odd_mix(a_lat, a_ctx, need_ctx, rope_mla, rope_gqa, w_in, q_norm_g, w_q_up, kv_norm_g, w_kv_up, sink, w_out):
    bsz, n, _ = a_lat.shape
    qn_l, qr_l, kn_l, kr_l, v_l, qg_l, kg_l, vg_l = odd_project(a_lat, w_in, q_norm_g, w_q_up, kv_norm_g, w_kv_up)
    qn_c, qr_c, kn_c, kr_c, v_c, qg_c, kg_c, vg_c = odd_project(a_ctx, w_in, q_norm_g, w_q_up, kv_norm_g, w_kv_up)
    mla_scale = (MLA_NOPE + MLA_ROPE) ** -0.5
    k_c = mla_keys(kn_c, kr_c)
    q_l = jnp.concatenate([qn_l, apply_rope(qr_l, rope_mla)], axis=-1)
    k_l = mla_keys(kn_l, apply_rope(kr_l, rope_mla))
    o_mla = dense_attention_blocked(q_l, jnp.concatenate([k_c, k_l], axis=1), jnp.concatenate([v_c, v_l], axis=1),
                                    mla_scale)
    o_win = window_gqa_sink(apply_rope(qg_l, rope_gqa), apply_rope(kg_l, rope_gqa), vg_l, kg_c, vg_c, sink)
    m_lat = jnp.concatenate([o_mla.reshape(bsz, n, -1), o_win.reshape(bsz, n, -1)], axis=-1) @ w_out
    if not need_ctx:
        return m_lat, None
    c_len = a_ctx.shape[1]
    o_mla_c = dense_attention_blocked(jnp.concatenate([qn_c, qr_c], axis=-1), k_c, v_c, mla_scale)
    o_win_c = ctx_gqa_sink(qg_c, kg_c, vg_c, sink)
    m_ctx = jnp.concatenate([o_mla_c.reshape(bsz, c_len, -1), o_win_c.reshape(bsz, c_len, -1)], axis=-1) @ w_out
    return m_lat, m_ctx


def swiglu(h, w_gate, w_up, w_down):
    return (jax.nn.silu(h @ w_gate) * (h @ w_up)) @ w_down


def moe_swiglu(h, router, w_gate, w_up, w_down):
    bsz, n, d = h.shape
    t = h.reshape(-1, d)
    logits = (t @ router).astype(jnp.float32)
    vals, idx = lax.top_k(logits, TOP_K)
    wts = jax.nn.softmax(vals, axis=-1)
    gates = jnp.sum(jax.nn.one_hot(idx, N_EXPERTS, dtype=jnp.float32) * wts[..., None], axis=1).astype(t.dtype)
    out = jnp.zeros_like(t)
    for e in range(N_EXPERTS):
        out = out + gates[:, e:e + 1] * swiglu(t, w_gate[e], w_up[e], w_down[e])
    return out.reshape(bsz, n, d)


def setup_inputs(seed: int = 0) -> dict:
    key = jax.random.key(seed)
    keys = iter(jax.random.split(key, 64))
    f32 = jnp.float32
    d = D_MODEL

    def nrm(shape, scale):
        return scale * jax.random.normal(next(keys), shape, f32)

    def gain(shape):
        return 1.0 + 0.05 * jax.random.normal(next(keys), shape, f32)

    dt0 = jnp.exp(jax.random.uniform(next(keys), (N_EVEN, 2, SSM_HEADS), f32, math.log(1e-3), math.log(1e-1)))
    a0 = jax.random.uniform(next(keys), (N_EVEN, 2, SSM_HEADS), f32, 1.0, 16.0)
    return {
        'x': nrm((BATCH, SEQ, d), 1.0),
        'c': nrm((BATCH, d), 1.0),
        'ctx': nrm((BATCH, CTX_LEN, d), 1.0),
        'c_ctx': nrm((d,), 1.0),
        'ada_w': nrm((DEPTH, d, 6 * d), d ** -0.5),
        'ada_b': nrm((DEPTH, 6 * d), 0.02),
        'mix_pre_g': gain((DEPTH, d)),
        'mix_post_g': gain((DEPTH, d)),
        'ffn_pre_g': gain((DEPTH, d)),
        'ffn_post_g': gain((DEPTH, d)),
        'ev_w_in': nrm((N_EVEN, d, EVEN_IN), d ** -0.5),
        'ev_hy_conv_w': nrm((N_EVEN, SHORT_CONV, 3 * HY_CH), SHORT_CONV ** -0.5),
        'ev_hy_conv_b': nrm((N_EVEN, 3 * HY_CH), 0.02),
        'ev_hy_filt_w1': nrm((N_EVEN, HY_EMB, HY_FILT_HID), HY_EMB ** -0.5),
        'ev_hy_filt_b1': nrm((N_EVEN, HY_FILT_HID), 0.1),
        'ev_hy_filt_w2': nrm((N_EVEN, HY_FILT_HID, HY_FILT_HID), HY_FILT_HID ** -0.5),
        'ev_hy_filt_b2': nrm((N_EVEN, HY_FILT_HID), 0.1),
        'ev_hy_filt_w3': nrm((N_EVEN, HY_FILT_HID, 2 * HY_CH), 0.1 * HY_FILT_HID ** -0.5),
        'ev_hy_freq': gain((N_EVEN, HY_FILT_HID)),
        'ev_hy_bias': nrm((N_EVEN, HY_CH), 0.5),
        'ev_ssm_conv_w': nrm((N_EVEN, SHORT_CONV, SSM_CONV_CH), SHORT_CONV ** -0.5),
        'ev_ssm_conv_b': nrm((N_EVEN, SSM_CONV_CH), 0.02),
        'ev_ssm_dt_bias': dt0 + jnp.log(-jnp.expm1(-dt0)),
        'ev_ssm_a_log': jnp.log(a0),
        'ev_ssm_d': gain((N_EVEN, SSM_HEADS)),
        'ev_ssm_norm_g': gain((N_EVEN, SSM_INNER)),
        'ev_w_out': nrm((N_EVEN, MIX_WIDTH, d), MIX_WIDTH ** -0.5),
        'ev_ffn_w_gate': nrm((N_EVEN, d, D_FF), d ** -0.5),
        'ev_ffn_w_up': nrm((N_EVEN, d, D_FF), d ** -0.5),
        'ev_ffn_w_down': nrm((N_EVEN, D_FF, d), D_FF ** -0.5),
        'od_w_in': nrm((N_ODD, d, ODD_IN), d ** -0.5),
        'od_mla_q_norm_g': gain((N_ODD, MLA_Q_LORA)),
        'od_mla_w_q_up': nrm((N_ODD, MLA_Q_LORA, MLA_HEADS * (MLA_NOPE + MLA_ROPE)), MLA_Q_LORA ** -0.5),
        'od_mla_kv_norm_g': gain((N_ODD, MLA_KV_LORA)),
        'od_mla_w_kv_up': nrm((N_ODD, MLA_KV_LORA, MLA_HEADS * (MLA_NOPE + MLA_V)), MLA_KV_LORA ** -0.5),
        'od_gqa_sink': nrm((N_ODD, GQA_HEADS), 0.5),
        'od_w_out': nrm((N_ODD, MIX_WIDTH, d), MIX_WIDTH ** -0.5),
        'od_router': nrm((N_ODD, d, N_EXPERTS), d ** -0.5),
        'od_moe_w_gate': nrm((N_ODD, N_EXPERTS, d, D_FF_EXPERT), d ** -0.5),
        'od_moe_w_up': nrm((N_ODD, N_EXPERTS, d, D_FF_EXPERT), d ** -0.5),
        'od_moe_w_down': nrm((N_ODD, N_EXPERTS, D_FF_EXPERT, d), D_FF_EXPERT ** -0.5),
    }


def reference(x, c, ctx, c_ctx, ada_w, ada_b, mix_pre_g, mix_post_g, ffn_pre_g, ffn_post_g,
              ev_w_in, ev_hy_conv_w, ev_hy_conv_b, ev_hy_filt_w1, ev_hy_filt_b1, ev_hy_filt_w2, ev_hy_filt_b2,
              ev_hy_filt_w3, ev_hy_freq, ev_hy_bias, ev_ssm_conv_w, ev_ssm_conv_b, ev_ssm_dt_bias, ev_ssm_a_log,
              ev_ssm_d, ev_ssm_norm_g, ev_w_out, ev_ffn_w_gate, ev_ffn_w_up, ev_ffn_w_down,
              od_w_in, od_mla_q_norm_g, od_mla_w_q_up, od_mla_kv_norm_g, od_mla_w_kv_up, od_gqa_sink, od_w_out,
              od_router, od_moe_w_gate, od_moe_w_up, od_moe_w_down):
    bsz, n, _ = x.shape
    rope_mla = axial_rope_tables(n, MLA_ROPE)
    rope_gqa = axial_rope_tables(n, HEAD_DIM)
    h_lat, h_ctx = x, ctx
    for i in range(DEPTH):
        j = i // 2
        last = i == DEPTH - 1
        sh1, sc1, g1, sh2, sc2, g2 = ada_params(c, ada_w[i], ada_b[i])
        csh1, csc1, cg1, csh2, csc2, cg2 = ada_params(c_ctx[None, :], ada_w[i], ada_b[i])
        a_lat = modulate(rmsnorm(h_lat, mix_pre_g[i]), sh1, sc1)
        a_ctx = modulate(rmsnorm(h_ctx, mix_pre_g[i]), csh1, csc1)
        if i % 2 == 0:
            ev = (ev_w_in[j], ev_hy_conv_w[j], ev_hy_conv_b[j], ev_hy_filt_w1[j], ev_hy_filt_b1[j], ev_hy_filt_w2[j],
                  ev_hy_filt_b2[j], ev_hy_filt_w3[j], ev_hy_freq[j], ev_hy_bias[j], ev_ssm_conv_w[j], ev_ssm_conv_b[j],
                  ev_ssm_dt_bias[j], ev_ssm_a_log[j], ev_ssm_d[j], ev_ssm_norm_g[j], ev_w_out[j])
            zero_state = jnp.zeros((bsz, SSM_HEADS, SSM_HEADDIM, SSM_STATE), jnp.float32)
            m_ctx, s_f, s_b = even_mix(a_ctx, zero_state, zero_state, *ev)
            m_lat, _, _ = even_mix(a_lat, s_f, s_b, *ev)
            ffn = functools.partial(swiglu, w_gate=ev_ffn_w_gate[j], w_up=ev_ffn_w_up[j], w_down=ev_ffn_w_down[j])
        else:
            m_lat, m_ctx = odd_mix(a_lat, a_ctx, not last, rope_mla, rope_gqa, od_w_in[j], od_mla_q_norm_g[j],
                                   od_mla_w_q_up[j], od_mla_kv_norm_g[j], od_mla_w_kv_up[j], od_gqa_sink[j],
                                   od_w_out[j])
            ffn = functools.partial(moe_swiglu, router=od_router[j], w_gate=od_moe_w_gate[j],
                                    w_up=od_moe_w_up[j], w_down=od_moe_w_down[j])
        h_lat = h_lat + g1 * rmsnorm(m_lat, mix_post_g[i])
        f_lat = ffn(modulate(rmsnorm(h_lat, ffn_pre_g[i]), sh2, sc2))
        h_lat = h_lat + g2 * rmsnorm(f_lat, ffn_post_g[i])
        if not last:
            h_ctx = h_ctx + cg1 * rmsnorm(m_ctx, mix_post_g[i])
            f_ctx = ffn(modulate(rmsnorm(h_ctx, ffn_pre_g[i]), csh2, csc2))
            h_ctx = h_ctx + cg2 * rmsnorm(f_ctx, ffn_post_g[i])
    return h_lat
```

```cpp
#include <hip/hip_runtime.h>
#include <cstdio>
#include <cstdint>

typedef unsigned short bf16_t;
typedef short bf16x8 __attribute__((ext_vector_type(8)));
typedef float f32x4 __attribute__((ext_vector_type(4)));
#define LAS __attribute__((address_space(3)))

constexpr int NB = 8, SEQ = 2048, DM = 1024, CTXL = 256;
constexpr int TL = NB * SEQ, TC = NB * CTXL, TT = TL + TC, NKEY = SEQ + CTXL;
constexpr int EVEN_IN = 3088, EVEN_PAD = 3328, ODD_PAD = 1280, DFF = 2816, DFE = 3584, NEXP = 8;
constexpr float EPS = 1e-6f;
constexpr float LOG2E = 1.4426950408889634f;
constexpr int NTHR = 512;
constexpr int LDS_BYTES = 147456;

constexpr size_t al256(size_t x) { return (x + 255) & ~(size_t)255; }
constexpr size_t WS_CTL = 0;
constexpr size_t WS_MOD = 65536;
constexpr size_t WS_ROPEM = WS_MOD + al256((size_t)2 * 9 * 6144 * 4);
constexpr size_t WS_ROPEG = WS_ROPEM + (size_t)2 * 2048 * 16 * 4;
constexpr size_t WS_SQ = WS_ROPEG + (size_t)2 * 2048 * 32 * 4;
constexpr size_t WS_SKV = WS_SQ + al256((size_t)TT * 4);
constexpr size_t WS_G8 = WS_SKV + al256((size_t)TT * 4);
constexpr size_t WS_HC = WS_G8 + (size_t)TL * 8 * 4;
constexpr size_t WS_W0 = WS_HC + (size_t)TC * DM * 4;
constexpr size_t W_IN0 = WS_W0;
constexpr size_t W_OUT0 = W_IN0 + (size_t)EVEN_PAD * 1024 * 2;
constexpr size_t W_GU0 = W_OUT0 + (size_t)1024 * 1024 * 2;
constexpr size_t W_DN0 = W_GU0 + (size_t)2 * DFF * 1024 * 2;
constexpr size_t W_IN1 = W_DN0 + (size_t)1024 * DFF * 2;
constexpr size_t W_QUP = W_IN1 + (size_t)ODD_PAD * 1024 * 2;
constexpr size_t W_KUP = W_QUP + (size_t)768 * 256 * 2;
constexpr size_t W_VUP = W_KUP + (size_t)512 * 256 * 2;
constexpr size_t W_OUT1 = W_VUP + (size_t)512 * 256 * 2;
constexpr size_t WS_ABUF = W_OUT1 + (size_t)1024 * 1024 * 2;
constexpr size_t WS_R1 = WS_ABUF + (size_t)TT * DM * 2;
constexpr size_t R1_BYTES = (size_t)34816 * DFE * 2;
constexpr size_t WS_R2 = WS_R1 + R1_BYTES;
constexpr size_t R2_BYTES = (size_t)NEXP * ((size_t)2 * DFE * 1024 + (size_t)1024 * DFE) * 2;
constexpr size_t WS_END = WS_R2 + R2_BYTES;
static_assert(WS_END <= (size_t)536000000, "workspace budget");
constexpr size_t L0_PROJ = WS_R1;
constexpr size_t L0_HMID = WS_R1;
constexpr size_t L0_XBC = L0_PROJ + (size_t)TT * EVEN_PAD * 2;
constexpr size_t L0_U = L0_XBC + (size_t)TT * 1024 * 2;
constexpr size_t L0_X0 = L0_U + (size_t)TT * 512 * 2;
constexpr size_t L0_DT = L0_X0 + (size_t)TT * 512 * 2;
constexpr size_t L0_YF = L0_DT + (size_t)TT * 16 * 4;
constexpr size_t L0_YB = L0_YF + (size_t)TT * 512 * 2;
static_assert(L0_YB + (size_t)TT * 512 * 2 <= WS_R1 + R1_BYTES, "R1 layer 0");
constexpr size_t L0_MBUF = WS_R2;
constexpr size_t L0_KL = L0_MBUF + (size_t)TT * DM * 4;
constexpr size_t L0_KC = L0_KL + (size_t)4096 * 512 * 4;
static_assert(L0_KC + (size_t)512 * 512 * 4 <= WS_R2 + R2_BYTES, "R2 layer 0");
constexpr size_t L1_HMID = WS_R1;
constexpr size_t L1_PROJ = WS_R1;
constexpr size_t L1_QM = L1_PROJ + (size_t)TT * ODD_PAD * 2;
constexpr size_t L1_KM = L1_QM + (size_t)TL * 768 * 2;
constexpr size_t L1_VT = L1_KM + (size_t)NB * NKEY * 768 * 2;
constexpr size_t L1_QG = L1_VT + (size_t)NB * 512 * NKEY * 2;
constexpr size_t L1_KG = L1_QG + (size_t)TL * 512 * 2;
constexpr size_t L1_VGT = L1_KG + (size_t)NB * NKEY * 128 * 2;
constexpr size_t L1_MBUF = L1_VGT + (size_t)NB * 128 * NKEY * 2;
static_assert(L1_MBUF + (size_t)TL * DM * 4 <= WS_R1 + R1_BYTES, "R1 layer 1");
static_assert(L1_HMID + (size_t)TL * DFE * 2 <= L1_MBUF, "dense hmid vs mbuf1");
constexpr size_t WM_GU = WS_R2;
constexpr size_t WM_DN = WM_GU + (size_t)NEXP * 2 * DFE * 1024 * 2;

__device__ __forceinline__ bf16_t f2bf(float f) { unsigned u = __float_as_uint(f); u += 0x7FFFu + ((u >> 16) & 1u); return (bf16_t)(u >> 16); }
__device__ __forceinline__ float bf2f(bf16_t b) { return __uint_as_float(((unsigned)b) << 16); }
__device__ __forceinline__ unsigned pack2(float lo, float hi) { return (unsigned)f2bf(lo) | ((unsigned)f2bf(hi) << 16); }
__device__ __forceinline__ float bflo(unsigned u) { return __uint_as_float(u << 16); }
__device__ __forceinline__ float bfhi(unsigned u) { return __uint_as_float(u & 0xFFFF0000u); }
__device__ __forceinline__ float wave_sum(float v) {
#pragma unroll
    for (int o = 32; o > 0; o >>= 1) v += __shfl_xor(v, o);
    return v;
}
__device__ __forceinline__ float silu_f(float x) { return x / (1.f + __expf(-x)); }
__device__ __forceinline__ float softplus_f(float x) { return x > 20.f ? x : log1pf(expf(x)); }

namespace pg8 {
constexpr int BM = 256, BK = 64, HALF = 128, HTB = HALF * BK * 2, STAGE_BYTES = 8 * HTB, NXCD = 8, WGM = 8;
__host__ __device__ __forceinline__ int lds_byte(int r, int c) { const int st = (r >> 4) * 2 + (c >> 5), rr = r & 15, cc = c & 31, ob = rr * 64 + cc * 2; return st * 1024 + (ob ^ (((ob >> 9) & 1) << 5)); }
__host__ __device__ __forceinline__ void stage_rc(int b, int& R, int& C) { const int st = b / 1024, sb = b % 1024, swz = sb ^ (((sb >> 9) & 1) << 5); R = (st >> 1) * 16 + swz / 64; C = (st & 1) * 32 + (swz % 64) / 2; }

struct Unit { int pm, pn; };
struct Gemm { const bf16_t* A; const bf16_t* Bt; int M, N, K, lda, ldb; };

struct StaticOrder {
    int nM, nN, nwg, G, c;
    __device__ void init(int M, int N, int G_, int c_) { nM = M / BM; nN = N / BM; nwg = nM * nN; G = G_; c = c_; }
    __device__ bool next(int i, Unit& u) const {
        const long L = (long)i * G + c; if (L >= nwg) return false;
        int wgid = (int)L; { const int q = nwg / NXCD, r = nwg % NXCD, xcd = wgid % NXCD, off = wgid / NXCD; wgid = (xcd < r ? xcd * (q + 1) : r * (q + 1) + (xcd - r) * q) + off; }
        const int nig = WGM * nN, gid = wgid / nig, fm = gid * WGM, gsz = (nM - fm) < WGM ? (nM - fm) : WGM;
        u.pm = fm + ((wgid % nig) % gsz); u.pn = (wgid % nig) / gsz; return true;
    }
};

template <class Epi, class Sched>
__device__ __forceinline__ void gemm_phase(LAS unsigned char* lds, const Gemm g, const Sched& S, const Epi& E) {
    const int tid = threadIdx.x, wid = __builtin_amdgcn_readfirstlane(tid >> 6), lane = tid & 63, wr = wid >> 2, wc = wid & 3, fr = lane & 15, fq = lane >> 4;
    int Kop = g.K; asm volatile("" : "+s"(Kop));
    const int K = Kop, nt = K / BK;
    unsigned voffA[2], voffB[2];
#pragma unroll
    for (int i = 0; i < 2; ++i) { int R, C; stage_rc(tid * 16 + i * 8192, R, C); voffA[i] = (unsigned)(R * g.lda + C) * 2u; voffB[i] = (unsigned)(R * g.ldb + C) * 2u; }
    const size_t kstep = (size_t)(BK * 2);
    const size_t hstepA = (size_t)HALF * g.lda * 2, hstepB = (size_t)HALF * g.ldb * 2;
    const size_t tstepA = 2 * hstepA, tstepB = 2 * hstepB;
    const unsigned ldsw = (unsigned)wid * 1024u;
    const int aoff = lds_byte(wr * 64 + fr, fq * 8), boff = lds_byte(wc * 32 + fr, fq * 8);
#define PG8_SA(b, h) (((b) * 2 + (h)) * HTB)
#define PG8_SB(b, h) ((4 + (b) * 2 + (h)) * HTB)
#define PG8_STAGE(bufoff, gbase, voff) do { _Pragma("unroll") for (int _i = 0; _i < 2; ++_i) \
        __builtin_amdgcn_global_load_lds((const unsigned*)((const char*)(gbase) + (voff)[_i]), (LAS unsigned*)(lds + (bufoff) + ldsw + _i * 8192), 16, 0, 0); } while (0)
#define PG8_LDA(dst, b, h) do { _Pragma("unroll") for (int m = 0; m < 4; ++m) _Pragma("unroll") for (int k = 0; k < 2; ++k) dst[m][k] = *(const LAS bf16x8*)(lds + PG8_SA(b, h) + aoff + m * 2048 + k * 1024); } while (0)
#define PG8_LDB(dst, b, h) do { _Pragma("unroll") for (int n = 0; n < 2; ++n) _Pragma("unroll") for (int k = 0; k < 2; ++k) dst[n][k] = *(const LAS bf16x8*)(lds + PG8_SB(b, h) + boff + n * 2048 + k * 1024); } while (0)
#define PG8_MMA(ai, bj, At, Bt) do { __builtin_amdgcn_s_setprio(1); _Pragma("unroll") for (int m = 0; m < 4; ++m) _Pragma("unroll") for (int n = 0; n < 2; ++n) _Pragma("unroll") for (int k = 0; k < 2; ++k) \
        acc[ai][bj][m][n] = __builtin_amdgcn_mfma_f32_16x16x32_bf16(Bt[n][k], At[m][k], acc[ai][bj][m][n], 0, 0, 0); __builtin_amdgcn_s_setprio(0); } while (0)
#define PG8_WAIT_V(n) asm volatile("s_waitcnt vmcnt(" #n ")" ::: "memory")
#define PG8_WAIT_L(n) asm volatile("s_waitcnt lgkmcnt(" #n ")" ::: "memory")
#define PG8_BAR __builtin_amdgcn_s_barrier()
#define PG8_SCHED __builtin_amdgcn_sched_barrier(0)
    Unit cur, nxt; int ui = 0;
    if (!S.next(0, cur)) return;
    f32x4 acc[2][2][4][2];
#pragma unroll
    for (int a = 0; a < 2; ++a)
#pragma unroll
        for (int b = 0; b < 2; ++b)
#pragma unroll
            for (int m = 0; m < 4; ++m)
#pragma unroll
                for (int n = 0; n < 2; ++n) acc[a][b][m][n] = (f32x4){0.f, 0.f, 0.f, 0.f};
    bf16x8 At[4][2], B0[2][2], B1[2][2];
    const char* cA = (const char*)g.A + (size_t)cur.pm * tstepA; const char* cB = (const char*)g.Bt + (size_t)cur.pn * tstepB;
    PG8_STAGE(PG8_SB(0, 0), cB, voffB); PG8_STAGE(PG8_SA(0, 0), cA, voffA); PG8_STAGE(PG8_SB(0, 1), cB + hstepB, voffB); PG8_STAGE(PG8_SA(0, 1), cA + hstepA, voffA);
    if (wr == 1) PG8_BAR;
    PG8_WAIT_V(4); PG8_BAR;
    PG8_STAGE(PG8_SB(1, 0), cB + kstep, voffB); PG8_STAGE(PG8_SA(1, 0), cA + kstep, voffA); PG8_STAGE(PG8_SB(1, 1), cB + hstepB + kstep, voffB);
    PG8_WAIT_V(6); PG8_BAR;
    for (;;) {
        const bool has_next = S.next(ui + 1, nxt);
        const char* nA = has_next ? (const char*)g.A + (size_t)nxt.pm * tstepA : cA; const char* nB = has_next ? (const char*)g.Bt + (size_t)nxt.pn * tstepB : cB;
        for (int t = 0; t < nt; t += 2) {
            const bool last = (t == nt - 2);
            const char* a1 = cA + (size_t)(t + 1) * kstep;
            const char* a2 = last ? nA : cA + (size_t)(t + 2) * kstep; const char* b2 = last ? nB : cB + (size_t)(t + 2) * kstep;
            const char* a3 = a2 + kstep; const char* b3 = b2 + kstep;
            PG8_LDB(B0, 0, 0); PG8_SCHED; PG8_LDA(At, 0, 0); PG8_STAGE(PG8_SA(1, 1), a1 + hstepA, voffA);
            PG8_WAIT_L(8); PG8_BAR; PG8_WAIT_L(0); PG8_MMA(0, 0, At, B0); PG8_BAR; PG8_SCHED;
            PG8_LDB(B1, 0, 1); PG8_STAGE(PG8_SB(0, 0), b2, voffB);
            PG8_BAR; PG8_WAIT_L(0); PG8_MMA(0, 1, At, B1); PG8_BAR;
            PG8_LDA(At, 0, 1); PG8_STAGE(PG8_SA(0, 0), a2, voffA);
            PG8_BAR; PG8_WAIT_L(0); PG8_MMA(1, 0, At, B0); PG8_BAR; PG8_SCHED;
            PG8_STAGE(PG8_SB(0, 1), b2 + hstepB, voffB);
            PG8_WAIT_V(6); PG8_BAR; PG8_MMA(1, 1, At, B1); PG8_BAR;
            PG8_LDB(B0, 1, 0); PG8_SCHED; PG8_LDA(At, 1, 0); PG8_STAGE(PG8_SA(0, 1), a2 + hstepA, voffA);
            PG8_WAIT_L(8); PG8_BAR; PG8_WAIT_L(0); PG8_MMA(0, 0, At, B0); PG8_BAR; PG8_SCHED;
            PG8_LDB(B1, 1, 1); PG8_STAGE(PG8_SB(1, 0), b3, voffB);
            PG8_BAR; PG8_WAIT_L(0); PG8_MMA(0, 1, At, B1); PG8_BAR;
            PG8_LDA(At, 1, 1); PG8_STAGE(PG8_SA(1, 0), a3, voffA);
            PG8_BAR; PG8_WAIT_L(0); PG8_MMA(1, 0, At, B0); PG8_BAR; PG8_SCHED;
            PG8_STAGE(PG8_SB(1, 1), b3 + hstepB, voffB);
            PG8_WAIT_V(6); PG8_BAR; PG8_MMA(1, 1, At, B1); PG8_BAR;
        }
        E(acc, cur, wr, wc, fr, fq);
        if (!has_next) break;
#pragma unroll
        for (int a = 0; a < 2; ++a)
#pragma unroll
            for (int b = 0; b < 2; ++b)
#pragma unroll
                for (int m = 0; m < 4; ++m)
#pragma unroll
                    for (int n = 0; n < 2; ++n) acc[a][b][m][n] = (f32x4){0.f, 0.f, 0.f, 0.f};
        cur = nxt; cA = nA; cB = nB; ++ui;
    }
    PG8_WAIT_V(0);
    if (wr == 0) PG8_BAR;
    PG8_BAR;
#undef PG8_SA
#undef PG8_SB
#undef PG8_STAGE
#undef PG8_LDA
#undef PG8_LDB
#undef PG8_MMA
#undef PG8_WAIT_V
#undef PG8_WAIT_L
#undef PG8_BAR
#undef PG8_SCHED
}

#define EPI_LOOP_BEGIN \
    _Pragma("unroll") for (int ai = 0; ai < 2; ++ai) _Pragma("unroll") for (int m = 0; m < 4; ++m) { asm volatile("" ::: "memory"); const int row = u.pm * BM + ai * HALF + wr * 64 + m * 16 + fr; \
    _Pragma("unroll") for (int bj = 0; bj < 2; ++bj) { const int cg = u.pn * BM + bj * HALF + wc * 32;
#define EPI_LOOP_END } }

struct EpiBf16Plain {
    bf16_t* O; int ldo;
    __device__ __forceinline__ void operator()(const f32x4 (&acc)[2][2][4][2], const Unit& u, int wr, int wc, int fr, int fq) const {
        EPI_LOOP_BEGIN
#pragma unroll
            for (int n = 0; n < 2; ++n) { const f32x4 v = acc[ai][bj][m][n]; uint2 p; p.x = pack2(v[0], v[1]); p.y = pack2(v[2], v[3]);
                *(uint2*)(O + (size_t)row * ldo + cg + 16 * n + 4 * fq) = p; }
        EPI_LOOP_END
    }
};
struct EpiF32Plain {
    float* C; int ldc;
    __device__ __forceinline__ void operator()(const f32x4 (&acc)[2][2][4][2], const Unit& u, int wr, int wc, int fr, int fq) const {
        EPI_LOOP_BEGIN
#pragma unroll
            for (int n = 0; n < 2; ++n) *(f32x4*)(C + (size_t)row * ldc + cg + 16 * n + 4 * fq) = acc[ai][bj][m][n];
        EPI_LOOP_END
    }
};
struct EpiSwiglu {
    bf16_t* O; int ldo;
    __device__ __forceinline__ void operator()(const f32x4 (&acc)[2][2][4][2], const Unit& u, int wr, int wc, int fr, int fq) const {
        EPI_LOOP_BEGIN
            const f32x4 gt = acc[ai][bj][m][0], up = acc[ai][bj][m][1]; const int h = u.pn * 128 + bj * 64 + wc * 16 + 4 * fq;
            uint2 p; p.x = pack2(silu_f(gt[0]) * up[0], silu_f(gt[1]) * up[1]); p.y = pack2(silu_f(gt[2]) * up[2], silu_f(gt[3]) * up[3]);
            *(uint2*)(O + (size_t)row * ldo + h) = p;
        EPI_LOOP_END
    }
};
struct EpiMoeAcc {
    float* C; const float* G8; int e; int first;
    __device__ __forceinline__ void operator()(const f32x4 (&acc)[2][2][4][2], const Unit& u, int wr, int wc, int fr, int fq) const {
        EPI_LOOP_BEGIN
            const float gw = G8[(size_t)row * 8 + e];
#pragma unroll
            for (int n = 0; n < 2; ++n) { float* p = C + (size_t)row * 1024 + cg + 16 * n + 4 * fq; f32x4 v = acc[ai][bj][m][n] * gw; if (!first) v += *(const f32x4*)p; *(f32x4*)p = v; }
        EPI_LOOP_END
    }
};
struct EpiQ {
    bf16_t* QM; const float* SQ; const float* cosT; const float* sinT; float qscale;
    __device__ __forceinline__ void operator()(const f32x4 (&acc)[2][2][4][2], const Unit& u, int wr, int wc, int fr, int fq) const {
        EPI_LOOP_BEGIN
            const float s = SQ[row] * qscale; f32x4 v0 = acc[ai][bj][m][0] * s, v1 = acc[ai][bj][m][1] * s;
            if ((cg % 96) == 64) { const int pos = row & (SEQ - 1); const f32x4 c = *(const f32x4*)(cosT + pos * 16 + 4 * fq), sn = *(const f32x4*)(sinT + pos * 16 + 4 * fq);
                const f32x4 o0 = v0 * c - v1 * sn, o1 = v1 * c + v0 * sn; v0 = o0; v1 = o1; }
            uint2 p; p.x = pack2(v0[0], v0[1]); p.y = pack2(v0[2], v0[3]); *(uint2*)(QM + (size_t)row * 768 + cg + 4 * fq) = p;
            p.x = pack2(v1[0], v1[1]); p.y = pack2(v1[2], v1[3]); *(uint2*)(QM + (size_t)row * 768 + cg + 16 + 4 * fq) = p;
        EPI_LOOP_END
    }
};
struct EpiK {
    bf16_t* KM; const float* SKV;
    __device__ __forceinline__ void operator()(const f32x4 (&acc)[2][2][4][2], const Unit& u, int wr, int wc, int fr, int fq) const {
        EPI_LOOP_BEGIN
            const float s = SKV[row]; const int b = row < TL ? (row >> 11) : ((row - TL) >> 8), key = row < TL ? CTXL + (row & (SEQ - 1)) : ((row - TL) & (CTXL - 1));
            bf16_t* base = KM + ((size_t)b * NKEY + key) * 768;
#pragma unroll
            for (int n = 0; n < 2; ++n) { const int c = cg + 16 * n + 4 * fq, h = c >> 6, d = c & 63; const f32x4 v = acc[ai][bj][m][n] * s;
                uint2 p; p.x = pack2(v[0], v[1]); p.y = pack2(v[2], v[3]); *(uint2*)(base + h * 96 + d) = p; }
        EPI_LOOP_END
    }
};
struct EpiVT {
    bf16_t* VT; const float* SKV;
    __device__ __forceinline__ void operator()(const f32x4 (&acc)[2][2][4][2], const Unit& u, int wr, int wc, int fr, int fq) const {
        EPI_LOOP_BEGIN
#pragma unroll
            for (int n = 0; n < 2; ++n) { const int tok = cg + 16 * n + 4 * fq; const f32x4 s = *(const f32x4*)(SKV + tok); const f32x4 v = acc[ai][bj][m][n] * s;
                const int b = tok < TL ? (tok >> 11) : ((tok - TL) >> 8), key = tok < TL ? CTXL + (tok & (SEQ - 1)) : ((tok - TL) & (CTXL - 1));
                uint2 p; p.x = pack2(v[0], v[1]); p.y = pack2(v[2], v[3]); *(uint2*)(VT + ((size_t)b * 512 + row) * NKEY + key) = p; }
        EPI_LOOP_END
    }
};
}

struct Args { const float* in[41]; float* out; unsigned char* ws; int ph_lo, ph_hi, ex, pad; };
enum { I_X = 0, I_C, I_CTX, I_CCTX, I_ADAW, I_ADAB, I_MIXPRE, I_MIXPOST, I_FFNPRE, I_FFNPOST, I_EVWIN, I_HYCW, I_HYCB, I_FW1, I_FB1, I_FW2, I_FB2, I_FW3, I_FREQ, I_HYBIAS,
       I_SCW, I_SCB, I_DTB, I_ALOG, I_SSMD, I_SSMNG, I_EVWOUT, I_FFNG, I_FFNU, I_FFND, I_ODWIN, I_QNG, I_QUP, I_KVNG, I_KVUP, I_SINK, I_ODWOUT, I_ROUTER, I_MOEG, I_MOEU, I_MOED };

struct Fr {
    const float* const* in; float* out; unsigned char* ws; unsigned char* lds; int tid, lane, wave, G, bid;
    template <class T> __device__ __forceinline__ T* w(size_t off) const { return (T*)(ws + off); }
};

__device__ __forceinline__ int colmap(int mode, int r, int nsrc, int& which) {
    which = 0;
    if (mode == 0) return r < nsrc ? r : -1;
    if (mode == 1) { const int tile = r >> 8, rho = r & 255, bj = rho >> 7, wc = (rho >> 5) & 3, n = (rho >> 4) & 1, x = rho & 15; which = n; return 128 * tile + 64 * bj + 16 * wc + x; }
    const int h = r >> 6, d = r & 63;
    return h * 128 + d + (mode == 3 ? 64 : 0);
}
__device__ void cvt_job(const Fr& F, const float* srcA, const float* srcB, const float* kscale, bf16_t* dst, int nrows, int kdst, int ksrc, int ldsrc, int nsrc, int mode) {
    float* tile = (float*)F.lds;
    const int nrt = nrows / 64, ntiles = nrt * (kdst / 64);
    for (int t = F.bid; t < ntiles; t += F.G) {
        const int r0 = (t % nrt) * 64, k0 = (t / nrt) * 64;
        const int rr = F.tid & 63; int which; const int col = colmap(mode, r0 + rr, nsrc, which); const float* src = which ? srcB : srcA;
#pragma unroll
        for (int p = 0; p < 8; ++p) { const int kl = p * 8 + (F.tid >> 6), k = k0 + kl; float v = 0.f;
            if (col >= 0 && k < ksrc) { v = src[(size_t)k * ldsrc + col]; if (kscale) v *= kscale[k]; }
            tile[kl * 65 + rr] = v; }
        __syncthreads();
#pragma unroll
        for (int q = 0; q < 2; ++q) { const int item = F.tid + 512 * q, r2 = item >> 4, kq = item & 15;
            uint2 p; p.x = pack2(tile[(kq * 4 + 0) * 65 + r2], tile[(kq * 4 + 1) * 65 + r2]); p.y = pack2(tile[(kq * 4 + 2) * 65 + r2], tile[(kq * 4 + 3) * 65 + r2]);
            *(uint2*)(dst + (size_t)(r0 + r2) * kdst + k0 + kq * 4) = p; }
        __syncthreads();
    }
}

__device__ void ph_ada(const Fr& F) {
    if (F.bid * NTHR >= 2 * 6144) return;
    float* sc = (float*)F.lds;
    for (int i = F.tid; i < 9 * 1024; i += NTHR) { const int r = i >> 10, k = i & 1023; const float v = r < 8 ? F.in[I_C][r * 1024 + k] : F.in[I_CCTX][k]; sc[i] = silu_f(v); }
    __syncthreads();
    float* MOD = F.w<float>(WS_MOD);
    for (int j = F.bid * NTHR + F.tid; j < 2 * 6144; j += F.G * NTHR) {
        const int l = j / 6144, jj = j % 6144; const float* wp = F.in[I_ADAW] + (size_t)l * 1024 * 6144 + jj;
        float acc[9];
#pragma unroll
        for (int r = 0; r < 9; ++r) acc[r] = 0.f;
        for (int k = 0; k < 1024; ++k) { const float wv = wp[(size_t)k * 6144];
#pragma unroll
            for (int r = 0; r < 9; ++r) acc[r] += sc[r * 1024 + k] * wv; }
        const float bb = F.in[I_ADAB][l * 6144 + jj];
#pragma unroll
        for (int r = 0; r < 9; ++r) MOD[(size_t)(l * 9 + r) * 6144 + jj] = acc[r] + bb;
    }
    __syncthreads();
}
__device__ void ph_filters(const Fr& F) {
    float* z = (float*)F.lds; float* h1 = z + 64; float* h2 = h1 + 64;
    const float* w1 = F.in[I_FW1]; const float* b1 = F.in[I_FB1]; const float* w2 = F.in[I_FW2]; const float* b2 = F.in[I_FB2]; const float* w3 = F.in[I_FW3]; const float* fq = F.in[I_FREQ]; const float* hb = F.in[I_HYBIAS];
    for (int item = F.bid; item < SEQ + CTXL; item += F.G) {
        const int n = item < SEQ ? SEQ : CTXL, pos = item < SEQ ? item : item - SEQ;
        const float fpos = (float)pos, t = fpos / (float)(n - 1), omega = (6.283185307179586f * fpos) / (float)n;
        if (F.tid < 33) { float v;
            if (F.tid == 0) v = t; else { const int i = (F.tid - 1) & 15; const float band = 1e-4f + (float)i * ((15.f - 1e-4f) / 15.f); const float a = omega * band; v = (F.tid <= 16) ? cosf(a) : -sinf(a); }
            z[F.tid] = v; }
        __syncthreads();
        if (F.tid < 64) { float a = b1[F.tid]; for (int i = 0; i < 33; ++i) a += z[i] * w1[i * 64 + F.tid]; h1[F.tid] = sinf(fq[F.tid] * a); }
        __syncthreads();
        if (F.tid < 64) { float a = b2[F.tid]; for (int i = 0; i < 64; ++i) a += h1[i] * w2[i * 64 + F.tid]; h2[F.tid] = sinf(fq[F.tid] * a); }
        __syncthreads();
        float* Kd = (n == SEQ) ? F.w<float>(L0_KL) : F.w<float>(L0_KC);
        for (int o = F.tid; o < 1024; o += NTHR) { float a = 0.f; for (int i = 0; i < 64; ++i) a += h2[i] * w3[i * 1024 + o];
            const int dir = o >> 9, c = o & 511; const float a0 = -3.0701134573253945f, b0 = -15.350567286626973f; const float delta = fabsf(a0 + (float)c * ((b0 - a0) / 511.f));
            const float val = a * expf(-t * delta);
            if (dir == 0) Kd[(size_t)(n - 1 + pos) * 512 + c] = val + (pos == 0 ? hb[c] : 0.f);
            else if (pos > 0) Kd[(size_t)(n - 1 - pos) * 512 + c] = val; }
        __syncthreads();
    }
}
__device__ void ph_rope_tables(const Fr& F) {
    float* cm = F.w<float>(WS_ROPEM); float* sm = cm + 2048 * 16; float* cgq = F.w<float>(WS_ROPEG); float* sg = cgq + 2048 * 32;
    for (int idx = F.bid * NTHR + F.tid; idx < 2048 * 16; idx += F.G * NTHR) { const int pos = idx >> 4, i = idx & 15; const float inv = powf(10000.f, -(float)(i & 7) / 8.f);
        const float p = (i < 8) ? (float)(pos >> 6) : (float)(pos & 63); const float ang = p * inv; cm[idx] = cosf(ang); sm[idx] = sinf(ang); }
    for (int idx = F.bid * NTHR + F.tid; idx < 2048 * 32; idx += F.G * NTHR) { const int pos = idx >> 5, i = idx & 31; const float inv = powf(10000.f, -(float)(i & 15) / 16.f);
        const float p = (i < 16) ? (float)(pos >> 6) : (float)(pos & 63); const float ang = p * inv; cgq[idx] = cosf(ang); sg[idx] = sinf(ang); }
}

__device__ __forceinline__ void store_bf16x4(bf16_t* p, float4 v) { uint2 q; q.x = pack2(v.x, v.y); q.y = pack2(v.z, v.w); *(uint2*)p = q; }
__device__ __forceinline__ float4 ld4(const float* p) { return *(const float4*)p; }
__device__ __forceinline__ float sumsq4(const float4 (&v)[4]) { float s = 0.f;
#pragma unroll
    for (int i = 0; i < 4; ++i) s += v[i].x * v[i].x + v[i].y * v[i].y + v[i].z * v[i].z + v[i].w * v[i].w;
    return s; }

__device__ void ph_norm0(const Fr& F) {
    const float* g = F.in[I_MIXPRE]; const float* MOD = F.w<float>(WS_MOD); bf16_t* A = F.w<bf16_t>(WS_ABUF);
    for (int row = F.bid * 8 + F.wave; row < TT; row += F.G * 8) {
        const float* src = row < TL ? F.in[I_X] + (size_t)row * 1024 : F.in[I_CTX] + (size_t)(row - TL) * 1024; const int mr = row < TL ? (row >> 11) : 8;
        float4 v[4];
#pragma unroll
        for (int i = 0; i < 4; ++i) v[i] = ld4(src + 4 * (F.lane + 64 * i));
        const float r = rsqrtf(wave_sum(sumsq4(v)) * (1.f / 1024.f) + EPS);
#pragma unroll
        for (int i = 0; i < 4; ++i) { const int c = 4 * (F.lane + 64 * i); const float4 gg = ld4(g + c), sh = ld4(MOD + (size_t)mr * 6144 + c), sc = ld4(MOD + (size_t)mr * 6144 + 1024 + c);
            float4 o; o.x = v[i].x * r * gg.x * (1.f + sc.x) + sh.x; o.y = v[i].y * r * gg.y * (1.f + sc.y) + sh.y; o.z = v[i].z * r * gg.z * (1.f + sc.z) + sh.z; o.w = v[i].w * r * gg.w * (1.f + sc.w) + sh.w;
            store_bf16x4(A + (size_t)row * 1024 + c, o); }
    }
}
template <int MODE>
__device__ void ph_thin(const Fr& F, const float* msrc, int nrows, const float* hs_lat, const float* hs_ctx, float* hd_lat, float* hd_ctx,
                        const float* postg, const float* MODg, int gate_off, const float* preg, const float* MODn, int sh_off, int sc_off) {
    bf16_t* A = F.w<bf16_t>(WS_ABUF);
    float* rt = (float*)F.lds;
    if (MODE == 1) { for (int i = F.tid; i < 1024 * 8; i += NTHR) rt[i] = F.in[I_ROUTER][i]; __syncthreads(); }
    for (int row = F.bid * 8 + F.wave; row < nrows; row += F.G * 8) {
        const int mr = row < TL ? (row >> 11) : 8;
        const float* hs = row < TL ? hs_lat + (size_t)row * 1024 : hs_ctx + (size_t)(row - TL) * 1024; float* hd = row < TL ? hd_lat + (size_t)row * 1024 : hd_ctx + (size_t)(row - TL) * 1024;
        float4 m[4], h[4];
#pragma unroll
        for (int i = 0; i < 4; ++i) { m[i] = ld4(msrc + (size_t)row * 1024 + 4 * (F.lane + 64 * i)); h[i] = ld4(hs + 4 * (F.lane + 64 * i)); }
        const float r = rsqrtf(wave_sum(sumsq4(m)) * (1.f / 1024.f) + EPS);
#pragma unroll
        for (int i = 0; i < 4; ++i) { const int c = 4 * (F.lane + 64 * i); const float4 pg = ld4(postg + c), gt = ld4(MODg + (size_t)mr * 6144 + gate_off + c);
            h[i].x += gt.x * (m[i].x * r * pg.x); h[i].y += gt.y * (m[i].y * r * pg.y); h[i].z += gt.z * (m[i].z * r * pg.z); h[i].w += gt.w * (m[i].w * r * pg.w);
            *(float4*)(hd + c) = h[i]; }
        if (MODE == 2) continue;
        const float r2 = rsqrtf(wave_sum(sumsq4(h)) * (1.f / 1024.f) + EPS);
        float lg[8];
#pragma unroll
        for (int e = 0; e < 8; ++e) lg[e] = 0.f;
#pragma unroll
        for (int i = 0; i < 4; ++i) { const int c = 4 * (F.lane + 64 * i); const float4 gg = ld4(preg + c), sh = ld4(MODn + (size_t)mr * 6144 + sh_off + c), sc = ld4(MODn + (size_t)mr * 6144 + sc_off + c);
            float4 o; o.x = h[i].x * r2 * gg.x * (1.f + sc.x) + sh.x; o.y = h[i].y * r2 * gg.y * (1.f + sc.y) + sh.y; o.z = h[i].z * r2 * gg.z * (1.f + sc.z) + sh.z; o.w = h[i].w * r2 * gg.w * (1.f + sc.w) + sh.w;
            store_bf16x4(A + (size_t)row * 1024 + c, o);
            if (MODE == 1) {
#pragma unroll
                for (int e = 0; e < 8; ++e) lg[e] += o.x * rt[(c + 0) * 8 + e] + o.y * rt[(c + 1) * 8 + e] + o.z * rt[(c + 2) * 8 + e] + o.w * rt[(c + 3) * 8 + e]; } }
        if (MODE == 1) {
#pragma unroll
            for (int e = 0; e < 8; ++e) lg[e] = wave_sum(lg[e]);
            int i1 = 0; float v1 = lg[0];
#pragma unroll
            for (int e = 1; e < 8; ++e) if (lg[e] > v1) { v1 = lg[e]; i1 = e; }
            int i2 = -1; float v2 = -3.0e38f;
#pragma unroll
            for (int e = 0; e < 8; ++e) if (e != i1 && lg[e] > v2) { v2 = lg[e]; i2 = e; }
            const float w1 = 1.f / (1.f + expf(v2 - v1)), w2 = 1.f - w1;
            if (F.lane < 8) F.w<float>(WS_G8)[(size_t)row * 8 + F.lane] = (F.lane == i1) ? w1 : ((F.lane == i2) ? w2 : 0.f);
        }
    }
    if (MODE == 1) __syncthreads();
}

__device__ __forceinline__ void ld8bf(const bf16_t* p, float (&o)[8]) { const uint4 q = *(const uint4*)p; o[0] = bflo(q.x); o[1] = bfhi(q.x); o[2] = bflo(q.y); o[3] = bfhi(q.y); o[4] = bflo(q.z); o[5] = bfhi(q.z); o[6] = bflo(q.w); o[7] = bfhi(q.w); }
__device__ __forceinline__ void st8bf(bf16_t* p, const float (&v)[8]) { uint4 q; q.x = pack2(v[0], v[1]); q.y = pack2(v[2], v[3]); q.z = pack2(v[4], v[5]); q.w = pack2(v[6], v[7]); *(uint4*)p = q; }
__device__ __forceinline__ void conv8(const bf16_t* prow, bool hasp, bool hasn, int pc, const float* w, const float* b, int wc, int wld, float (&o)[8]) {
    float xm[8], x0[8], xp[8]; ld8bf(prow + pc, x0);
    if (hasp) ld8bf(prow - EVEN_PAD + pc, xm); else {
#pragma unroll
        for (int j = 0; j < 8; ++j) xm[j] = 0.f; }
    if (hasn) ld8bf(prow + EVEN_PAD + pc, xp); else {
#pragma unroll
        for (int j = 0; j < 8; ++j) xp[j] = 0.f; }
#pragma unroll
    for (int j = 0; j < 8; ++j) o[j] = w[wc + j] * xm[j] + w[wld + wc + j] * x0[j] + w[2 * wld + wc + j] * xp[j] + b[wc + j];
}
__device__ void ph_convpass(const Fr& F) {
    const bf16_t* PROJ = F.w<bf16_t>(L0_PROJ); bf16_t* U = F.w<bf16_t>(L0_U); bf16_t* X0 = F.w<bf16_t>(L0_X0); bf16_t* XBC = F.w<bf16_t>(L0_XBC); float* DT = F.w<float>(L0_DT);
    const float* hw = F.in[I_HYCW]; const float* hb = F.in[I_HYCB]; const float* sw = F.in[I_SCW]; const float* sb = F.in[I_SCB]; const float* dtb = F.in[I_DTB];
    for (int row = F.bid * 8 + F.wave; row < TT; row += F.G * 8) {
        const int t = row < TL ? (row & (SEQ - 1)) : ((row - TL) & (CTXL - 1)), n = row < TL ? SEQ : CTXL; const bool hasp = t > 0, hasn = t < n - 1;
        const bf16_t* prow = PROJ + (size_t)row * EVEN_PAD; const int c = F.lane * 8;
        float a0[8], a1[8], a2[8];
        conv8(prow, hasp, hasn, c, hw, hb, c, 1536, a0); conv8(prow, hasp, hasn, 512 + c, hw, hb, 512 + c, 1536, a1); conv8(prow, hasp, hasn, 1024 + c, hw, hb, 1024 + c, 1536, a2);
#pragma unroll
        for (int j = 0; j < 8; ++j) a1[j] *= a2[j];
        st8bf(X0 + (size_t)row * 512 + c, a0); st8bf(U + (size_t)row * 512 + c, a1);
#pragma unroll
        for (int i = 0; i < 2; ++i) { const int cc = c + 512 * i; conv8(prow, hasp, hasn, 2048 + cc, sw, sb, cc, 1024, a0);
#pragma unroll
            for (int j = 0; j < 8; ++j) a0[j] = silu_f(a0[j]);
            st8bf(XBC + (size_t)row * 1024 + cc, a0); }
        if (F.lane < 16) DT[(size_t)row * 16 + F.lane] = softplus_f(bf2f(prow[3072 + F.lane]) + dtb[F.lane]);
    }
}

__device__ void ph_hyena_naive(const Fr& F) {
    float* us = (float*)F.lds;
    float* kw = us + 64 * 64;
    const bf16_t* U = F.w<bf16_t>(L0_U); const bf16_t* X0 = F.w<bf16_t>(L0_X0); bf16_t* A = F.w<bf16_t>(WS_ABUF);
    const int cc = F.tid & 63, tg = F.tid >> 6;
    for (int u = F.bid; u < 2048 + 256; u += F.G) {
        const bool lat = u < 2048; const int uu = lat ? u : u - 2048; const int ntt = lat ? 32 : 4;
        const int b = uu / (ntt * 8), tt = (uu % (ntt * 8)) / 8, ct = uu % 8, n = lat ? SEQ : CTXL; const int rowbase = lat ? b * SEQ : TL + b * CTXL, t0 = tt * 64;
        const float* Kd = lat ? F.w<float>(L0_KL) : F.w<float>(L0_KC);
        float acc[8];
#pragma unroll
        for (int i = 0; i < 8; ++i) acc[i] = 0.f;
        for (int s0 = 0; s0 < n; s0 += 64) {
            __syncthreads();
            for (int i = F.tid; i < 64 * 64; i += NTHR) { const int sl = i >> 6, c2 = i & 63; us[i] = bf2f(U[(size_t)(rowbase + s0 + sl) * 512 + ct * 64 + c2]); }
            for (int i = F.tid; i < 127 * 64; i += NTHR) { const int j = i >> 6, c2 = i & 63; kw[i] = Kd[(size_t)(t0 - s0 - 63 + j + n - 1) * 512 + ct * 64 + c2]; }
            __syncthreads();
            for (int sl = 0; sl < 64; ++sl) { const float uv = us[sl * 64 + cc];
#pragma unroll
                for (int i = 0; i < 8; ++i) acc[i] += uv * kw[(tg * 8 + i - sl + 63) * 64 + cc]; }
        }
#pragma unroll
        for (int i = 0; i < 8; ++i) { const size_t row = (size_t)(rowbase + t0 + tg * 8 + i); const float x0 = bf2f(X0[row * 512 + ct * 64 + cc]); A[row * 1024 + ct * 64 + cc] = f2bf(x0 * acc[i]); }
    }
    __syncthreads();
}

__device__ void ph_ssd_naive(const Fr& F) {
    constexpr int TS = 32;
    float* xs = (float*)F.lds;
    float* Bs = xs + TS * 64;
    float* Cs = Bs + TS * 128;
    float* dts = Cs + TS * 128;
    float* ys = dts + TS;
    int* rows = (int*)(ys + TS * 64);
    const bf16_t* XBC = F.w<bf16_t>(L0_XBC); const float* DT = F.w<float>(L0_DT);
    const int p = F.tid >> 3, ns = F.tid & 7;
    for (int u = F.bid; u < NB * 8 * 2; u += F.G) {
        const int b = u >> 4, h = (u >> 1) & 7, dir = u & 1, g = h >> 2;
        const float Aneg = -expf(F.in[I_ALOG][dir * 8 + h]);
        bf16_t* Y = dir ? F.w<bf16_t>(L0_YB) : F.w<bf16_t>(L0_YF);
        float st[16];
#pragma unroll
        for (int i = 0; i < 16; ++i) st[i] = 0.f;
        for (int k0 = 0; k0 < NKEY; k0 += TS) {
            __syncthreads();
            if (F.tid < TS) { const int k = k0 + F.tid; int row;
                if (k < CTXL) row = TL + b * CTXL + (dir ? (CTXL - 1 - k) : k); else { const int kk = k - CTXL; row = b * SEQ + (dir ? (SEQ - 1 - kk) : kk); }
                rows[F.tid] = row; dts[F.tid] = DT[(size_t)row * 16 + dir * 8 + h]; }
            __syncthreads();
            for (int i = F.tid; i < TS * 64; i += NTHR) { const int s = i >> 6, c = i & 63; xs[i] = bf2f(XBC[(size_t)rows[s] * 1024 + h * 64 + c]); }
            for (int i = F.tid; i < TS * 128; i += NTHR) { const int s = i >> 7, c = i & 127; Bs[i] = bf2f(XBC[(size_t)rows[s] * 1024 + 512 + g * 128 + c]); Cs[i] = bf2f(XBC[(size_t)rows[s] * 1024 + 768 + g * 128 + c]); }
            __syncthreads();
            for (int s = 0; s < TS; ++s) {
                const float dtv = dts[s], dA = expf(dtv * Aneg), xd = xs[s * 64 + p] * dtv; float y = 0.f;
#pragma unroll
                for (int i = 0; i < 16; ++i) { st[i] = st[i] * dA + xd * Bs[s * 128 + ns * 16 + i]; y += st[i] * Cs[s * 128 + ns * 16 + i]; }
                y += __shfl_xor(y, 1); y += __shfl_xor(y, 2); y += __shfl_xor(y, 4);
                if (ns == 0) ys[s * 64 + p] = y;
            }
            __syncthreads();
            for (int i = F.tid; i < TS * 64; i += NTHR) { const int s = i >> 6, c = i & 63; Y[(size_t)rows[s] * 512 + h * 64 + c] = f2bf(ys[i]); }
        }
    }
    __syncthreads();
}
__device__ void ph_ssd_combine(const Fr& F) {
    const bf16_t* YF = F.w<bf16_t>(L0_YF); const bf16_t* YB = F.w<bf16_t>(L0_YB); const bf16_t* XBC = F.w<bf16_t>(L0_XBC); const bf16_t* PROJ = F.w<bf16_t>(L0_PROJ); bf16_t* A = F.w<bf16_t>(WS_ABUF);
    const float* dsk = F.in[I_SSMD]; const float* ng = F.in[I_SSMNG];
    for (int row = F.bid * 8 + F.wave; row < TT; row += F.G * 8) {
        const int c = F.lane * 8; float yf[8], yb[8], xv[8], zv[8], y[8];
        ld8bf(YF + (size_t)row * 512 + c, yf); ld8bf(YB + (size_t)row * 512 + c, yb); ld8bf(XBC + (size_t)row * 1024 + c, xv); ld8bf(PROJ + (size_t)row * EVEN_PAD + 1536 + c, zv);
        const float dd = dsk[c >> 6]; float ss = 0.f;
#pragma unroll
        for (int j = 0; j < 8; ++j) { y[j] = (yf[j] + yb[j] + xv[j] * dd) * silu_f(zv[j]); ss += y[j] * y[j]; }
#pragma unroll
        for (int o = 16; o > 0; o >>= 1) ss += __shfl_xor(ss, o);
        const float r = rsqrtf(ss * (1.f / 256.f) + EPS);
#pragma unroll
        for (int j = 0; j < 8; ++j) y[j] = y[j] * r * ng[c + j];
        st8bf(A + (size_t)row * 1024 + 512 + c, y);
    }
}

__device__ void ph_attn_prep(const Fr& F) {
    const bf16_t* P = F.w<bf16_t>(L1_PROJ); float* SQ = F.w<float>(WS_SQ); float* SKV = F.w<float>(WS_SKV);
    bf16_t* KM = F.w<bf16_t>(L1_KM); bf16_t* QG = F.w<bf16_t>(L1_QG); bf16_t* KG = F.w<bf16_t>(L1_KG); bf16_t* VGT = F.w<bf16_t>(L1_VGT);
    const float* cm = F.w<float>(WS_ROPEM); const float* sm = cm + 2048 * 16; const float* cg = F.w<float>(WS_ROPEG); const float* sg = cg + 2048 * 32;
    const float gscale = 0.125f * LOG2E;
    for (int row = F.bid * 8 + F.wave; row < TT; row += F.G * 8) {
        const bf16_t* pr = P + (size_t)row * ODD_PAD; const bool lat = row < TL; const int pos = row & (SEQ - 1);
        const int b = lat ? (row >> 11) : ((row - TL) >> 8), key = lat ? CTXL + pos : ((row - TL) & (CTXL - 1));
        { float s = 0.f;
#pragma unroll
          for (int i = 0; i < 4; ++i) { const float v = bf2f(pr[F.lane + 64 * i]); s += v * v; }
          s = wave_sum(s); if (F.lane == 0) SQ[row] = rsqrtf(s * (1.f / 256.f) + EPS);
          float s2 = 0.f;
#pragma unroll
          for (int i = 0; i < 2; ++i) { const float v = bf2f(pr[256 + F.lane + 64 * i]); s2 += v * v; }
          s2 = wave_sum(s2); if (F.lane == 0) SKV[row] = rsqrtf(s2 * (1.f / 128.f) + EPS); }
        { const int i = F.lane & 15, hi = (F.lane >> 4) & 1; float v = 0.f;
          if (F.lane < 32) { const float x1 = bf2f(pr[384 + i]), x2 = bf2f(pr[400 + i]);
              if (lat) { const float c = cm[pos * 16 + i], s = sm[pos * 16 + i]; v = hi ? (x2 * c + x1 * s) : (x1 * c - x2 * s); } else v = hi ? x2 : x1; }
          const bf16_t bv = f2bf(v);
          if (F.lane < 32) { bf16_t* kb = KM + ((size_t)b * NKEY + key) * 768 + 64 + F.lane;
#pragma unroll
              for (int h = 0; h < 8; ++h) kb[h * 96] = bv; } }
        if (lat) {
#pragma unroll
            for (int h = 0; h < 8; ++h) { const int i = F.lane & 31, hi = F.lane >> 5; const float x1 = bf2f(pr[416 + h * 64 + i]), x2 = bf2f(pr[416 + h * 64 + 32 + i]);
                const float c = cg[pos * 32 + i], s = sg[pos * 32 + i]; const float v = hi ? (x2 * c + x1 * s) : (x1 * c - x2 * s);
                QG[(size_t)row * 512 + h * 64 + F.lane] = f2bf(v * gscale); } }
#pragma unroll
        for (int kv = 0; kv < 2; ++kv) { const int i = F.lane & 31, hi = F.lane >> 5; const float x1 = bf2f(pr[928 + kv * 64 + i]), x2 = bf2f(pr[928 + kv * 64 + 32 + i]); float v;
            if (lat) { const float c = cg[pos * 32 + i], s = sg[pos * 32 + i]; v = hi ? (x2 * c + x1 * s) : (x1 * c - x2 * s); } else v = hi ? x2 : x1;
            KG[((size_t)b * NKEY + key) * 128 + kv * 64 + F.lane] = f2bf(v);
            VGT[((size_t)(b * 2 + kv) * 64 + F.lane) * NKEY + key] = pr[1056 + kv * 64 + F.lane]; }
    }
}

__device__ void ph_attn_naive(const Fr& F) {
    float* Ks = (float*)F.lds;
    float* Vs = Ks + 64 * 96;
    bf16_t* A = F.w<bf16_t>(WS_ABUF);
    { const bf16_t* QM = F.w<bf16_t>(L1_QM); const bf16_t* KM = F.w<bf16_t>(L1_KM); const bf16_t* VT = F.w<bf16_t>(L1_VT);
      for (int u = F.bid; u < NB * 8 * 4; u += F.G) {
        const int b = u >> 5, h = (u >> 2) & 7, qt = u & 3; const int row = b * SEQ + qt * 512 + F.tid;
        float q[96];
#pragma unroll
        for (int i = 0; i < 12; ++i) { float t8[8]; ld8bf(QM + (size_t)row * 768 + h * 96 + i * 8, t8);
#pragma unroll
            for (int j = 0; j < 8; ++j) q[i * 8 + j] = t8[j]; }
        float o[64];
#pragma unroll
        for (int i = 0; i < 64; ++i) o[i] = 0.f;
        float mx = -1.0e30f, l = 0.f;
        for (int k0 = 0; k0 < NKEY; k0 += 64) {
            __syncthreads();
            for (int i = F.tid; i < 64 * 96; i += NTHR) { const int kk = i / 96, d = i % 96; Ks[i] = bf2f(KM[((size_t)b * NKEY + k0 + kk) * 768 + h * 96 + d]); }
            for (int i = F.tid; i < 64 * 64; i += NTHR) { const int dv = i >> 6, kk = i & 63; Vs[kk * 64 + dv] = bf2f(VT[((size_t)(b * 8 + h) * 64 + dv) * NKEY + k0 + kk]); }
            __syncthreads();
            for (int kk = 0; kk < 64; ++kk) {
                float s = 0.f;
#pragma unroll
                for (int d = 0; d < 96; ++d) s += q[d] * Ks[kk * 96 + d];
                if (s > mx) { const float al = exp2f(mx - s); l *= al;
#pragma unroll
                    for (int i = 0; i < 64; ++i) o[i] *= al;
                    mx = s; }
                const float p = exp2f(s - mx); l += p;
#pragma unroll
                for (int i = 0; i < 64; ++i) o[i] += p * Vs[kk * 64 + i];
            }
        }
        const float il = 1.f / l;
#pragma unroll
        for (int i = 0; i < 8; ++i) { float t8[8];
#pragma unroll
            for (int j = 0; j < 8; ++j) t8[j] = o[i * 8 + j] * il;
            st8bf(A + (size_t)row * 1024 + h * 64 + i * 8, t8); }
      } }
    { const bf16_t* QG = F.w<bf16_t>(L1_QG); const bf16_t* KG = F.w<bf16_t>(L1_KG); const bf16_t* VGT = F.w<bf16_t>(L1_VGT);
      for (int u = F.bid; u < NB * 8 * 4; u += F.G) {
        const int b = u >> 5, hd = (u >> 2) & 7, qt = u & 3, kv = hd >> 2; const int q0 = qt * 512, qpos = q0 + F.tid, row = b * SEQ + qpos;
        float q[64];
#pragma unroll
        for (int i = 0; i < 8; ++i) { float t8[8]; ld8bf(QG + (size_t)row * 512 + hd * 64 + i * 8, t8);
#pragma unroll
            for (int j = 0; j < 8; ++j) q[i * 8 + j] = t8[j]; }
        float o[64];
#pragma unroll
        for (int i = 0; i < 64; ++i) o[i] = 0.f;
        float mx = F.in[I_SINK][hd] * LOG2E, l = 1.f;
        const int lat_lo = (q0 - 128) > 0 ? (q0 - 128) : 0, lat_hi = (q0 + 512 + 128) < SEQ ? (q0 + 512 + 128) : SEQ;
        const int ntile = 4 + (lat_hi - lat_lo) / 64;
        for (int tI = 0; tI < ntile; ++tI) {
            const int kidx0 = tI < 4 ? tI * 64 : CTXL + lat_lo + (tI - 4) * 64;
            __syncthreads();
            for (int i = F.tid; i < 64 * 64; i += NTHR) { const int kk = i >> 6, d = i & 63; Ks[kk * 64 + d] = bf2f(KG[((size_t)b * NKEY + kidx0 + kk) * 128 + kv * 64 + d]); }
            for (int i = F.tid; i < 64 * 64; i += NTHR) { const int dv = i >> 6, kk = i & 63; Vs[kk * 64 + dv] = bf2f(VGT[((size_t)(b * 2 + kv) * 64 + dv) * NKEY + kidx0 + kk]); }
            __syncthreads();
            for (int kk = 0; kk < 64; ++kk) {
                bool valid = true;
                if (tI >= 4) { const int kpos = kidx0 - CTXL + kk; const int rel = kpos - qpos; valid = (rel <= 128) && (rel >= -128); }
                if (valid) {
                    float s = 0.f;
#pragma unroll
                    for (int d = 0; d < 64; ++d) s += q[d] * Ks[kk * 64 + d];
                    if (s > mx) { const float al = exp2f(mx - s); l *= al;
#pragma unroll
                        for (int i = 0; i < 64; ++i) o[i] *= al;
                        mx = s; }
                    const float p = exp2f(s - mx); l += p;
#pragma unroll
                    for (int i = 0; i < 64; ++i) o[i] += p * Vs[kk * 64 + i];
                }
            }
        }
        const float il = 1.f / l;
#pragma unroll
        for (int i = 0; i < 8; ++i) { float t8[8];
#pragma unroll
            for (int j = 0; j < 8; ++j) t8[j] = o[i * 8 + j] * il;
            st8bf(A + (size_t)row * 1024 + 512 + hd * 64 + i * 8, t8); }
      } }
    __syncthreads();
}

template <class Epi>
__device__ __forceinline__ void run_gemm(const Fr& F, const bf16_t* A, int lda, const bf16_t* Bt, int ldb, int M, int N, int K, const Epi& E) {
    pg8::Gemm g{A, Bt, M, N, K, lda, ldb}; pg8::StaticOrder S; S.init(M, N, F.G, F.bid);
    pg8::gemm_phase<Epi, pg8::StaticOrder>((LAS unsigned char*)F.lds, g, S, E);
}

__global__ void __launch_bounds__(NTHR, 2) fwd(Args args) {
    extern __shared__ __attribute__((aligned(16))) unsigned char lds[];
    Fr F; F.in = args.in; F.out = args.out; F.ws = args.ws; F.lds = lds; F.tid = threadIdx.x; F.lane = F.tid & 63; F.wave = __builtin_amdgcn_readfirstlane(F.tid >> 6); F.G = gridDim.x; F.bid = blockIdx.x;
    const int lo = args.ph_lo, hi = args.ph_hi;
#ifndef PHMASK
#define PHMASK 0xFFFFFFFFu
#endif
#define IN(k) (((PHMASK >> (k)) & 1u) && lo <= (k) && (k) < hi)
    const float* MOD0 = F.w<float>(WS_MOD); const float* MOD1 = MOD0 + 9 * 6144;
    bf16_t* ABUF = F.w<bf16_t>(WS_ABUF);

    if (IN(0)) {
        cvt_job(F, F.in[I_EVWIN], nullptr, nullptr, F.w<bf16_t>(W_IN0), EVEN_PAD, 1024, 1024, EVEN_IN, EVEN_IN, 0);
        cvt_job(F, F.in[I_EVWOUT], nullptr, nullptr, F.w<bf16_t>(W_OUT0), 1024, 1024, 1024, 1024, 1024, 0);
        cvt_job(F, F.in[I_FFNG], F.in[I_FFNU], nullptr, F.w<bf16_t>(W_GU0), 2 * DFF, 1024, 1024, DFF, DFF, 1);
        cvt_job(F, F.in[I_FFND], nullptr, nullptr, F.w<bf16_t>(W_DN0), 1024, DFF, DFF, 1024, 1024, 0);
        cvt_job(F, F.in[I_ODWIN], nullptr, nullptr, F.w<bf16_t>(W_IN1), ODD_PAD, 1024, 1024, 1184, 1184, 0);
        cvt_job(F, F.in[I_QUP], nullptr, F.in[I_QNG], F.w<bf16_t>(W_QUP), 768, 256, 256, 768, 768, 0);
        cvt_job(F, F.in[I_KVUP], nullptr, F.in[I_KVNG], F.w<bf16_t>(W_KUP), 512, 256, 128, 1024, 1024, 2);
        cvt_job(F, F.in[I_KVUP], nullptr, F.in[I_KVNG], F.w<bf16_t>(W_VUP), 512, 256, 128, 1024, 1024, 3);
        cvt_job(F, F.in[I_ODWOUT], nullptr, nullptr, F.w<bf16_t>(W_OUT1), 1024, 1024, 1024, 1024, 1024, 0);
        ph_ada(F); ph_filters(F); ph_rope_tables(F);
    }
    if (IN(1)) ph_norm0(F);
    if (IN(2)) run_gemm(F, ABUF, 1024, F.w<bf16_t>(W_IN0), 1024, TT, EVEN_PAD, 1024, pg8::EpiBf16Plain{F.w<bf16_t>(L0_PROJ), EVEN_PAD});
    if (IN(3)) ph_convpass(F);
    if (IN(4)) ph_hyena_naive(F);
    if (IN(5)) ph_ssd_naive(F);
    if (IN(6)) ph_ssd_combine(F);
    if (IN(7)) run_gemm(F, ABUF, 1024, F.w<bf16_t>(W_OUT0), 1024, TT, 1024, 1024, pg8::EpiF32Plain{F.w<float>(L0_MBUF), 1024});
    if (IN(8)) ph_thin<0>(F, F.w<float>(L0_MBUF), TT, F.in[I_X], F.in[I_CTX], F.out, F.w<float>(WS_HC), F.in[I_MIXPOST], MOD0, 2048, F.in[I_FFNPRE], MOD0, 3072, 4096);
    if (IN(9)) run_gemm(F, ABUF, 1024, F.w<bf16_t>(W_GU0), 1024, TT, 2 * DFF, 1024, pg8::EpiSwiglu{F.w<bf16_t>(L0_HMID), DFF});
    if (IN(10)) run_gemm(F, F.w<bf16_t>(L0_HMID), DFF, F.w<bf16_t>(W_DN0), DFF, TT, 1024, DFF, pg8::EpiF32Plain{F.w<float>(L0_MBUF), 1024});
    if (IN(11)) ph_thin<0>(F, F.w<float>(L0_MBUF), TT, F.out, F.w<float>(WS_HC), F.out, F.w<float>(WS_HC), F.in[I_FFNPOST], MOD0, 5120, F.in[I_MIXPRE] + 1024, MOD1, 0, 1024);
    if (IN(12)) run_gemm(F, ABUF, 1024, F.w<bf16_t>(W_IN1), 1024, TT, ODD_PAD, 1024, pg8::EpiBf16Plain{F.w<bf16_t>(L1_PROJ), ODD_PAD});
    if (IN(13)) ph_attn_prep(F);
    if (IN(14)) {
        const float* cm = F.w<float>(WS_ROPEM);
#ifndef P14
#define P14 7
#endif
        if (P14 & 1) run_gemm(F, F.w<bf16_t>(L1_PROJ), ODD_PAD, F.w<bf16_t>(W_QUP), 256, TL, 768, 256, pg8::EpiQ{F.w<bf16_t>(L1_QM), F.w<float>(WS_SQ), cm, cm + 2048 * 16, 0.10206207261596575f * LOG2E});
        if (P14 & 2) run_gemm(F, F.w<bf16_t>(L1_PROJ) + 256, ODD_PAD, F.w<bf16_t>(W_KUP), 256, TT, 512, 256, pg8::EpiK{F.w<bf16_t>(L1_KM), F.w<float>(WS_SKV)});
        if (P14 & 4) run_gemm(F, F.w<bf16_t>(W_VUP), 256, F.w<bf16_t>(L1_PROJ) + 256, ODD_PAD, 512, TT, 256, pg8::EpiVT{F.w<bf16_t>(L1_VT), F.w<float>(WS_SKV)});
    }
    if (IN(15)) ph_attn_naive(F);
    if (IN(16)) run_gemm(F, ABUF, 1024, F.w<bf16_t>(W_OUT1), 1024, TL, 1024, 1024, pg8::EpiF32Plain{F.w<float>(L1_MBUF), 1024});
    if (IN(17)) ph_thin<1>(F, F.w<float>(L1_MBUF), TL, F.out, nullptr, F.out, nullptr, F.in[I_MIXPOST] + 1024, MOD1, 2048, F.in[I_FFNPRE] + 1024, MOD1, 3072, 4096);
    if (IN(18)) {
        for (int e = 0; e < NEXP; ++e) {
            cvt_job(F, F.in[I_MOEG] + (size_t)e * 1024 * DFE, F.in[I_MOEU] + (size_t)e * 1024 * DFE, nullptr, F.w<bf16_t>(WM_GU) + (size_t)e * 2 * DFE * 1024, 2 * DFE, 1024, 1024, DFE, DFE, 1);
            cvt_job(F, F.in[I_MOED] + (size_t)e * DFE * 1024, nullptr, nullptr, F.w<bf16_t>(WM_DN) + (size_t)e * 1024 * DFE, 1024, DFE, DFE, 1024, 1024, 0);
        }
    }
    if (IN(19)) { const int e = args.ex; run_gemm(F, ABUF, 1024, F.w<bf16_t>(WM_GU) + (size_t)e * 2 * DFE * 1024, 1024, TL, 2 * DFE, 1024, pg8::EpiSwiglu{F.w<bf16_t>(L1_HMID), DFE}); }
    if (IN(20)) { const int e = args.ex; run_gemm(F, F.w<bf16_t>(L1_HMID), DFE, F.w<bf16_t>(WM_DN) + (size_t)e * 1024 * DFE, DFE, TL, 1024, DFE, pg8::EpiMoeAcc{F.w<float>(L1_MBUF), F.w<float>(WS_G8), e, e == 0 ? 1 : 0}); }
    if (IN(21)) ph_thin<2>(F, F.w<float>(L1_MBUF), TL, F.out, nullptr, F.out, nullptr, F.in[I_FFNPOST] + 1024, MOD1, 5120, nullptr, nullptr, 0, 0);
#undef IN
}

extern "C" void kernel_launch(void* const* d_in, const int* in_sizes, int n_in, void* d_out, int out_size, void* d_ws, size_t ws_size, hipStream_t stream) {
    static int grid = 0;
    if (grid == 0) {
        if (n_in != 41 || out_size != TL * DM || ws_size < WS_END) { fprintf(stderr, "kernel_launch: unexpected shapes (n_in %d, out %d, ws %zu < %zu)\n", n_in, out_size, ws_size, (size_t)WS_END); grid = -1; return; }
        int dev = 0, cus = 0;
        if (hipGetDevice(&dev) != hipSuccess || hipDeviceGetAttribute(&cus, hipDeviceAttributeMultiprocessorCount, dev) != hipSuccess) { grid = -1; return; }
        if (hipFuncSetAttribute((const void*)fwd, hipFuncAttributeMaxDynamicSharedMemorySize, LDS_BYTES) != hipSuccess) { fprintf(stderr, "kernel_launch: hipFuncSetAttribute failed\n"); grid = -1; return; }
        int per_cu = 0;
        if (hipOccupancyMaxActiveBlocksPerMultiprocessor(&per_cu, (const void*)fwd, NTHR, LDS_BYTES) != hipSuccess || per_cu < 1) fprintf(stderr, "kernel_launch: occupancy query says %d\n", per_cu);
        (void)hipGetLastError();
        grid = cus;
    }
    if (grid < 0) return;
    hipMemsetAsync((char*)d_ws + WS_CTL, 0, 65536, stream);
    Args a{};
    for (int i = 0; i < 41; ++i) a.in[i] = (const float*)d_in[i];
    a.out = (float*)d_out; a.ws = (unsigned char*)d_ws;
    auto launch = [&](int lo, int hi, int ex) { a.ph_lo = lo; a.ph_hi = hi; a.ex = ex; hipLaunchKernelGGL(fwd, dim3(grid), dim3(NTHR), LDS_BYTES, stream, a); };
    for (int p = 0; p <= 18; ++p) launch(p, p + 1, 0);
    for (int e = 0; e < NEXP; ++e) { launch(19, 20, e); launch(20, 21, e); }
    launch(21, 22, 0);
}
```

```cpp
#include <hip/hip_runtime.h>
#include <cstdio>
#include <cstdint>

typedef unsigned short bf16_t;
typedef short bf16x8 __attribute__((ext_vector_type(8)));
typedef float f32x4 __attribute__((ext_vector_type(4)));
#define LAS __attribute__((address_space(3)))

constexpr int NB = 8, SEQ = 2048, DM = 1024, CTXL = 256;
constexpr int TL = NB * SEQ, TC = NB * CTXL, TT = TL + TC, NKEY = SEQ + CTXL;
constexpr int EVEN_IN = 3088, EVEN_PAD = 3328, ODD_PAD = 1280, DFF = 2816, DFE = 3584, NEXP = 8;
constexpr float EPS = 1e-6f;
constexpr float LOG2E = 1.4426950408889634f;
constexpr int NTHR = 512;
constexpr int LDS_BYTES = 147456;

constexpr size_t al256(size_t x) { return (x + 255) & ~(size_t)255; }
constexpr size_t WS_CTL = 0;
constexpr size_t WS_CNT = 16384;
constexpr size_t WS_MOD = 65536;
constexpr size_t WS_ROPEM = WS_MOD + al256((size_t)2 * 9 * 6144 * 4);
constexpr size_t WS_ROPEG = WS_ROPEM + (size_t)2 * 2048 * 16 * 4;
constexpr size_t WS_SQ = WS_ROPEG + (size_t)2 * 2048 * 32 * 4;
constexpr size_t WS_SKV = WS_SQ + al256((size_t)TT * 4);
constexpr size_t WS_TOPW = WS_SKV + al256((size_t)TT * 4);
constexpr size_t WS_LISTE = WS_TOPW + (size_t)TL * 2 * 4;
constexpr int MAXROWS = 34816;
constexpr size_t WS_ROWINFO = WS_LISTE + (size_t)NEXP * TL * 4;
constexpr size_t WS_ROWW = WS_ROWINFO + (size_t)MAXROWS * 4;
constexpr size_t WS_SROW = WS_ROWW + (size_t)MAXROWS * 4;
constexpr size_t WS_W0 = WS_SROW + (size_t)TL * 2 * 4;
constexpr size_t W_IN0 = WS_W0;
constexpr size_t W_OUT0 = W_IN0 + (size_t)EVEN_PAD * 1024 * 2;
constexpr size_t W_GU0 = W_OUT0 + (size_t)1024 * 1024 * 2;
constexpr size_t W_DN0 = W_GU0 + (size_t)2 * DFF * 1024 * 2;
constexpr size_t W_IN1 = W_DN0 + (size_t)1024 * DFF * 2;
constexpr size_t W_QUP = W_IN1 + (size_t)ODD_PAD * 1024 * 2;
constexpr size_t W_KUP = W_QUP + (size_t)768 * 256 * 2;
constexpr size_t W_VUP = W_KUP + (size_t)512 * 256 * 2;
constexpr size_t W_OUT1 = W_VUP + (size_t)512 * 256 * 2;
constexpr size_t WS_ABUF = W_OUT1 + (size_t)1024 * 1024 * 2;
constexpr size_t WS_AG = WS_W0;
constexpr size_t WS_MOUT = WS_W0;
constexpr size_t XG_END0 = WS_ABUF + (size_t)TT * DM * 2, XG_END1 = WS_AG + (size_t)MAXROWS * DM * 2;
constexpr size_t WS_R1 = al256(XG_END0 > XG_END1 ? XG_END0 : XG_END1);
constexpr size_t R1_BYTES = (size_t)MAXROWS * DFE * 2;
constexpr size_t WS_R2 = WS_R1 + R1_BYTES;
constexpr size_t R2_BYTES = (size_t)132 * 1024 * 1024;
constexpr size_t WS_XTR = WS_R2 + R2_BYTES;
constexpr size_t WS_HB = WS_XTR + (size_t)32 * 6 * 65536 * 2;
constexpr size_t WS_END = WS_HB + (size_t)TT * DM * 2;
static_assert(WS_END <= (size_t)536000000, "workspace budget");
constexpr size_t L0_PROJ = WS_R1;
constexpr size_t L0_HMID = WS_R1;
constexpr size_t L0_XBC = L0_PROJ + (size_t)TT * EVEN_PAD * 2;
constexpr size_t L0_U = L0_XBC + (size_t)TT * 1024 * 2;
constexpr size_t L0_X0 = L0_U + (size_t)TT * 512 * 2;
constexpr size_t L0_DT = L0_X0 + (size_t)TT * 512 * 2;
constexpr size_t L0_YF = L0_DT + (size_t)TT * 16 * 4;
constexpr size_t L0_YB = L0_YF + (size_t)TT * 512 * 2;
static_assert(L0_YB + (size_t)TT * 512 * 2 <= WS_R1 + R1_BYTES, "R1 layer 0");
constexpr size_t L0_MBUF = WS_R1 + (size_t)128 * 1024 * 1024;
static_assert(L0_MBUF >= L0_HMID + (size_t)TT * DFF * 2 && L0_MBUF + (size_t)TT * DM * 2 <= WS_R1 + R1_BYTES, "MBUF0 placement");
constexpr size_t L0_XT = WS_R1 + (size_t)176 * 1024 * 1024;
static_assert(L0_XT >= L0_MBUF + (size_t)TT * DM * 2 && L0_XT + (size_t)32 * 10 * 65536 * 2 <= WS_R1 + R1_BYTES, "XT0 placement");
constexpr size_t L0_FL = WS_R2 + (size_t)TT * DM * 2;
constexpr size_t L0_FC = L0_FL + (size_t)512 * 4096 * 2;
constexpr size_t L0_YT = L0_FC + (size_t)512 * 512 * 2;
constexpr size_t L0_ST = L0_YT + (size_t)512 * 8 * NKEY * 2;
constexpr size_t L0_ACS = L0_ST + (size_t)2304 * 8192 * 4;
constexpr size_t L0_ATOT = L0_ACS + (size_t)2304 * 128 * 4;
constexpr size_t L0_STIN = WS_R2;
static_assert(L0_ATOT + (size_t)2304 * 4 <= WS_R2 + R2_BYTES, "R2 layer 0");
constexpr size_t L1_HMID = WS_R1;
constexpr size_t L1_A2TMP = WS_R1;
constexpr size_t L1_PROJ = WS_R1;
constexpr size_t L1_QM = L1_PROJ + (size_t)TT * ODD_PAD * 2;
constexpr size_t L1_KM = L1_QM + (size_t)TL * 768 * 2;
constexpr size_t L1_VT = L1_KM + (size_t)NB * NKEY * 768 * 2;
constexpr size_t L1_QG = L1_VT + (size_t)NB * 512 * NKEY * 2;
constexpr size_t L1_KG = L1_QG + (size_t)TL * 512 * 2;
constexpr size_t L1_VGT = L1_KG + (size_t)NB * NKEY * 128 * 2;
constexpr size_t L1_MBUF = L1_VGT + (size_t)NB * 128 * NKEY * 2;
static_assert(L1_MBUF + (size_t)TL * DM * 4 <= WS_R1 + R1_BYTES, "R1 layer 1");
static_assert(L1_A2TMP + (size_t)TL * DM * 2 <= L1_MBUF, "a2tmp vs mbuf1");
constexpr size_t WM_GU = WS_R2;
constexpr size_t WM_DN = WM_GU + (size_t)NEXP * 2 * DFE * 1024;
static_assert(WM_DN + (size_t)NEXP * 1024 * DFE <= WS_R2 + R2_BYTES, "fp8 expert weights vs R2");

typedef __bf16 bf16v2 __attribute__((ext_vector_type(2)));
typedef float f32v2 __attribute__((ext_vector_type(2)));
__device__ __forceinline__ bf16_t f2bf(float f) { return __builtin_bit_cast(unsigned short, (__bf16)f); }
__device__ __forceinline__ float bf2f(bf16_t b) { return __uint_as_float(((unsigned)b) << 16); }
__device__ __forceinline__ unsigned pack2(float lo, float hi) { f32v2 v = {lo, hi}; return __builtin_bit_cast(unsigned, __builtin_convertvector(v, bf16v2)); }
#ifndef MOE_FP8
#define MOE_FP8 1
#endif
constexpr float F8_WSCALE = 64.f, F8_HSCALE = 8.f;
__device__ __forceinline__ unsigned pack4_fp8(float a, float b, float c, float d) { unsigned r = 0u; r = __builtin_amdgcn_cvt_pk_fp8_f32(a, b, r, false); r = __builtin_amdgcn_cvt_pk_fp8_f32(c, d, r, true); return r; }
__device__ __forceinline__ float bflo(unsigned u) { return __uint_as_float(u << 16); }
__device__ __forceinline__ float bfhi(unsigned u) { return __uint_as_float(u & 0xFFFF0000u); }
__device__ __forceinline__ float wave_sum(float v) {
#pragma unroll
    for (int o = 32; o > 0; o >>= 1) v += __shfl_xor(v, o);
    return v;
}
__device__ __forceinline__ float silu_f(float x) { return x * __builtin_amdgcn_rcpf(1.f + __builtin_amdgcn_exp2f(-x * LOG2E)); }
__device__ __forceinline__ float softplus_f(float x) { return x > 20.f ? x : log1pf(expf(x)); }

namespace pg8 {
constexpr int BM = 256, BK = 64, HALF = 128, HTB = HALF * BK * 2, STAGE_BYTES = 8 * HTB, NXCD = 8, WGM = 8;
__host__ __device__ __forceinline__ int lds_byte(int r, int c) { const int st = (r >> 4) * 2 + (c >> 5), rr = r & 15, cc = c & 31, ob = rr * 64 + cc * 2; return st * 1024 + (ob ^ (((ob >> 9) & 1) << 5)); }
__host__ __device__ __forceinline__ void stage_rc(int b, int& R, int& C) { const int st = b / 1024, sb = b % 1024, swz = sb ^ (((sb >> 9) & 1) << 5); R = (st >> 1) * 16 + swz / 64; C = (st & 1) * 32 + (swz % 64) / 2; }

struct Unit { int pm, pn, e, kt0, nkt, ks; };
struct Gemm { const bf16_t* A; const bf16_t* Bt; int M, N, K, lda, ldb; size_t bstride; };

struct StaticOrder {
    int nM, nN, nwg, G, c;
    __device__ __forceinline__ void init(int M, int N, int G_, int c_) { nM = M / BM; nN = N / BM; nwg = nM * nN; G = G_; c = c_; }
    __device__ __forceinline__ bool next(int i, Unit& u) const {
        const long L = (long)i * G + c; if (L >= nwg) return false;
        int wgid = (int)L; { const int q = nwg / NXCD, r = nwg % NXCD, xcd = wgid % NXCD, off = wgid / NXCD; wgid = (xcd < r ? xcd * (q + 1) : r * (q + 1) + (xcd - r) * q) + off; }
        const int nig = WGM * nN, gid = wgid / nig, fm = gid * WGM, gsz = (nM - fm) < WGM ? (nM - fm) : WGM;
        u.pm = fm + ((wgid % nig) % gsz); u.pn = (wgid % nig) / gsz; u.e = 0; u.kt0 = 0; u.nkt = 0; u.ks = 0; return true;
    }
};


struct GroupedOrder {
    int ts1, ts2, ts3, ts4, ts5, ts6, ts7, NT, nrow, nN, G, c;
    __device__ __forceinline__ static void tail_of(int NT, int nN, int G, int nkt_full, int& NTF, int& S) {
        NTF = NT; S = 1;
        if (nN == 4 && (G % 4) == 0) { const int ntf = ((NT * 4) / G) * (G / 4); const int R = (NT - ntf) * 4; if (R > 0 && ntf > 0 && R * 7 <= G && nkt_full % 14 == 0) { NTF = ntf; S = 7; } }
    }
    __device__ __forceinline__ void init(const unsigned* cnt, int nN_, int G_, int c_, int nkt_full = 0, bool head_only = false) {
        int t[9]; t[0] = 0;
#pragma unroll
        for (int e = 0; e < 8; ++e) t[e + 1] = t[e] + __builtin_amdgcn_readfirstlane((int)((__hip_atomic_load(cnt + e, __ATOMIC_RELAXED, __HIP_MEMORY_SCOPE_AGENT) + 255u) >> 8));
        ts1 = t[1]; ts2 = t[2]; ts3 = t[3]; ts4 = t[4]; ts5 = t[5]; ts6 = t[6]; ts7 = t[7]; NT = t[8]; nN = nN_; G = G_; c = c_; nrow = NT;
        if (head_only) { int ntf, s; tail_of(NT, nN, G, nkt_full, ntf, s); nrow = ntf; }
    }
    __device__ __forceinline__ int expert_of(int j) const { return (j >= ts1) + (j >= ts2) + (j >= ts3) + (j >= ts4) + (j >= ts5) + (j >= ts6) + (j >= ts7); }
    __device__ __forceinline__ bool next(int i, Unit& u) const {
        const int nwg = nrow * nN; const long L = (long)i * G + c; u.kt0 = 0; u.nkt = 0; u.ks = 0; if (L >= nwg) return false;
        int wgid = (int)L; { const int q = nwg / NXCD, r = nwg % NXCD, xcd = wgid % NXCD, off = wgid / NXCD; wgid = (xcd < r ? xcd * (q + 1) : r * (q + 1) + (xcd - r) * q) + off; }
        const int nig = WGM * nN, gid = wgid / nig, fm = gid * WGM, gsz = (nrow - fm) < WGM ? (nrow - fm) : WGM;
        const int j = fm + ((wgid % nig) % gsz); u.pm = j; u.pn = (wgid % nig) / gsz; u.e = expert_of(j); return true;
    }
};
struct TailOrder {
    int ts1, ts2, ts3, ts4, ts5, ts6, ts7, nsub, NTF, nkt, c;
    __device__ __forceinline__ void init(const unsigned* cnt, int G, int c_, int nkt_full) {
        int t[9]; t[0] = 0;
#pragma unroll
        for (int e = 0; e < 8; ++e) t[e + 1] = t[e] + __builtin_amdgcn_readfirstlane((int)((__hip_atomic_load(cnt + e, __ATOMIC_RELAXED, __HIP_MEMORY_SCOPE_AGENT) + 255u) >> 8));
        ts1 = t[1]; ts2 = t[2]; ts3 = t[3]; ts4 = t[4]; ts5 = t[5]; ts6 = t[6]; ts7 = t[7]; int s; GroupedOrder::tail_of(t[8], 4, G, nkt_full, NTF, s);
        nsub = (s == 7) ? (t[8] - NTF) * 28 : 0; nkt = nkt_full / 7; c = c_;
    }
    __device__ __forceinline__ bool next(int i, Unit& u) const {
        if (i > 0 || c >= nsub) return false;
        const int tu = c / 7, ks = c - tu * 7, j = NTF + (tu >> 2); u.pm = j; u.pn = tu & 3; u.e = (j >= ts1) + (j >= ts2) + (j >= ts3) + (j >= ts4) + (j >= ts5) + (j >= ts6) + (j >= ts7);
        u.nkt = nkt; u.kt0 = ks * nkt; u.ks = ks; return true;
    }
};

typedef int i32x4v __attribute__((ext_vector_type(4)));
typedef int i32x8v __attribute__((ext_vector_type(8)));
template <class Epi, class Sched, bool FP8 = false>
__device__ __forceinline__ void gemm_phase(LAS unsigned char* lds, const Gemm g, const Sched& S, const Epi& E) {
    const int tid = threadIdx.x, wid = __builtin_amdgcn_readfirstlane(tid >> 6), lane = tid & 63, wr = wid >> 2, wc = wid & 3, fr = lane & 15, fq = lane >> 4;
    int Kop = g.K; asm volatile("" : "+s"(Kop));
    const int K = Kop, nt = K / BK;
    unsigned voffA[2], voffB[2];
#pragma unroll
    for (int i = 0; i < 2; ++i) { int R, C; stage_rc(tid * 16 + i * 8192, R, C); voffA[i] = (unsigned)(R * g.lda + C) * 2u; voffB[i] = (unsigned)(R * g.ldb + C) * 2u; }
    const size_t kstep = (size_t)(BK * 2);
    const size_t hstepA = (size_t)HALF * g.lda * 2, hstepB = (size_t)HALF * g.ldb * 2;
    const size_t tstepA = 2 * hstepA, tstepB = 2 * hstepB;
    const unsigned ldsw = (unsigned)wid * 1024u;
    const int aoff = lds_byte(wr * 64 + fr, fq * 8), boff = lds_byte(wc * 32 + fr, fq * 8);
#define PG8_SA(b, h) (((b) * 2 + (h)) * HTB)
#define PG8_SB(b, h) ((4 + (b) * 2 + (h)) * HTB)
#define PG8_STAGE(bufoff, gbase, voff) do { _Pragma("unroll") for (int _i = 0; _i < 2; ++_i) \
        __builtin_amdgcn_global_load_lds((const unsigned*)((const char*)(gbase) + (voff)[_i]), (LAS unsigned*)(lds + (bufoff) + ldsw + _i * 8192), 16, 0, 0); } while (0)
#define PG8_LDA(dst, b, h) do { if constexpr (FP8) { _Pragma("unroll") for (int m = 0; m < 4; ++m) dst##8[m] = __builtin_shufflevector(*(const LAS i32x4v*)(lds + PG8_SA(b, h) + aoff + m * 2048), *(const LAS i32x4v*)(lds + PG8_SA(b, h) + aoff + m * 2048 + 1024), 0, 1, 2, 3, 4, 5, 6, 7); } \
        else { _Pragma("unroll") for (int m = 0; m < 4; ++m) _Pragma("unroll") for (int k = 0; k < 2; ++k) dst[m][k] = *(const LAS bf16x8*)(lds + PG8_SA(b, h) + aoff + m * 2048 + k * 1024); } } while (0)
#define PG8_LDB(dst, b, h) do { if constexpr (FP8) { _Pragma("unroll") for (int n = 0; n < 2; ++n) dst##8[n] = __builtin_shufflevector(*(const LAS i32x4v*)(lds + PG8_SB(b, h) + boff + n * 2048), *(const LAS i32x4v*)(lds + PG8_SB(b, h) + boff + n * 2048 + 1024), 0, 1, 2, 3, 4, 5, 6, 7); } \
        else { _Pragma("unroll") for (int n = 0; n < 2; ++n) _Pragma("unroll") for (int k = 0; k < 2; ++k) dst[n][k] = *(const LAS bf16x8*)(lds + PG8_SB(b, h) + boff + n * 2048 + k * 1024); } } while (0)
#define PG8_MMA(ai, bj, At, Bt) do { __builtin_amdgcn_s_setprio(1); \
        if constexpr (FP8) { _Pragma("unroll") for (int m = 0; m < 4; ++m) _Pragma("unroll") for (int n = 0; n < 2; ++n) \
            asm volatile("v_mfma_scale_f32_16x16x128_f8f6f4 %0, %1, %2, %0, %3, %3 op_sel_hi:[0,0,0]" : "+v"(acc[ai][bj][m][n]) : "v"(Bt##8[n]), "v"(At##8[m]), "v"(f8one)); } \
        else { _Pragma("unroll") for (int m = 0; m < 4; ++m) _Pragma("unroll") for (int n = 0; n < 2; ++n) _Pragma("unroll") for (int k = 0; k < 2; ++k) \
            acc[ai][bj][m][n] = __builtin_amdgcn_mfma_f32_16x16x32_bf16(Bt[n][k], At[m][k], acc[ai][bj][m][n], 0, 0, 0); } \
        __builtin_amdgcn_s_setprio(0); } while (0)
#define PG8_WAIT_V(n) asm volatile("s_waitcnt vmcnt(" #n ")" ::: "memory")
#define PG8_WAIT_L(n) asm volatile("s_waitcnt lgkmcnt(" #n ")" ::: "memory")
#define PG8_BAR __builtin_amdgcn_s_barrier()
#define PG8_SCHED __builtin_amdgcn_sched_barrier(0)
    Unit cur, nxt; int ui = 0;
    if (!S.next(0, cur)) return;
    f32x4 acc[2][2][4][2];
#pragma unroll
    for (int a = 0; a < 2; ++a)
#pragma unroll
        for (int b = 0; b < 2; ++b)
#pragma unroll
            for (int m = 0; m < 4; ++m)
#pragma unroll
                for (int n = 0; n < 2; ++n) acc[a][b][m][n] = (f32x4){0.f, 0.f, 0.f, 0.f};
    bf16x8 At[4][2], B0[2][2], B1[2][2];
    i32x8v At8[4], B08[2], B18[2];
    const int f8one = 0x7f7f7f7f;
    const char* cA = (const char*)g.A + (size_t)cur.pm * tstepA + (size_t)cur.kt0 * kstep; const char* cB = (const char*)g.Bt + (size_t)cur.e * g.bstride + (size_t)cur.pn * tstepB + (size_t)cur.kt0 * kstep;
    PG8_STAGE(PG8_SB(0, 0), cB, voffB); PG8_STAGE(PG8_SA(0, 0), cA, voffA); PG8_STAGE(PG8_SB(0, 1), cB + hstepB, voffB); PG8_STAGE(PG8_SA(0, 1), cA + hstepA, voffA);
    if (wr == 1) PG8_BAR;
    PG8_WAIT_V(4); PG8_BAR;
    PG8_STAGE(PG8_SB(1, 0), cB + kstep, voffB); PG8_STAGE(PG8_SA(1, 0), cA + kstep, voffA); PG8_STAGE(PG8_SB(1, 1), cB + hstepB + kstep, voffB);
    PG8_WAIT_V(6); PG8_BAR;
    for (;;) {
        const bool has_next = S.next(ui + 1, nxt);
        const char* nA = has_next ? (const char*)g.A + (size_t)nxt.pm * tstepA + (size_t)nxt.kt0 * kstep : cA; const char* nB = has_next ? (const char*)g.Bt + (size_t)nxt.e * g.bstride + (size_t)nxt.pn * tstepB + (size_t)nxt.kt0 * kstep : cB;
        const int ntc = cur.nkt ? cur.nkt : nt;
        for (int t = 0; t < ntc; t += 2) {
            const bool last = (t == ntc - 2);
            const char* a1 = cA + (size_t)(t + 1) * kstep;
            const char* a2 = last ? nA : cA + (size_t)(t + 2) * kstep; const char* b2 = last ? nB : cB + (size_t)(t + 2) * kstep;
            const char* a3 = a2 + kstep; const char* b3 = b2 + kstep;
            PG8_LDB(B0, 0, 0); PG8_SCHED; PG8_LDA(At, 0, 0); PG8_STAGE(PG8_SA(1, 1), a1 + hstepA, voffA);
            PG8_WAIT_L(8); PG8_BAR; PG8_WAIT_L(0); PG8_MMA(0, 0, At, B0); PG8_BAR; PG8_SCHED;
            PG8_LDB(B1, 0, 1); PG8_STAGE(PG8_SB(0, 0), b2, voffB);
            PG8_BAR; PG8_WAIT_L(0); PG8_MMA(0, 1, At, B1); PG8_BAR;
            PG8_LDA(At, 0, 1); PG8_STAGE(PG8_SA(0, 0), a2, voffA);
            PG8_BAR; PG8_WAIT_L(0); PG8_MMA(1, 0, At, B0); PG8_BAR; PG8_SCHED;
            PG8_STAGE(PG8_SB(0, 1), b2 + hstepB, voffB);
            PG8_WAIT_V(6); PG8_BAR; PG8_MMA(1, 1, At, B1); PG8_BAR;
            PG8_LDB(B0, 1, 0); PG8_SCHED; PG8_LDA(At, 1, 0); PG8_STAGE(PG8_SA(0, 1), a2 + hstepA, voffA);
            PG8_WAIT_L(8); PG8_BAR; PG8_WAIT_L(0); PG8_MMA(0, 0, At, B0); PG8_BAR; PG8_SCHED;
            PG8_LDB(B1, 1, 1); PG8_STAGE(PG8_SB(1, 0), b3, voffB);
            PG8_BAR; PG8_WAIT_L(0); PG8_MMA(0, 1, At, B1); PG8_BAR;
            PG8_LDA(At, 1, 1); PG8_STAGE(PG8_SA(1, 0), a3, voffA);
            PG8_BAR; PG8_WAIT_L(0); PG8_MMA(1, 0, At, B0); PG8_BAR; PG8_SCHED;
            PG8_STAGE(PG8_SB(1, 1), b3 + hstepB, voffB);
            PG8_WAIT_V(6); PG8_BAR; PG8_MMA(1, 1, At, B1); PG8_BAR;
        }
        if constexpr (FP8) asm volatile("s_nop 15\n\ts_nop 15\n\ts_nop 15\n\ts_nop 15" ::: "memory");
        E(acc, cur, wr, wc, fr, fq);
        if (!has_next) break;
#pragma unroll
        for (int a = 0; a < 2; ++a)
#pragma unroll
            for (int b = 0; b < 2; ++b)
#pragma unroll
                for (int m = 0; m < 4; ++m)
#pragma unroll
                    for (int n = 0; n < 2; ++n) acc[a][b][m][n] = (f32x4){0.f, 0.f, 0.f, 0.f};
        cur = nxt; cA = nA; cB = nB; ++ui;
    }
    PG8_WAIT_V(0);
    if (wr == 0) PG8_BAR;
    PG8_BAR;
#undef PG8_SA
#undef PG8_SB
#undef PG8_STAGE
#undef PG8_LDA
#undef PG8_LDB
#undef PG8_MMA
#undef PG8_WAIT_V
#undef PG8_WAIT_L
#undef PG8_BAR
#undef PG8_SCHED
}

__host__ __device__ __forceinline__ int perm256(int rho) { return 64 * ((rho >> 5) & 3) + 16 * ((rho >> 2) & 3) + 8 * (rho >> 7) + 4 * ((rho >> 4) & 1) + (rho & 3); }
#define EPI_ROWS_BEGIN _Pragma("unroll") for (int ai = 0; ai < 2; ++ai) _Pragma("unroll") for (int m = 0; m < 4; ++m) { asm volatile("" ::: "memory"); const int row = u.pm * BM + ai * HALF + wr * 64 + m * 16 + fr;
#define EPI_ROWS_END }
#define EPI_LOOP_BEGIN EPI_ROWS_BEGIN _Pragma("unroll") for (int bj = 0; bj < 2; ++bj) { const int cg = u.pn * BM + bj * HALF + wc * 32;
#define EPI_LOOP_END } }
__device__ __forceinline__ uint4 pack8(const f32x4 a, const f32x4 b) { uint4 p; p.x = pack2(a[0], a[1]); p.y = pack2(a[2], a[3]); p.z = pack2(b[0], b[1]); p.w = pack2(b[2], b[3]); return p; }

struct EpiBf16Plain {
    bf16_t* O; int ldo;
    __device__ __forceinline__ void operator()(const f32x4 (&acc)[2][2][4][2], const Unit& u, int wr, int wc, int fr, int fq) const {
        EPI_ROWS_BEGIN
            uint4* p = (uint4*)(O + (size_t)row * ldo + u.pn * BM + 64 * wc + 16 * fq);
            p[0] = pack8(acc[ai][0][m][0], acc[ai][0][m][1]); p[1] = pack8(acc[ai][1][m][0], acc[ai][1][m][1]);
        EPI_ROWS_END
    }
};
struct EpiSwiglu {
    bf16_t* O; int ldo;
    __device__ __forceinline__ void operator()(const f32x4 (&acc)[2][2][4][2], const Unit& u, int wr, int wc, int fr, int fq) const {
        EPI_ROWS_BEGIN
            f32x4 h0, h1;
#pragma unroll
            for (int i = 0; i < 4; ++i) { h0[i] = silu_f(acc[ai][0][m][0][i]) * acc[ai][0][m][1][i]; h1[i] = silu_f(acc[ai][1][m][0][i]) * acc[ai][1][m][1][i]; }
            *(uint4*)(O + (size_t)row * ldo + u.pn * 128 + 32 * wc + 8 * fq) = pack8(h0, h1);
        EPI_ROWS_END
    }
};
struct EpiSwigluF8 {
    unsigned char* O; int ldo;
    __device__ __forceinline__ void operator()(const f32x4 (&acc)[2][2][4][2], const Unit& u, int wr, int wc, int fr, int fq) const {
        constexpr float inv = 1.f / F8_WSCALE;
        EPI_ROWS_BEGIN
            float h[8];
#pragma unroll
            for (int i = 0; i < 4; ++i) { h[i] = silu_f(acc[ai][0][m][0][i] * inv) * (acc[ai][0][m][1][i] * (inv * F8_HSCALE)); h[4 + i] = silu_f(acc[ai][1][m][0][i] * inv) * (acc[ai][1][m][1][i] * (inv * F8_HSCALE)); }
#pragma unroll
            for (int i = 0; i < 8; ++i) h[i] = __builtin_amdgcn_fmed3f(h[i], -448.f, 448.f);
            uint2 p; p.x = pack4_fp8(h[0], h[1], h[2], h[3]); p.y = pack4_fp8(h[4], h[5], h[6], h[7]);
            *(uint2*)(O + (size_t)row * ldo + u.pn * 128 + 32 * wc + 8 * fq) = p;
        EPI_ROWS_END
    }
};
struct EpiMoeOut {
    bf16_t* MOUT; const uint2* RIW; float oscale;
    __device__ __forceinline__ void operator()(const f32x4 (&acc)[2][2][4][2], const Unit& u, int wr, int wc, int fr, int fq) const {
        EPI_ROWS_BEGIN
            const uint2 iw = RIW[row]; const int info = (int)iw.x; const float gw = __uint_as_float(iw.y) * oscale;
            if (info >= 0) { uint4* p = (uint4*)(MOUT + ((size_t)(info & 1) * TL + (size_t)(info >> 1)) * 1024 + u.pn * BM + 64 * wc + 16 * fq);
                p[0] = pack8(acc[ai][0][m][0] * gw, acc[ai][0][m][1] * gw); p[1] = pack8(acc[ai][1][m][0] * gw, acc[ai][1][m][1] * gw); }
        EPI_ROWS_END
    }
};
struct EpiXtr {
    bf16_t* MOUT; const uint2* RIW; bf16_t* XTR; int NTF, S; float oscale;
    __device__ __forceinline__ void operator()(const f32x4 (&acc)[2][2][4][2], const Unit& u, int wr, int wc, int fr, int fq) const {
        const bool k0 = (u.ks == 0); const int stride = k0 ? 1024 : 256;
        bf16_t* base = (k0 ? MOUT + u.pn * BM : XTR + (size_t)(((u.pm - NTF) * 4 + u.pn) * (S - 1) + (u.ks - 1)) * 65536) + 64 * wc + 16 * fq;
        EPI_ROWS_BEGIN
            const uint2 iw = RIW[row]; const int info = (int)iw.x; const float gw = __uint_as_float(iw.y) * oscale;
            const int ridx = k0 ? ((info & 1) * TL + (info >> 1)) : (row & 255);
            if (info >= 0 || !k0) { uint4* p = (uint4*)(base + (size_t)ridx * stride); p[0] = pack8(acc[ai][0][m][0] * gw, acc[ai][0][m][1] * gw); p[1] = pack8(acc[ai][1][m][0] * gw, acc[ai][1][m][1] * gw); }
        EPI_ROWS_END
    }
};
struct EpiTailBf16 {
    bf16_t* O; int ldo; bf16_t* XT; int NTF, S;
    __device__ __forceinline__ void operator()(const f32x4 (&acc)[2][2][4][2], const Unit& u, int wr, int wc, int fr, int fq) const {
        const bool k0 = (u.ks == 0); const int stride = k0 ? ldo : 256;
        bf16_t* base = (k0 ? O + u.pn * BM : XT + (size_t)(((u.pm - NTF) * 4 + u.pn) * (S - 1) + (u.ks - 1)) * 65536) + 64 * wc + 16 * fq;
        EPI_ROWS_BEGIN
            uint4* p = (uint4*)(base + (size_t)(k0 ? row : (row & 255)) * stride);
            p[0] = pack8(acc[ai][0][m][0], acc[ai][0][m][1]); p[1] = pack8(acc[ai][1][m][0], acc[ai][1][m][1]);
        EPI_ROWS_END
    }
};
template <int S> struct DenseTailOrder {
    int NTF, nsub, nkt, G, c;
    __device__ __forceinline__ void init(int NTF_, int NTT, int nkt_full, int G_, int c_) { NTF = NTF_; nsub = NTT * 4 * S; int k = nkt_full / S; asm volatile("" : "+s"(k)); nkt = k; G = G_; c = c_; }
    __device__ __forceinline__ bool next(int i, Unit& u) const {
        const int L = i * G + c; if (L >= nsub) return false;
        const int tu = L / S, ks = L - tu * S; u.pm = NTF + (tu >> 2); u.pn = tu & 3; u.e = 0; u.nkt = nkt; u.kt0 = ks * nkt; u.ks = ks; return true;
    }
};
struct EpiQ {
    bf16_t* QM; const float* SQ; const float* cosT; const float* sinT; float qscale;
    __device__ __forceinline__ void operator()(const f32x4 (&acc)[2][2][4][2], const Unit& u, int wr, int wc, int fr, int fq) const {
        EPI_LOOP_BEGIN
            const float s = SQ[row] * qscale; f32x4 v0 = acc[ai][bj][m][0] * s, v1 = acc[ai][bj][m][1] * s;
            if ((cg % 96) == 64) { const int pos = row & (SEQ - 1); const f32x4 c = *(const f32x4*)(cosT + pos * 16 + 4 * fq), sn = *(const f32x4*)(sinT + pos * 16 + 4 * fq);
                const f32x4 o0 = v0 * c - v1 * sn, o1 = v1 * c + v0 * sn; v0 = o0; v1 = o1; }
            uint2 p; p.x = pack2(v0[0], v0[1]); p.y = pack2(v0[2], v0[3]); *(uint2*)(QM + (size_t)row * 768 + cg + 4 * fq) = p;
            p.x = pack2(v1[0], v1[1]); p.y = pack2(v1[2], v1[3]); *(uint2*)(QM + (size_t)row * 768 + cg + 16 + 4 * fq) = p;
        EPI_LOOP_END
    }
};
struct EpiK {
    bf16_t* KM; const float* SKV;
    __device__ __forceinline__ void operator()(const f32x4 (&acc)[2][2][4][2], const Unit& u, int wr, int wc, int fr, int fq) const {
        EPI_ROWS_BEGIN
            const float s = SKV[row]; const int b = row < TL ? (row >> 11) : ((row - TL) >> 8), key = row < TL ? CTXL + (row & (SEQ - 1)) : ((row - TL) & (CTXL - 1));
            const int c = u.pn * BM + 64 * wc + 16 * fq, h = c >> 6, d = c & 63;
            uint4* p = (uint4*)(KM + ((size_t)b * NKEY + key) * 768 + h * 96 + d);
            p[0] = pack8(acc[ai][0][m][0] * s, acc[ai][0][m][1] * s); p[1] = pack8(acc[ai][1][m][0] * s, acc[ai][1][m][1] * s);
        EPI_ROWS_END
    }
};
struct EpiVT {
    bf16_t* VT; const float* SKV;
    __device__ __forceinline__ void operator()(const f32x4 (&acc)[2][2][4][2], const Unit& u, int wr, int wc, int fr, int fq) const {
        EPI_LOOP_BEGIN
#pragma unroll
            for (int n = 0; n < 2; ++n) { const int tok = cg + 16 * n + 4 * fq; const f32x4 s = *(const f32x4*)(SKV + tok); const f32x4 v = acc[ai][bj][m][n] * s;
                const int b = tok < TL ? (tok >> 11) : ((tok - TL) >> 8), key = tok < TL ? CTXL + (tok & (SEQ - 1)) : ((tok - TL) & (CTXL - 1));
                uint2 p; p.x = pack2(v[0], v[1]); p.y = pack2(v[2], v[3]); *(uint2*)(VT + ((size_t)b * 512 + row) * NKEY + key) = p; }
        EPI_LOOP_END
    }
};
}


#define XB_TMO      128
#define XB_XCNT(j)  (256  + 64 * (j))
#define XB_XSUB(j)  (1280 + 64 * (j))
#define XB_XGEN(j)  (2304 + 64 * (j))
#define XB_TOP      3328
#define XB_TOPGEN   3392
#define XCD_BAR_WORDS 3456
#define XB_SPIN_CAP (1u << 18)
__device__ __forceinline__ unsigned xb_ld(unsigned* p)              { return __hip_atomic_load(p, __ATOMIC_RELAXED, __HIP_MEMORY_SCOPE_AGENT); }
__device__ __forceinline__ unsigned xb_add(unsigned* p, unsigned v) { return __hip_atomic_fetch_add(p, v, __ATOMIC_RELAXED, __HIP_MEMORY_SCOPE_AGENT); }
__device__ __forceinline__ unsigned xb_xcc_id() { return (unsigned)__builtin_amdgcn_s_getreg((3 << 11) | 20) & 0xFu; }
#define XB_SPIN(cond, bar) do { unsigned _sp = 0; while (cond) { __builtin_amdgcn_s_sleep(1); \
    if ((++_sp & 255u) == 0u) { if (xb_ld(&(bar)[XB_TMO])) break; if (_sp > XB_SPIN_CAP) { atomicAdd(&(bar)[XB_TMO], 1u); break; } } } } while (0)
struct XcdBarrier { unsigned* bar; unsigned x; volatile LAS unsigned* st; };
__device__ __forceinline__ XcdBarrier xcd_barrier_post(unsigned* bar, volatile LAS unsigned* st) {
    XcdBarrier b; b.bar = bar; b.x = xb_xcc_id(); b.st = st;
    if (threadIdx.x == 0) (void)xb_add(&bar[XB_XCNT(b.x)], 1u);
    return b;
}
__device__ __forceinline__ void xcd_barrier_complete(unsigned* bar, unsigned x, unsigned& nloc, unsigned& nx) {
    const unsigned G = gridDim.x * gridDim.y * gridDim.z;
    unsigned sum, cnt, mine, sp = 0u;
    for (;;) {
        sum = 0u; cnt = 0u; mine = 0u;
#pragma unroll
        for (unsigned j = 0; j < 16; ++j) { const unsigned c = xb_ld(&bar[XB_XCNT(j)]); sum += c; cnt += (c > 0u) ? 1u : 0u; mine = (j == x) ? c : mine; }
        if (sum == G) break;
        __builtin_amdgcn_s_sleep(1);
        if ((++sp & 255u) == 0u) { if (xb_ld(&bar[XB_TMO])) break; if (sp > XB_SPIN_CAP) { atomicAdd(&bar[XB_TMO], 1u); break; } }
    }
    nloc = mine > 0u ? mine : 1u; nx = cnt > 0u ? cnt : 1u;
}
__device__ __forceinline__ void xcd_barrier(const XcdBarrier& b) {
    asm volatile("s_waitcnt vmcnt(0)" ::: "memory");
    __syncthreads();
    if (threadIdx.x == 0) {
        unsigned* bar = b.bar;
        __builtin_amdgcn_s_waitcnt(0);
        unsigned nloc = b.st[0], nx = b.st[1];
        if (nloc == 0u) { xcd_barrier_complete(bar, b.x, nloc, nx); b.st[0] = nloc; b.st[1] = nx; }
        const unsigned old = xb_add(&bar[XB_XSUB(b.x)], 1u);
        const unsigned gen = old / nloc;
        if (old + 1u == (gen + 1u) * nloc) {
            __builtin_amdgcn_fence(__ATOMIC_RELEASE, "agent");
            asm volatile("s_waitcnt vmcnt(0)" ::: "memory");
            const unsigned og = xb_add(&bar[XB_TOP], 1u);
            const unsigned tg = og / nx;
            if (og + 1u == (tg + 1u) * nx) xb_add(&bar[XB_TOPGEN], 1u);
            else XB_SPIN(xb_ld(&bar[XB_TOPGEN]) == tg, bar);
            __builtin_amdgcn_fence(__ATOMIC_ACQUIRE, "agent");
            xb_add(&bar[XB_XGEN(b.x)], 1u);
            asm volatile("s_waitcnt vmcnt(0)" ::: "memory");
        } else {
            XB_SPIN(xb_ld(&bar[XB_XGEN(b.x)]) == gen, bar);
            __builtin_amdgcn_fence(__ATOMIC_ACQUIRE, "agent");
            asm volatile("s_waitcnt vmcnt(0)" ::: "memory");
        }
    }
    __syncthreads();
}

struct Args { const float* in[41]; float* out; unsigned char* ws; int ph_lo, ph_hi, ex, pad; };
enum { I_X = 0, I_C, I_CTX, I_CCTX, I_ADAW, I_ADAB, I_MIXPRE, I_MIXPOST, I_FFNPRE, I_FFNPOST, I_EVWIN, I_HYCW, I_HYCB, I_FW1, I_FB1, I_FW2, I_FB2, I_FW3, I_FREQ, I_HYBIAS,
       I_SCW, I_SCB, I_DTB, I_ALOG, I_SSMD, I_SSMNG, I_EVWOUT, I_FFNG, I_FFNU, I_FFND, I_ODWIN, I_QNG, I_QUP, I_KVNG, I_KVUP, I_SINK, I_ODWOUT, I_ROUTER, I_MOEG, I_MOEU, I_MOED };

struct Fr {
    const float* const* in; float* out; unsigned char* ws; unsigned char* lds; int tid, lane, wave, G, bid;
    template <class T> __device__ __forceinline__ T* w(size_t off) const { return (T*)(ws + off); }
};

__device__ __forceinline__ int colmap(int mode, int perm, int r, int nsrc, int& which) {
    which = 0;
    if (mode == 1) { const int tile = r >> 8, rho = r & 255, bj = rho >> 7, wc = (rho >> 5) & 3, n = (rho >> 4) & 1, fq = (rho >> 2) & 3, i = rho & 3; which = n; return 128 * tile + 32 * wc + 8 * fq + 4 * bj + i; }
    const int c = perm ? ((r & ~255) + pg8::perm256(r & 255)) : r;
    if (mode == 0) return c < nsrc ? c : -1;
    return (c >> 6) * 128 + (c & 63) + (mode == 3 ? 64 : 0);
}
__device__ __forceinline__ void cvt_job(const Fr& F, const float* srcA, const float* srcB, const float* kscale, bf16_t* dst, int nrows, int kdst, int ksrc, int ldsrc, int nsrc, int mode, int perm, int boff) {
    float* tile = (float*)F.lds;
    const int nrt = nrows / 256, ntiles = nrt * (kdst / 64);
    const int kk = F.tid >> 6, rq = F.tid & 63;
    float4 v[8];
#define CVT_LOAD(t) do { const int r0 = ((t) % nrt) * 256, k0 = ((t) / nrt) * 64; int which; const int col = colmap(mode, perm, r0 + rq * 4, nsrc, which); const float* src = which ? srcB : srcA; \
        _Pragma("unroll") for (int p = 0; p < 8; ++p) { const int k = k0 + p * 8 + kk; v[p] = make_float4(0.f, 0.f, 0.f, 0.f); \
            if (col >= 0 && k < ksrc) { v[p] = *(const float4*)(src + (size_t)k * ldsrc + col); if (kscale) { const float ks = kscale[k]; v[p].x *= ks; v[p].y *= ks; v[p].z *= ks; v[p].w *= ks; } } } } while (0)
    int t = (F.bid + F.G - (boff % F.G)) % F.G;
    if (t < ntiles) CVT_LOAD(t);
    while (t < ntiles) {
        const int r0 = (t % nrt) * 256, k0 = (t / nrt) * 64;
        __syncthreads();
#pragma unroll
        for (int p = 0; p < 8; ++p) *(float4*)(tile + (p * 8 + kk) * 260 + rq * 4) = v[p];
        const int tn = t + F.G;
        if (tn < ntiles) CVT_LOAD(tn);
        __syncthreads();
        { const int r2 = F.tid >> 1, kq = F.tid & 1; const float* tp = tile + (kq * 32) * 260 + r2; uint4* dp = (uint4*)(dst + (size_t)(r0 + r2) * kdst + k0 + kq * 32);
#pragma unroll
          for (int q = 0; q < 4; ++q) { uint4 o; o.x = pack2(tp[(8 * q + 0) * 260], tp[(8 * q + 1) * 260]); o.y = pack2(tp[(8 * q + 2) * 260], tp[(8 * q + 3) * 260]);
              o.z = pack2(tp[(8 * q + 4) * 260], tp[(8 * q + 5) * 260]); o.w = pack2(tp[(8 * q + 6) * 260], tp[(8 * q + 7) * 260]); dp[q] = o; } }
        t = tn;
    }
#undef CVT_LOAD
    __syncthreads();
}

constexpr int CVT_T_GU = 28 * 16, CVT_T_DN = 4 * 56, CVT_T_E = CVT_T_GU + CVT_T_DN, CVT_T_ALL = NEXP * CVT_T_E;
__device__ __forceinline__ void cvt_moe_range(const Fr& F, int g_begin, int g_end, int rank, int stride) {
    float* tile = (float*)F.lds;
    const int kk = F.tid >> 6, rq = F.tid & 63;
    float4 va[8], vb[8];
#define CVM_DECODE(g) const int _e = (g) / CVT_T_E, _r = (g) % CVT_T_E; const bool _gu = _r < CVT_T_GU; const int _rr = _gu ? _r : _r - CVT_T_GU; \
        const int _nkt = _gu ? 16 : 56; const int k0 = (_rr % _nkt) * 64, r0 = (_rr / _nkt) * 256;     const int ldsrc = _gu ? DFE : 1024, kdst = _gu ? 1024 : DFE; \
        const float* srcA = _gu ? F.in[I_MOEG] + (size_t)_e * 1024 * DFE : F.in[I_MOED] + (size_t)_e * DFE * 1024; const float* srcB = F.in[I_MOEU] + (size_t)_e * 1024 * DFE; \
        unsigned char* dst = _gu ? F.w<unsigned char>(WM_GU) + (size_t)_e * 2 * DFE * 1024 * (MOE_FP8 ? 1 : 2) : F.w<unsigned char>(WM_DN) + (size_t)_e * 1024 * DFE * (MOE_FP8 ? 1 : 2);
#define CVM_LOAD(g, v) do { CVM_DECODE(g) (void)dst; (void)kdst; int which; const int col = colmap(_gu ? 1 : 0, 1, r0 + rq * 4, _gu ? DFE : 1024, which); const float* src = which ? srcB : srcA; \
        _Pragma("unroll") for (int p = 0; p < 8; ++p) { const int k = k0 + p * 8 + kk; v[p] = *(const float4*)(src + (size_t)k * ldsrc + col); } } while (0)
#define CVM_STEP(g, v) do { __syncthreads(); \
        _Pragma("unroll") for (int p = 0; p < 8; ++p) { float4 _t; _t.x = v[p].x; _t.y = v[p].y; _t.z = v[p].z; _t.w = v[p].w; *(float4*)(tile + (p * 8 + kk) * 260 + rq * 4) = _t; } \
        if ((g) + 2 * stride < g_end) CVM_LOAD((g) + 2 * stride, v); \
        __syncthreads(); \
        { CVM_DECODE(g) (void)srcA; (void)srcB; (void)ldsrc; const int r2 = F.tid >> 1, kq = F.tid & 1; const float* tp = tile + (kq * 32) * 260 + r2; \
          if (MOE_FP8) { uint4* dp = (uint4*)(dst + (size_t)(r0 + r2) * kdst + k0 + kq * 32); \
            _Pragma("unroll") for (int q = 0; q < 2; ++q) { uint4 o; \
              o.x = pack4_fp8(tp[(16 * q + 0) * 260] * F8_WSCALE, tp[(16 * q + 1) * 260] * F8_WSCALE, tp[(16 * q + 2) * 260] * F8_WSCALE, tp[(16 * q + 3) * 260] * F8_WSCALE); \
              o.y = pack4_fp8(tp[(16 * q + 4) * 260] * F8_WSCALE, tp[(16 * q + 5) * 260] * F8_WSCALE, tp[(16 * q + 6) * 260] * F8_WSCALE, tp[(16 * q + 7) * 260] * F8_WSCALE); \
              o.z = pack4_fp8(tp[(16 * q + 8) * 260] * F8_WSCALE, tp[(16 * q + 9) * 260] * F8_WSCALE, tp[(16 * q + 10) * 260] * F8_WSCALE, tp[(16 * q + 11) * 260] * F8_WSCALE); \
              o.w = pack4_fp8(tp[(16 * q + 12) * 260] * F8_WSCALE, tp[(16 * q + 13) * 260] * F8_WSCALE, tp[(16 * q + 14) * 260] * F8_WSCALE, tp[(16 * q + 15) * 260] * F8_WSCALE); dp[q] = o; } } \
          else { uint4* dp = (uint4*)(dst + ((size_t)(r0 + r2) * kdst + k0 + kq * 32) * 2); \
          _Pragma("unroll") for (int q = 0; q < 4; ++q) { uint4 o; o.x = pack2(tp[(8 * q + 0) * 260], tp[(8 * q + 1) * 260]); o.y = pack2(tp[(8 * q + 2) * 260], tp[(8 * q + 3) * 260]); \
              o.z = pack2(tp[(8 * q + 4) * 260], tp[(8 * q + 5) * 260]); o.w = pack2(tp[(8 * q + 6) * 260], tp[(8 * q + 7) * 260]); dp[q] = o; } } } } while (0)
    int g = g_begin + rank;
    if (g < g_end) CVM_LOAD(g, va);
    if (g + stride < g_end) CVM_LOAD(g + stride, vb);
    while (g < g_end) {
        CVM_STEP(g, va);
        g += stride; if (g >= g_end) break;
        CVM_STEP(g, vb);
        g += stride;
    }
#undef CVM_STEP
#undef CVM_LOAD
#undef CVM_DECODE
    __syncthreads();
}
__device__ __forceinline__ void cvt_fill(const Fr& F, int nwg, int quota, int g0) {
    const int R = (nwg + F.G - 1) / F.G, first_short = nwg - (R - 1) * F.G, nshort = R * F.G - nwg;
    if (F.bid >= first_short) { const int g_end = g0 + nshort * quota; cvt_moe_range(F, g0, g_end < CVT_T_ALL ? g_end : CVT_T_ALL, F.bid - first_short, nshort); }
}
constexpr int CVQ8 = 0, CVQ10 = 7, CVQ11 = 0, CVQ13 = 7;
constexpr int NWG8 = (TT / 256) * 4, NWG10 = (TT / 256) * (2 * DFF / 256), NWG11 = NWG8, NWG13 = (TT / 256) * (ODD_PAD / 256);
__device__ __forceinline__ int cvt_nshort(int nwg, int G) { return ((nwg + G - 1) / G) * G - nwg; }
__device__ __forceinline__ int cvt_g0(int G, int phase) {
    int g = 0; if (phase > 8) g += cvt_nshort(NWG8, G) * CVQ8; if (phase > 10) g += cvt_nshort(NWG10, G) * CVQ10; if (phase > 11) g += cvt_nshort(NWG11, G) * CVQ11; if (phase > 13) g += cvt_nshort(NWG13, G) * CVQ13;
    return g < CVT_T_ALL ? g : CVT_T_ALL;
}

__device__ __forceinline__ void ph_ada(const Fr& F) {
    float* sc = (float*)F.lds;
    float* part = sc + 9 * 1024;
    for (int i = F.tid; i < 9 * 1024; i += NTHR) { const int r = i >> 10, k = i & 1023; const float v = r < 8 ? F.in[I_C][r * 1024 + k] : F.in[I_CCTX][k]; sc[i] = silu_f(v); }
    __syncthreads();
    float* MOD = F.w<float>(WS_MOD);
    for (int un = F.bid; un < 2 * 6144 / 64; un += F.G) {
        const int j = un * 64 + F.lane, l = j / 6144, jj = j % 6144; const float* wp = F.in[I_ADAW] + (size_t)l * 1024 * 6144 + (size_t)(F.wave * 128) * 6144 + jj;
        float acc[9];
#pragma unroll
        for (int r = 0; r < 9; ++r) acc[r] = 0.f;
#pragma unroll 16
        for (int k = 0; k < 128; ++k) { const float wv = wp[(size_t)k * 6144];
#pragma unroll
            for (int r = 0; r < 9; ++r) acc[r] += sc[r * 1024 + F.wave * 128 + k] * wv; }
#pragma unroll
        for (int r = 0; r < 9; ++r) part[(F.wave * 9 + r) * 64 + F.lane] = acc[r];
        __syncthreads();
        for (int o = F.tid; o < 9 * 64; o += NTHR) { const int r = o >> 6, cix = o & 63; float sum = 0.f;
#pragma unroll
            for (int w2 = 0; w2 < 8; ++w2) sum += part[(w2 * 9 + r) * 64 + cix];
            const int j2 = un * 64 + cix, l2 = j2 / 6144, jj2 = j2 % 6144; MOD[(size_t)(l2 * 9 + r) * 6144 + jj2] = sum + F.in[I_ADAB][l2 * 6144 + jj2]; }
        __syncthreads();
    }
}
__device__ __forceinline__ void ph_filters(const Fr& F) {
    constexpr int NPB = 12;
    float* w1s = (float*)F.lds;
    float* w2s = w1s + 33 * 64;
    float* zs = w2s + 64 * 64;
    float* h1 = zs + NPB * 36;
    float* h2 = h1 + NPB * 64;
    const float* w3 = F.in[I_FW3]; const float* fqv = F.in[I_FREQ]; const float* hb = F.in[I_HYBIAS];
    for (int i = F.tid; i < 33 * 64; i += NTHR) w1s[i] = F.in[I_FW1][i];
    for (int i = F.tid; i < 64 * 64; i += NTHR) w2s[i] = F.in[I_FW2][i];
    const int total = SEQ + CTXL; int np = 0; for (int it = F.bid; it < total && np < NPB; it += F.G) ++np;
    for (int i = F.tid; i < np * 33; i += NTHR) { const int pi = i / 33, zi = i % 33, item = F.bid + pi * F.G; const int n = item < SEQ ? SEQ : CTXL, pos = item < SEQ ? item : item - SEQ;
        const float fpos = (float)pos, t = fpos / (float)(n - 1), omega = (6.283185307179586f * fpos) / (float)n; float v;
        if (zi == 0) v = t; else { const int bi = (zi - 1) & 15; const float band = 1e-4f + (float)bi * ((15.f - 1e-4f) / 15.f); const float a = omega * band; v = (zi <= 16) ? cosf(a) : -sinf(a); }
        zs[pi * 36 + zi] = v; }
    __syncthreads();
    for (int i = F.tid; i < np * 64; i += NTHR) { const int pi = i >> 6, j = i & 63; float a = F.in[I_FB1][j]; for (int k = 0; k < 33; ++k) a += zs[pi * 36 + k] * w1s[k * 64 + j]; h1[i] = sinf(fqv[j] * a); }
    __syncthreads();
    for (int i = F.tid; i < np * 64; i += NTHR) { const int pi = i >> 6, j = i & 63; float a = F.in[I_FB2][j]; for (int k = 0; k < 64; ++k) a += h1[pi * 64 + k] * w2s[k * 64 + j]; h2[i] = sinf(fqv[j] * a); }
    __syncthreads();
#pragma unroll 1
    for (int oo = 0; oo < 2; ++oo) { const int o = F.tid + 512 * oo; float acc[NPB];
#pragma unroll
        for (int pi = 0; pi < NPB; ++pi) acc[pi] = 0.f;
        for (int k = 0; k < 64; ++k) { const float wv = w3[k * 1024 + o];
#pragma unroll
            for (int pi = 0; pi < NPB; ++pi) acc[pi] += h2[pi * 64 + k] * wv; }
        const int dir = o >> 9, c = o & 511; const float a0 = -3.0701134573253945f, b0 = -15.350567286626973f; const float delta = fabsf(a0 + (float)c * ((b0 - a0) / 511.f));
#pragma unroll
        for (int pi = 0; pi < NPB; ++pi) if (pi < np) { const int item = F.bid + pi * F.G; const int n = item < SEQ ? SEQ : CTXL, pos = item < SEQ ? item : item - SEQ; const float t = (float)pos / (float)(n - 1);
            bf16_t* Rd = (n == SEQ) ? F.w<bf16_t>(L0_FL) : F.w<bf16_t>(L0_FC); const int n2 = 2 * n; const float val = acc[pi] * expf(-t * delta);
            if (dir == 0) Rd[(size_t)c * n2 + (n - pos)] = f2bf(val + (pos == 0 ? hb[c] : 0.f)); else if (pos > 0) Rd[(size_t)c * n2 + (n + pos)] = f2bf(val); }
    }
    __syncthreads();
}
__device__ __forceinline__ void ph_rope_tables(const Fr& F) {
    float* cm = F.w<float>(WS_ROPEM); float* sm = cm + 2048 * 16; float* cgq = F.w<float>(WS_ROPEG); float* sg = cgq + 2048 * 32;
    for (int idx = F.bid * NTHR + F.tid; idx < 2048 * 16; idx += F.G * NTHR) { const int pos = idx >> 4, i = idx & 15; const float inv = powf(10000.f, -(float)(i & 7) / 8.f);
        const float p = (i < 8) ? (float)(pos >> 6) : (float)(pos & 63); const float ang = p * inv; cm[idx] = cosf(ang); sm[idx] = sinf(ang); }
    for (int idx = F.bid * NTHR + F.tid; idx < 2048 * 32; idx += F.G * NTHR) { const int pos = idx >> 5, i = idx & 31; const float inv = powf(10000.f, -(float)(i & 15) / 16.f);
        const float p = (i < 16) ? (float)(pos >> 6) : (float)(pos & 63); const float ang = p * inv; cgq[idx] = cosf(ang); sg[idx] = sinf(ang); }
}

__device__ __forceinline__ void store_bf16x4(bf16_t* p, float4 v) { uint2 q; q.x = pack2(v.x, v.y); q.y = pack2(v.z, v.w); *(uint2*)p = q; }
__device__ __forceinline__ float4 ld4(const float* p) { return *(const float4*)p; }
__device__ __forceinline__ float sumsq4(const float4 (&v)[4]) { float s = 0.f;
#pragma unroll
    for (int i = 0; i < 4; ++i) s += v[i].x * v[i].x + v[i].y * v[i].y + v[i].z * v[i].z + v[i].w * v[i].w;
    return s; }

__device__ __forceinline__ void ph_norm0(const Fr& F) {
    const float* g = F.in[I_MIXPRE]; const float* MOD = F.w<float>(WS_MOD); bf16_t* A = F.w<bf16_t>(WS_ABUF);
    const int RPW = (TT + F.G * 8 - 1) / (F.G * 8); const int rbeg = (F.bid * 8 + F.wave) * RPW, rend = (rbeg + RPW < TT) ? rbeg + RPW : TT;
    float4 gv[4], shv[4], scv[4]; int mr_cur = -1;
#pragma unroll
    for (int i = 0; i < 4; ++i) gv[i] = ld4(g + 4 * (F.lane + 64 * i));
    for (int row0 = rbeg; row0 < rend; row0 += 2) {
        const int row1 = row0 + 1; const bool has1 = row1 < rend; const int r1 = has1 ? row1 : row0;
        const float* s0 = row0 < TL ? F.in[I_X] + (size_t)row0 * 1024 : F.in[I_CTX] + (size_t)(row0 - TL) * 1024; const float* s1 = r1 < TL ? F.in[I_X] + (size_t)r1 * 1024 : F.in[I_CTX] + (size_t)(r1 - TL) * 1024;
        float4 v0[4], v1[4];
#pragma unroll
        for (int i = 0; i < 4; ++i) { v0[i] = ld4(s0 + 4 * (F.lane + 64 * i)); v1[i] = ld4(s1 + 4 * (F.lane + 64 * i)); }
        const float q0 = rsqrtf(wave_sum(sumsq4(v0)) * (1.f / 1024.f) + EPS), q1 = rsqrtf(wave_sum(sumsq4(v1)) * (1.f / 1024.f) + EPS);
#pragma unroll
        for (int rr = 0; rr < 2; ++rr) { if (rr && !has1) break; const int row = rr ? row1 : row0; const int mr = row < TL ? (row >> 11) : 8; const float r = rr ? q1 : q0;
            if (mr != mr_cur) { mr_cur = mr;
#pragma unroll
                for (int i = 0; i < 4; ++i) { const int c = 4 * (F.lane + 64 * i); shv[i] = ld4(MOD + (size_t)mr * 6144 + c); scv[i] = ld4(MOD + (size_t)mr * 6144 + 1024 + c); } }
#pragma unroll
            for (int i = 0; i < 4; ++i) { const int c = 4 * (F.lane + 64 * i); const float4 gg = gv[i], sh = shv[i], sc = scv[i]; const float4 v = rr ? v1[i] : v0[i];
                float4 o; o.x = v.x * r * gg.x * (1.f + sc.x) + sh.x; o.y = v.y * r * gg.y * (1.f + sc.y) + sh.y; o.z = v.z * r * gg.z * (1.f + sc.z) + sh.z; o.w = v.w * r * gg.w * (1.f + sc.w) + sh.w;
                store_bf16x4(A + (size_t)row * 1024 + c, o); } }
    }
}
template <int MODE, bool SRCF32, bool DSTF32>
__device__ __forceinline__ void ph_thin(const Fr& F, const float* msrc, int nrows, const float* hs_lat, const float* hs_ctx, float* hd_lat, float* hd_ctx,
                        const float* postg, const float* MODg, int gate_off, const float* preg, const float* MODn, int sh_off, int sc_off, bf16_t* adst, int xNTF = 0, int xS = 1, const bf16_t* xt2 = nullptr, int xS2 = 1) {
    float* rt = (float*)F.lds;
    int* cntL = (int*)(F.lds + 32768);
    int* blkBase = cntL + 8;
    int* selInfo = cntL + 16;
    if (MODE == 1) { for (int i = F.tid; i < 1024 * 8; i += NTHR) rt[(i & 7) * 1024 + (i >> 3)] = F.in[I_ROUTER][i]; if (F.tid < 8) cntL[F.tid] = 0; __syncthreads(); }
    int li = F.wave;
#define THIN_LOAD(row, m, h) do { \
        const float* hs = SRCF32 ? ((row) < TL ? hs_lat + (size_t)(row) * 1024 : hs_ctx + (size_t)((row) - TL) * 1024) : nullptr; const bf16_t* hbs = F.w<bf16_t>(WS_HB) + (size_t)(row) * 1024; \
        int tail0 = -1, tail1 = -1; \
        if (MODE == 2 && xS > 1) { const int2 sr = *(const int2*)(F.w<int>(WS_SROW) + (size_t)(row) * 2); const int r0 = __builtin_amdgcn_readfirstlane(sr.x), r1 = __builtin_amdgcn_readfirstlane(sr.y); \
            if ((r0 >> 8) >= xNTF) tail0 = r0 - xNTF * 256; if ((r1 >> 8) >= xNTF) tail1 = r1 - xNTF * 256; } \
        _Pragma("unroll") for (int i = 0; i < 4; ++i) { const int c = 4 * (F.lane + 64 * i); \
            if (SRCF32) h[i] = ld4(hs + c); else { const uint2 hv = *(const uint2*)(hbs + c); h[i].x = bflo(hv.x); h[i].y = bfhi(hv.x); h[i].z = bflo(hv.y); h[i].w = bfhi(hv.y); } \
            if (MODE == 2) { const bf16_t* mo = (const bf16_t*)msrc; const uint2 a = *(const uint2*)(mo + (size_t)(row) * 1024 + c), b = *(const uint2*)(mo + ((size_t)TL + (row)) * 1024 + c); \
                m[i].x = bflo(a.x) + bflo(b.x); m[i].y = bfhi(a.x) + bfhi(b.x); m[i].z = bflo(a.y) + bflo(b.y); m[i].w = bfhi(a.y) + bfhi(b.y); \
                if (tail0 >= 0) { const bf16_t* xp = F.w<bf16_t>(WS_XTR) + ((size_t)((tail0 >> 8) * 4 + i) * (xS - 1) * 256 + (tail0 & 255)) * 256 + (c & 255); \
                    for (int s2 = 0; s2 < xS - 1; ++s2) { const uint2 e = *(const uint2*)(xp + (size_t)s2 * 65536); m[i].x += bflo(e.x); m[i].y += bfhi(e.x); m[i].z += bflo(e.y); m[i].w += bfhi(e.y); } } \
                if (tail1 >= 0) { const bf16_t* xp = F.w<bf16_t>(WS_XTR) + ((size_t)((tail1 >> 8) * 4 + i) * (xS - 1) * 256 + (tail1 & 255)) * 256 + (c & 255); \
                    for (int s2 = 0; s2 < xS - 1; ++s2) { const uint2 e = *(const uint2*)(xp + (size_t)s2 * 65536); m[i].x += bflo(e.x); m[i].y += bfhi(e.x); m[i].z += bflo(e.y); m[i].w += bfhi(e.y); } } } \
            else { const uint2 a = *(const uint2*)((const bf16_t*)msrc + (size_t)(row) * 1024 + c); m[i].x = bflo(a.x); m[i].y = bfhi(a.x); m[i].z = bflo(a.y); m[i].w = bfhi(a.y); \
                if (MODE == 0 && xS2 > 1 && (row) >= TL) { \
                    const bf16_t* xp = xt2 + ((size_t)(((((row) - TL) >> 8) * 4 + i) * (xS2 - 1)) * 256 + ((row) & 255)) * 256 + (c & 255); \
                    for (int s2 = 0; s2 < xS2 - 1; ++s2) { const uint2 e = *(const uint2*)(xp + (size_t)s2 * 65536); m[i].x += bflo(e.x); m[i].y += bfhi(e.x); m[i].z += bflo(e.y); m[i].w += bfhi(e.y); } } } } } while (0)
    const int RPW = (nrows + F.G * 8 - 1) / (F.G * 8); int row = (F.bid * 8 + F.wave) * RPW; const int rend = (row + RPW < nrows) ? row + RPW : nrows;
    li = F.wave * RPW;
    float4 m[4], h[4], mN[4], hN[4], pgv[4], ggv[4], gtv[4], shv[4], scv[4]; int mr_cur = -1;
#pragma unroll
    for (int i = 0; i < 4; ++i) { const int c = 4 * (F.lane + 64 * i); pgv[i] = ld4(postg + c); if (MODE != 2) ggv[i] = ld4(preg + c); }
    if (row < rend) THIN_LOAD(row, m, h);
    for (; row < rend; ++row, ++li) {
        const int rown = row + 1;
        if (rown < rend) THIN_LOAD(rown, mN, hN);
        const int mr = row < TL ? (row >> 11) : 8;
        if (mr != mr_cur) { mr_cur = mr;
#pragma unroll
            for (int i = 0; i < 4; ++i) { const int c = 4 * (F.lane + 64 * i); gtv[i] = ld4(MODg + (size_t)mr * 6144 + gate_off + c);
                if (MODE != 2) { shv[i] = ld4(MODn + (size_t)mr * 6144 + sh_off + c); scv[i] = ld4(MODn + (size_t)mr * 6144 + sc_off + c); } } }
        float* hd = DSTF32 ? hd_lat + (size_t)row * 1024 : nullptr;
        bf16_t* hb = F.w<bf16_t>(WS_HB) + (size_t)row * 1024;
        const float r = rsqrtf(wave_sum(sumsq4(m)) * (1.f / 1024.f) + EPS);
#pragma unroll
        for (int i = 0; i < 4; ++i) { const int c = 4 * (F.lane + 64 * i); const float4 pg = pgv[i], gt = gtv[i];
            h[i].x += gt.x * (m[i].x * r * pg.x); h[i].y += gt.y * (m[i].y * r * pg.y); h[i].z += gt.z * (m[i].z * r * pg.z); h[i].w += gt.w * (m[i].w * r * pg.w);
            if (DSTF32) *(float4*)(hd + c) = h[i]; else store_bf16x4(hb + c, h[i]); }
        if (MODE != 2) {
        const float r2 = rsqrtf(wave_sum(sumsq4(h)) * (1.f / 1024.f) + EPS);
        float lg[8];
#pragma unroll
        for (int e = 0; e < 8; ++e) lg[e] = 0.f;
#pragma unroll
        for (int i = 0; i < 4; ++i) { const int c = 4 * (F.lane + 64 * i); const float4 gg = ggv[i], sh = shv[i], sc = scv[i];
            float4 o; o.x = h[i].x * r2 * gg.x * (1.f + sc.x) + sh.x; o.y = h[i].y * r2 * gg.y * (1.f + sc.y) + sh.y; o.z = h[i].z * r2 * gg.z * (1.f + sc.z) + sh.z; o.w = h[i].w * r2 * gg.w * (1.f + sc.w) + sh.w;
            store_bf16x4(adst + (size_t)row * 1024 + c, o);
            if (MODE == 1) {
#pragma unroll
                for (int e = 0; e < 8; ++e) { const float4 rv = *(const float4*)(rt + e * 1024 + c); lg[e] += o.x * rv.x + o.y * rv.y + o.z * rv.z + o.w * rv.w; } } }
        if (MODE == 1) {
#pragma unroll
            for (int e = 0; e < 8; ++e) lg[e] = wave_sum(lg[e]);
            int i1 = 0; float v1 = lg[0];
#pragma unroll
            for (int e = 1; e < 8; ++e) if (lg[e] > v1) { v1 = lg[e]; i1 = e; }
            int i2 = -1; float v2 = -3.0e38f;
#pragma unroll
            for (int e = 0; e < 8; ++e) if (e != i1 && lg[e] > v2) { v2 = lg[e]; i2 = e; }
            const float w1 = 1.f / (1.f + expf(v2 - v1)), w2 = 1.f - w1;
            if (F.lane == 0) { float* tw = F.w<float>(WS_TOPW) + (size_t)row * 2; tw[0] = w1; tw[1] = w2;
                const int r1 = atomicAdd(&cntL[i1], 1), r2i = atomicAdd(&cntL[i2], 1);
                selInfo[li * 2 + 0] = i1 | (r1 << 8); selInfo[li * 2 + 1] = i2 | (r2i << 8); }
        }
        }
#pragma unroll
        for (int i = 0; i < 4; ++i) { m[i] = mN[i]; h[i] = hN[i]; }
    }
#undef THIN_LOAD
    if (MODE == 1) {
        __syncthreads();
        if (F.tid < 8) blkBase[F.tid] = (int)__hip_atomic_fetch_add(F.w<unsigned>(WS_CNT) + F.tid, (unsigned)cntL[F.tid], __ATOMIC_RELAXED, __HIP_MEMORY_SCOPE_AGENT);
        __syncthreads();
        int* LISTE = F.w<int>(WS_LISTE);
        for (int idx = F.tid; idx < 16 * RPW; idx += NTHR) { const int l2 = idx >> 1, k = idx & 1; const int row = (F.bid * 8 + l2 / RPW) * RPW + l2 % RPW;
            if (row < nrows) { const int si = selInfo[idx], e = si & 255, rk = si >> 8; LISTE[(size_t)e * TL + blkBase[e] + rk] = row * 2 + k; } }
        __syncthreads();
    }
}
__device__ __forceinline__ void ph_moe_gather(const Fr& F) {
    const unsigned* cnt = F.w<unsigned>(WS_CNT); int ts[9]; ts[0] = 0;
#pragma unroll
    for (int e = 0; e < 8; ++e) ts[e + 1] = ts[e] + (int)((__hip_atomic_load(cnt + e, __ATOMIC_RELAXED, __HIP_MEMORY_SCOPE_AGENT) + 255u) >> 8);
    const int nrows = ts[8] * 256; const int* LISTE = F.w<int>(WS_LISTE); const float* TOPW = F.w<float>(WS_TOPW);
    const bf16_t* a2 = F.w<bf16_t>(L1_A2TMP); bf16_t* AG = F.w<bf16_t>(WS_AG); uint2* RIW = F.w<uint2>(WS_ROWINFO);
    const int RPW = (nrows + F.G * 8 - 1) / (F.G * 8), rbeg = (F.bid * 8 + F.wave) * RPW, rend = (rbeg + RPW < nrows) ? rbeg + RPW : nrows;
    int my_info = -1;
    { const int r = rbeg + F.lane;
      if (F.lane < RPW && r < rend) { const int j = r >> 8; int e = 0;
#pragma unroll
          for (int k = 1; k < 8; ++k) e += (j >= ts[k]) ? 1 : 0;
          int tse = ts[0];
#pragma unroll
          for (int k = 1; k < 8; ++k) tse = (e == k) ? ts[k] : tse;
          const int i = r - tse * 256; const int ce = (int)__hip_atomic_load(cnt + e, __ATOMIC_RELAXED, __HIP_MEMORY_SCOPE_AGENT); float w = 0.f;
          if (i < ce) { my_info = LISTE[(size_t)e * TL + i]; w = TOPW[my_info]; F.w<int>(WS_SROW)[my_info] = r; }
          RIW[r] = make_uint2((unsigned)my_info, __float_as_uint(w)); } }
    static_assert(MOE_FP8, "the gather below writes e4m3 rows");
    uint4 v0 = make_uint4(0u, 0u, 0u, 0u), v1 = v0, n0 = v0, n1 = v0;
    if (rbeg < rend) { const int info = __builtin_amdgcn_readlane(my_info, 0); if (info >= 0) { const uint4* src = (const uint4*)(a2 + (size_t)(info >> 1) * 1024 + F.lane * 16); v0 = src[0]; v1 = src[1]; } }
    for (int r = rbeg; r < rend; ++r) {
        n0 = make_uint4(0u, 0u, 0u, 0u); n1 = n0;
        if (r + 1 < rend) { const int info = __builtin_amdgcn_readlane(my_info, r + 1 - rbeg); if (info >= 0) { const uint4* src = (const uint4*)(a2 + (size_t)(info >> 1) * 1024 + F.lane * 16); n0 = src[0]; n1 = src[1]; } }
        uint4 o; o.x = pack4_fp8(bflo(v0.x), bfhi(v0.x), bflo(v0.y), bfhi(v0.y)); o.y = pack4_fp8(bflo(v0.z), bfhi(v0.z), bflo(v0.w), bfhi(v0.w));
        o.z = pack4_fp8(bflo(v1.x), bfhi(v1.x), bflo(v1.y), bfhi(v1.y)); o.w = pack4_fp8(bflo(v1.z), bfhi(v1.z), bflo(v1.w), bfhi(v1.w));
        *(uint4*)((unsigned char*)AG + (size_t)r * 1024 + F.lane * 16) = o;
        v0 = n0; v1 = n1;
    }
}
__device__ __forceinline__ void ld8bf(const bf16_t* p, float (&o)[8]) { const uint4 q = *(const uint4*)p; o[0] = bflo(q.x); o[1] = bfhi(q.x); o[2] = bflo(q.y); o[3] = bfhi(q.y); o[4] = bflo(q.z); o[5] = bfhi(q.z); o[6] = bflo(q.w); o[7] = bfhi(q.w); }
__device__ __forceinline__ void st8bf(bf16_t* p, const float (&v)[8]) { uint4 q; q.x = pack2(v[0], v[1]); q.y = pack2(v[2], v[3]); q.z = pack2(v[4], v[5]); q.w = pack2(v[6], v[7]); *(uint4*)p = q; }
struct CW { float w0[8], w1[8], w2[8], bb[8]; };
__device__ __forceinline__ void cw_load(CW& c, const float* w, const float* b, int wc, int wld) {
    const float4 a0 = ld4(w + wc), a1 = ld4(w + wc + 4), b0 = ld4(w + wld + wc), b1 = ld4(w + wld + wc + 4), c0 = ld4(w + 2 * wld + wc), c1 = ld4(w + 2 * wld + wc + 4), d0 = ld4(b + wc), d1 = ld4(b + wc + 4);
    c.w0[0] = a0.x; c.w0[1] = a0.y; c.w0[2] = a0.z; c.w0[3] = a0.w; c.w0[4] = a1.x; c.w0[5] = a1.y; c.w0[6] = a1.z; c.w0[7] = a1.w;
    c.w1[0] = b0.x; c.w1[1] = b0.y; c.w1[2] = b0.z; c.w1[3] = b0.w; c.w1[4] = b1.x; c.w1[5] = b1.y; c.w1[6] = b1.z; c.w1[7] = b1.w;
    c.w2[0] = c0.x; c.w2[1] = c0.y; c.w2[2] = c0.z; c.w2[3] = c0.w; c.w2[4] = c1.x; c.w2[5] = c1.y; c.w2[6] = c1.z; c.w2[7] = c1.w;
    c.bb[0] = d0.x; c.bb[1] = d0.y; c.bb[2] = d0.z; c.bb[3] = d0.w; c.bb[4] = d1.x; c.bb[5] = d1.y; c.bb[6] = d1.z; c.bb[7] = d1.w;
}
__device__ __forceinline__ void conv8(const bf16_t* prow, bool hasp, bool hasn, int pc, const CW& c, float (&o)[8]) {
    float xm[8], x0[8], xp[8]; ld8bf(prow + pc, x0);
    if (hasp) ld8bf(prow - EVEN_PAD + pc, xm); else {
#pragma unroll
        for (int j = 0; j < 8; ++j) xm[j] = 0.f; }
    if (hasn) ld8bf(prow + EVEN_PAD + pc, xp); else {
#pragma unroll
        for (int j = 0; j < 8; ++j) xp[j] = 0.f; }
#pragma unroll
    for (int j = 0; j < 8; ++j) o[j] = c.w0[j] * xm[j] + c.w1[j] * x0[j] + c.w2[j] * xp[j] + c.bb[j];
}
__device__ __forceinline__ void ph_convpass(const Fr& F) {
    const bf16_t* PROJ = F.w<bf16_t>(L0_PROJ); bf16_t* U = F.w<bf16_t>(L0_U); bf16_t* X0 = F.w<bf16_t>(L0_X0); bf16_t* XBC = F.w<bf16_t>(L0_XBC); float* DT = F.w<float>(L0_DT);
    const float* hw = F.in[I_HYCW]; const float* hb = F.in[I_HYCB]; const float* sw = F.in[I_SCW]; const float* sb = F.in[I_SCB]; const float* dtb = F.in[I_DTB];
    {
        const int c = F.lane * 8; CW cx0, cb0, cb1; cw_load(cx0, hw, hb, c, 1536); cw_load(cb0, sw, sb, c, 1024); cw_load(cb1, sw, sb, c + 512, 1024);
        const float dtbv = F.lane < 16 ? dtb[F.lane] : 0.f;
        for (int row = F.bid * 8 + F.wave; row < TT; row += F.G * 8) {
            const int t = row < TL ? (row & (SEQ - 1)) : ((row - TL) & (CTXL - 1)), n = row < TL ? SEQ : CTXL; const bool hasp = t > 0, hasn = t < n - 1;
            const bf16_t* prow = PROJ + (size_t)row * EVEN_PAD;
            float a0[8];
            conv8(prow, hasp, hasn, c, cx0, a0);
            st8bf(X0 + (size_t)row * 512 + c, a0);
            conv8(prow, hasp, hasn, 2048 + c, cb0, a0);
#pragma unroll
            for (int j = 0; j < 8; ++j) a0[j] = silu_f(a0[j]);
            st8bf(XBC + (size_t)row * 1024 + c, a0);
            conv8(prow, hasp, hasn, 2048 + 512 + c, cb1, a0);
#pragma unroll
            for (int j = 0; j < 8; ++j) a0[j] = silu_f(a0[j]);
            st8bf(XBC + (size_t)row * 1024 + 512 + c, a0);
            if (F.lane < 16) DT[(size_t)row * 16 + F.lane] = softplus_f(bf2f(prow[3072 + F.lane]) + dtbv);
        }
    }
    bf16_t* ut = (bf16_t*)F.lds;
    {   const int tok = F.tid >> 3, cq = F.tid & 7; const int cgp = F.bid & 3;
        CW c1a, c1b, cva, cvb; { const int ch = cgp * 128 + cq * 16; cw_load(c1a, hw, hb, 512 + ch, 1536); cw_load(c1b, hw, hb, 512 + ch + 8, 1536); cw_load(cva, hw, hb, 1024 + ch, 1536); cw_load(cvb, hw, hb, 1024 + ch + 8, 1536); }
        for (int un = F.bid; un < (TT / 64) * 4; un += F.G) {
            const int tile = un >> 2, row0 = tile * 64; const int row = row0 + tok;
            const int t = row < TL ? (row & (SEQ - 1)) : ((row - TL) & (CTXL - 1)), n = row < TL ? SEQ : CTXL; const bool hasp = t > 0, hasn = t < n - 1;
            const bf16_t* prow = PROJ + (size_t)row * EVEN_PAD; const int ch = cgp * 128 + cq * 16;
            { float a1[8], a2[8]; conv8(prow, hasp, hasn, 512 + ch, c1a, a1); conv8(prow, hasp, hasn, 1024 + ch, cva, a2);
#pragma unroll
              for (int j = 0; j < 8; ++j) ut[(cq * 16 + j) * 66 + tok] = f2bf(a1[j] * a2[j]);
              conv8(prow, hasp, hasn, 512 + ch + 8, c1b, a1); conv8(prow, hasp, hasn, 1024 + ch + 8, cvb, a2);
#pragma unroll
              for (int j = 0; j < 8; ++j) ut[(cq * 16 + 8 + j) * 66 + tok] = f2bf(a1[j] * a2[j]); }
            __syncthreads();
            { const int ch2 = F.tid >> 2, part = F.tid & 3; const int b = row0 < TL ? (row0 >> 11) : ((row0 - TL) >> 8), off = row0 < TL ? CTXL + (row0 & (SEQ - 1)) : ((row0 - TL) & (CTXL - 1));
              const unsigned* src = (const unsigned*)(ut + ch2 * 66 + part * 16); uint4 v0, v1; v0.x = src[0]; v0.y = src[1]; v0.z = src[2]; v0.w = src[3]; v1.x = src[4]; v1.y = src[5]; v1.z = src[6]; v1.w = src[7];
              uint4* dst = (uint4*)(U + ((size_t)(cgp * 128 + ch2) * 8 + b) * NKEY + off + part * 16); dst[0] = v0; dst[1] = v1; }
            __syncthreads();
        }
    }
}

__device__ __forceinline__ unsigned alignhalf(unsigned hi, unsigned lo) { return (lo >> 16) | (hi << 16); }
template <int RHO> __device__ __forceinline__ uint4 shift_copy(const uint4 prev, const uint4 cur) {
    const unsigned cc[8] = {prev.x, prev.y, prev.z, prev.w, cur.x, cur.y, cur.z, cur.w};
    constexpr int o = 16 - 2 * RHO, d0 = o / 4; uint4 r;
    if constexpr ((o & 3) == 0) { r.x = cc[d0]; r.y = cc[d0 + 1]; r.z = cc[d0 + 2]; r.w = cc[d0 + 3]; }
    else { r.x = alignhalf(cc[d0 + 1], cc[d0]); r.y = alignhalf(cc[d0 + 2], cc[d0 + 1]); r.z = alignhalf(cc[d0 + 3], cc[d0 + 2]); r.w = alignhalf(cc[d0 + 4], cc[d0 + 3]); }
    return r;
}
__device__ __forceinline__ void build_copies(unsigned char* cp, int cs, const bf16_t* R, int nch, int i) {
    if (i < nch) { const uint4 cur = *(const uint4*)(R + 8 * i); const uint4 prev = i > 0 ? *(const uint4*)(R + 8 * i - 8) : make_uint4(0u, 0u, 0u, 0u);
        *(uint4*)(cp + 0 * cs + i * 16) = cur;
        *(uint4*)(cp + 1 * cs + i * 16) = shift_copy<1>(prev, cur); *(uint4*)(cp + 2 * cs + i * 16) = shift_copy<2>(prev, cur); *(uint4*)(cp + 3 * cs + i * 16) = shift_copy<3>(prev, cur);
        *(uint4*)(cp + 4 * cs + i * 16) = shift_copy<4>(prev, cur); *(uint4*)(cp + 5 * cs + i * 16) = shift_copy<5>(prev, cur); *(uint4*)(cp + 6 * cs + i * 16) = shift_copy<6>(prev, cur);
        *(uint4*)(cp + 7 * cs + i * 16) = shift_copy<7>(prev, cur); }
}
__device__ __forceinline__ void ph_hyena_mfma(const Fr& F) {
    const bf16_t* U = F.w<bf16_t>(L0_U); bf16_t* YT = F.w<bf16_t>(L0_YT);
    const int w = F.wave, rr = F.lane & 15, g = F.lane >> 4;
    {   constexpr int CS = 8224, US = 4128;
        unsigned char* Cp = F.lds; unsigned char* Ub = F.lds + 8 * CS;
        const int p = w & 1, q = w >> 1;
        for (int c = F.bid; c < 512; c += F.G) {
            __syncthreads();
            build_copies(Cp, CS, F.w<bf16_t>(L0_FL) + (size_t)c * 4096, 512, F.tid);
#pragma unroll
            for (int k = 0; k < 4; ++k) { const int id = F.tid + 512 * k, b = id >> 8, ch = id & 255; *(uint4*)(Ub + b * US + ch * 16) = *(const uint4*)(U + ((size_t)c * 8 + b) * NKEY + CTXL + ch * 8); }
            __syncthreads();
            const unsigned char* abase = Cp + (rr & 7) * CS + (2048 - 16 * (32 * q + p) - 8 * (rr >> 3) + 8 * g) * 2;
            const unsigned char* ubase = Ub + (rr & 7) * US + 16 * g;
            f32x4 acc[16]; bf16x8 af[16];
#pragma unroll
            for (int i = 0; i < 16; ++i) { acc[i] = (f32x4){0.f, 0.f, 0.f, 0.f}; af[i] = *(const bf16x8*)(abase - 64 * i); }
            for (int jj = 0; jj < 4; ++jj) {
#pragma unroll
                for (int js = 0; js < 16; ++js) { const int J = 16 * jj + js;
                    af[(16 - js) & 15] = *(const bf16x8*)(abase + 64 * J);
                    const bf16x8 bfr = *(const bf16x8*)(ubase + 64 * J);
#pragma unroll
                    for (int i = 0; i < 16; ++i) acc[i] = __builtin_amdgcn_mfma_f32_16x16x32_bf16(af[(i - js) & 15], bfr, acc[i], 0, 0, 0);
                }
            }
            if (rr < 8) {
#pragma unroll
                for (int i = 0; i < 16; ++i) { const int t = 16 * (32 * q + p + 2 * i) + 4 * g; uint2 pk; pk.x = pack2(acc[i][0], acc[i][1]); pk.y = pack2(acc[i][2], acc[i][3]);
                    *(uint2*)(YT + ((size_t)c * 8 + rr) * NKEY + CTXL + t) = pk; }
            }
        }
    }
    {   constexpr int CS = 1056, US = 544;
        unsigned char* Cp = F.lds; unsigned char* Ub = F.lds + 8 * CS;
        for (int c = F.bid; c < 512; c += F.G) {
            __syncthreads();
            build_copies(Cp, CS, F.w<bf16_t>(L0_FC) + (size_t)c * 512, 64, F.tid);
            if (F.tid < 256) { const int b = F.tid >> 5, ch = F.tid & 31; *(uint4*)(Ub + b * US + ch * 16) = *(const uint4*)(U + ((size_t)c * 8 + b) * NKEY + ch * 8); }
            __syncthreads();
            f32x4 acc[2];
#pragma unroll
            for (int ii = 0; ii < 2; ++ii) acc[ii] = (f32x4){0.f, 0.f, 0.f, 0.f};
#pragma unroll
            for (int J = 0; J < 8; ++J) { const bf16x8 bfr = *(const bf16x8*)(Ub + (rr & 7) * US + 16 * g + 64 * J);
#pragma unroll
                for (int ii = 0; ii < 2; ++ii) { const int d = 2 * w + ii - 2 * J; const bf16x8 a = *(const bf16x8*)(Cp + (rr & 7) * CS + (256 - 16 * d - 8 * (rr >> 3) + 8 * g) * 2);
                    acc[ii] = __builtin_amdgcn_mfma_f32_16x16x32_bf16(a, bfr, acc[ii], 0, 0, 0); } }
            if (rr < 8) {
#pragma unroll
                for (int ii = 0; ii < 2; ++ii) { const int t = 16 * (2 * w + ii) + 4 * g; uint2 pk; pk.x = pack2(acc[ii][0], acc[ii][1]); pk.y = pack2(acc[ii][2], acc[ii][3]);
                    *(uint2*)(YT + ((size_t)c * 8 + rr) * NKEY + t) = pk; }
            }
        }
    }
    __syncthreads();
}
__device__ __forceinline__ void ph_hyena_post(const Fr& F) {
    const bf16_t* YT = F.w<bf16_t>(L0_YT); const bf16_t* X0 = F.w<bf16_t>(L0_X0); bf16_t* A = F.w<bf16_t>(WS_ABUF);
    bf16_t* yt = (bf16_t*)F.lds;
    for (int un = F.bid; un < (TT / 64) * 4; un += F.G) {
        const int tile = un >> 2, cgp = un & 3, row0 = tile * 64;
        { const int ch = F.tid >> 2, part = F.tid & 3; const int b = row0 < TL ? (row0 >> 11) : ((row0 - TL) >> 8), off = row0 < TL ? CTXL + (row0 & (SEQ - 1)) : ((row0 - TL) & (CTXL - 1));
          const uint4* src = (const uint4*)(YT + ((size_t)(cgp * 128 + ch) * 8 + b) * NKEY + off + part * 16); const uint4 v0 = src[0], v1 = src[1];
          unsigned* dst = (unsigned*)(yt + ch * 66 + part * 16); dst[0] = v0.x; dst[1] = v0.y; dst[2] = v0.z; dst[3] = v0.w; dst[4] = v1.x; dst[5] = v1.y; dst[6] = v1.z; dst[7] = v1.w; }
        __syncthreads();
        { const int tok = F.tid >> 3, cq = F.tid & 7, row = row0 + tok;
#pragma unroll
          for (int hf = 0; hf < 2; ++hf) { const int ch = cgp * 128 + cq * 16 + hf * 8; float x0[8], o[8]; ld8bf(X0 + (size_t)row * 512 + ch, x0);
#pragma unroll
              for (int j = 0; j < 8; ++j) o[j] = x0[j] * bf2f(yt[(cq * 16 + hf * 8 + j) * 66 + tok]);
              st8bf(A + (size_t)row * 1024 + ch, o); } }
        __syncthreads();
    }
}

__device__ __forceinline__ int ssd_rowbase(int b, int cpos) { return cpos < 2 ? TL + b * CTXL + cpos * 128 : b * SEQ + (cpos - 2) * 128; }
typedef short s16x4 __attribute__((ext_vector_type(4)));
__device__ __forceinline__ s16x4 tr_read16(const unsigned char* img, int P, int row0, int col0, int lane) {
    const int q4 = (lane & 15) >> 2, p4 = lane & 3;
    return __builtin_amdgcn_ds_read_tr16_b64_v4i16((LAS s16x4*)(LAS unsigned char*)(img + (row0 + q4) * P + (col0 + 4 * p4) * 2));
}
__device__ __forceinline__ bf16x8 tr_pair(const unsigned char* img, int P, int rowa, int rowb, int col0, int lane) {
    union { bf16x8 v; s16x4 h[2]; } u; u.h[0] = tr_read16(img, P, rowa, col0, lane); u.h[1] = tr_read16(img, P, rowb, col0, lane); return u.v;
}
__device__ __forceinline__ void ph_ssd_a(const Fr& F) {
    constexpr int PT = 272, PX = 144;
    unsigned char* XD = F.lds;
    unsigned char* Bn = XD + 128 * PX;
    unsigned char* Bd = Bn + 128 * PT;
    unsigned char* Cn = Bd + 128 * PT;
    float* acs = (float*)(Cn + 128 * PT);
    float* dts = acs + 128;
    const bf16_t* XBC = F.w<bf16_t>(L0_XBC); const float* DT = F.w<float>(L0_DT);
    const int w = F.wave, cl = F.lane & 15, g = F.lane >> 4;
    for (int u = F.bid; u < NB * 18 * 16; u += F.G) {
        const int b = u / 288, rem = u % 288, cpos = rem >> 4, h = (rem >> 1) & 7, dir = rem & 1, grp = h >> 2;
        const int rowbase = ssd_rowbase(b, cpos), su = ((b * 2 + dir) * 8 + h) * 18 + cpos;
        const float Aneg = -expf(F.in[I_ALOG][dir * 8 + h]);
        __syncthreads();
        if (w == 0) { const int q0 = 2 * F.lane, p0 = dir ? 127 - q0 : q0, p1 = dir ? 126 - q0 : q0 + 1;
            const float d0 = DT[(size_t)(rowbase + p0) * 16 + dir * 8 + h], d1 = DT[(size_t)(rowbase + p1) * 16 + dir * 8 + h]; const float a0 = d0 * Aneg, a1 = d1 * Aneg;
            float sc = a0 + a1;
#pragma unroll
            for (int o = 1; o < 64; o <<= 1) { const float t = __shfl_up(sc, o); if (F.lane >= o) sc += t; }
            const float ex = sc - (a0 + a1); acs[q0] = ex + a0; acs[q0 + 1] = ex + a0 + a1; dts[q0] = d0; dts[q0 + 1] = d1;
            float* ACS = F.w<float>(L0_ACS) + (size_t)su * 128; ACS[p0] = ex + a0; ACS[p1] = ex + a0 + a1;
            if (F.lane == 63) F.w<float>(L0_ATOT)[su] = ex + a0 + a1; }
        __syncthreads();
        const float atot = acs[127];
#pragma unroll
        for (int k = 0; k < 2; ++k) { const int id = F.tid + 512 * k, q = id >> 3, pc = id & 7, pos = dir ? 127 - q : q; float v[8]; ld8bf(XBC + (size_t)(rowbase + pos) * 1024 + h * 64 + pc * 8, v); const float dv = dts[q];
            uint4 o; o.x = pack2(v[0] * dv, v[1] * dv); o.y = pack2(v[2] * dv, v[3] * dv); o.z = pack2(v[4] * dv, v[5] * dv); o.w = pack2(v[6] * dv, v[7] * dv);
            *(uint4*)(XD + q * PX + pc * 16) = o; }
#pragma unroll
        for (int k = 0; k < 4; ++k) { const int id = F.tid + 512 * k, q = id >> 4, nc = id & 15, pos = dir ? 127 - q : q; const bf16_t* src = XBC + (size_t)(rowbase + pos) * 1024 + 512 + grp * 128 + nc * 8;
            const uint4 bv = *(const uint4*)src, cv = *(const uint4*)(src + 256);
            *(uint4*)(Bn + q * PT + nc * 16) = bv; *(uint4*)(Cn + q * PT + nc * 16) = cv;
            const float dec = __expf(atot - acs[q]); uint4 o;
            o.x = pack2(bflo(bv.x) * dec, bfhi(bv.x) * dec); o.y = pack2(bflo(bv.y) * dec, bfhi(bv.y) * dec); o.z = pack2(bflo(bv.z) * dec, bfhi(bv.z) * dec); o.w = pack2(bflo(bv.w) * dec, bfhi(bv.w) * dec);
            *(uint4*)(Bd + q * PT + nc * 16) = o; }
        __syncthreads();
        const int q = 16 * w + cl; const float aq = acs[q];
        bf16x8 cf[4];
#pragma unroll
        for (int ks = 0; ks < 4; ++ks) cf[ks] = *(const bf16x8*)(Cn + q * PT + (32 * ks + 8 * g) * 2);
        unsigned pk[8][2];
#pragma unroll
        for (int sb = 0; sb < 8; ++sb) { pk[sb][0] = 0u; pk[sb][1] = 0u;
            if (sb <= w) { f32x4 gacc = (f32x4){0.f, 0.f, 0.f, 0.f};
#pragma unroll
                for (int ks = 0; ks < 4; ++ks) { const bf16x8 bf = *(const bf16x8*)(Bn + (16 * sb + cl) * PT + (32 * ks + 8 * g) * 2); gacc = __builtin_amdgcn_mfma_f32_16x16x32_bf16(bf, cf[ks], gacc, 0, 0, 0); }
                const f32x4 as = *(const f32x4*)(acs + 16 * sb + 4 * g); float sv[4];
#pragma unroll
                for (int e = 0; e < 4; ++e) { const int sI = 16 * sb + 4 * g + e; sv[e] = (sI <= q) ? gacc[e] * __expf(aq - as[e]) : 0.f; }
                pk[sb][0] = pack2(sv[0], sv[1]); pk[sb][1] = pack2(sv[2], sv[3]); } }
        f32x4 yacc[4];
#pragma unroll
        for (int pb = 0; pb < 4; ++pb) yacc[pb] = (f32x4){0.f, 0.f, 0.f, 0.f};
#pragma unroll
        for (int k2 = 0; k2 < 4; ++k2) if (2 * k2 <= w) {
            union { bf16x8 v; unsigned wd[4]; } pf; pf.wd[0] = pk[2 * k2][0]; pf.wd[1] = pk[2 * k2][1]; pf.wd[2] = pk[2 * k2 + 1][0]; pf.wd[3] = pk[2 * k2 + 1][1];
#pragma unroll
            for (int pb = 0; pb < 4; ++pb) { const bf16x8 xa = tr_pair(XD, PX, 32 * k2 + 4 * g, 32 * k2 + 16 + 4 * g, 16 * pb, F.lane);
                yacc[pb] = __builtin_amdgcn_mfma_f32_16x16x32_bf16(xa, pf.v, yacc[pb], 0, 0, 0); } }
        { bf16_t* Y = (dir ? F.w<bf16_t>(L0_YB) : F.w<bf16_t>(L0_YF)) + (size_t)(rowbase + (dir ? 127 - q : q)) * 512 + h * 64 + 4 * g;
#pragma unroll
          for (int pb = 0; pb < 4; ++pb) { uint2 o; o.x = pack2(yacc[pb][0], yacc[pb][1]); o.y = pack2(yacc[pb][2], yacc[pb][3]); *(uint2*)(Y + 16 * pb) = o; } }
        { float* ST = F.w<float>(L0_ST) + (size_t)su * 8192;
          bf16x8 af[4];
#pragma unroll
          for (int ks = 0; ks < 4; ++ks) af[ks] = tr_pair(Bd, PT, 32 * ks + 8 * g, 32 * ks + 8 * g + 4, 16 * w, F.lane);
#pragma unroll
          for (int pb = 0; pb < 4; ++pb) { f32x4 sacc = (f32x4){0.f, 0.f, 0.f, 0.f};
#pragma unroll
              for (int ks = 0; ks < 4; ++ks) { const bf16x8 xb = tr_pair(XD, PX, 32 * ks + 8 * g, 32 * ks + 8 * g + 4, 16 * pb, F.lane); sacc = __builtin_amdgcn_mfma_f32_16x16x32_bf16(af[ks], xb, sacc, 0, 0, 0); }
              *(f32x4*)(ST + (size_t)(16 * pb + cl) * 128 + 16 * w + 4 * g) = sacc; } }
    }
    __syncthreads();
}
__device__ __forceinline__ void ph_ssd_b(const Fr& F) {
    const float* ST = F.w<float>(L0_ST); const float* ATOT = F.w<float>(L0_ATOT); bf16_t* STIN = F.w<bf16_t>(L0_STIN);
    for (int idx = F.bid * NTHR + F.tid; idx < 128 * 2048; idx += F.G * NTHR) {
        const int chain = idx >> 11, e4 = idx & 2047, dir = (chain >> 3) & 1;
        f32x4 run = (f32x4){0.f, 0.f, 0.f, 0.f};
        for (int k = 0; k < 18; ++k) { const int cpos = dir ? (k < 2 ? 1 - k : 19 - k) : k; const size_t su = (size_t)chain * 18 + cpos;
            uint2 o; o.x = pack2(run[0], run[1]); o.y = pack2(run[2], run[3]); *(uint2*)(STIN + su * 8192 + e4 * 4) = o;
            const f32x4 st = *(const f32x4*)(ST + su * 8192 + e4 * 4); const float dc = __expf(ATOT[su]); run = run * dc + st; }
    }
}
__device__ __forceinline__ void ph_ssd_c(const Fr& F) {
    constexpr int PT = 272;
    unsigned char* Cn = F.lds;
    unsigned char* Sin = Cn + 64 * PT;
    float* ssx = (float*)(Sin + 4 * 64 * PT);
    const bf16_t* XBC = F.w<bf16_t>(L0_XBC); const bf16_t* PROJ = F.w<bf16_t>(L0_PROJ); const bf16_t* STIN = F.w<bf16_t>(L0_STIN); const float* ACS = F.w<float>(L0_ACS);
    const bf16_t* YF = F.w<bf16_t>(L0_YF); const bf16_t* YB = F.w<bf16_t>(L0_YB); bf16_t* A = F.w<bf16_t>(WS_ABUF);
    const float* dsk = F.in[I_SSMD]; const float* ng = F.in[I_SSMNG];
    const int w = F.wave, pw = w & 3, hp = w >> 2;
    for (int u = F.bid; u < NB * 18 * 4; u += F.G) {
        int tz = threadIdx.x; asm volatile("" : "+v"(tz));
        const int cl = tz & 15, g = (tz >> 4) & 3;
        const int b = u / 72, rem = u % 72, cpos = rem >> 2, grp = (rem >> 1) & 1, ph = rem & 1; const int rowbase = ssd_rowbase(b, cpos);
        const int lpos = 16 * pw + cl, pos = ph * 64 + lpos; const size_t row = (size_t)(rowbase + pos);
        __syncthreads();
#pragma unroll
        for (int k = 0; k < 2; ++k) { const int id = tz + 512 * k, q = id >> 4, nc = id & 15; *(uint4*)(Cn + q * PT + nc * 16) = *(const uint4*)(XBC + (size_t)(rowbase + ph * 64 + q) * 1024 + 768 + grp * 128 + nc * 8); }
        float ss = 0.f;
        uint4 sreg0, sreg1, sreg2, sreg3, sreg4, sreg5, sreg6, sreg7;
#define SSDC_SRC(k, it) (STIN + ((size_t)(b * 16 + (((tz + 512 * (k)) >> 10) & 1) * 8 + grp * 4 + 2 * ((tz + 512 * (k)) >> 11) + (it)) * 18 + cpos) * 8192 + (((tz + 512 * (k)) >> 4) & 63) * 128 + ((tz + 512 * (k)) & 15) * 8)
#define SSDC_SLOAD(it) do { sreg0 = *(const uint4*)SSDC_SRC(0, it); sreg1 = *(const uint4*)SSDC_SRC(1, it); sreg2 = *(const uint4*)SSDC_SRC(2, it); sreg3 = *(const uint4*)SSDC_SRC(3, it); \
            sreg4 = *(const uint4*)SSDC_SRC(4, it); sreg5 = *(const uint4*)SSDC_SRC(5, it); sreg6 = *(const uint4*)SSDC_SRC(6, it); sreg7 = *(const uint4*)SSDC_SRC(7, it); } while (0)
#define SSDC_LDSW(k, v) *(uint4*)(Sin + ((tz + 512 * (k)) >> 10) * 64 * PT + (((tz + 512 * (k)) >> 4) & 63) * PT + ((tz + 512 * (k)) & 15) * 16) = v
        SSDC_SLOAD(0);
#pragma unroll 1
        for (int it = 0; it < 2; ++it) {
            const int h = grp * 4 + 2 * hp + it; const size_t su0 = (size_t)(b * 16 + h) * 18 + cpos, su1 = (size_t)(b * 16 + 8 + h) * 18 + cpos;
            uint2 eyf[4], eyb[4], exv[4], ezv[4];
#pragma unroll
            for (int pb = 0; pb < 4; ++pb) { const int ch = h * 64 + 16 * pb + 4 * g;
                eyf[pb] = *(const uint2*)(YF + row * 512 + ch); eyb[pb] = *(const uint2*)(YB + row * 512 + ch); exv[pb] = *(const uint2*)(XBC + row * 1024 + ch); ezv[pb] = *(const uint2*)(PROJ + row * EVEN_PAD + 1536 + ch); }
            const float a0 = ACS[su0 * 128 + pos], a1 = ACS[su1 * 128 + pos];
            __syncthreads();
            SSDC_LDSW(0, sreg0); SSDC_LDSW(1, sreg1); SSDC_LDSW(2, sreg2); SSDC_LDSW(3, sreg3); SSDC_LDSW(4, sreg4); SSDC_LDSW(5, sreg5); SSDC_LDSW(6, sreg6); SSDC_LDSW(7, sreg7);
            if (it < 1) SSDC_SLOAD(it + 1);
            __syncthreads();
            const float sc0 = __expf(a0), sc1 = __expf(a1);
            const unsigned char* S0 = Sin + (hp * 2) * 64 * PT; const unsigned char* S1 = S0 + 64 * PT;
            f32x4 t0[4], t1[4];
#pragma unroll
            for (int pb = 0; pb < 4; ++pb) { t0[pb] = (f32x4){0.f, 0.f, 0.f, 0.f}; t1[pb] = (f32x4){0.f, 0.f, 0.f, 0.f}; }
#pragma unroll
            for (int ks = 0; ks < 4; ++ks) { const bf16x8 cf = *(const bf16x8*)(Cn + lpos * PT + (32 * ks + 8 * g) * 2);
#pragma unroll
                for (int pb = 0; pb < 4; ++pb) { const bf16x8 s0 = *(const bf16x8*)(S0 + (16 * pb + cl) * PT + (32 * ks + 8 * g) * 2), s1 = *(const bf16x8*)(S1 + (16 * pb + cl) * PT + (32 * ks + 8 * g) * 2);
                    t0[pb] = __builtin_amdgcn_mfma_f32_16x16x32_bf16(s0, cf, t0[pb], 0, 0, 0); t1[pb] = __builtin_amdgcn_mfma_f32_16x16x32_bf16(s1, cf, t1[pb], 0, 0, 0); } }
            const float dd = dsk[h];
#pragma unroll
            for (int pb = 0; pb < 4; ++pb) { const int ch = h * 64 + 16 * pb + 4 * g;
                const uint2 yf = eyf[pb], yb = eyb[pb], xv = exv[pb], zv = ezv[pb];
                f32x4 y = t0[pb] * sc0 + t1[pb] * sc1;
                y[0] = (y[0] + bflo(yf.x) + bflo(yb.x) + bflo(xv.x) * dd) * silu_f(bflo(zv.x)); y[1] = (y[1] + bfhi(yf.x) + bfhi(yb.x) + bfhi(xv.x) * dd) * silu_f(bfhi(zv.x));
                y[2] = (y[2] + bflo(yf.y) + bflo(yb.y) + bflo(xv.y) * dd) * silu_f(bflo(zv.y)); y[3] = (y[3] + bfhi(yf.y) + bfhi(yb.y) + bfhi(xv.y) * dd) * silu_f(bfhi(zv.y));
                uint2 o; o.x = pack2(y[0], y[1]); o.y = pack2(y[2], y[3]);
                const float r0 = bflo(o.x), r1 = bfhi(o.x), r2 = bflo(o.y), r3 = bfhi(o.y); ss += r0 * r0 + r1 * r1 + r2 * r2 + r3 * r3;
                *(uint2*)(A + row * 1024 + 512 + ch) = o; }
        }
#undef SSDC_SLOAD
#undef SSDC_SRC
#undef SSDC_LDSW
        ss += __shfl_xor(ss, 16); ss += __shfl_xor(ss, 32);
        if (g == 0) ssx[hp * 64 + lpos] = ss;
        __syncthreads();
        const float rn = rsqrtf((ssx[lpos] + ssx[64 + lpos]) * (1.f / 256.f) + EPS);
#pragma unroll 4
        for (int i = 0; i < 8; ++i) { const int ch = grp * 256 + (2 * hp + (i >> 2)) * 64 + 16 * (i & 3) + 4 * g; bf16_t* ap = A + row * 1024 + 512 + ch; const uint2 v = *(const uint2*)ap; const f32x4 gg = *(const f32x4*)(ng + ch);
            uint2 o; o.x = pack2(bflo(v.x) * rn * gg[0], bfhi(v.x) * rn * gg[1]); o.y = pack2(bflo(v.y) * rn * gg[2], bfhi(v.y) * rn * gg[3]); *(uint2*)ap = o; }
    }
    __syncthreads();
}

__device__ __forceinline__ uint4 rope8(const uint4 mine, const uint4 other, const float* ct, const float* st, bool upper, bool apply, float scale) {
    float m[8], o[8], r[8]; const unsigned mw[4] = {mine.x, mine.y, mine.z, mine.w}, ow[4] = {other.x, other.y, other.z, other.w};
#pragma unroll
    for (int j = 0; j < 4; ++j) { m[2 * j] = bflo(mw[j]); m[2 * j + 1] = bfhi(mw[j]); o[2 * j] = bflo(ow[j]); o[2 * j + 1] = bfhi(ow[j]); }
    if (apply) { const float4 c0 = ld4(ct), c1 = ld4(ct + 4), s0 = ld4(st), s1 = ld4(st + 4); const float c[8] = {c0.x, c0.y, c0.z, c0.w, c1.x, c1.y, c1.z, c1.w}, sn[8] = {s0.x, s0.y, s0.z, s0.w, s1.x, s1.y, s1.z, s1.w};
#pragma unroll
        for (int j = 0; j < 8; ++j) r[j] = (upper ? (m[j] * c[j] + o[j] * sn[j]) : (m[j] * c[j] - o[j] * sn[j])) * scale; }
    else {
#pragma unroll
        for (int j = 0; j < 8; ++j) r[j] = m[j] * scale; }
    uint4 q; q.x = pack2(r[0], r[1]); q.y = pack2(r[2], r[3]); q.z = pack2(r[4], r[5]); q.w = pack2(r[6], r[7]); return q;
}
__device__ __forceinline__ uint4 shfl_xor_u4(const uint4 v, int m) { uint4 r; r.x = __shfl_xor(v.x, m); r.y = __shfl_xor(v.y, m); r.z = __shfl_xor(v.z, m); r.w = __shfl_xor(v.w, m); return r; }
__device__ __forceinline__ void ph_attn_prep(const Fr& F) {
    const bf16_t* P = F.w<bf16_t>(L1_PROJ); float* SQ = F.w<float>(WS_SQ); float* SKV = F.w<float>(WS_SKV);
    bf16_t* KM = F.w<bf16_t>(L1_KM); bf16_t* QG = F.w<bf16_t>(L1_QG); bf16_t* KG = F.w<bf16_t>(L1_KG); bf16_t* VGT = F.w<bf16_t>(L1_VGT);
    const float* cm = F.w<float>(WS_ROPEM); const float* sm = cm + 2048 * 16; const float* cg = F.w<float>(WS_ROPEG); const float* sg = cg + 2048 * 32;
    const float gscale = 0.125f * LOG2E;
    for (int row = F.bid * 8 + F.wave; row < TT; row += F.G * 8) {
        const bf16_t* pr = P + (size_t)row * ODD_PAD; const bool lat = row < TL; const int pos = row & (SEQ - 1), l = F.lane;
        const int b = lat ? (row >> 11) : ((row - TL) >> 8), key = lat ? CTXL + pos : ((row - TL) & (CTXL - 1));
        { float s = 0.f; if (l < 48) { float v[8]; ld8bf(pr + l * 8, v);
#pragma unroll
              for (int j = 0; j < 8; ++j) s += v[j] * v[j]; }
          const float sq = wave_sum(l < 32 ? s : 0.f), skv = wave_sum(l >= 32 ? s : 0.f);
          if (l == 0) { SQ[row] = rsqrtf(sq * (1.f / 256.f) + EPS); SKV[row] = rsqrtf(skv * (1.f / 128.f) + EPS); } }
        { const uint4 mine = *(const uint4*)(pr + 416 + l * 8); const uint4 other = shfl_xor_u4(mine, 4); const int sub = l & 7, i0 = (sub & 3) * 8;
          if (lat) *(uint4*)(QG + (size_t)row * 512 + l * 8) = rope8(mine, other, cg + pos * 32 + i0, sg + pos * 32 + i0, sub >= 4, true, gscale); }
        { const int lk = l & 15; const uint4 mine = *(const uint4*)(pr + 928 + lk * 8); const uint4 other = shfl_xor_u4(mine, 4); const int sub = lk & 7, i0 = (sub & 3) * 8;
          const uint4 r = rope8(mine, other, cg + pos * 32 + i0, sg + pos * 32 + i0, sub >= 4, lat, 1.f);
          if (l < 16) *(uint4*)(KG + ((size_t)b * NKEY + key) * 128 + lk * 8) = r; }
        { const int lr = l & 3; const uint4 mine = *(const uint4*)(pr + 384 + lr * 8); const uint4 other = shfl_xor_u4(mine, 2); const int i0 = (lr & 1) * 8;
          const uint4 r = rope8(mine, other, cm + pos * 16 + i0, sm + pos * 16 + i0, lr >= 2, lat, 1.f);
          if (l < 4) { bf16_t* kb = KM + ((size_t)b * NKEY + key) * 768 + 64 + lr * 8;
#pragma unroll
              for (int h = 0; h < 8; ++h) *(uint4*)(kb + h * 96) = r; } }
    }
    bf16_t* vt = (bf16_t*)F.lds;
    for (int un = F.bid; un < TT / 64; un += F.G) {
        const int row0 = un * 64; const int b = row0 < TL ? (row0 >> 11) : ((row0 - TL) >> 8), key0 = row0 < TL ? CTXL + (row0 & (SEQ - 1)) : ((row0 - TL) & (CTXL - 1));
        { const int tok = F.tid >> 3, cq = F.tid & 7; const uint4 a = *(const uint4*)(P + (size_t)(row0 + tok) * ODD_PAD + 1056 + cq * 16), c2 = *(const uint4*)(P + (size_t)(row0 + tok) * ODD_PAD + 1056 + cq * 16 + 8);
          const unsigned wv[8] = {a.x, a.y, a.z, a.w, c2.x, c2.y, c2.z, c2.w};
#pragma unroll
          for (int j = 0; j < 8; ++j) { vt[(cq * 16 + 2 * j) * 66 + tok] = (bf16_t)(wv[j] & 0xFFFFu); vt[(cq * 16 + 2 * j + 1) * 66 + tok] = (bf16_t)(wv[j] >> 16); } }
        __syncthreads();
        { const int ch = F.tid >> 2, part = F.tid & 3; const unsigned* src = (const unsigned*)(vt + ch * 66 + part * 16); uint4 v0, v1; v0.x = src[0]; v0.y = src[1]; v0.z = src[2]; v0.w = src[3]; v1.x = src[4]; v1.y = src[5]; v1.z = src[6]; v1.w = src[7];
          uint4* dst = (uint4*)(VGT + ((size_t)(b * 2 + (ch >> 6)) * 64 + (ch & 63)) * NKEY + key0 + part * 16); dst[0] = v0; dst[1] = v1; }
        __syncthreads();
    }
}

typedef float f32x16 __attribute__((ext_vector_type(16)));
template <bool GQA>
__device__ __forceinline__ void ph_attn_mfma(const Fr& F) {
    constexpr int DQK = GQA ? 64 : 96, NKS = DQK / 16, KP = GQA ? 144 : 208, VP = 136, KCH = DQK / 8, NKCH = 64 * KCH;
    constexpr int KBYTES = 64 * KP, VBYTES = 64 * VP;
    unsigned char* Kb = F.lds; unsigned char* Vb = F.lds + 2 * KBYTES;
    bf16_t* A = F.w<bf16_t>(WS_ABUF);
    const int r = F.lane & 31, hh = F.lane >> 5;
    for (int u = F.bid; u < 512; u += F.G) {
        int b, ntile, lat_lo = 0, qpos, ocol; const bf16_t* qp; const bf16_t* kbase; const bf16_t* vtb; int kstride; float m_run, l_run;
        if (!GQA) { b = u >> 6; const int h = (u >> 3) & 7, qb = u & 7; qpos = qb * 256 + F.wave * 32 + r; ntile = NKEY / 64;
            qp = F.w<bf16_t>(L1_QM) + (size_t)(b * SEQ + qpos) * 768 + h * 96; kbase = F.w<bf16_t>(L1_KM) + (size_t)b * NKEY * 768 + h * 96; kstride = 768;
            vtb = F.w<bf16_t>(L1_VT) + (size_t)(b * 8 + h) * 64 * NKEY; m_run = 0.f; l_run = 0.f; ocol = h * 64; }
        else { b = u >> 6; const int kv = (u >> 5) & 1, qb = (u >> 1) & 15, pr = u & 1; const int head = kv * 4 + pr * 2 + (F.wave >> 2); qpos = qb * 128 + (F.wave & 3) * 32 + r;
            lat_lo = qb * 128 - 128 > 0 ? qb * 128 - 128 : 0; const int lat_hi = qb * 128 + 256 < SEQ ? qb * 128 + 256 : SEQ; ntile = 4 + (lat_hi - lat_lo) / 64;
            qp = F.w<bf16_t>(L1_QG) + (size_t)(b * SEQ + qpos) * 512 + head * 64; kbase = F.w<bf16_t>(L1_KG) + (size_t)b * NKEY * 128 + kv * 64; kstride = 128;
            vtb = F.w<bf16_t>(L1_VGT) + (size_t)(b * 2 + kv) * 64 * NKEY; m_run = F.in[I_SINK][head] * LOG2E; l_run = hh ? 0.f : 1.f; ocol = 512 + head * 64; }
        bf16x8 qf[NKS];
#pragma unroll
        for (int ks = 0; ks < NKS; ++ks) qf[ks] = *(const bf16x8*)(qp + 16 * ks + 8 * hh);
        f32x16 o0, o1;
#pragma unroll
        for (int i = 0; i < 16; ++i) { o0[i] = 0.f; o1[i] = 0.f; }
        const int kr0 = F.tid / KCH, kc0 = F.tid % KCH, kr1 = (F.tid + 512) / KCH, kc1 = (F.tid + 512) % KCH; const bool has2 = (F.tid + 512) < NKCH;
        const int vr = F.tid >> 3, vc = F.tid & 7;
        uint4 kreg0, kreg1 = make_uint4(0u, 0u, 0u, 0u), vreg;
        bf16x8 kf[NKS][2];
#define ATT_KIDX(t) ((!GQA || (t) < 4) ? (t) * 64 : CTXL + lat_lo + ((t) - 4) * 64)
#define ATT_LOAD(t) do { const int _k0 = ATT_KIDX(t); kreg0 = *(const uint4*)(kbase + (size_t)(_k0 + kr0) * kstride + kc0 * 8); \
            if (has2) kreg1 = *(const uint4*)(kbase + (size_t)(_k0 + kr1) * kstride + kc1 * 8); vreg = *(const uint4*)(vtb + (size_t)vr * NKEY + _k0 + vc * 8); } while (0)
#define ATT_WRITE(buf) do { *(uint4*)(Kb + (buf) * KBYTES + kr0 * KP + kc0 * 16) = kreg0; if (has2) *(uint4*)(Kb + (buf) * KBYTES + kr1 * KP + kc1 * 16) = kreg1; \
            *(uint2*)(Vb + (buf) * VBYTES + vr * VP + vc * 16) = make_uint2(vreg.x, vreg.y); *(uint2*)(Vb + (buf) * VBYTES + vr * VP + vc * 16 + 8) = make_uint2(vreg.z, vreg.w); } while (0)
#define ATT_KFRAGS(buf) do { const unsigned char* kb = Kb + (buf) * KBYTES; \
            _Pragma("unroll") for (int ks = 0; ks < NKS; ++ks) { kf[ks][0] = *(const bf16x8*)(kb + r * KP + (16 * ks + 8 * hh) * 2); kf[ks][1] = *(const bf16x8*)(kb + (32 + r) * KP + (16 * ks + 8 * hh) * 2); } } while (0)
        __syncthreads();
        ATT_LOAD(0); ATT_WRITE(0);
        __syncthreads();
        ATT_KFRAGS(0);
        for (int t = 0; t < ntile; ++t) {
            const int buf = t & 1; const bool more = (t + 1) < ntile;
            if (more) ATT_LOAD(t + 1);
            const unsigned char* vb = Vb + buf * VBYTES;
            f32x16 s0, s1;
#pragma unroll
            for (int i = 0; i < 16; ++i) { s0[i] = -m_run; s1[i] = -m_run; }
#pragma unroll
            for (int ks = 0; ks < NKS; ++ks) { s0 = __builtin_amdgcn_mfma_f32_32x32x16_bf16(kf[ks][0], qf[ks], s0, 0, 0, 0); s1 = __builtin_amdgcn_mfma_f32_32x32x16_bf16(kf[ks][1], qf[ks], s1, 0, 0, 0); }
            union { bf16x8 v; uint2 h2[2]; } vf[4][2];
#pragma unroll
            for (int s2 = 0; s2 < 4; ++s2) { vf[s2][0].h2[0] = *(const uint2*)(vb + r * VP + (16 * s2 + 4 * hh) * 2); vf[s2][0].h2[1] = *(const uint2*)(vb + r * VP + (16 * s2 + 8 + 4 * hh) * 2);
                vf[s2][1].h2[0] = *(const uint2*)(vb + (32 + r) * VP + (16 * s2 + 4 * hh) * 2); vf[s2][1].h2[1] = *(const uint2*)(vb + (32 + r) * VP + (16 * s2 + 8 + 4 * hh) * 2); }
            __builtin_amdgcn_sched_barrier(0);
            if (GQA && t >= 4) { const int kp0 = lat_lo + (t - 4) * 64 + 4 * hh - qpos;
#pragma unroll
                for (int i = 0; i < 16; ++i) { const int rel = kp0 + (i & 3) + 8 * (i >> 2); if (rel > 128 || rel < -128) s0[i] = -1.0e30f; if (rel + 32 > 128 || rel + 32 < -128) s1[i] = -1.0e30f; } }
            float tmax = s0[0];
#pragma unroll
            for (int i = 1; i < 16; ++i) tmax = fmaxf(tmax, s0[i]);
#pragma unroll
            for (int i = 0; i < 16; ++i) tmax = fmaxf(tmax, s1[i]);
            tmax = fmaxf(tmax, __shfl_xor(tmax, 32));
            const float dm = fmaxf(tmax, 0.f); const bool grow = __any(tmax > 0.f) != 0; float alpha = 1.f;
            float ls = 0.f;
            if (grow) { alpha = __builtin_amdgcn_exp2f(-dm); m_run += dm;
#pragma unroll
                for (int i = 0; i < 16; ++i) { s0[i] = __builtin_amdgcn_exp2f(s0[i] - dm); s1[i] = __builtin_amdgcn_exp2f(s1[i] - dm); ls += s0[i] + s1[i]; } }
            else {
#pragma unroll
                for (int i = 0; i < 16; ++i) { s0[i] = __builtin_amdgcn_exp2f(s0[i]); s1[i] = __builtin_amdgcn_exp2f(s1[i]); ls += s0[i] + s1[i]; } }
            l_run = l_run * alpha + ls;
            if (grow) {
#pragma unroll
                for (int i = 0; i < 16; ++i) { o0[i] *= alpha; o1[i] *= alpha; } }
#pragma unroll
            for (int s2 = 0; s2 < 4; ++s2) {
                union { bf16x8 v; unsigned w[4]; } pf;
#pragma unroll
                for (int j = 0; j < 4; ++j) { const int ri = 8 * (s2 & 1) + 2 * j; pf.w[j] = (s2 < 2) ? pack2(s0[ri], s0[ri + 1]) : pack2(s1[ri], s1[ri + 1]); }
                o0 = __builtin_amdgcn_mfma_f32_32x32x16_bf16(vf[s2][0].v, pf.v, o0, 0, 0, 0); o1 = __builtin_amdgcn_mfma_f32_32x32x16_bf16(vf[s2][1].v, pf.v, o1, 0, 0, 0);
            }
            if (more) ATT_WRITE(buf ^ 1);
            __syncthreads();
            if (more) ATT_KFRAGS(buf ^ 1);
        }
#undef ATT_KFRAGS
#undef ATT_KIDX
#undef ATT_LOAD
#undef ATT_WRITE
        const float inv = 1.f / (l_run + __shfl_xor(l_run, 32));
        bf16_t* op = A + (size_t)(b * SEQ + qpos) * 1024 + ocol + 4 * hh;
#pragma unroll
        for (int t4 = 0; t4 < 4; ++t4) { uint2 p;
            p.x = pack2(o0[4 * t4] * inv, o0[4 * t4 + 1] * inv); p.y = pack2(o0[4 * t4 + 2] * inv, o0[4 * t4 + 3] * inv); *(uint2*)(op + 8 * t4) = p;
            p.x = pack2(o1[4 * t4] * inv, o1[4 * t4 + 1] * inv); p.y = pack2(o1[4 * t4 + 2] * inv, o1[4 * t4 + 3] * inv); *(uint2*)(op + 32 + 8 * t4) = p; }
    }
    __syncthreads();
}

template <class Epi>
__device__ __forceinline__ void run_gemm(const Fr& F, const bf16_t* A, int lda, const bf16_t* Bt, int ldb, int M, int N, int K, const Epi& E) {
    pg8::Gemm g{A, Bt, M, N, K, lda, ldb, 0}; pg8::StaticOrder S; S.init(M, N, F.G, F.bid);
    pg8::gemm_phase<Epi, pg8::StaticOrder>((LAS unsigned char*)F.lds, g, S, E);
}

__global__ void __launch_bounds__(NTHR, 2) fwd(Args args) {
    extern __shared__ __attribute__((aligned(16))) unsigned char lds[];
    Fr F; F.in = args.in; F.out = args.out; F.ws = args.ws; F.lds = lds; F.tid = threadIdx.x; F.lane = F.tid & 63; F.wave = __builtin_amdgcn_readfirstlane(F.tid >> 6); F.G = gridDim.x; F.bid = blockIdx.x;
    const int lo = args.ph_lo, hi = args.ph_hi;
#ifndef PHMASK
#define PHMASK 0xFFFFFFFFu
#endif
#define IN(k) (((PHMASK >> (k)) & 1u) && lo <= (k) && (k) < hi)
    const float* MOD0 = F.w<float>(WS_MOD); const float* MOD1 = MOD0 + 9 * 6144;
    const bool multi_phase = (hi - lo) > 1;
    if (F.tid == 0) *(uint4*)(lds + LDS_BYTES - 16) = make_uint4(0u, 0u, 0u, 0u);
    __syncthreads();
    XcdBarrier bar; bar.bar = F.w<unsigned>(WS_CTL); bar.x = 0; bar.st = (volatile LAS unsigned*)(LAS unsigned char*)(lds + LDS_BYTES - 16);
    if (multi_phase) bar = xcd_barrier_post(F.w<unsigned>(WS_CTL), (volatile LAS unsigned*)(LAS unsigned char*)(lds + LDS_BYTES - 16));
#define SEAM(k) do { if (IN(k) && IN((k) + 1)) xcd_barrier(bar); } while (0)
    bf16_t* ABUF = F.w<bf16_t>(WS_ABUF);

#ifndef DUPMASK
#define DUPMASK 0u
#endif
#define PHASE(k, ...) if (IN(k)) { __VA_ARGS__ } if (IN(k) && ((DUPMASK >> (k)) & 1u)) { xcd_barrier(bar); __VA_ARGS__ } SEAM(k);
    PHASE(0,
        ph_ada(F);
        cvt_job(F, F.in[I_EVWIN], nullptr, nullptr, F.w<bf16_t>(W_IN0), EVEN_PAD, 1024, 1024, EVEN_IN, EVEN_IN, 0, 1, 0);
        cvt_job(F, F.in[I_EVWOUT], nullptr, nullptr, F.w<bf16_t>(W_OUT0), 1024, 1024, 1024, 1024, 1024, 0, 1, 208);
        cvt_job(F, F.in[I_FFNG], F.in[I_FFNU], nullptr, F.w<bf16_t>(W_GU0), 2 * DFF, 1024, 1024, DFF, DFF, 1, 1, 272);
        cvt_job(F, F.in[I_FFND], nullptr, nullptr, F.w<bf16_t>(W_DN0), 1024, DFF, DFF, 1024, 1024, 0, 1, 624);
        cvt_job(F, F.in[I_ODWIN], nullptr, nullptr, F.w<bf16_t>(W_IN1), ODD_PAD, 1024, 1024, 1184, 1184, 0, 1, 800);
        cvt_job(F, F.in[I_QUP], nullptr, F.in[I_QNG], F.w<bf16_t>(W_QUP), 768, 256, 256, 768, 768, 0, 0, 880);
        cvt_job(F, F.in[I_KVUP], nullptr, F.in[I_KVNG], F.w<bf16_t>(W_KUP), 512, 256, 128, 1024, 1024, 2, 1, 892);
        cvt_job(F, F.in[I_KVUP], nullptr, F.in[I_KVNG], F.w<bf16_t>(W_VUP), 512, 256, 128, 1024, 1024, 3, 0, 900);
        cvt_job(F, F.in[I_ODWOUT], nullptr, nullptr, F.w<bf16_t>(W_OUT1), 1024, 1024, 1024, 1024, 1024, 0, 1, 908);
        ph_filters(F); ph_rope_tables(F);)
    PHASE(1, ph_norm0(F);)
    PHASE(2, run_gemm(F, ABUF, 1024, F.w<bf16_t>(W_IN0), 1024, TT, EVEN_PAD, 1024, pg8::EpiBf16Plain{F.w<bf16_t>(L0_PROJ), EVEN_PAD});)
    PHASE(3, ph_convpass(F);)
    PHASE(4, ph_ssd_a(F); ph_hyena_mfma(F);)
    PHASE(6, ph_ssd_b(F);)
    PHASE(7, ph_ssd_c(F); ph_hyena_post(F);)
    PHASE(8,
        run_gemm(F, ABUF, 1024, F.w<bf16_t>(W_OUT0), 1024, TL, 1024, 1024, pg8::EpiBf16Plain{F.w<bf16_t>(L0_MBUF), 1024});
        { pg8::Gemm g{ABUF, F.w<bf16_t>(W_OUT0), TT, 1024, 1024, 1024, 1024, 0}; pg8::DenseTailOrder<8> S; S.init(TL / 256, TC / 256, 1024 / 64, F.G, F.bid);
          pg8::gemm_phase<pg8::EpiTailBf16, pg8::DenseTailOrder<8>>((LAS unsigned char*)F.lds, g, S, pg8::EpiTailBf16{F.w<bf16_t>(L0_MBUF), 1024, F.w<bf16_t>(L0_XT), TL / 256, 8}); }
        cvt_fill(F, NWG8, CVQ8, cvt_g0(F.G, 8));)
    PHASE(9, ph_thin<0, true, false>(F, (const float*)F.w<bf16_t>(L0_MBUF), TT, F.in[I_X], F.in[I_CTX], nullptr, nullptr, F.in[I_MIXPOST], MOD0, 2048, F.in[I_FFNPRE], MOD0, 3072, 4096, ABUF, 0, 1, F.w<bf16_t>(L0_XT), 8);)
    PHASE(10, run_gemm(F, ABUF, 1024, F.w<bf16_t>(W_GU0), 1024, TT, 2 * DFF, 1024, pg8::EpiSwiglu{F.w<bf16_t>(L0_HMID), DFF}); cvt_fill(F, NWG10, CVQ10, cvt_g0(F.G, 10));)
    PHASE(11,
        run_gemm(F, F.w<bf16_t>(L0_HMID), DFF, F.w<bf16_t>(W_DN0), DFF, TL, 1024, DFF, pg8::EpiBf16Plain{F.w<bf16_t>(L0_MBUF), 1024});
        { pg8::Gemm g{F.w<bf16_t>(L0_HMID), F.w<bf16_t>(W_DN0), TT, 1024, DFF, DFF, DFF, 0}; pg8::DenseTailOrder<11> S; S.init(TL / 256, TC / 256, DFF / 64, F.G, F.bid);
          pg8::gemm_phase<pg8::EpiTailBf16, pg8::DenseTailOrder<11>>((LAS unsigned char*)F.lds, g, S, pg8::EpiTailBf16{F.w<bf16_t>(L0_MBUF), 1024, F.w<bf16_t>(L0_XT), TL / 256, 11}); }
        cvt_fill(F, NWG11, CVQ11, cvt_g0(F.G, 11));)
    PHASE(12, ph_thin<0, false, false>(F, (const float*)F.w<bf16_t>(L0_MBUF), TT, nullptr, nullptr, nullptr, nullptr, F.in[I_FFNPOST], MOD0, 5120, F.in[I_MIXPRE] + 1024, MOD1, 0, 1024, ABUF, 0, 1, F.w<bf16_t>(L0_XT), 11);)
    PHASE(13, run_gemm(F, ABUF, 1024, F.w<bf16_t>(W_IN1), 1024, TT, ODD_PAD, 1024, pg8::EpiBf16Plain{F.w<bf16_t>(L1_PROJ), ODD_PAD}); cvt_fill(F, NWG13, CVQ13, cvt_g0(F.G, 13));)
    PHASE(14, ph_attn_prep(F);)
    PHASE(15,
        run_gemm(F, F.w<bf16_t>(L1_PROJ), ODD_PAD, F.w<bf16_t>(W_QUP), 256, TL, 768, 256, pg8::EpiQ{F.w<bf16_t>(L1_QM), F.w<float>(WS_SQ), F.w<float>(WS_ROPEM), F.w<float>(WS_ROPEM) + 2048 * 16, 0.10206207261596575f * LOG2E});
        run_gemm(F, F.w<bf16_t>(L1_PROJ) + 256, ODD_PAD, F.w<bf16_t>(W_KUP), 256, TT, 512, 256, pg8::EpiK{F.w<bf16_t>(L1_KM), F.w<float>(WS_SKV)});
        run_gemm(F, F.w<bf16_t>(W_VUP), 256, F.w<bf16_t>(L1_PROJ) + 256, ODD_PAD, 512, TT, 256, pg8::EpiVT{F.w<bf16_t>(L1_VT), F.w<float>(WS_SKV)});)
    PHASE(16, ph_attn_mfma<false>(F); ph_attn_mfma<true>(F);)
    PHASE(17, run_gemm(F, ABUF, 1024, F.w<bf16_t>(W_OUT1), 1024, TL, 1024, 1024, pg8::EpiBf16Plain{F.w<bf16_t>(L1_MBUF), 1024});)
    PHASE(18, ph_thin<1, false, false>(F, (const float*)F.w<bf16_t>(L1_MBUF), TL, nullptr, nullptr, nullptr, nullptr, F.in[I_MIXPOST] + 1024, MOD1, 2048, F.in[I_FFNPRE] + 1024, MOD1, 3072, 4096, F.w<bf16_t>(L1_A2TMP));)
    PHASE(19,
        ph_moe_gather(F);
        cvt_moe_range(F, cvt_g0(F.G, 19), CVT_T_ALL, F.bid, F.G);)
    PHASE(20,
        if (MOE_FP8) { pg8::Gemm g{F.w<bf16_t>(WS_AG), F.w<bf16_t>(WM_GU), 0, 2 * DFE, 512, 512, 512, (size_t)2 * DFE * 1024}; pg8::GroupedOrder S; S.init(F.w<unsigned>(WS_CNT), 2 * DFE / 256, F.G, F.bid);
            pg8::gemm_phase<pg8::EpiSwigluF8, pg8::GroupedOrder, true>((LAS unsigned char*)F.lds, g, S, pg8::EpiSwigluF8{F.w<unsigned char>(L1_HMID), DFE}); }
        else { pg8::Gemm g{F.w<bf16_t>(WS_AG), F.w<bf16_t>(WM_GU), 0, 2 * DFE, 1024, 1024, 1024, (size_t)2 * DFE * 1024 * 2}; pg8::GroupedOrder S; S.init(F.w<unsigned>(WS_CNT), 2 * DFE / 256, F.G, F.bid);
            pg8::gemm_phase<pg8::EpiSwiglu, pg8::GroupedOrder>((LAS unsigned char*)F.lds, g, S, pg8::EpiSwiglu{F.w<bf16_t>(L1_HMID), DFE}); })
    PHASE(21,
        constexpr int KE = MOE_FP8 ? DFE / 2 : DFE;
        constexpr float osc = MOE_FP8 ? 1.f / (F8_WSCALE * F8_HSCALE) : 1.f;
        pg8::Gemm g{F.w<bf16_t>(L1_HMID), F.w<bf16_t>(WM_DN), 0, 1024, KE, KE, KE, (size_t)1024 * KE * 2};
        { pg8::GroupedOrder S; S.init(F.w<unsigned>(WS_CNT), 4, F.G, F.bid, KE / 64, true);
          pg8::gemm_phase<pg8::EpiMoeOut, pg8::GroupedOrder, MOE_FP8 != 0>((LAS unsigned char*)F.lds, g, S, pg8::EpiMoeOut{F.w<bf16_t>(WS_MOUT), F.w<uint2>(WS_ROWINFO), osc}); }
        { pg8::TailOrder S; S.init(F.w<unsigned>(WS_CNT), F.G, F.bid, KE / 64);
          pg8::gemm_phase<pg8::EpiXtr, pg8::TailOrder, MOE_FP8 != 0>((LAS unsigned char*)F.lds, g, S, pg8::EpiXtr{F.w<bf16_t>(WS_MOUT), F.w<uint2>(WS_ROWINFO), F.w<bf16_t>(WS_XTR), S.NTF, 7, osc}); })
    PHASE(22,
        pg8::TailOrder S; S.init(F.w<unsigned>(WS_CNT), F.G, F.bid, (MOE_FP8 ? DFE / 2 : DFE) / 64);
        ph_thin<2, false, true>(F, (const float*)F.w<bf16_t>(WS_MOUT), TL, nullptr, nullptr, F.out, nullptr, F.in[I_FFNPOST] + 1024, MOD1, 5120, nullptr, nullptr, 0, 0, nullptr, S.NTF, S.nsub > 0 ? 7 : 1);)
#undef IN
}

extern "C" void kernel_launch(void* const* d_in, const int* in_sizes, int n_in, void* d_out, int out_size, void* d_ws, size_t ws_size, hipStream_t stream) {
    static int grid = 0;
    if (grid == 0) {
        if (n_in != 41 || out_size != TL * DM || ws_size < WS_END) { fprintf(stderr, "kernel_launch: unexpected shapes (n_in %d, out %d, ws %zu < %zu)\n", n_in, out_size, ws_size, (size_t)WS_END); grid = -1; return; }
        int dev = 0, cus = 0;
        if (hipGetDevice(&dev) != hipSuccess || hipDeviceGetAttribute(&cus, hipDeviceAttributeMultiprocessorCount, dev) != hipSuccess) { grid = -1; return; }
        if (hipFuncSetAttribute((const void*)fwd, hipFuncAttributeMaxDynamicSharedMemorySize, LDS_BYTES) != hipSuccess) { fprintf(stderr, "kernel_launch: hipFuncSetAttribute failed\n"); grid = -1; return; }
        int per_cu = 0;
        if (hipOccupancyMaxActiveBlocksPerMultiprocessor(&per_cu, (const void*)fwd, NTHR, LDS_BYTES) != hipSuccess || per_cu < 1) fprintf(stderr, "kernel_launch: occupancy query says %d\n", per_cu);
        (void)hipGetLastError();
        grid = cus;
        if (grid % 4 != 0) { fprintf(stderr, "kernel_launch: the kernel needs a grid size that is a multiple of 4 (got %d CUs)\n", grid); grid = -1; return; }
    }
    if (grid < 0) return;
    (void)hipMemsetAsync((char*)d_ws + WS_CTL, 0, 65536, stream);
    Args a{};
    for (int i = 0; i < 41; ++i) a.in[i] = (const float*)d_in[i];
    a.out = (float*)d_out; a.ws = (unsigned char*)d_ws;
    auto launch = [&](int lo, int hi, int ex) { a.ph_lo = lo; a.ph_hi = hi; a.ex = ex; hipLaunchKernelGGL(fwd, dim3(grid), dim3(NTHR), LDS_BYTES, stream, a); };
#if defined(MULTI)
    for (int p = 0; p <= 22; ++p) launch(p, p + 1, 0);
#else
    launch(0, 23, 0);
#endif
}
```

```cpp
#include <hip/hip_runtime.h>
#include <cstdio>
#include <cstdint>

typedef unsigned short bf16_t;
typedef short bf16x8 __attribute__((ext_vector_type(8)));
typedef float f32x4 __attribute__((ext_vector_type(4)));
#define LAS __attribute__((address_space(3)))

constexpr int NB = 8, SEQ = 2048, DM = 1024, CTXL = 256;
constexpr int TL = NB * SEQ, TC = NB * CTXL, TT = TL + TC, NKEY = SEQ + CTXL;
constexpr int EVEN_IN = 3088, EVEN_PAD = 3328, ODD_PAD = 1280, DFF = 2816, DFE = 3584, NEXP = 8;
constexpr float EPS = 1e-6f;
constexpr float LOG2E = 1.4426950408889634f;
constexpr int NTHR = 512;
constexpr int LDS_BYTES = 147456;

constexpr size_t al256(size_t x) { return (x + 255) & ~(size_t)255; }
constexpr size_t WS_CTL = 0;
constexpr size_t WS_CNT = 16384;
constexpr size_t WS_MOD = 65536;
constexpr size_t WS_ROPEM = WS_MOD + al256((size_t)2 * 9 * 6144 * 4);
constexpr size_t WS_ROPEG = WS_ROPEM + (size_t)2 * 2048 * 16 * 4;
constexpr size_t WS_SQ = WS_ROPEG + (size_t)2 * 2048 * 32 * 4;
constexpr size_t WS_SKV = WS_SQ + al256((size_t)TT * 4);
constexpr size_t WS_TOPW = WS_SKV + al256((size_t)TT * 4);
constexpr size_t WS_LISTE = WS_TOPW + (size_t)TL * 2 * 4;
constexpr int MAXROWS = 34816;
constexpr size_t WS_ROWINFO = WS_LISTE + (size_t)NEXP * TL * 4;
constexpr size_t WS_ROWW = WS_ROWINFO + (size_t)MAXROWS * 4;
constexpr size_t WS_SROW = WS_ROWW + (size_t)MAXROWS * 4;
constexpr size_t WS_W0 = WS_SROW + (size_t)TL * 2 * 4;
constexpr size_t W_IN0 = WS_W0;
constexpr size_t W_OUT0 = W_IN0 + (size_t)EVEN_PAD * 1024 * 2;
constexpr size_t W_GU0 = W_OUT0 + (size_t)1024 * 1024 * 2;
constexpr size_t W_DN0 = W_GU0 + (size_t)2 * DFF * 1024 * 2;
constexpr size_t W_IN1 = W_DN0 + (size_t)1024 * DFF * 2;
constexpr size_t W_QUP = W_IN1 + (size_t)ODD_PAD * 1024 * 2;
constexpr size_t W_KUP = W_QUP + (size_t)768 * 256 * 2;
constexpr size_t W_VUP = W_KUP + (size_t)512 * 256 * 2;
constexpr size_t W_OUT1 = W_VUP + (size_t)512 * 256 * 2;
constexpr size_t WS_ABUF = W_OUT1 + (size_t)1024 * 1024 * 2;
constexpr size_t WS_AG = WS_W0;
constexpr size_t WS_MOUT = WS_W0;
constexpr size_t XG_END0 = WS_ABUF + (size_t)TT * DM * 2, XG_END1 = WS_AG + (size_t)MAXROWS * DM * 2;
constexpr size_t WS_R1 = al256(XG_END0 > XG_END1 ? XG_END0 : XG_END1);
constexpr size_t R1_BYTES = (size_t)MAXROWS * DFE * 2;
constexpr size_t WS_R2 = WS_R1 + R1_BYTES;
constexpr size_t R2_BYTES = (size_t)132 * 1024 * 1024;
constexpr size_t WS_XTR = WS_R2 + R2_BYTES;
constexpr size_t WS_HB = WS_XTR + (size_t)32 * 6 * 65536 * 2;
constexpr size_t WS_END = WS_HB + (size_t)TT * DM * 2;
static_assert(WS_END <= (size_t)536000000, "workspace budget");
constexpr size_t L0_PROJ = WS_R1;
constexpr size_t L0_HMID = WS_R1;
constexpr size_t L0_XBC = L0_PROJ + (size_t)TT * EVEN_PAD * 2;
constexpr size_t L0_U = L0_XBC + (size_t)TT * 1024 * 2;
constexpr size_t L0_X0 = L0_U + (size_t)TT * 512 * 2;
constexpr size_t L0_DT = L0_X0 + (size_t)TT * 512 * 2;
constexpr size_t L0_YF = L0_DT + (size_t)TT * 16 * 4;
constexpr size_t L0_YB = L0_YF + (size_t)TT * 512 * 2;
static_assert(L0_YB + (size_t)TT * 512 * 2 <= WS_R1 + R1_BYTES, "R1 layer 0");
constexpr size_t L0_MBUF = WS_R1 + (size_t)128 * 1024 * 1024;
static_assert(L0_MBUF >= L0_HMID + (size_t)TT * DFF * 2 && L0_MBUF + (size_t)TT * DM * 2 <= WS_R1 + R1_BYTES, "MBUF0 placement");
constexpr size_t L0_XT = WS_R1 + (size_t)176 * 1024 * 1024;
static_assert(L0_XT >= L0_MBUF + (size_t)TT * DM * 2 && L0_XT + (size_t)32 * 10 * 65536 * 2 <= WS_R1 + R1_BYTES, "XT0 placement");
constexpr size_t L0_FL = WS_R2 + (size_t)TT * DM * 2;
constexpr size_t L0_FC = L0_FL + (size_t)512 * 4096 * 2;
constexpr size_t L0_YT = L0_FC + (size_t)512 * 512 * 2;
constexpr size_t L0_ST = L0_YT + (size_t)512 * 8 * NKEY * 2;
constexpr size_t L0_ACS = L0_ST + (size_t)2304 * 8192 * 4;
constexpr size_t L0_ATOT = L0_ACS + (size_t)2304 * 128 * 4;
constexpr size_t L0_STIN = WS_R2;
static_assert(L0_ATOT + (size_t)2304 * 4 <= WS_R2 + R2_BYTES, "R2 layer 0");
constexpr size_t L1_HMID = WS_R1;
constexpr size_t L1_A2TMP = WS_R1;
constexpr size_t L1_PROJ = WS_R1;
constexpr size_t L1_QM = L1_PROJ + (size_t)TT * ODD_PAD * 2;
constexpr size_t L1_KM = L1_QM + (size_t)TL * 768 * 2;
constexpr size_t L1_VT = L1_KM + (size_t)NB * NKEY * 768 * 2;
constexpr size_t L1_QG = L1_VT + (size_t)NB * 512 * NKEY * 2;
constexpr size_t L1_KG = L1_QG + (size_t)TL * 512 * 2;
constexpr size_t L1_VGT = L1_KG + (size_t)NB * NKEY * 128 * 2;
constexpr size_t L1_MBUF = L1_VGT + (size_t)NB * 128 * NKEY * 2;
static_assert(L1_MBUF + (size_t)TL * DM * 4 <= WS_R1 + R1_BYTES, "R1 layer 1");
static_assert(L1_A2TMP + (size_t)TL * DM * 2 <= L1_MBUF, "a2tmp vs mbuf1");
constexpr size_t WM_GU = WS_R2;
constexpr size_t WM_DN = WM_GU + (size_t)NEXP * 2 * DFE * 1024;
static_assert(WM_DN + (size_t)NEXP * 1024 * DFE <= WS_R2 + R2_BYTES, "fp8 expert weights vs R2");

typedef __bf16 bf16v2 __attribute__((ext_vector_type(2)));
typedef float f32v2 __attribute__((ext_vector_type(2)));
__device__ __forceinline__ bf16_t f2bf(float f) { return __builtin_bit_cast(unsigned short, (__bf16)f); }
__device__ __forceinline__ float bf2f(bf16_t b) { return __uint_as_float(((unsigned)b) << 16); }
__device__ __forceinline__ unsigned pack2(float lo, float hi) { f32v2 v = {lo, hi}; return __builtin_bit_cast(unsigned, __builtin_convertvector(v, bf16v2)); }
#ifndef MOE_FP8
#define MOE_FP8 1
#endif
constexpr float F8_WSCALE = 64.f, F8_HSCALE = 8.f;
__device__ __forceinline__ unsigned pack4_fp8(float a, float b, float c, float d) { unsigned r = 0u; r = __builtin_amdgcn_cvt_pk_fp8_f32(a, b, r, false); r = __builtin_amdgcn_cvt_pk_fp8_f32(c, d, r, true); return r; }
__device__ __forceinline__ float bflo(unsigned u) { return __uint_as_float(u << 16); }
__device__ __forceinline__ float bfhi(unsigned u) { return __uint_as_float(u & 0xFFFF0000u); }
__device__ __forceinline__ float wave_sum(float v) {
#pragma unroll
    for (int o = 32; o > 0; o >>= 1) v += __shfl_xor(v, o);
    return v;
}
__device__ __forceinline__ float silu_f(float x) { return x * __builtin_amdgcn_rcpf(1.f + __builtin_amdgcn_exp2f(-x * LOG2E)); }
__device__ __forceinline__ float softplus_f(float x) { return x > 20.f ? x : log1pf(expf(x)); }

namespace pg8 {
constexpr int BM = 256, BK = 64, HALF = 128, HTB = HALF * BK * 2, STAGE_BYTES = 8 * HTB, NXCD = 8, WGM = 8;
__host__ __device__ __forceinline__ int lds_byte(int r, int c) { const int st = (r >> 4) * 2 + (c >> 5), rr = r & 15, cc = c & 31, ob = rr * 64 + cc * 2; return st * 1024 + (ob ^ (((ob >> 9) & 1) << 5)); }
__host__ __device__ __forceinline__ void stage_rc(int b, int& R, int& C) { const int st = b / 1024, sb = b % 1024, swz = sb ^ (((sb >> 9) & 1) << 5); R = (st >> 1) * 16 + swz / 64; C = (st & 1) * 32 + (swz % 64) / 2; }

struct Unit { int pm, pn, e, kt0, nkt, ks; };
struct Gemm { const bf16_t* A; const bf16_t* Bt; int M, N, K, lda, ldb; size_t bstride; };

struct StaticOrder {
    int nM, nN, nwg, G, c;
    __device__ __forceinline__ void init(int M, int N, int G_, int c_) { nM = M / BM; nN = N / BM; nwg = nM * nN; G = G_; c = c_; }
    __device__ __forceinline__ bool next(int i, Unit& u) const {
        const long L = (long)i * G + c; if (L >= nwg) return false;
        int wgid = (int)L; { const int q = nwg / NXCD, r = nwg % NXCD, xcd = wgid % NXCD, off = wgid / NXCD; wgid = (xcd < r ? xcd * (q + 1) : r * (q + 1) + (xcd - r) * q) + off; }
        const int nig = WGM * nN, gid = wgid / nig, fm = gid * WGM, gsz = (nM - fm) < WGM ? (nM - fm) : WGM;
        u.pm = fm + ((wgid % nig) % gsz); u.pn = (wgid % nig) / gsz; u.e = 0; u.kt0 = 0; u.nkt = 0; u.ks = 0; return true;
    }
};


struct GroupedOrder {
    int ts1, ts2, ts3, ts4, ts5, ts6, ts7, NT, nrow, nN, G, c;
    __device__ __forceinline__ static void tail_of(int NT, int nN, int G, int nkt_full, int& NTF, int& S) {
        NTF = NT; S = 1;
        if (nN == 4 && (G % 4) == 0) { const int ntf = ((NT * 4) / G) * (G / 4); const int R = (NT - ntf) * 4; if (R > 0 && ntf > 0 && R * 7 <= G && nkt_full % 14 == 0) { NTF = ntf; S = 7; } }
    }
    __device__ __forceinline__ void init(const unsigned* cnt, int nN_, int G_, int c_, int nkt_full = 0, bool head_only = false) {
        int t[9]; t[0] = 0;
#pragma unroll
        for (int e = 0; e < 8; ++e) t[e + 1] = t[e] + __builtin_amdgcn_readfirstlane((int)((__hip_atomic_load(cnt + e, __ATOMIC_RELAXED, __HIP_MEMORY_SCOPE_AGENT) + 255u) >> 8));
        ts1 = t[1]; ts2 = t[2]; ts3 = t[3]; ts4 = t[4]; ts5 = t[5]; ts6 = t[6]; ts7 = t[7]; NT = t[8]; nN = nN_; G = G_; c = c_; nrow = NT;
        if (head_only) { int ntf, s; tail_of(NT, nN, G, nkt_full, ntf, s); nrow = ntf; }
    }
    __device__ __forceinline__ int expert_of(int j) const { return (j >= ts1) + (j >= ts2) + (j >= ts3) + (j >= ts4) + (j >= ts5) + (j >= ts6) + (j >= ts7); }
    __device__ __forceinline__ bool next(int i, Unit& u) const {
        const int nwg = nrow * nN; const long L = (long)i * G + c; u.kt0 = 0; u.nkt = 0; u.ks = 0; if (L >= nwg) return false;
        int wgid = (int)L; { const int q = nwg / NXCD, r = nwg % NXCD, xcd = wgid % NXCD, off = wgid / NXCD; wgid = (xcd < r ? xcd * (q + 1) : r * (q + 1) + (xcd - r) * q) + off; }
        const int nig = WGM * nN, gid = wgid / nig, fm = gid * WGM, gsz = (nrow - fm) < WGM ? (nrow - fm) : WGM;
        const int j = fm + ((wgid % nig) % gsz); u.pm = j; u.pn = (wgid % nig) / gsz; u.e = expert_of(j); return true;
    }
};
struct TailOrder {
    int ts1, ts2, ts3, ts4, ts5, ts6, ts7, nsub, NTF, nkt, c;
    __device__ __forceinline__ void init(const unsigned* cnt, int G, int c_, int nkt_full) {
        int t[9]; t[0] = 0;
#pragma unroll
        for (int e = 0; e < 8; ++e) t[e + 1] = t[e] + __builtin_amdgcn_readfirstlane((int)((__hip_atomic_load(cnt + e, __ATOMIC_RELAXED, __HIP_MEMORY_SCOPE_AGENT) + 255u) >> 8));
        ts1 = t[1]; ts2 = t[2]; ts3 = t[3]; ts4 = t[4]; ts5 = t[5]; ts6 = t[6]; ts7 = t[7]; int s; GroupedOrder::tail_of(t[8], 4, G, nkt_full, NTF, s);
        nsub = (s == 7) ? (t[8] - NTF) * 28 : 0; nkt = nkt_full / 7; c = c_;
    }
    __device__ __forceinline__ bool next(int i, Unit& u) const {
        if (i > 0 || c >= nsub) return false;
        const int tu = c / 7, ks = c - tu * 7, j = NTF + (tu >> 2); u.pm = j; u.pn = tu & 3; u.e = (j >= ts1) + (j >= ts2) + (j >= ts3) + (j >= ts4) + (j >= ts5) + (j >= ts6) + (j >= ts7);
        u.nkt = nkt; u.kt0 = ks * nkt; u.ks = ks; return true;
    }
};

typedef int i32x4v __attribute__((ext_vector_type(4)));
typedef int i32x8v __attribute__((ext_vector_type(8)));
template <class Epi, class Sched, bool FP8 = false>
__device__ __forceinline__ void gemm_phase(LAS unsigned char* lds, const Gemm g, const Sched& S, const Epi& E) {
    const int tid = threadIdx.x, wid = __builtin_amdgcn_readfirstlane(tid >> 6), lane = tid & 63, wr = wid >> 2, wc = wid & 3, fr = lane & 15, fq = lane >> 4;
    int Kop = g.K; asm volatile("" : "+s"(Kop));
    const int K = Kop, nt = K / BK;
    unsigned voffA[2], voffB[2];
#pragma unroll
    for (int i = 0; i < 2; ++i) { int R, C; stage_rc(tid * 16 + i * 8192, R, C); voffA[i] = (unsigned)(R * g.lda + C) * 2u; voffB[i] = (unsigned)(R * g.ldb + C) * 2u; }
    const size_t kstep = (size_t)(BK * 2);
    const size_t hstepA = (size_t)HALF * g.lda * 2, hstepB = (size_t)HALF * g.ldb * 2;
    const size_t tstepA = 2 * hstepA, tstepB = 2 * hstepB;
    const unsigned ldsw = (unsigned)wid * 1024u;
    const int aoff = lds_byte(wr * 64 + fr, fq * 8), boff = lds_byte(wc * 32 + fr, fq * 8);
#define PG8_SA(b, h) (((b) * 2 + (h)) * HTB)
#define PG8_SB(b, h) ((4 + (b) * 2 + (h)) * HTB)
#define PG8_STAGE(bufoff, gbase, voff) do { _Pragma("unroll") for (int _i = 0; _i < 2; ++_i) \
        __builtin_amdgcn_global_load_lds((const unsigned*)((const char*)(gbase) + (voff)[_i]), (LAS unsigned*)(lds + (bufoff) + ldsw + _i * 8192), 16, 0, 0); } while (0)
#define PG8_LDA(dst, b, h) do { if constexpr (FP8) { _Pragma("unroll") for (int m = 0; m < 4; ++m) dst##8[m] = __builtin_shufflevector(*(const LAS i32x4v*)(lds + PG8_SA(b, h) + aoff + m * 2048), *(const LAS i32x4v*)(lds + PG8_SA(b, h) + aoff + m * 2048 + 1024), 0, 1, 2, 3, 4, 5, 6, 7); } \
        else { _Pragma("unroll") for (int m = 0; m < 4; ++m) _Pragma("unroll") for (int k = 0; k < 2; ++k) dst[m][k] = *(const LAS bf16x8*)(lds + PG8_SA(b, h) + aoff + m * 2048 + k * 1024); } } while (0)
#define PG8_LDB(dst, b, h) do { if constexpr (FP8) { _Pragma("unroll") for (int n = 0; n < 2; ++n) dst##8[n] = __builtin_shufflevector(*(const LAS i32x4v*)(lds + PG8_SB(b, h) + boff + n * 2048), *(const LAS i32x4v*)(lds + PG8_SB(b, h) + boff + n * 2048 + 1024), 0, 1, 2, 3, 4, 5, 6, 7); } \
        else { _Pragma("unroll") for (int n = 0; n < 2; ++n) _Pragma("unroll") for (int k = 0; k < 2; ++k) dst[n][k] = *(const LAS bf16x8*)(lds + PG8_SB(b, h) + boff + n * 2048 + k * 1024); } } while (0)
#define PG8_MMA(ai, bj, At, Bt) do { __builtin_amdgcn_s_setprio(1); \
        if constexpr (FP8) { _Pragma("unroll") for (int m = 0; m < 4; ++m) _Pragma("unroll") for (int n = 0; n < 2; ++n) \
            asm volatile("v_mfma_scale_f32_16x16x128_f8f6f4 %0, %1, %2, %0, %3, %3 op_sel_hi:[0,0,0]" : "+v"(acc[ai][bj][m][n]) : "v"(Bt##8[n]), "v"(At##8[m]), "v"(f8one)); } \
        else { _Pragma("unroll") for (int m = 0; m < 4; ++m) _Pragma("unroll") for (int n = 0; n < 2; ++n) _Pragma("unroll") for (int k = 0; k < 2; ++k) \
            acc[ai][bj][m][n] = __builtin_amdgcn_mfma_f32_16x16x32_bf16(Bt[n][k], At[m][k], acc[ai][bj][m][n], 0, 0, 0); } \
        __builtin_amdgcn_s_setprio(0); } while (0)
#define PG8_WAIT_V(n) asm volatile("s_waitcnt vmcnt(" #n ")" ::: "memory")
#define PG8_WAIT_L(n) asm volatile("s_waitcnt lgkmcnt(" #n ")" ::: "memory")
#define PG8_BAR __builtin_amdgcn_s_barrier()
#define PG8_SCHED __builtin_amdgcn_sched_barrier(0)
    Unit cur, nxt; int ui = 0;
    if (!S.next(0, cur)) return;
    f32x4 acc[2][2][4][2];
#pragma unroll
    for (int a = 0; a < 2; ++a)
#pragma unroll
        for (int b = 0; b < 2; ++b)
#pragma unroll
            for (int m = 0; m < 4; ++m)
#pragma unroll
                for (int n = 0; n < 2; ++n) acc[a][b][m][n] = (f32x4){0.f, 0.f, 0.f, 0.f};
    bf16x8 At[4][2], B0[2][2], B1[2][2];
    i32x8v At8[4], B08[2], B18[2];
    const int f8one = 0x7f7f7f7f;
    const char* cA = (const char*)g.A + (size_t)cur.pm * tstepA + (size_t)cur.kt0 * kstep; const char* cB = (const char*)g.Bt + (size_t)cur.e * g.bstride + (size_t)cur.pn * tstepB + (size_t)cur.kt0 * kstep;
    PG8_STAGE(PG8_SB(0, 0), cB, voffB); PG8_STAGE(PG8_SA(0, 0), cA, voffA); PG8_STAGE(PG8_SB(0, 1), cB + hstepB, voffB); PG8_STAGE(PG8_SA(0, 1), cA + hstepA, voffA);
    if (wr == 1) PG8_BAR;
    PG8_WAIT_V(4); PG8_BAR;
    PG8_STAGE(PG8_SB(1, 0), cB + kstep, voffB); PG8_STAGE(PG8_SA(1, 0), cA + kstep, voffA); PG8_STAGE(PG8_SB(1, 1), cB + hstepB + kstep, voffB);
    PG8_WAIT_V(6); PG8_BAR;
    for (;;) {
        const bool has_next = S.next(ui + 1, nxt);
        const char* nA = has_next ? (const char*)g.A + (size_t)nxt.pm * tstepA + (size_t)nxt.kt0 * kstep : cA; const char* nB = has_next ? (const char*)g.Bt + (size_t)nxt.e * g.bstride + (size_t)nxt.pn * tstepB + (size_t)nxt.kt0 * kstep : cB;
        const int ntc = cur.nkt ? cur.nkt : nt;
        for (int t = 0; t < ntc; t += 2) {
            const bool last = (t == ntc - 2);
            const char* a1 = cA + (size_t)(t + 1) * kstep;
            const char* a2 = last ? nA : cA + (size_t)(t + 2) * kstep; const char* b2 = last ? nB : cB + (size_t)(t + 2) * kstep;
            const char* a3 = a2 + kstep; const char* b3 = b2 + kstep;
            PG8_LDB(B0, 0, 0); PG8_SCHED; PG8_LDA(At, 0, 0); PG8_STAGE(PG8_SA(1, 1), a1 + hstepA, voffA);
            PG8_WAIT_L(8); PG8_BAR; PG8_WAIT_L(0); PG8_MMA(0, 0, At, B0); PG8_BAR; PG8_SCHED;
            PG8_LDB(B1, 0, 1); PG8_STAGE(PG8_SB(0, 0), b2, voffB);
            PG8_BAR; PG8_WAIT_L(0); PG8_MMA(0, 1, At, B1); PG8_BAR;
            PG8_LDA(At, 0, 1); PG8_STAGE(PG8_SA(0, 0), a2, voffA);
            PG8_BAR; PG8_WAIT_L(0); PG8_MMA(1, 0, At, B0); PG8_BAR; PG8_SCHED;
            PG8_STAGE(PG8_SB(0, 1), b2 + hstepB, voffB);
            PG8_WAIT_V(6); PG8_BAR; PG8_MMA(1, 1, At, B1); PG8_BAR;
            PG8_LDB(B0, 1, 0); PG8_SCHED; PG8_LDA(At, 1, 0); PG8_STAGE(PG8_SA(0, 1), a2 + hstepA, voffA);
            PG8_WAIT_L(8); PG8_BAR; PG8_WAIT_L(0); PG8_MMA(0, 0, At, B0); PG8_BAR; PG8_SCHED;
            PG8_LDB(B1, 1, 1); PG8_STAGE(PG8_SB(1, 0), b3, voffB);
            PG8_BAR; PG8_WAIT_L(0); PG8_MMA(0, 1, At, B1); PG8_BAR;
            PG8_LDA(At, 1, 1); PG8_STAGE(PG8_SA(1, 0), a3, voffA);
            PG8_BAR; PG8_WAIT_L(0); PG8_MMA(1, 0, At, B0); PG8_BAR; PG8_SCHED;
            PG8_STAGE(PG8_SB(1, 1), b3 + hstepB, voffB);
            PG8_WAIT_V(6); PG8_BAR; PG8_MMA(1, 1, At, B1); PG8_BAR;
        }
        if constexpr (FP8) asm volatile("s_nop 15\n\ts_nop 15\n\ts_nop 15\n\ts_nop 15" ::: "memory");
        E(acc, cur, wr, wc, fr, fq);
        if (!has_next) break;
#pragma unroll
        for (int a = 0; a < 2; ++a)
#pragma unroll
            for (int b = 0; b < 2; ++b)
#pragma unroll
                for (int m = 0; m < 4; ++m)
#pragma unroll
                    for (int n = 0; n < 2; ++n) acc[a][b][m][n] = (f32x4){0.f, 0.f, 0.f, 0.f};
        cur = nxt; cA = nA; cB = nB; ++ui;
    }
    PG8_WAIT_V(0);
    if (wr == 0) PG8_BAR;
    PG8_BAR;
#undef PG8_SA
#undef PG8_SB
#undef PG8_STAGE
#undef PG8_LDA
#undef PG8_LDB
#undef PG8_MMA
#undef PG8_WAIT_V
#undef PG8_WAIT_L
#undef PG8_BAR
#undef PG8_SCHED
}

__host__ __device__ __forceinline__ int perm256(int rho) { return 64 * ((rho >> 5) & 3) + 16 * ((rho >> 2) & 3) + 8 * (rho >> 7) + 4 * ((rho >> 4) & 1) + (rho & 3); }
#define EPI_ROWS_BEGIN _Pragma("unroll") for (int ai = 0; ai < 2; ++ai) _Pragma("unroll") for (int m = 0; m < 4; ++m) { asm volatile("" ::: "memory"); const int row = u.pm * BM + ai * HALF + wr * 64 + m * 16 + fr;
#define EPI_ROWS_END }
#define EPI_LOOP_BEGIN EPI_ROWS_BEGIN _Pragma("unroll") for (int bj = 0; bj < 2; ++bj) { const int cg = u.pn * BM + bj * HALF + wc * 32;
#define EPI_LOOP_END } }
__device__ __forceinline__ uint4 pack8(const f32x4 a, const f32x4 b) { uint4 p; p.x = pack2(a[0], a[1]); p.y = pack2(a[2], a[3]); p.z = pack2(b[0], b[1]); p.w = pack2(b[2], b[3]); return p; }

struct EpiBf16Plain {
    bf16_t* O; int ldo;
    __device__ __forceinline__ void operator()(const f32x4 (&acc)[2][2][4][2], const Unit& u, int wr, int wc, int fr, int fq) const {
        EPI_ROWS_BEGIN
            uint4* p = (uint4*)(O + (size_t)row * ldo + u.pn * BM + 64 * wc + 16 * fq);
            p[0] = pack8(acc[ai][0][m][0], acc[ai][0][m][1]); p[1] = pack8(acc[ai][1][m][0], acc[ai][1][m][1]);
        EPI_ROWS_END
    }
};
struct EpiSwiglu {
    bf16_t* O; int ldo;
    __device__ __forceinline__ void operator()(const f32x4 (&acc)[2][2][4][2], const Unit& u, int wr, int wc, int fr, int fq) const {
        EPI_ROWS_BEGIN
            f32x4 h0, h1;
#pragma unroll
            for (int i = 0; i < 4; ++i) { h0[i] = silu_f(acc[ai][0][m][0][i]) * acc[ai][0][m][1][i]; h1[i] = silu_f(acc[ai][1][m][0][i]) * acc[ai][1][m][1][i]; }
            *(uint4*)(O + (size_t)row * ldo + u.pn * 128 + 32 * wc + 8 * fq) = pack8(h0, h1);
        EPI_ROWS_END
    }
};
struct EpiSwigluF8 {
    unsigned char* O; int ldo;
    __device__ __forceinline__ void operator()(const f32x4 (&acc)[2][2][4][2], const Unit& u, int wr, int wc, int fr, int fq) const {
        constexpr float inv = 1.f / F8_WSCALE;
        EPI_ROWS_BEGIN
            float h[8];
#pragma unroll
            for (int i = 0; i < 4; ++i) { h[i] = silu_f(acc[ai][0][m][0][i] * inv) * (acc[ai][0][m][1][i] * (inv * F8_HSCALE)); h[4 + i] = silu_f(acc[ai][1][m][0][i] * inv) * (acc[ai][1][m][1][i] * (inv * F8_HSCALE)); }
#pragma unroll
            for (int i = 0; i < 8; ++i) h[i] = __builtin_amdgcn_fmed3f(h[i], -448.f, 448.f);
            uint2 p; p.x = pack4_fp8(h[0], h[1], h[2], h[3]); p.y = pack4_fp8(h[4], h[5], h[6], h[7]);
            *(uint2*)(O + (size_t)row * ldo + u.pn * 128 + 32 * wc + 8 * fq) = p;
        EPI_ROWS_END
    }
};
struct EpiMoeOut {
    bf16_t* MOUT; const uint2* RIW; float oscale;
    __device__ __forceinline__ void operator()(const f32x4 (&acc)[2][2][4][2], const Unit& u, int wr, int wc, int fr, int fq) const {
        EPI_ROWS_BEGIN
            const uint2 iw = RIW[row]; const int info = (int)iw.x; const float gw = __uint_as_float(iw.y) * oscale;
            if (info >= 0) { uint4* p = (uint4*)(MOUT + ((size_t)(info & 1) * TL + (size_t)(info >> 1)) * 1024 + u.pn * BM + 64 * wc + 16 * fq);
                p[0] = pack8(acc[ai][0][m][0] * gw, acc[ai][0][m][1] * gw); p[1] = pack8(acc[ai][1][m][0] * gw, acc[ai][1][m][1] * gw); }
        EPI_ROWS_END
    }
};
struct EpiXtr {
    bf16_t* MOUT; const uint2* RIW; bf16_t* XTR; int NTF, S; float oscale;
    __device__ __forceinline__ void operator()(const f32x4 (&acc)[2][2][4][2], const Unit& u, int wr, int wc, int fr, int fq) const {
        const bool k0 = (u.ks == 0); const int stride = k0 ? 1024 : 256;
        bf16_t* base = (k0 ? MOUT + u.pn * BM : XTR + (size_t)(((u.pm - NTF) * 4 + u.pn) * (S - 1) + (u.ks - 1)) * 65536) + 64 * wc + 16 * fq;
        EPI_ROWS_BEGIN
            const uint2 iw = RIW[row]; const int info = (int)iw.x; const float gw = __uint_as_float(iw.y) * oscale;
            const int ridx = k0 ? ((info & 1) * TL + (info >> 1)) : (row & 255);
            if (info >= 0 || !k0) { uint4* p = (uint4*)(base + (size_t)ridx * stride); p[0] = pack8(acc[ai][0][m][0] * gw, acc[ai][0][m][1] * gw); p[1] = pack8(acc[ai][1][m][0] * gw, acc[ai][1][m][1] * gw); }
        EPI_ROWS_END
    }
};
struct EpiTailBf16 {
    bf16_t* O; int ldo; bf16_t* XT; int NTF, S;
    __device__ __forceinline__ void operator()(const f32x4 (&acc)[2][2][4][2], const Unit& u, int wr, int wc, int fr, int fq) const {
        const bool k0 = (u.ks == 0); const int stride = k0 ? ldo : 256;
        bf16_t* base = (k0 ? O + u.pn * BM : XT + (size_t)(((u.pm - NTF) * 4 + u.pn) * (S - 1) + (u.ks - 1)) * 65536) + 64 * wc + 16 * fq;
        EPI_ROWS_BEGIN
            uint4* p = (uint4*)(base + (size_t)(k0 ? row : (row & 255)) * stride);
            p[0] = pack8(acc[ai][0][m][0], acc[ai][0][m][1]); p[1] = pack8(acc[ai][1][m][0], acc[ai][1][m][1]);
        EPI_ROWS_END
    }
};
template <int S> struct DenseTailOrder {
    int NTF, nsub, nkt, G, c;
    __device__ __forceinline__ void init(int NTF_, int NTT, int nkt_full, int G_, int c_) { NTF = NTF_; nsub = NTT * 4 * S; int k = nkt_full / S; asm volatile("" : "+s"(k)); nkt = k; G = G_; c = c_; }
    __device__ __forceinline__ bool next(int i, Unit& u) const {
        const int L = i * G + c; if (L >= nsub) return false;
        const int tu = L / S, ks = L - tu * S; u.pm = NTF + (tu >> 2); u.pn = tu & 3; u.e = 0; u.nkt = nkt; u.kt0 = ks * nkt; u.ks = ks; return true;
    }
};
struct EpiQ {
    bf16_t* QM; const float* SQ; const float* cosT; const float* sinT; float qscale;
    __device__ __forceinline__ void operator()(const f32x4 (&acc)[2][2][4][2], const Unit& u, int wr, int wc, int fr, int fq) const {
        EPI_LOOP_BEGIN
            const float s = SQ[row] * qscale; f32x4 v0 = acc[ai][bj][m][0] * s, v1 = acc[ai][bj][m][1] * s;
            if ((cg % 96) == 64) { const int pos = row & (SEQ - 1); const f32x4 c = *(const f32x4*)(cosT + pos * 16 + 4 * fq), sn = *(const f32x4*)(sinT + pos * 16 + 4 * fq);
                const f32x4 o0 = v0 * c - v1 * sn, o1 = v1 * c + v0 * sn; v0 = o0; v1 = o1; }
            uint2 p; p.x = pack2(v0[0], v0[1]); p.y = pack2(v0[2], v0[3]); *(uint2*)(QM + (size_t)row * 768 + cg + 4 * fq) = p;
            p.x = pack2(v1[0], v1[1]); p.y = pack2(v1[2], v1[3]); *(uint2*)(QM + (size_t)row * 768 + cg + 16 + 4 * fq) = p;
        EPI_LOOP_END
    }
};
struct EpiK {
    bf16_t* KM; const float* SKV;
    __device__ __forceinline__ void operator()(const f32x4 (&acc)[2][2][4][2], const Unit& u, int wr, int wc, int fr, int fq) const {
        EPI_ROWS_BEGIN
            const float s = SKV[row]; const int b = row < TL ? (row >> 11) : ((row - TL) >> 8), key = row < TL ? CTXL + (row & (SEQ - 1)) : ((row - TL) & (CTXL - 1));
            const int c = u.pn * BM + 64 * wc + 16 * fq, h = c >> 6, d = c & 63;
            uint4* p = (uint4*)(KM + ((size_t)b * NKEY + key) * 768 + h * 96 + d);
            p[0] = pack8(acc[ai][0][m][0] * s, acc[ai][0][m][1] * s); p[1] = pack8(acc[ai][1][m][0] * s, acc[ai][1][m][1] * s);
        EPI_ROWS_END
    }
};
struct EpiVT {
    bf16_t* VT; const float* SKV;
    __device__ __forceinline__ void operator()(const f32x4 (&acc)[2][2][4][2], const Unit& u, int wr, int wc, int fr, int fq) const {
        EPI_LOOP_BEGIN
#pragma unroll
            for (int n = 0; n < 2; ++n) { const int tok = cg + 16 * n + 4 * fq; const f32x4 s = *(const f32x4*)(SKV + tok); const f32x4 v = acc[ai][bj][m][n] * s;
                const int b = tok < TL ? (tok >> 11) : ((tok - TL) >> 8), key = tok < TL ? CTXL + (tok & (SEQ - 1)) : ((tok - TL) & (CTXL - 1));
                uint2 p; p.x = pack2(v[0], v[1]); p.y = pack2(v[2], v[3]); *(uint2*)(VT + ((size_t)b * 512 + row) * NKEY + key) = p; }
        EPI_LOOP_END
    }
};
}


#define XB_TMO      128
#define XB_XCNT(j)  (256  + 64 * (j))
#define XB_XSUB(j)  (1280 + 64 * (j))
#define XB_XGEN(j)  (2304 + 64 * (j))
#define XB_TOP      3328
#define XB_TOPGEN   3392
#define XCD_BAR_WORDS 3456
#define XB_SPIN_CAP (1u << 18)
__device__ __forceinline__ unsigned xb_ld(unsigned* p)              { return __hip_atomic_load(p, __ATOMIC_RELAXED, __HIP_MEMORY_SCOPE_AGENT); }
__device__ __forceinline__ unsigned xb_add(unsigned* p, unsigned v) { return __hip_atomic_fetch_add(p, v, __ATOMIC_RELAXED, __HIP_MEMORY_SCOPE_AGENT); }
__device__ __forceinline__ unsigned xb_xcc_id() { return (unsigned)__builtin_amdgcn_s_getreg((3 << 11) | 20) & 0xFu; }
#define XB_SPIN(cond, bar) do { unsigned _sp = 0; while (cond) { __builtin_amdgcn_s_sleep(1); \
    if ((++_sp & 255u) == 0u) { if (xb_ld(&(bar)[XB_TMO])) break; if (_sp > XB_SPIN_CAP) { atomicAdd(&(bar)[XB_TMO], 1u); break; } } } } while (0)
struct XcdBarrier { unsigned* bar; unsigned x; volatile LAS unsigned* st; };
__device__ __forceinline__ XcdBarrier xcd_barrier_post(unsigned* bar, volatile LAS unsigned* st) {
    XcdBarrier b; b.bar = bar; b.x = xb_xcc_id(); b.st = st;
    if (threadIdx.x == 0) (void)xb_add(&bar[XB_XCNT(b.x)], 1u);
    return b;
}
__device__ __forceinline__ void xcd_barrier_complete(unsigned* bar, unsigned x, unsigned& nloc, unsigned& nx) {
    const unsigned G = gridDim.x * gridDim.y * gridDim.z;
    unsigned sum, cnt, mine, sp = 0u;
    for (;;) {
        sum = 0u; cnt = 0u; mine = 0u;
#pragma unroll
        for (unsigned j = 0; j < 16; ++j) { const unsigned c = xb_ld(&bar[XB_XCNT(j)]); sum += c; cnt += (c > 0u) ? 1u : 0u; mine = (j == x) ? c : mine; }
        if (sum == G) break;
        __builtin_amdgcn_s_sleep(1);
        if ((++sp & 255u) == 0u) { if (xb_ld(&bar[XB_TMO])) break; if (sp > XB_SPIN_CAP) { atomicAdd(&bar[XB_TMO], 1u); break; } }
    }
    nloc = mine > 0u ? mine : 1u; nx = cnt > 0u ? cnt : 1u;
}
__device__ __forceinline__ void xcd_barrier(const XcdBarrier& b) {
    asm volatile("s_waitcnt vmcnt(0)" ::: "memory");
    __syncthreads();
    if (threadIdx.x == 0) {
        unsigned* bar = b.bar;
        __builtin_amdgcn_s_waitcnt(0);
        unsigned nloc = b.st[0], nx = b.st[1];
        if (nloc == 0u) { xcd_barrier_complete(bar, b.x, nloc, nx); b.st[0] = nloc; b.st[1] = nx; }
        const unsigned old = xb_add(&bar[XB_XSUB(b.x)], 1u);
        const unsigned gen = old / nloc;
        if (old + 1u == (gen + 1u) * nloc) {
            __builtin_amdgcn_fence(__ATOMIC_RELEASE, "agent");
            asm volatile("s_waitcnt vmcnt(0)" ::: "memory");
            const unsigned og = xb_add(&bar[XB_TOP], 1u);
            const unsigned tg = og / nx;
            if (og + 1u == (tg + 1u) * nx) xb_add(&bar[XB_TOPGEN], 1u);
            else XB_SPIN(xb_ld(&bar[XB_TOPGEN]) == tg, bar);
            __builtin_amdgcn_fence(__ATOMIC_ACQUIRE, "agent");
            xb_add(&bar[XB_XGEN(b.x)], 1u);
            asm volatile("s_waitcnt vmcnt(0)" ::: "memory");
        } else {
            XB_SPIN(xb_ld(&bar[XB_XGEN(b.x)]) == gen, bar);
            __builtin_amdgcn_fence(__ATOMIC_ACQUIRE, "agent");
            asm volatile("s_waitcnt vmcnt(0)" ::: "memory");
        }
    }
    __syncthreads();
}

struct Args { const float* in[41]; float* out; unsigned char* ws; int ph_lo, ph_hi, ex, pad; };
enum { I_X = 0, I_C, I_CTX, I_CCTX, I_ADAW, I_ADAB, I_MIXPRE, I_MIXPOST, I_FFNPRE, I_FFNPOST, I_EVWIN, I_HYCW, I_HYCB, I_FW1, I_FB1, I_FW2, I_FB2, I_FW3, I_FREQ, I_HYBIAS,
       I_SCW, I_SCB, I_DTB, I_ALOG, I_SSMD, I_SSMNG, I_EVWOUT, I_FFNG, I_FFNU, I_FFND, I_ODWIN, I_QNG, I_QUP, I_KVNG, I_KVUP, I_SINK, I_ODWOUT, I_ROUTER, I_MOEG, I_MOEU, I_MOED };

struct Fr {
    const float* const* in; float* out; unsigned char* ws; unsigned char* lds; int tid, lane, wave, G, bid;
    template <class T> __device__ __forceinline__ T* w(size_t off) const { return (T*)(ws + off); }
};

__device__ __forceinline__ int colmap(int mode, int perm, int r, int nsrc, int& which) {
    which = 0;
    if (mode == 1) { const int tile = r >> 8, rho = r & 255, bj = rho >> 7, wc = (rho >> 5) & 3, n = (rho >> 4) & 1, fq = (rho >> 2) & 3, i = rho & 3; which = n; return 128 * tile + 32 * wc + 8 * fq + 4 * bj + i; }
    const int c = perm ? ((r & ~255) + pg8::perm256(r & 255)) : r;
    if (mode == 0) return c < nsrc ? c : -1;
    return (c >> 6) * 128 + (c & 63) + (mode == 3 ? 64 : 0);
}
__device__ __forceinline__ void cvt_job(const Fr& F, const float* srcA, const float* srcB, const float* kscale, bf16_t* dst, int nrows, int kdst, int ksrc, int ldsrc, int nsrc, int mode, int perm, int boff) {
    float* tile = (float*)F.lds;
    const int nrt = nrows / 256, ntiles = nrt * (kdst / 64);
    const int kk = F.tid >> 6, rq = F.tid & 63;
    float4 v[8];
#define CVT_LOAD(t) do { const int r0 = ((t) % nrt) * 256, k0 = ((t) / nrt) * 64; int which; const int col = colmap(mode, perm, r0 + rq * 4, nsrc, which); const float* src = which ? srcB : srcA; \
        _Pragma("unroll") for (int p = 0; p < 8; ++p) { const int k = k0 + p * 8 + kk; v[p] = make_float4(0.f, 0.f, 0.f, 0.f); \
            if (col >= 0 && k < ksrc) { v[p] = *(const float4*)(src + (size_t)k * ldsrc + col); if (kscale) { const float ks = kscale[k]; v[p].x *= ks; v[p].y *= ks; v[p].z *= ks; v[p].w *= ks; } } } } while (0)
    int t = (F.bid + F.G - (boff % F.G)) % F.G;
    if (t < ntiles) CVT_LOAD(t);
    while (t < ntiles) {
        const int r0 = (t % nrt) * 256, k0 = (t / nrt) * 64;
        __syncthreads();
#pragma unroll
        for (int p = 0; p < 8; ++p) *(float4*)(tile + (p * 8 + kk) * 260 + rq * 4) = v[p];
        const int tn = t + F.G;
        if (tn < ntiles) CVT_LOAD(tn);
        __syncthreads();
        { const int r2 = F.tid >> 1, kq = F.tid & 1; const float* tp = tile + (kq * 32) * 260 + r2; uint4* dp = (uint4*)(dst + (size_t)(r0 + r2) * kdst + k0 + kq * 32);
#pragma unroll
          for (int q = 0; q < 4; ++q) { uint4 o; o.x = pack2(tp[(8 * q + 0) * 260], tp[(8 * q + 1) * 260]); o.y = pack2(tp[(8 * q + 2) * 260], tp[(8 * q + 3) * 260]);
              o.z = pack2(tp[(8 * q + 4) * 260], tp[(8 * q + 5) * 260]); o.w = pack2(tp[(8 * q + 6) * 260], tp[(8 * q + 7) * 260]); dp[q] = o; } }
        t = tn;
    }
#undef CVT_LOAD
    __syncthreads();
}

constexpr int CVT_T_GU = 28 * 16, CVT_T_DN = 4 * 56, CVT_T_E = CVT_T_GU + CVT_T_DN, CVT_T_ALL = NEXP * CVT_T_E;
__device__ __forceinline__ void cvt_moe_range(const Fr& F, int g_begin, int g_end, int rank, int stride) {
    float* tile = (float*)F.lds;
    const int kk = F.tid >> 6, rq = F.tid & 63;
    float4 va[8], vb[8];
#define CVM_DECODE(g) const int _e = (g) / CVT_T_E, _r = (g) % CVT_T_E; const bool _gu = _r < CVT_T_GU; const int _rr = _gu ? _r : _r - CVT_T_GU; \
        const int _nkt = _gu ? 16 : 56; const int k0 = (_rr % _nkt) * 64, r0 = (_rr / _nkt) * 256;     const int ldsrc = _gu ? DFE : 1024, kdst = _gu ? 1024 : DFE; \
        const float* srcA = _gu ? F.in[I_MOEG] + (size_t)_e * 1024 * DFE : F.in[I_MOED] + (size_t)_e * DFE * 1024; const float* srcB = F.in[I_MOEU] + (size_t)_e * 1024 * DFE; \
        unsigned char* dst = _gu ? F.w<unsigned char>(WM_GU) + (size_t)_e * 2 * DFE * 1024 * (MOE_FP8 ? 1 : 2) : F.w<unsigned char>(WM_DN) + (size_t)_e * 1024 * DFE * (MOE_FP8 ? 1 : 2);
#define CVM_LOAD(g, v) do { CVM_DECODE(g) (void)dst; (void)kdst; int which; const int col = colmap(_gu ? 1 : 0, 1, r0 + rq * 4, _gu ? DFE : 1024, which); const float* src = which ? srcB : srcA; \
        _Pragma("unroll") for (int p = 0; p < 8; ++p) { const int k = k0 + p * 8 + kk; v[p] = *(const float4*)(src + (size_t)k * ldsrc + col); } } while (0)
#define CVM_STEP(g, v) do { __syncthreads(); \
        _Pragma("unroll") for (int p = 0; p < 8; ++p) { float4 _t; _t.x = v[p].x; _t.y = v[p].y; _t.z = v[p].z; _t.w = v[p].w; *(float4*)(tile + (p * 8 + kk) * 260 + rq * 4) = _t; } \
        if ((g) + 2 * stride < g_end) CVM_LOAD((g) + 2 * stride, v); \
        __syncthreads(); \
        { CVM_DECODE(g) (void)srcA; (void)srcB; (void)ldsrc; const int r2 = F.tid >> 1, kq = F.tid & 1; const float* tp = tile + (kq * 32) * 260 + r2; \
          if (MOE_FP8) { uint4* dp = (uint4*)(dst + (size_t)(r0 + r2) * kdst + k0 + kq * 32); \
            _Pragma("unroll") for (int q = 0; q < 2; ++q) { uint4 o; \
              o.x = pack4_fp8(tp[(16 * q + 0) * 260] * F8_WSCALE, tp[(16 * q + 1) * 260] * F8_WSCALE, tp[(16 * q + 2) * 260] * F8_WSCALE, tp[(16 * q + 3) * 260] * F8_WSCALE); \
              o.y = pack4_fp8(tp[(16 * q + 4) * 260] * F8_WSCALE, tp[(16 * q + 5) * 260] * F8_WSCALE, tp[(16 * q + 6) * 260] * F8_WSCALE, tp[(16 * q + 7) * 260] * F8_WSCALE); \
              o.z = pack4_fp8(tp[(16 * q + 8) * 260] * F8_WSCALE, tp[(16 * q + 9) * 260] * F8_WSCALE, tp[(16 * q + 10) * 260] * F8_WSCALE, tp[(16 * q + 11) * 260] * F8_WSCALE); \
              o.w = pack4_fp8(tp[(16 * q + 12) * 260] * F8_WSCALE, tp[(16 * q + 13) * 260] * F8_WSCALE, tp[(16 * q + 14) * 260] * F8_WSCALE, tp[(16 * q + 15) * 260] * F8_WSCALE); dp[q] = o; } } \
          else { uint4* dp = (uint4*)(dst + ((size_t)(r0 + r2) * kdst + k0 + kq * 32) * 2); \
          _Pragma("unroll") for (int q = 0; q < 4; ++q) { uint4 o; o.x = pack2(tp[(8 * q + 0) * 260], tp[(8 * q + 1) * 260]); o.y = pack2(tp[(8 * q + 2) * 260], tp[(8 * q + 3) * 260]); \
              o.z = pack2(tp[(8 * q + 4) * 260], tp[(8 * q + 5) * 260]); o.w = pack2(tp[(8 * q + 6) * 260], tp[(8 * q + 7) * 260]); dp[q] = o; } } } } while (0)
    int g = g_begin + rank;
    if (g < g_end) CVM_LOAD(g, va);
    if (g + stride < g_end) CVM_LOAD(g + stride, vb);
    while (g < g_end) {
        CVM_STEP(g, va);
        g += stride; if (g >= g_end) break;
        CVM_STEP(g, vb);
        g += stride;
    }
#undef CVM_STEP
#undef CVM_LOAD
#undef CVM_DECODE
    __syncthreads();
}
__device__ __forceinline__ void cvt_fill(const Fr& F, int nwg, int quota, int g0) {
    const int R = (nwg + F.G - 1) / F.G, first_short = nwg - (R - 1) * F.G, nshort = R * F.G - nwg;
    if (F.bid >= first_short) { const int g_end = g0 + nshort * quota; cvt_moe_range(F, g0, g_end < CVT_T_ALL ? g_end : CVT_T_ALL, F.bid - first_short, nshort); }
}
constexpr int CVQ8 = 0, CVQ10 = 7, CVQ11 = 0, CVQ13 = 7;
constexpr int NWG8 = (TT / 256) * 4, NWG10 = (TT / 256) * (2 * DFF / 256), NWG11 = NWG8, NWG13 = (TT / 256) * (ODD_PAD / 256);
__device__ __forceinline__ int cvt_nshort(int nwg, int G) { return ((nwg + G - 1) / G) * G - nwg; }
__device__ __forceinline__ int cvt_g0(int G, int phase) {
    int g = 0; if (phase > 8) g += cvt_nshort(NWG8, G) * CVQ8; if (phase > 10) g += cvt_nshort(NWG10, G) * CVQ10; if (phase > 11) g += cvt_nshort(NWG11, G) * CVQ11; if (phase > 13) g += cvt_nshort(NWG13, G) * CVQ13;
    return g < CVT_T_ALL ? g : CVT_T_ALL;
}

__device__ __forceinline__ void ph_ada(const Fr& F) {
    float* sc = (float*)F.lds;
    float* part = sc + 9 * 1024;
    for (int i = F.tid; i < 9 * 1024; i += NTHR) { const int r = i >> 10, k = i & 1023; const float v = r < 8 ? F.in[I_C][r * 1024 + k] : F.in[I_CCTX][k]; sc[i] = silu_f(v); }
    __syncthreads();
    float* MOD = F.w<float>(WS_MOD);
    for (int un = F.bid; un < 2 * 6144 / 64; un += F.G) {
        const int j = un * 64 + F.lane, l = j / 6144, jj = j % 6144; const float* wp = F.in[I_ADAW] + (size_t)l * 1024 * 6144 + (size_t)(F.wave * 128) * 6144 + jj;
        float acc[9];
#pragma unroll
        for (int r = 0; r < 9; ++r) acc[r] = 0.f;
#pragma unroll 16
        for (int k = 0; k < 128; ++k) { const float wv = wp[(size_t)k * 6144];
#pragma unroll
            for (int r = 0; r < 9; ++r) acc[r] += sc[r * 1024 + F.wave * 128 + k] * wv; }
#pragma unroll
        for (int r = 0; r < 9; ++r) part[(F.wave * 9 + r) * 64 + F.lane] = acc[r];
        __syncthreads();
        for (int o = F.tid; o < 9 * 64; o += NTHR) { const int r = o >> 6, cix = o & 63; float sum = 0.f;
#pragma unroll
            for (int w2 = 0; w2 < 8; ++w2) sum += part[(w2 * 9 + r) * 64 + cix];
            const int j2 = un * 64 + cix, l2 = j2 / 6144, jj2 = j2 % 6144; MOD[(size_t)(l2 * 9 + r) * 6144 + jj2] = sum + F.in[I_ADAB][l2 * 6144 + jj2]; }
        __syncthreads();
    }
}
__device__ __forceinline__ void ph_filters(const Fr& F) {
    constexpr int NPB = 12;
    float* w1s = (float*)F.lds;
    float* w2s = w1s + 33 * 64;
    float* zs = w2s + 64 * 64;
    float* h1 = zs + NPB * 36;
    float* h2 = h1 + NPB * 64;
    const float* w3 = F.in[I_FW3]; const float* fqv = F.in[I_FREQ]; const float* hb = F.in[I_HYBIAS];
    for (int i = F.tid; i < 33 * 64; i += NTHR) w1s[i] = F.in[I_FW1][i];
    for (int i = F.tid; i < 64 * 64; i += NTHR) w2s[i] = F.in[I_FW2][i];
    const int total = SEQ + CTXL; int np = 0; for (int it = F.bid; it < total && np < NPB; it += F.G) ++np;
    for (int i = F.tid; i < np * 33; i += NTHR) { const int pi = i / 33, zi = i % 33, item = F.bid + pi * F.G; const int n = item < SEQ ? SEQ : CTXL, pos = item < SEQ ? item : item - SEQ;
        const float fpos = (float)pos, t = fpos / (float)(n - 1), omega = (6.283185307179586f * fpos) / (float)n; float v;
        if (zi == 0) v = t; else { const int bi = (zi - 1) & 15; const float band = 1e-4f + (float)bi * ((15.f - 1e-4f) / 15.f); const float a = omega * band; v = (zi <= 16) ? cosf(a) : -sinf(a); }
        zs[pi * 36 + zi] = v; }
    __syncthreads();
    for (int i = F.tid; i < np * 64; i += NTHR) { const int pi = i >> 6, j = i & 63; float a = F.in[I_FB1][j]; for (int k = 0; k < 33; ++k) a += zs[pi * 36 + k] * w1s[k * 64 + j]; h1[i] = sinf(fqv[j] * a); }
    __syncthreads();
    for (int i = F.tid; i < np * 64; i += NTHR) { const int pi = i >> 6, j = i & 63; float a = F.in[I_FB2][j]; for (int k = 0; k < 64; ++k) a += h1[pi * 64 + k] * w2s[k * 64 + j]; h2[i] = sinf(fqv[j] * a); }
    __syncthreads();
#pragma unroll 1
    for (int oo = 0; oo < 2; ++oo) { const int o = F.tid + 512 * oo; float acc[NPB];
#pragma unroll
        for (int pi = 0; pi < NPB; ++pi) acc[pi] = 0.f;
        for (int k = 0; k < 64; ++k) { const float wv = w3[k * 1024 + o];
#pragma unroll
            for (int pi = 0; pi < NPB; ++pi) acc[pi] += h2[pi * 64 + k] * wv; }
        const int dir = o >> 9, c = o & 511; const float a0 = -3.0701134573253945f, b0 = -15.350567286626973f; const float delta = fabsf(a0 + (float)c * ((b0 - a0) / 511.f));
#pragma unroll
        for (int pi = 0; pi < NPB; ++pi) if (pi < np) { const int item = F.bid + pi * F.G; const int n = item < SEQ ? SEQ : CTXL, pos = item < SEQ ? item : item - SEQ; const float t = (float)pos / (float)(n - 1);
            bf16_t* Rd = (n == SEQ) ? F.w<bf16_t>(L0_FL) : F.w<bf16_t>(L0_FC); const int n2 = 2 * n; const float val = acc[pi] * expf(-t * delta);
            if (dir == 0) Rd[(size_t)c * n2 + (n - pos)] = f2bf(val + (pos == 0 ? hb[c] : 0.f)); else if (pos > 0) Rd[(size_t)c * n2 + (n + pos)] = f2bf(val); }
    }
    __syncthreads();
}
__device__ __forceinline__ void ph_rope_tables(const Fr& F) {
    float* cm = F.w<float>(WS_ROPEM); float* sm = cm + 2048 * 16; float* cgq = F.w<float>(WS_ROPEG); float* sg = cgq + 2048 * 32;
    for (int idx = F.bid * NTHR + F.tid; idx < 2048 * 16; idx += F.G * NTHR) { const int pos = idx >> 4, i = idx & 15; const float inv = powf(10000.f, -(float)(i & 7) / 8.f);
        const float p = (i < 8) ? (float)(pos >> 6) : (float)(pos & 63); const float ang = p * inv; cm[idx] = cosf(ang); sm[idx] = sinf(ang); }
    for (int idx = F.bid * NTHR + F.tid; idx < 2048 * 32; idx += F.G * NTHR) { const int pos = idx >> 5, i = idx & 31; const float inv = powf(10000.f, -(float)(i & 15) / 16.f);
        const float p = (i < 16) ? (float)(pos >> 6) : (float)(pos & 63); const float ang = p * inv; cgq[idx] = cosf(ang); sg[idx] = sinf(ang); }
}

__device__ __forceinline__ void store_bf16x4(bf16_t* p, float4 v) { uint2 q; q.x = pack2(v.x, v.y); q.y = pack2(v.z, v.w); *(uint2*)p = q; }
__device__ __forceinline__ float4 ld4(const float* p) { return *(const float4*)p; }
__device__ __forceinline__ float sumsq4(const float4 (&v)[4]) { float s = 0.f;
#pragma unroll
    for (int i = 0; i < 4; ++i) s += v[i].x * v[i].x + v[i].y * v[i].y + v[i].z * v[i].z + v[i].w * v[i].w;
    return s; }

struct RowSched { int b, k0, WPB, NW, gw, nlat, ntot;
    __device__ __forceinline__ void init(int G, int bid, int wave, int nrows) { NW = G * 8; gw = bid * 8 + wave; WPB = NW / 8; b = gw / WPB; k0 = gw % WPB;
        nlat = (SEQ - k0 + WPB - 1) / WPB; const int nctx = (nrows > TL && gw < TC) ? (TC - gw + NW - 1) / NW : 0; ntot = nlat + nctx; }
    __device__ __forceinline__ int row_at(int s) const { return s < nlat ? b * SEQ + k0 + WPB * s : TL + gw + NW * (s - nlat); }
};
__device__ __forceinline__ void ph_norm0(const Fr& F) {
    const float* g = F.in[I_MIXPRE]; const float* MOD = F.w<float>(WS_MOD); bf16_t* A = F.w<bf16_t>(WS_ABUF);
    RowSched RS; RS.init(F.G, F.bid, F.wave, TT);
    float4 gv[4], shv[4], scv[4]; int mr_cur = -1;
#pragma unroll
    for (int i = 0; i < 4; ++i) gv[i] = ld4(g + 4 * (F.lane + 64 * i));
    for (int si = 0; si < RS.ntot; si += 2) {
        const int row0 = RS.row_at(si); const bool has1 = si + 1 < RS.ntot; const int row1 = has1 ? RS.row_at(si + 1) : row0; const int r1 = row1;
        const float* s0 = row0 < TL ? F.in[I_X] + (size_t)row0 * 1024 : F.in[I_CTX] + (size_t)(row0 - TL) * 1024; const float* s1 = r1 < TL ? F.in[I_X] + (size_t)r1 * 1024 : F.in[I_CTX] + (size_t)(r1 - TL) * 1024;
        float4 v0[4], v1[4];
#pragma unroll
        for (int i = 0; i < 4; ++i) { v0[i] = ld4(s0 + 4 * (F.lane + 64 * i)); v1[i] = ld4(s1 + 4 * (F.lane + 64 * i)); }
        const float q0 = rsqrtf(wave_sum(sumsq4(v0)) * (1.f / 1024.f) + EPS), q1 = rsqrtf(wave_sum(sumsq4(v1)) * (1.f / 1024.f) + EPS);
#pragma unroll
        for (int rr = 0; rr < 2; ++rr) { if (rr && !has1) break; const int row = rr ? row1 : row0; const int mr = row < TL ? (row >> 11) : 8; const float r = rr ? q1 : q0;
            if (mr != mr_cur) { mr_cur = mr;
#pragma unroll
                for (int i = 0; i < 4; ++i) { const int c = 4 * (F.lane + 64 * i); shv[i] = ld4(MOD + (size_t)mr * 6144 + c); scv[i] = ld4(MOD + (size_t)mr * 6144 + 1024 + c); } }
#pragma unroll
            for (int i = 0; i < 4; ++i) { const int c = 4 * (F.lane + 64 * i); const float4 gg = gv[i], sh = shv[i], sc = scv[i]; const float4 v = rr ? v1[i] : v0[i];
                float4 o; o.x = v.x * r * gg.x * (1.f + sc.x) + sh.x; o.y = v.y * r * gg.y * (1.f + sc.y) + sh.y; o.z = v.z * r * gg.z * (1.f + sc.z) + sh.z; o.w = v.w * r * gg.w * (1.f + sc.w) + sh.w;
                store_bf16x4(A + (size_t)row * 1024 + c, o); } }
    }
}
template <int MODE, bool SRCF32, bool DSTF32>
__device__ __forceinline__ void ph_thin(const Fr& F, const float* msrc, int nrows, const float* hs_lat, const float* hs_ctx, float* hd_lat, float* hd_ctx,
                        const float* postg, const float* MODg, int gate_off, const float* preg, const float* MODn, int sh_off, int sc_off, bf16_t* adst, int xNTF = 0, int xS = 1, const bf16_t* xt2 = nullptr, int xS2 = 1) {
    float* rt = (float*)F.lds;
    int* cntL = (int*)(F.lds + 32768);
    int* blkBase = cntL + 8;
    int* selInfo = cntL + 16;
    if (MODE == 1) { for (int i = F.tid; i < 1024 * 8; i += NTHR) rt[(i & 7) * 1024 + (i >> 3)] = F.in[I_ROUTER][i]; if (F.tid < 8) cntL[F.tid] = 0; __syncthreads(); }
    int li = F.wave;
#define THIN_LOAD(row, m, h) do { \
        const float* hs = SRCF32 ? ((row) < TL ? hs_lat + (size_t)(row) * 1024 : hs_ctx + (size_t)((row) - TL) * 1024) : nullptr; const bf16_t* hbs = F.w<bf16_t>(WS_HB) + (size_t)(row) * 1024; \
        int tail0 = -1, tail1 = -1; \
        if (MODE == 2 && xS > 1) { const int2 sr = *(const int2*)(F.w<int>(WS_SROW) + (size_t)(row) * 2); const int r0 = __builtin_amdgcn_readfirstlane(sr.x), r1 = __builtin_amdgcn_readfirstlane(sr.y); \
            if ((r0 >> 8) >= xNTF) tail0 = r0 - xNTF * 256; if ((r1 >> 8) >= xNTF) tail1 = r1 - xNTF * 256; } \
        _Pragma("unroll") for (int i = 0; i < 4; ++i) { const int c = 4 * (F.lane + 64 * i); \
            if (SRCF32) h[i] = ld4(hs + c); else { const uint2 hv = *(const uint2*)(hbs + c); h[i].x = bflo(hv.x); h[i].y = bfhi(hv.x); h[i].z = bflo(hv.y); h[i].w = bfhi(hv.y); } \
            if (MODE == 2) { const bf16_t* mo = (const bf16_t*)msrc; const uint2 a = *(const uint2*)(mo + (size_t)(row) * 1024 + c), b = *(const uint2*)(mo + ((size_t)TL + (row)) * 1024 + c); \
                m[i].x = bflo(a.x) + bflo(b.x); m[i].y = bfhi(a.x) + bfhi(b.x); m[i].z = bflo(a.y) + bflo(b.y); m[i].w = bfhi(a.y) + bfhi(b.y); \
                if (tail0 >= 0) { const bf16_t* xp = F.w<bf16_t>(WS_XTR) + ((size_t)((tail0 >> 8) * 4 + i) * (xS - 1) * 256 + (tail0 & 255)) * 256 + (c & 255); \
                    for (int s2 = 0; s2 < xS - 1; ++s2) { const uint2 e = *(const uint2*)(xp + (size_t)s2 * 65536); m[i].x += bflo(e.x); m[i].y += bfhi(e.x); m[i].z += bflo(e.y); m[i].w += bfhi(e.y); } } \
                if (tail1 >= 0) { const bf16_t* xp = F.w<bf16_t>(WS_XTR) + ((size_t)((tail1 >> 8) * 4 + i) * (xS - 1) * 256 + (tail1 & 255)) * 256 + (c & 255); \
                    for (int s2 = 0; s2 < xS - 1; ++s2) { const uint2 e = *(const uint2*)(xp + (size_t)s2 * 65536); m[i].x += bflo(e.x); m[i].y += bfhi(e.x); m[i].z += bflo(e.y); m[i].w += bfhi(e.y); } } } \
            else { const uint2 a = *(const uint2*)((const bf16_t*)msrc + (size_t)(row) * 1024 + c); m[i].x = bflo(a.x); m[i].y = bfhi(a.x); m[i].z = bflo(a.y); m[i].w = bfhi(a.y); \
                if (MODE == 0 && xS2 > 1 && (row) >= TL) { \
                    const bf16_t* xp = xt2 + ((size_t)(((((row) - TL) >> 8) * 4 + i) * (xS2 - 1)) * 256 + ((row) & 255)) * 256 + (c & 255); \
                    for (int s2 = 0; s2 < xS2 - 1; ++s2) { const uint2 e = *(const uint2*)(xp + (size_t)s2 * 65536); m[i].x += bflo(e.x); m[i].y += bfhi(e.x); m[i].z += bflo(e.y); m[i].w += bfhi(e.y); } } } } } while (0)
    RowSched RS; RS.init(F.G, F.bid, F.wave, nrows); const int RPW = 16;
    li = F.wave * RPW;
    float4 m[4], h[4], mN[4], hN[4], pgv[4], ggv[4], gtv[4], shv[4], scv[4]; int mr_cur = -1;
#pragma unroll
    for (int i = 0; i < 4; ++i) { const int c = 4 * (F.lane + 64 * i); pgv[i] = ld4(postg + c); if (MODE != 2) ggv[i] = ld4(preg + c); }
    if (RS.ntot > 0) { const int rw = RS.row_at(0); THIN_LOAD(rw, m, h); }
    for (int si = 0; si < RS.ntot; ++si, ++li) {
        const int row = RS.row_at(si);
        if (si + 1 < RS.ntot) { const int rown = RS.row_at(si + 1); THIN_LOAD(rown, mN, hN); }
        const int mr = row < TL ? (row >> 11) : 8;
        if (mr != mr_cur) { mr_cur = mr;
#pragma unroll
            for (int i = 0; i < 4; ++i) { const int c = 4 * (F.lane + 64 * i); gtv[i] = ld4(MODg + (size_t)mr * 6144 + gate_off + c);
                if (MODE != 2) { shv[i] = ld4(MODn + (size_t)mr * 6144 + sh_off + c); scv[i] = ld4(MODn + (size_t)mr * 6144 + sc_off + c); } } }
        float* hd = DSTF32 ? hd_lat + (size_t)row * 1024 : nullptr;
        bf16_t* hb = F.w<bf16_t>(WS_HB) + (size_t)row * 1024;
        const float r = rsqrtf(wave_sum(sumsq4(m)) * (1.f / 1024.f) + EPS);
#pragma unroll
        for (int i = 0; i < 4; ++i) { const int c = 4 * (F.lane + 64 * i); const float4 pg = pgv[i], gt = gtv[i];
            h[i].x += gt.x * (m[i].x * r * pg.x); h[i].y += gt.y * (m[i].y * r * pg.y); h[i].z += gt.z * (m[i].z * r * pg.z); h[i].w += gt.w * (m[i].w * r * pg.w);
            if (DSTF32) *(float4*)(hd + c) = h[i]; else store_bf16x4(hb + c, h[i]); }
        if (MODE != 2) {
        const float r2 = rsqrtf(wave_sum(sumsq4(h)) * (1.f / 1024.f) + EPS);
        float lg[8];
#pragma unroll
        for (int e = 0; e < 8; ++e) lg[e] = 0.f;
#pragma unroll
        for (int i = 0; i < 4; ++i) { const int c = 4 * (F.lane + 64 * i); const float4 gg = ggv[i], sh = shv[i], sc = scv[i];
            float4 o; o.x = h[i].x * r2 * gg.x * (1.f + sc.x) + sh.x; o.y = h[i].y * r2 * gg.y * (1.f + sc.y) + sh.y; o.z = h[i].z * r2 * gg.z * (1.f + sc.z) + sh.z; o.w = h[i].w * r2 * gg.w * (1.f + sc.w) + sh.w;
            store_bf16x4(adst + (size_t)row * 1024 + c, o);
            if (MODE == 1) {
#pragma unroll
                for (int e = 0; e < 8; ++e) { const float4 rv = *(const float4*)(rt + e * 1024 + c); lg[e] += o.x * rv.x + o.y * rv.y + o.z * rv.z + o.w * rv.w; } } }
        if (MODE == 1) {
#pragma unroll
            for (int e = 0; e < 8; ++e) lg[e] = wave_sum(lg[e]);
            int i1 = 0; float v1 = lg[0];
#pragma unroll
            for (int e = 1; e < 8; ++e) if (lg[e] > v1) { v1 = lg[e]; i1 = e; }
            int i2 = -1; float v2 = -3.0e38f;
#pragma unroll
            for (int e = 0; e < 8; ++e) if (e != i1 && lg[e] > v2) { v2 = lg[e]; i2 = e; }
            const float w1 = 1.f / (1.f + expf(v2 - v1)), w2 = 1.f - w1;
            if (F.lane == 0) { float* tw = F.w<float>(WS_TOPW) + (size_t)row * 2; tw[0] = w1; tw[1] = w2;
                const int r1 = atomicAdd(&cntL[i1], 1), r2i = atomicAdd(&cntL[i2], 1);
                selInfo[li * 2 + 0] = i1 | (r1 << 8); selInfo[li * 2 + 1] = i2 | (r2i << 8); }
        }
        }
#pragma unroll
        for (int i = 0; i < 4; ++i) { m[i] = mN[i]; h[i] = hN[i]; }
    }
#undef THIN_LOAD
    if (MODE == 1) {
        __syncthreads();
        if (F.tid < 8) blkBase[F.tid] = (int)__hip_atomic_fetch_add(F.w<unsigned>(WS_CNT) + F.tid, (unsigned)cntL[F.tid], __ATOMIC_RELAXED, __HIP_MEMORY_SCOPE_AGENT);
        __syncthreads();
        int* LISTE = F.w<int>(WS_LISTE);
        for (int idx = F.tid; idx < 16 * RPW; idx += NTHR) { const int l2 = idx >> 1, k = idx & 1; RowSched R2; R2.init(F.G, F.bid, l2 / RPW, nrows); const int it2 = l2 % RPW; const int row = it2 < R2.ntot ? R2.row_at(it2) : nrows;
            if (row < nrows) { const int si = selInfo[idx], e = si & 255, rk = si >> 8; LISTE[(size_t)e * TL + blkBase[e] + rk] = row * 2 + k; } }
        __syncthreads();
    }
}
__device__ __forceinline__ void ph_moe_gather(const Fr& F) {
    const unsigned* cnt = F.w<unsigned>(WS_CNT); int ts[9]; ts[0] = 0;
#pragma unroll
    for (int e = 0; e < 8; ++e) ts[e + 1] = ts[e] + (int)((__hip_atomic_load(cnt + e, __ATOMIC_RELAXED, __HIP_MEMORY_SCOPE_AGENT) + 255u) >> 8);
    const int nrows = ts[8] * 256; const int* LISTE = F.w<int>(WS_LISTE); const float* TOPW = F.w<float>(WS_TOPW);
    const bf16_t* a2 = F.w<bf16_t>(L1_A2TMP); bf16_t* AG = F.w<bf16_t>(WS_AG); uint2* RIW = F.w<uint2>(WS_ROWINFO);
    const int RPW = (nrows + F.G * 8 - 1) / (F.G * 8), rbeg = (F.bid * 8 + F.wave) * RPW, rend = (rbeg + RPW < nrows) ? rbeg + RPW : nrows;
    int my_info = -1;
    { const int r = rbeg + F.lane;
      if (F.lane < RPW && r < rend) { const int j = r >> 8; int e = 0;
#pragma unroll
          for (int k = 1; k < 8; ++k) e += (j >= ts[k]) ? 1 : 0;
          int tse = ts[0];
#pragma unroll
          for (int k = 1; k < 8; ++k) tse = (e == k) ? ts[k] : tse;
          const int i = r - tse * 256; const int ce = (int)__hip_atomic_load(cnt + e, __ATOMIC_RELAXED, __HIP_MEMORY_SCOPE_AGENT); float w = 0.f;
          if (i < ce) { my_info = LISTE[(size_t)e * TL + i]; w = TOPW[my_info]; F.w<int>(WS_SROW)[my_info] = r; }
          RIW[r] = make_uint2((unsigned)my_info, __float_as_uint(w)); } }
    static_assert(MOE_FP8, "the gather below writes e4m3 rows");
    uint4 v0 = make_uint4(0u, 0u, 0u, 0u), v1 = v0, n0 = v0, n1 = v0;
    if (rbeg < rend) { const int info = __builtin_amdgcn_readlane(my_info, 0); if (info >= 0) { const uint4* src = (const uint4*)(a2 + (size_t)(info >> 1) * 1024 + F.lane * 16); v0 = src[0]; v1 = src[1]; } }
    for (int r = rbeg; r < rend; ++r) {
        n0 = make_uint4(0u, 0u, 0u, 0u); n1 = n0;
        if (r + 1 < rend) { const int info = __builtin_amdgcn_readlane(my_info, r + 1 - rbeg); if (info >= 0) { const uint4* src = (const uint4*)(a2 + (size_t)(info >> 1) * 1024 + F.lane * 16); n0 = src[0]; n1 = src[1]; } }
        uint4 o; o.x = pack4_fp8(bflo(v0.x), bfhi(v0.x), bflo(v0.y), bfhi(v0.y)); o.y = pack4_fp8(bflo(v0.z), bfhi(v0.z), bflo(v0.w), bfhi(v0.w));
        o.z = pack4_fp8(bflo(v1.x), bfhi(v1.x), bflo(v1.y), bfhi(v1.y)); o.w = pack4_fp8(bflo(v1.z), bfhi(v1.z), bflo(v1.w), bfhi(v1.w));
        *(uint4*)((unsigned char*)AG + (size_t)r * 1024 + F.lane * 16) = o;
        v0 = n0; v1 = n1;
    }
}
__device__ __forceinline__ void ld8bf(const bf16_t* p, float (&o)[8]) { const uint4 q = *(const uint4*)p; o[0] = bflo(q.x); o[1] = bfhi(q.x); o[2] = bflo(q.y); o[3] = bfhi(q.y); o[4] = bflo(q.z); o[5] = bfhi(q.z); o[6] = bflo(q.w); o[7] = bfhi(q.w); }
__device__ __forceinline__ void st8bf(bf16_t* p, const float (&v)[8]) { uint4 q; q.x = pack2(v[0], v[1]); q.y = pack2(v[2], v[3]); q.z = pack2(v[4], v[5]); q.w = pack2(v[6], v[7]); *(uint4*)p = q; }
struct CW { float w0[8], w1[8], w2[8], bb[8]; };
__device__ __forceinline__ void cw_load(CW& c, const float* w, const float* b, int wc, int wld) {
    const float4 a0 = ld4(w + wc), a1 = ld4(w + wc + 4), b0 = ld4(w + wld + wc), b1 = ld4(w + wld + wc + 4), c0 = ld4(w + 2 * wld + wc), c1 = ld4(w + 2 * wld + wc + 4), d0 = ld4(b + wc), d1 = ld4(b + wc + 4);
    c.w0[0] = a0.x; c.w0[1] = a0.y; c.w0[2] = a0.z; c.w0[3] = a0.w; c.w0[4] = a1.x; c.w0[5] = a1.y; c.w0[6] = a1.z; c.w0[7] = a1.w;
    c.w1[0] = b0.x; c.w1[1] = b0.y; c.w1[2] = b0.z; c.w1[3] = b0.w; c.w1[4] = b1.x; c.w1[5] = b1.y; c.w1[6] = b1.z; c.w1[7] = b1.w;
    c.w2[0] = c0.x; c.w2[1] = c0.y; c.w2[2] = c0.z; c.w2[3] = c0.w; c.w2[4] = c1.x; c.w2[5] = c1.y; c.w2[6] = c1.z; c.w2[7] = c1.w;
    c.bb[0] = d0.x; c.bb[1] = d0.y; c.bb[2] = d0.z; c.bb[3] = d0.w; c.bb[4] = d1.x; c.bb[5] = d1.y; c.bb[6] = d1.z; c.bb[7] = d1.w;
}
__device__ __forceinline__ void conv8(const bf16_t* prow, bool hasp, bool hasn, int pc, const CW& c, float (&o)[8]) {
    float xm[8], x0[8], xp[8]; ld8bf(prow + pc, x0);
    if (hasp) ld8bf(prow - EVEN_PAD + pc, xm); else {
#pragma unroll
        for (int j = 0; j < 8; ++j) xm[j] = 0.f; }
    if (hasn) ld8bf(prow + EVEN_PAD + pc, xp); else {
#pragma unroll
        for (int j = 0; j < 8; ++j) xp[j] = 0.f; }
#pragma unroll
    for (int j = 0; j < 8; ++j) o[j] = c.w0[j] * xm[j] + c.w1[j] * x0[j] + c.w2[j] * xp[j] + c.bb[j];
}
__device__ __forceinline__ void ph_convpass(const Fr& F) {
    const bf16_t* PROJ = F.w<bf16_t>(L0_PROJ); bf16_t* U = F.w<bf16_t>(L0_U); bf16_t* X0 = F.w<bf16_t>(L0_X0); bf16_t* XBC = F.w<bf16_t>(L0_XBC); float* DT = F.w<float>(L0_DT);
    const float* hw = F.in[I_HYCW]; const float* hb = F.in[I_HYCB]; const float* sw = F.in[I_SCW]; const float* sb = F.in[I_SCB]; const float* dtb = F.in[I_DTB];
    {
        const int c = F.lane * 8; CW cx0, cb0, cb1; cw_load(cx0, hw, hb, c, 1536); cw_load(cb0, sw, sb, c, 1024); cw_load(cb1, sw, sb, c + 512, 1024);
        const float dtbv = F.lane < 16 ? dtb[F.lane] : 0.f;
        for (int row = F.bid * 8 + F.wave; row < TT; row += F.G * 8) {
            const int t = row < TL ? (row & (SEQ - 1)) : ((row - TL) & (CTXL - 1)), n = row < TL ? SEQ : CTXL; const bool hasp = t > 0, hasn = t < n - 1;
            const bf16_t* prow = PROJ + (size_t)row * EVEN_PAD;
            float a0[8];
            conv8(prow, hasp, hasn, c, cx0, a0);
            st8bf(X0 + (size_t)row * 512 + c, a0);
            conv8(prow, hasp, hasn, 2048 + c, cb0, a0);
#pragma unroll
            for (int j = 0; j < 8; ++j) a0[j] = silu_f(a0[j]);
            st8bf(XBC + (size_t)row * 1024 + c, a0);
            conv8(prow, hasp, hasn, 2048 + 512 + c, cb1, a0);
#pragma unroll
            for (int j = 0; j < 8; ++j) a0[j] = silu_f(a0[j]);
            st8bf(XBC + (size_t)row * 1024 + 512 + c, a0);
            if (F.lane < 16) DT[(size_t)row * 16 + F.lane] = softplus_f(bf2f(prow[3072 + F.lane]) + dtbv);
        }
    }
    bf16_t* ut = (bf16_t*)F.lds;
    {   const int tok = F.tid >> 3, cq = F.tid & 7; const int cgp = F.bid & 3;
        CW c1a, c1b, cva, cvb; { const int ch = cgp * 128 + cq * 16; cw_load(c1a, hw, hb, 512 + ch, 1536); cw_load(c1b, hw, hb, 512 + ch + 8, 1536); cw_load(cva, hw, hb, 1024 + ch, 1536); cw_load(cvb, hw, hb, 1024 + ch + 8, 1536); }
        for (int un = F.bid; un < (TT / 64) * 4; un += F.G) {
            const int tile = un >> 2, row0 = tile * 64; const int row = row0 + tok;
            const int t = row < TL ? (row & (SEQ - 1)) : ((row - TL) & (CTXL - 1)), n = row < TL ? SEQ : CTXL; const bool hasp = t > 0, hasn = t < n - 1;
            const bf16_t* prow = PROJ + (size_t)row * EVEN_PAD; const int ch = cgp * 128 + cq * 16;
            { float a1[8], a2[8]; conv8(prow, hasp, hasn, 512 + ch, c1a, a1); conv8(prow, hasp, hasn, 1024 + ch, cva, a2);
#pragma unroll
              for (int j = 0; j < 8; ++j) ut[(cq * 16 + j) * 66 + tok] = f2bf(a1[j] * a2[j]);
              conv8(prow, hasp, hasn, 512 + ch + 8, c1b, a1); conv8(prow, hasp, hasn, 1024 + ch + 8, cvb, a2);
#pragma unroll
              for (int j = 0; j < 8; ++j) ut[(cq * 16 + 8 + j) * 66 + tok] = f2bf(a1[j] * a2[j]); }
            __syncthreads();
            { const int ch2 = F.tid >> 2, part = F.tid & 3; const int b = row0 < TL ? (row0 >> 11) : ((row0 - TL) >> 8), off = row0 < TL ? CTXL + (row0 & (SEQ - 1)) : ((row0 - TL) & (CTXL - 1));
              const unsigned* src = (const unsigned*)(ut + ch2 * 66 + part * 16); uint4 v0, v1; v0.x = src[0]; v0.y = src[1]; v0.z = src[2]; v0.w = src[3]; v1.x = src[4]; v1.y = src[5]; v1.z = src[6]; v1.w = src[7];
              uint4* dst = (uint4*)(U + ((size_t)(cgp * 128 + ch2) * 8 + b) * NKEY + off + part * 16); dst[0] = v0; dst[1] = v1; }
            __syncthreads();
        }
    }
}

__device__ __forceinline__ unsigned alignhalf(unsigned hi, unsigned lo) { return (lo >> 16) | (hi << 16); }
template <int RHO> __device__ __forceinline__ uint4 shift_copy(const uint4 prev, const uint4 cur) {
    const unsigned cc[8] = {prev.x, prev.y, prev.z, prev.w, cur.x, cur.y, cur.z, cur.w};
    constexpr int o = 16 - 2 * RHO, d0 = o / 4; uint4 r;
    if constexpr ((o & 3) == 0) { r.x = cc[d0]; r.y = cc[d0 + 1]; r.z = cc[d0 + 2]; r.w = cc[d0 + 3]; }
    else { r.x = alignhalf(cc[d0 + 1], cc[d0]); r.y = alignhalf(cc[d0 + 2], cc[d0 + 1]); r.z = alignhalf(cc[d0 + 3], cc[d0 + 2]); r.w = alignhalf(cc[d0 + 4], cc[d0 + 3]); }
    return r;
}
__device__ __forceinline__ void build_copies(unsigned char* cp, int cs, const bf16_t* R, int nch, int i) {
    if (i < nch) { const uint4 cur = *(const uint4*)(R + 8 * i); const uint4 prev = i > 0 ? *(const uint4*)(R + 8 * i - 8) : make_uint4(0u, 0u, 0u, 0u);
        *(uint4*)(cp + 0 * cs + i * 16) = cur;
        *(uint4*)(cp + 1 * cs + i * 16) = shift_copy<1>(prev, cur); *(uint4*)(cp + 2 * cs + i * 16) = shift_copy<2>(prev, cur); *(uint4*)(cp + 3 * cs + i * 16) = shift_copy<3>(prev, cur);
        *(uint4*)(cp + 4 * cs + i * 16) = shift_copy<4>(prev, cur); *(uint4*)(cp + 5 * cs + i * 16) = shift_copy<5>(prev, cur); *(uint4*)(cp + 6 * cs + i * 16) = shift_copy<6>(prev, cur);
        *(uint4*)(cp + 7 * cs + i * 16) = shift_copy<7>(prev, cur); }
}
__device__ __forceinline__ void ph_hyena_mfma(const Fr& F) {
    const bf16_t* U = F.w<bf16_t>(L0_U); bf16_t* YT = F.w<bf16_t>(L0_YT);
    const int w = F.wave, rr = F.lane & 15, g = F.lane >> 4;
    {   constexpr int CS = 8224, US = 4128;
        unsigned char* Cp = F.lds; unsigned char* Ub = F.lds + 8 * CS;
        const int p = w & 1, q = w >> 1;
        for (int c = F.bid; c < 512; c += F.G) {
            __syncthreads();
            build_copies(Cp, CS, F.w<bf16_t>(L0_FL) + (size_t)c * 4096, 512, F.tid);
#pragma unroll
            for (int k = 0; k < 4; ++k) { const int id = F.tid + 512 * k, b = id >> 8, ch = id & 255; *(uint4*)(Ub + b * US + ch * 16) = *(const uint4*)(U + ((size_t)c * 8 + b) * NKEY + CTXL + ch * 8); }
            __syncthreads();
            const unsigned char* abase = Cp + (rr & 7) * CS + (2048 - 16 * (32 * q + p) - 8 * (rr >> 3) + 8 * g) * 2;
            const unsigned char* ubase = Ub + (rr & 7) * US + 16 * g;
            f32x4 acc[16]; bf16x8 af[16];
#pragma unroll
            for (int i = 0; i < 16; ++i) { acc[i] = (f32x4){0.f, 0.f, 0.f, 0.f}; af[i] = *(const bf16x8*)(abase - 64 * i); }
            for (int jj = 0; jj < 4; ++jj) {
#pragma unroll
                for (int js = 0; js < 16; ++js) { const int J = 16 * jj + js;
                    af[(16 - js) & 15] = *(const bf16x8*)(abase + 64 * J);
                    const bf16x8 bfr = *(const bf16x8*)(ubase + 64 * J);
#pragma unroll
                    for (int i = 0; i < 16; ++i) acc[i] = __builtin_amdgcn_mfma_f32_16x16x32_bf16(af[(i - js) & 15], bfr, acc[i], 0, 0, 0);
                }
            }
            if (rr < 8) {
#pragma unroll
                for (int i = 0; i < 16; ++i) { const int t = 16 * (32 * q + p + 2 * i) + 4 * g; uint2 pk; pk.x = pack2(acc[i][0], acc[i][1]); pk.y = pack2(acc[i][2], acc[i][3]);
                    *(uint2*)(YT + ((size_t)c * 8 + rr) * NKEY + CTXL + t) = pk; }
            }
        }
    }
    {   constexpr int CS = 1056, US = 544;
        unsigned char* Cp = F.lds; unsigned char* Ub = F.lds + 8 * CS;
        for (int c = F.bid; c < 512; c += F.G) {
            __syncthreads();
            build_copies(Cp, CS, F.w<bf16_t>(L0_FC) + (size_t)c * 512, 64, F.tid);
            if (F.tid < 256) { const int b = F.tid >> 5, ch = F.tid & 31; *(uint4*)(Ub + b * US + ch * 16) = *(const uint4*)(U + ((size_t)c * 8 + b) * NKEY + ch * 8); }
            __syncthreads();
            f32x4 acc[2];
#pragma unroll
            for (int ii = 0; ii < 2; ++ii) acc[ii] = (f32x4){0.f, 0.f, 0.f, 0.f};
#pragma unroll
            for (int J = 0; J < 8; ++J) { const bf16x8 bfr = *(const bf16x8*)(Ub + (rr & 7) * US + 16 * g + 64 * J);
#pragma unroll
                for (int ii = 0; ii < 2; ++ii) { const int d = 2 * w + ii - 2 * J; const bf16x8 a = *(const bf16x8*)(Cp + (rr & 7) * CS + (256 - 16 * d - 8 * (rr >> 3) + 8 * g) * 2);
                    acc[ii] = __builtin_amdgcn_mfma_f32_16x16x32_bf16(a, bfr, acc[ii], 0, 0, 0); } }
            if (rr < 8) {
#pragma unroll
                for (int ii = 0; ii < 2; ++ii) { const int t = 16 * (2 * w + ii) + 4 * g; uint2 pk; pk.x = pack2(acc[ii][0], acc[ii][1]); pk.y = pack2(acc[ii][2], acc[ii][3]);
                    *(uint2*)(YT + ((size_t)c * 8 + rr) * NKEY + t) = pk; }
            }
        }
    }
    __syncthreads();
}
__device__ __forceinline__ void ph_hyena_post(const Fr& F) {
    const bf16_t* YT = F.w<bf16_t>(L0_YT); const bf16_t* X0 = F.w<bf16_t>(L0_X0); bf16_t* A = F.w<bf16_t>(WS_ABUF);
    bf16_t* yt = (bf16_t*)F.lds;
    for (int un = F.bid; un < (TT / 64) * 4; un += F.G) {
        const int tile = un >> 2, cgp = un & 3, row0 = tile * 64;
        { const int ch = F.tid >> 2, part = F.tid & 3; const int b = row0 < TL ? (row0 >> 11) : ((row0 - TL) >> 8), off = row0 < TL ? CTXL + (row0 & (SEQ - 1)) : ((row0 - TL) & (CTXL - 1));
          const uint4* src = (const uint4*)(YT + ((size_t)(cgp * 128 + ch) * 8 + b) * NKEY + off + part * 16); const uint4 v0 = src[0], v1 = src[1];
          unsigned* dst = (unsigned*)(yt + ch * 66 + part * 16); dst[0] = v0.x; dst[1] = v0.y; dst[2] = v0.z; dst[3] = v0.w; dst[4] = v1.x; dst[5] = v1.y; dst[6] = v1.z; dst[7] = v1.w; }
        __syncthreads();
        { const int tok = F.tid >> 3, cq = F.tid & 7, row = row0 + tok;
#pragma unroll
          for (int hf = 0; hf < 2; ++hf) { const int ch = cgp * 128 + cq * 16 + hf * 8; float x0[8], o[8]; ld8bf(X0 + (size_t)row * 512 + ch, x0);
#pragma unroll
              for (int j = 0; j < 8; ++j) o[j] = x0[j] * bf2f(yt[(cq * 16 + hf * 8 + j) * 66 + tok]);
              st8bf(A + (size_t)row * 1024 + ch, o); } }
        __syncthreads();
    }
}

__device__ __forceinline__ int ssd_rowbase(int b, int cpos) { return cpos < 2 ? TL + b * CTXL + cpos * 128 : b * SEQ + (cpos - 2) * 128; }
typedef short s16x4 __attribute__((ext_vector_type(4)));
__device__ __forceinline__ s16x4 tr_read16(const unsigned char* img, int P, int row0, int col0, int lane) {
    const int q4 = (lane & 15) >> 2, p4 = lane & 3;
    return __builtin_amdgcn_ds_read_tr16_b64_v4i16((LAS s16x4*)(LAS unsigned char*)(img + (row0 + q4) * P + (col0 + 4 * p4) * 2));
}
__device__ __forceinline__ bf16x8 tr_pair(const unsigned char* img, int P, int rowa, int rowb, int col0, int lane) {
    union { bf16x8 v; s16x4 h[2]; } u; u.h[0] = tr_read16(img, P, rowa, col0, lane); u.h[1] = tr_read16(img, P, rowb, col0, lane); return u.v;
}
__device__ __forceinline__ void ph_ssd_a(const Fr& F) {
    constexpr int PT = 272, PX = 144;
    unsigned char* XD = F.lds;
    unsigned char* Bn = XD + 128 * PX;
    unsigned char* Bd = Bn + 128 * PT;
    unsigned char* Cn = Bd + 128 * PT;
    float* acs = (float*)(Cn + 128 * PT);
    float* dts = acs + 128;
    const bf16_t* XBC = F.w<bf16_t>(L0_XBC); const float* DT = F.w<float>(L0_DT);
    const int w = F.wave, cl = F.lane & 15, g = F.lane >> 4;
    for (int u = F.bid; u < NB * 18 * 16; u += F.G) {
        const int b = u / 288, rem = u % 288, cpos = rem >> 4, h = (rem >> 1) & 7, dir = rem & 1, grp = h >> 2;
        const int rowbase = ssd_rowbase(b, cpos), su = ((b * 2 + dir) * 8 + h) * 18 + cpos;
        const float Aneg = -expf(F.in[I_ALOG][dir * 8 + h]);
        __syncthreads();
        if (w == 0) { const int q0 = 2 * F.lane, p0 = dir ? 127 - q0 : q0, p1 = dir ? 126 - q0 : q0 + 1;
            const float d0 = DT[(size_t)(rowbase + p0) * 16 + dir * 8 + h], d1 = DT[(size_t)(rowbase + p1) * 16 + dir * 8 + h]; const float a0 = d0 * Aneg, a1 = d1 * Aneg;
            float sc = a0 + a1;
#pragma unroll
            for (int o = 1; o < 64; o <<= 1) { const float t = __shfl_up(sc, o); if (F.lane >= o) sc += t; }
            const float ex = sc - (a0 + a1); acs[q0] = ex + a0; acs[q0 + 1] = ex + a0 + a1; dts[q0] = d0; dts[q0 + 1] = d1;
            float* ACS = F.w<float>(L0_ACS) + (size_t)su * 128; ACS[p0] = ex + a0; ACS[p1] = ex + a0 + a1;
            if (F.lane == 63) F.w<float>(L0_ATOT)[su] = ex + a0 + a1; }
        __syncthreads();
        const float atot = acs[127];
#pragma unroll
        for (int k = 0; k < 2; ++k) { const int id = F.tid + 512 * k, q = id >> 3, pc = id & 7, pos = dir ? 127 - q : q; float v[8]; ld8bf(XBC + (size_t)(rowbase + pos) * 1024 + h * 64 + pc * 8, v); const float dv = dts[q];
            uint4 o; o.x = pack2(v[0] * dv, v[1] * dv); o.y = pack2(v[2] * dv, v[3] * dv); o.z = pack2(v[4] * dv, v[5] * dv); o.w = pack2(v[6] * dv, v[7] * dv);
            *(uint4*)(XD + q * PX + pc * 16) = o; }
#pragma unroll
        for (int k = 0; k < 4; ++k) { const int id = F.tid + 512 * k, q = id >> 4, nc = id & 15, pos = dir ? 127 - q : q; const bf16_t* src = XBC + (size_t)(rowbase + pos) * 1024 + 512 + grp * 128 + nc * 8;
            const uint4 bv = *(const uint4*)src, cv = *(const uint4*)(src + 256);
            *(uint4*)(Bn + q * PT + nc * 16) = bv; *(uint4*)(Cn + q * PT + nc * 16) = cv;
            const float dec = __expf(atot - acs[q]); uint4 o;
            o.x = pack2(bflo(bv.x) * dec, bfhi(bv.x) * dec); o.y = pack2(bflo(bv.y) * dec, bfhi(bv.y) * dec); o.z = pack2(bflo(bv.z) * dec, bfhi(bv.z) * dec); o.w = pack2(bflo(bv.w) * dec, bfhi(bv.w) * dec);
            *(uint4*)(Bd + q * PT + nc * 16) = o; }
        __syncthreads();
        const int q = 16 * w + cl; const float aq = acs[q];
        bf16x8 cf[4];
#pragma unroll
        for (int ks = 0; ks < 4; ++ks) cf[ks] = *(const bf16x8*)(Cn + q * PT + (32 * ks + 8 * g) * 2);
        unsigned pk[8][2];
#pragma unroll
        for (int sb = 0; sb < 8; ++sb) { pk[sb][0] = 0u; pk[sb][1] = 0u;
            if (sb <= w) { f32x4 gacc = (f32x4){0.f, 0.f, 0.f, 0.f};
#pragma unroll
                for (int ks = 0; ks < 4; ++ks) { const bf16x8 bf = *(const bf16x8*)(Bn + (16 * sb + cl) * PT + (32 * ks + 8 * g) * 2); gacc = __builtin_amdgcn_mfma_f32_16x16x32_bf16(bf, cf[ks], gacc, 0, 0, 0); }
                const f32x4 as = *(const f32x4*)(acs + 16 * sb + 4 * g); float sv[4];
#pragma unroll
                for (int e = 0; e < 4; ++e) { const int sI = 16 * sb + 4 * g + e; sv[e] = (sI <= q) ? gacc[e] * __expf(aq - as[e]) : 0.f; }
                pk[sb][0] = pack2(sv[0], sv[1]); pk[sb][1] = pack2(sv[2], sv[3]); } }
        f32x4 yacc[4];
#pragma unroll
        for (int pb = 0; pb < 4; ++pb) yacc[pb] = (f32x4){0.f, 0.f, 0.f, 0.f};
#pragma unroll
        for (int k2 = 0; k2 < 4; ++k2) if (2 * k2 <= w) {
            union { bf16x8 v; unsigned wd[4]; } pf; pf.wd[0] = pk[2 * k2][0]; pf.wd[1] = pk[2 * k2][1]; pf.wd[2] = pk[2 * k2 + 1][0]; pf.wd[3] = pk[2 * k2 + 1][1];
#pragma unroll
            for (int pb = 0; pb < 4; ++pb) { const bf16x8 xa = tr_pair(XD, PX, 32 * k2 + 4 * g, 32 * k2 + 16 + 4 * g, 16 * pb, F.lane);
                yacc[pb] = __builtin_amdgcn_mfma_f32_16x16x32_bf16(xa, pf.v, yacc[pb], 0, 0, 0); } }
        { bf16_t* Y = (dir ? F.w<bf16_t>(L0_YB) : F.w<bf16_t>(L0_YF)) + (size_t)(rowbase + (dir ? 127 - q : q)) * 512 + h * 64 + 4 * g;
#pragma unroll
          for (int pb = 0; pb < 4; ++pb) { uint2 o; o.x = pack2(yacc[pb][0], yacc[pb][1]); o.y = pack2(yacc[pb][2], yacc[pb][3]); *(uint2*)(Y + 16 * pb) = o; } }
        { float* ST = F.w<float>(L0_ST) + (size_t)su * 8192;
          bf16x8 af[4];
#pragma unroll
          for (int ks = 0; ks < 4; ++ks) af[ks] = tr_pair(Bd, PT, 32 * ks + 8 * g, 32 * ks + 8 * g + 4, 16 * w, F.lane);
#pragma unroll
          for (int pb = 0; pb < 4; ++pb) { f32x4 sacc = (f32x4){0.f, 0.f, 0.f, 0.f};
#pragma unroll
              for (int ks = 0; ks < 4; ++ks) { const bf16x8 xb = tr_pair(XD, PX, 32 * ks + 8 * g, 32 * ks + 8 * g + 4, 16 * pb, F.lane); sacc = __builtin_amdgcn_mfma_f32_16x16x32_bf16(af[ks], xb, sacc, 0, 0, 0); }
              *(f32x4*)(ST + (size_t)(16 * pb + cl) * 128 + 16 * w + 4 * g) = sacc; } }
    }
    __syncthreads();
}
__device__ __forceinline__ void ph_ssd_b(const Fr& F) {
    const float* ST = F.w<float>(L0_ST); const float* ATOT = F.w<float>(L0_ATOT); bf16_t* STIN = F.w<bf16_t>(L0_STIN);
    for (int idx = F.bid * NTHR + F.tid; idx < 128 * 2048; idx += F.G * NTHR) {
        const int chain = idx >> 11, e4 = idx & 2047, dir = (chain >> 3) & 1;
        f32x4 run = (f32x4){0.f, 0.f, 0.f, 0.f};
        for (int k = 0; k < 18; ++k) { const int cpos = dir ? (k < 2 ? 1 - k : 19 - k) : k; const size_t su = (size_t)chain * 18 + cpos;
            uint2 o; o.x = pack2(run[0], run[1]); o.y = pack2(run[2], run[3]); *(uint2*)(STIN + su * 8192 + e4 * 4) = o;
            const f32x4 st = *(const f32x4*)(ST + su * 8192 + e4 * 4); const float dc = __expf(ATOT[su]); run = run * dc + st; }
    }
}
__device__ __forceinline__ void ph_ssd_c(const Fr& F) {
    constexpr int PT = 272;
    unsigned char* Cn = F.lds;
    unsigned char* Sin = Cn + 64 * PT;
    float* ssx = (float*)(Sin + 4 * 64 * PT);
    const bf16_t* XBC = F.w<bf16_t>(L0_XBC); const bf16_t* PROJ = F.w<bf16_t>(L0_PROJ); const bf16_t* STIN = F.w<bf16_t>(L0_STIN); const float* ACS = F.w<float>(L0_ACS);
    const bf16_t* YF = F.w<bf16_t>(L0_YF); const bf16_t* YB = F.w<bf16_t>(L0_YB); bf16_t* A = F.w<bf16_t>(WS_ABUF);
    const float* dsk = F.in[I_SSMD]; const float* ng = F.in[I_SSMNG];
    const int w = F.wave, pw = w & 3, hp = w >> 2;
    for (int u = F.bid; u < NB * 18 * 4; u += F.G) {
        int tz = threadIdx.x; asm volatile("" : "+v"(tz));
        const int cl = tz & 15, g = (tz >> 4) & 3;
        const int b = u / 72, rem = u % 72, cpos = rem >> 2, grp = (rem >> 1) & 1, ph = rem & 1; const int rowbase = ssd_rowbase(b, cpos);
        const int lpos = 16 * pw + cl, pos = ph * 64 + lpos; const size_t row = (size_t)(rowbase + pos);
        __syncthreads();
#pragma unroll
        for (int k = 0; k < 2; ++k) { const int id = tz + 512 * k, q = id >> 4, nc = id & 15; *(uint4*)(Cn + q * PT + nc * 16) = *(const uint4*)(XBC + (size_t)(rowbase + ph * 64 + q) * 1024 + 768 + grp * 128 + nc * 8); }
        float ss = 0.f;
        uint4 sreg0, sreg1, sreg2, sreg3, sreg4, sreg5, sreg6, sreg7;
#define SSDC_SRC(k, it) (STIN + ((size_t)(b * 16 + (((tz + 512 * (k)) >> 10) & 1) * 8 + grp * 4 + 2 * ((tz + 512 * (k)) >> 11) + (it)) * 18 + cpos) * 8192 + (((tz + 512 * (k)) >> 4) & 63) * 128 + ((tz + 512 * (k)) & 15) * 8)
#define SSDC_SLOAD(it) do { sreg0 = *(const uint4*)SSDC_SRC(0, it); sreg1 = *(const uint4*)SSDC_SRC(1, it); sreg2 = *(const uint4*)SSDC_SRC(2, it); sreg3 = *(const uint4*)SSDC_SRC(3, it); \
            sreg4 = *(const uint4*)SSDC_SRC(4, it); sreg5 = *(const uint4*)SSDC_SRC(5, it); sreg6 = *(const uint4*)SSDC_SRC(6, it); sreg7 = *(const uint4*)SSDC_SRC(7, it); } while (0)
#define SSDC_LDSW(k, v) *(uint4*)(Sin + ((tz + 512 * (k)) >> 10) * 64 * PT + (((tz + 512 * (k)) >> 4) & 63) * PT + ((tz + 512 * (k)) & 15) * 16) = v
        SSDC_SLOAD(0);
#pragma unroll 1
        for (int it = 0; it < 2; ++it) {
            const int h = grp * 4 + 2 * hp + it; const size_t su0 = (size_t)(b * 16 + h) * 18 + cpos, su1 = (size_t)(b * 16 + 8 + h) * 18 + cpos;
            uint2 eyf[4], eyb[4], exv[4], ezv[4];
#pragma unroll
            for (int pb = 0; pb < 4; ++pb) { const int ch = h * 64 + 16 * pb + 4 * g;
                eyf[pb] = *(const uint2*)(YF + row * 512 + ch); eyb[pb] = *(const uint2*)(YB + row * 512 + ch); exv[pb] = *(const uint2*)(XBC + row * 1024 + ch); ezv[pb] = *(const uint2*)(PROJ + row * EVEN_PAD + 1536 + ch); }
            const float a0 = ACS[su0 * 128 + pos], a1 = ACS[su1 * 128 + pos];
            __syncthreads();
            SSDC_LDSW(0, sreg0); SSDC_LDSW(1, sreg1); SSDC_LDSW(2, sreg2); SSDC_LDSW(3, sreg3); SSDC_LDSW(4, sreg4); SSDC_LDSW(5, sreg5); SSDC_LDSW(6, sreg6); SSDC_LDSW(7, sreg7);
            if (it < 1) SSDC_SLOAD(it + 1);
            __syncthreads();
            const float sc0 = __expf(a0), sc1 = __expf(a1);
            const unsigned char* S0 = Sin + (hp * 2) * 64 * PT; const unsigned char* S1 = S0 + 64 * PT;
            f32x4 t0[4], t1[4];
#pragma unroll
            for (int pb = 0; pb < 4; ++pb) { t0[pb] = (f32x4){0.f, 0.f, 0.f, 0.f}; t1[pb] = (f32x4){0.f, 0.f, 0.f, 0.f}; }
#pragma unroll
            for (int ks = 0; ks < 4; ++ks) { const bf16x8 cf = *(const bf16x8*)(Cn + lpos * PT + (32 * ks + 8 * g) * 2);
#pragma unroll
                for (int pb = 0; pb < 4; ++pb) { const bf16x8 s0 = *(const bf16x8*)(S0 + (16 * pb + cl) * PT + (32 * ks + 8 * g) * 2), s1 = *(const bf16x8*)(S1 + (16 * pb + cl) * PT + (32 * ks + 8 * g) * 2);
                    t0[pb] = __builtin_amdgcn_mfma_f32_16x16x32_bf16(s0, cf, t0[pb], 0, 0, 0); t1[pb] = __builtin_amdgcn_mfma_f32_16x16x32_bf16(s1, cf, t1[pb], 0, 0, 0); } }
            const float dd = dsk[h];
#pragma unroll
            for (int pb = 0; pb < 4; ++pb) { const int ch = h * 64 + 16 * pb + 4 * g;
                const uint2 yf = eyf[pb], yb = eyb[pb], xv = exv[pb], zv = ezv[pb];
                f32x4 y = t0[pb] * sc0 + t1[pb] * sc1;
                y[0] = (y[0] + bflo(yf.x) + bflo(yb.x) + bflo(xv.x) * dd) * silu_f(bflo(zv.x)); y[1] = (y[1] + bfhi(yf.x) + bfhi(yb.x) + bfhi(xv.x) * dd) * silu_f(bfhi(zv.x));
                y[2] = (y[2] + bflo(yf.y) + bflo(yb.y) + bflo(xv.y) * dd) * silu_f(bflo(zv.y)); y[3] = (y[3] + bfhi(yf.y) + bfhi(yb.y) + bfhi(xv.y) * dd) * silu_f(bfhi(zv.y));
                uint2 o; o.x = pack2(y[0], y[1]); o.y = pack2(y[2], y[3]);
                const float r0 = bflo(o.x), r1 = bfhi(o.x), r2 = bflo(o.y), r3 = bfhi(o.y); ss += r0 * r0 + r1 * r1 + r2 * r2 + r3 * r3;
                *(uint2*)(A + row * 1024 + 512 + ch) = o; }
        }
#undef SSDC_SLOAD
#undef SSDC_SRC
#undef SSDC_LDSW
        ss += __shfl_xor(ss, 16); ss += __shfl_xor(ss, 32);
        if (g == 0) ssx[hp * 64 + lpos] = ss;
        __syncthreads();
        const float rn = rsqrtf((ssx[lpos] + ssx[64 + lpos]) * (1.f / 256.f) + EPS);
#pragma unroll 4
        for (int i = 0; i < 8; ++i) { const int ch = grp * 256 + (2 * hp + (i >> 2)) * 64 + 16 * (i & 3) + 4 * g; bf16_t* ap = A + row * 1024 + 512 + ch; const uint2 v = *(const uint2*)ap; const f32x4 gg = *(const f32x4*)(ng + ch);
            uint2 o; o.x = pack2(bflo(v.x) * rn * gg[0], bfhi(v.x) * rn * gg[1]); o.y = pack2(bflo(v.y) * rn * gg[2], bfhi(v.y) * rn * gg[3]); *(uint2*)ap = o; }
    }
    __syncthreads();
}

__device__ __forceinline__ uint4 rope8(const uint4 mine, const uint4 other, const float* ct, const float* st, bool upper, bool apply, float scale) {
    float m[8], o[8], r[8]; const unsigned mw[4] = {mine.x, mine.y, mine.z, mine.w}, ow[4] = {other.x, other.y, other.z, other.w};
#pragma unroll
    for (int j = 0; j < 4; ++j) { m[2 * j] = bflo(mw[j]); m[2 * j + 1] = bfhi(mw[j]); o[2 * j] = bflo(ow[j]); o[2 * j + 1] = bfhi(ow[j]); }
    if (apply) { const float4 c0 = ld4(ct), c1 = ld4(ct + 4), s0 = ld4(st), s1 = ld4(st + 4); const float c[8] = {c0.x, c0.y, c0.z, c0.w, c1.x, c1.y, c1.z, c1.w}, sn[8] = {s0.x, s0.y, s0.z, s0.w, s1.x, s1.y, s1.z, s1.w};
#pragma unroll
        for (int j = 0; j < 8; ++j) r[j] = (upper ? (m[j] * c[j] + o[j] * sn[j]) : (m[j] * c[j] - o[j] * sn[j])) * scale; }
    else {
#pragma unroll
        for (int j = 0; j < 8; ++j) r[j] = m[j] * scale; }
    uint4 q; q.x = pack2(r[0], r[1]); q.y = pack2(r[2], r[3]); q.z = pack2(r[4], r[5]); q.w = pack2(r[6], r[7]); return q;
}
__device__ __forceinline__ uint4 shfl_xor_u4(const uint4 v, int m) { uint4 r; r.x = __shfl_xor(v.x, m); r.y = __shfl_xor(v.y, m); r.z = __shfl_xor(v.z, m); r.w = __shfl_xor(v.w, m); return r; }
__device__ __forceinline__ void ph_attn_prep(const Fr& F) {
    const bf16_t* P = F.w<bf16_t>(L1_PROJ); float* SQ = F.w<float>(WS_SQ); float* SKV = F.w<float>(WS_SKV);
    bf16_t* KM = F.w<bf16_t>(L1_KM); bf16_t* QG = F.w<bf16_t>(L1_QG); bf16_t* KG = F.w<bf16_t>(L1_KG); bf16_t* VGT = F.w<bf16_t>(L1_VGT);
    const float* cm = F.w<float>(WS_ROPEM); const float* sm = cm + 2048 * 16; const float* cg = F.w<float>(WS_ROPEG); const float* sg = cg + 2048 * 32;
    const float gscale = 0.125f * LOG2E;
    for (int row = F.bid * 8 + F.wave; row < TT; row += F.G * 8) {
        const bf16_t* pr = P + (size_t)row * ODD_PAD; const bool lat = row < TL; const int pos = row & (SEQ - 1), l = F.lane;
        const int b = lat ? (row >> 11) : ((row - TL) >> 8), key = lat ? CTXL + pos : ((row - TL) & (CTXL - 1));
        { float s = 0.f; if (l < 48) { float v[8]; ld8bf(pr + l * 8, v);
#pragma unroll
              for (int j = 0; j < 8; ++j) s += v[j] * v[j]; }
          const float sq = wave_sum(l < 32 ? s : 0.f), skv = wave_sum(l >= 32 ? s : 0.f);
          if (l == 0) { SQ[row] = rsqrtf(sq * (1.f / 256.f) + EPS); SKV[row] = rsqrtf(skv * (1.f / 128.f) + EPS); } }
        { const uint4 mine = *(const uint4*)(pr + 416 + l * 8); const uint4 other = shfl_xor_u4(mine, 4); const int sub = l & 7, i0 = (sub & 3) * 8;
          if (lat) *(uint4*)(QG + (size_t)row * 512 + l * 8) = rope8(mine, other, cg + pos * 32 + i0, sg + pos * 32 + i0, sub >= 4, true, gscale); }
        { const int lk = l & 15; const uint4 mine = *(const uint4*)(pr + 928 + lk * 8); const uint4 other = shfl_xor_u4(mine, 4); const int sub = lk & 7, i0 = (sub & 3) * 8;
          const uint4 r = rope8(mine, other, cg + pos * 32 + i0, sg + pos * 32 + i0, sub >= 4, lat, 1.f);
          if (l < 16) *(uint4*)(KG + ((size_t)b * NKEY + key) * 128 + lk * 8) = r; }
        { const int lr = l & 3; const uint4 mine = *(const uint4*)(pr + 384 + lr * 8); const uint4 other = shfl_xor_u4(mine, 2); const int i0 = (lr & 1) * 8;
          const uint4 r = rope8(mine, other, cm + pos * 16 + i0, sm + pos * 16 + i0, lr >= 2, lat, 1.f);
          if (l < 4) { bf16_t* kb = KM + ((size_t)b * NKEY + key) * 768 + 64 + lr * 8;
#pragma unroll
              for (int h = 0; h < 8; ++h) *(uint4*)(kb + h * 96) = r; } }
    }
    bf16_t* vt = (bf16_t*)F.lds;
    for (int un = F.bid; un < TT / 64; un += F.G) {
        const int row0 = un * 64; const int b = row0 < TL ? (row0 >> 11) : ((row0 - TL) >> 8), key0 = row0 < TL ? CTXL + (row0 & (SEQ - 1)) : ((row0 - TL) & (CTXL - 1));
        { const int tok = F.tid >> 3, cq = F.tid & 7; const uint4 a = *(const uint4*)(P + (size_t)(row0 + tok) * ODD_PAD + 1056 + cq * 16), c2 = *(const uint4*)(P + (size_t)(row0 + tok) * ODD_PAD + 1056 + cq * 16 + 8);
          const unsigned wv[8] = {a.x, a.y, a.z, a.w, c2.x, c2.y, c2.z, c2.w};
#pragma unroll
          for (int j = 0; j < 8; ++j) { vt[(cq * 16 + 2 * j) * 66 + tok] = (bf16_t)(wv[j] & 0xFFFFu); vt[(cq * 16 + 2 * j + 1) * 66 + tok] = (bf16_t)(wv[j] >> 16); } }
        __syncthreads();
        { const int ch = F.tid >> 2, part = F.tid & 3; const unsigned* src = (const unsigned*)(vt + ch * 66 + part * 16); uint4 v0, v1; v0.x = src[0]; v0.y = src[1]; v0.z = src[2]; v0.w = src[3]; v1.x = src[4]; v1.y = src[5]; v1.z = src[6]; v1.w = src[7];
          uint4* dst = (uint4*)(VGT + ((size_t)(b * 2 + (ch >> 6)) * 64 + (ch & 63)) * NKEY + key0 + part * 16); dst[0] = v0; dst[1] = v1; }
        __syncthreads();
    }
}

typedef float f32x16 __attribute__((ext_vector_type(16)));
template <bool GQA>
__device__ __forceinline__ void ph_attn_mfma(const Fr& F) {
    constexpr int DQK = GQA ? 64 : 96, NKS = DQK / 16, KP = GQA ? 144 : 208, VP = 136, KCH = DQK / 8, NKCH = 64 * KCH;
    constexpr int KBYTES = 64 * KP, VBYTES = 64 * VP;
    unsigned char* Kb = F.lds; unsigned char* Vb = F.lds + 2 * KBYTES;
    bf16_t* A = F.w<bf16_t>(WS_ABUF);
    const int r = F.lane & 31, hh = F.lane >> 5;
    for (int u = F.bid; u < 512; u += F.G) {
        int b, ntile, lat_lo = 0, qpos, ocol; const bf16_t* qp; const bf16_t* kbase; const bf16_t* vtb; int kstride; float m_run, l_run;
        if (!GQA) { b = u >> 6; const int h = (u >> 3) & 7, qb = u & 7; qpos = qb * 256 + F.wave * 32 + r; ntile = NKEY / 64;
            qp = F.w<bf16_t>(L1_QM) + (size_t)(b * SEQ + qpos) * 768 + h * 96; kbase = F.w<bf16_t>(L1_KM) + (size_t)b * NKEY * 768 + h * 96; kstride = 768;
            vtb = F.w<bf16_t>(L1_VT) + (size_t)(b * 8 + h) * 64 * NKEY; m_run = 0.f; l_run = 0.f; ocol = h * 64; }
        else { b = u >> 6; const int kv = (u >> 5) & 1, qb = (u >> 1) & 15, pr = u & 1; const int head = kv * 4 + pr * 2 + (F.wave >> 2); qpos = qb * 128 + (F.wave & 3) * 32 + r;
            lat_lo = qb * 128 - 128 > 0 ? qb * 128 - 128 : 0; const int lat_hi = qb * 128 + 256 < SEQ ? qb * 128 + 256 : SEQ; ntile = 4 + (lat_hi - lat_lo) / 64;
            qp = F.w<bf16_t>(L1_QG) + (size_t)(b * SEQ + qpos) * 512 + head * 64; kbase = F.w<bf16_t>(L1_KG) + (size_t)b * NKEY * 128 + kv * 64; kstride = 128;
            vtb = F.w<bf16_t>(L1_VGT) + (size_t)(b * 2 + kv) * 64 * NKEY; m_run = F.in[I_SINK][head] * LOG2E; l_run = hh ? 0.f : 1.f; ocol = 512 + head * 64; }
        bf16x8 qf[NKS];
#pragma unroll
        for (int ks = 0; ks < NKS; ++ks) qf[ks] = *(const bf16x8*)(qp + 16 * ks + 8 * hh);
        f32x16 o0, o1;
#pragma unroll
        for (int i = 0; i < 16; ++i) { o0[i] = 0.f; o1[i] = 0.f; }
        const int kr0 = F.tid / KCH, kc0 = F.tid % KCH, kr1 = (F.tid + 512) / KCH, kc1 = (F.tid + 512) % KCH; const bool has2 = (F.tid + 512) < NKCH;
        const int vr = F.tid >> 3, vc = F.tid & 7;
        uint4 kreg0, kreg1 = make_uint4(0u, 0u, 0u, 0u), vreg;
        bf16x8 kf[NKS][2];
#define ATT_KIDX(t) ((!GQA || (t) < 4) ? (t) * 64 : CTXL + lat_lo + ((t) - 4) * 64)
#define ATT_LOAD(t) do { const int _k0 = ATT_KIDX(t); kreg0 = *(const uint4*)(kbase + (size_t)(_k0 + kr0) * kstride + kc0 * 8); \
            if (has2) kreg1 = *(const uint4*)(kbase + (size_t)(_k0 + kr1) * kstride + kc1 * 8); vreg = *(const uint4*)(vtb + (size_t)vr * NKEY + _k0 + vc * 8); } while (0)
#define ATT_WRITE(buf) do { *(uint4*)(Kb + (buf) * KBYTES + kr0 * KP + kc0 * 16) = kreg0; if (has2) *(uint4*)(Kb + (buf) * KBYTES + kr1 * KP + kc1 * 16) = kreg1; \
            *(uint2*)(Vb + (buf) * VBYTES + vr * VP + vc * 16) = make_uint2(vreg.x, vreg.y); *(uint2*)(Vb + (buf) * VBYTES + vr * VP + vc * 16 + 8) = make_uint2(vreg.z, vreg.w); } while (0)
#define ATT_KFRAGS(buf) do { const unsigned char* kb = Kb + (buf) * KBYTES; \
            _Pragma("unroll") for (int ks = 0; ks < NKS; ++ks) { kf[ks][0] = *(const bf16x8*)(kb + r * KP + (16 * ks + 8 * hh) * 2); kf[ks][1] = *(const bf16x8*)(kb + (32 + r) * KP + (16 * ks + 8 * hh) * 2); } } while (0)
        __syncthreads();
        ATT_LOAD(0); ATT_WRITE(0);
        __syncthreads();
        ATT_KFRAGS(0);
        for (int t = 0; t < ntile; ++t) {
            const int buf = t & 1; const bool more = (t + 1) < ntile;
            if (more) ATT_LOAD(t + 1);
            const unsigned char* vb = Vb + buf * VBYTES;
            f32x16 s0, s1;
#pragma unroll
            for (int i = 0; i < 16; ++i) { s0[i] = -m_run; s1[i] = -m_run; }
#pragma unroll
            for (int ks = 0; ks < NKS; ++ks) { s0 = __builtin_amdgcn_mfma_f32_32x32x16_bf16(kf[ks][0], qf[ks], s0, 0, 0, 0); s1 = __builtin_amdgcn_mfma_f32_32x32x16_bf16(kf[ks][1], qf[ks], s1, 0, 0, 0); }
            union { bf16x8 v; uint2 h2[2]; } vf[4][2];
#pragma unroll
            for (int s2 = 0; s2 < 4; ++s2) { vf[s2][0].h2[0] = *(const uint2*)(vb + r * VP + (16 * s2 + 4 * hh) * 2); vf[s2][0].h2[1] = *(const uint2*)(vb + r * VP + (16 * s2 + 8 + 4 * hh) * 2);
                vf[s2][1].h2[0] = *(const uint2*)(vb + (32 + r) * VP + (16 * s2 + 4 * hh) * 2); vf[s2][1].h2[1] = *(const uint2*)(vb + (32 + r) * VP + (16 * s2 + 8 + 4 * hh) * 2); }
            __builtin_amdgcn_sched_barrier(0);
            if (GQA && t >= 4) { const int kp0 = lat_lo + (t - 4) * 64 + 4 * hh - qpos;
#pragma unroll
                for (int i = 0; i < 16; ++i) { const int rel = kp0 + (i & 3) + 8 * (i >> 2); if (rel > 128 || rel < -128) s0[i] = -1.0e30f; if (rel + 32 > 128 || rel + 32 < -128) s1[i] = -1.0e30f; } }
            float tmax = s0[0];
#pragma unroll
            for (int i = 1; i < 16; ++i) tmax = fmaxf(tmax, s0[i]);
#pragma unroll
            for (int i = 0; i < 16; ++i) tmax = fmaxf(tmax, s1[i]);
            tmax = fmaxf(tmax, __shfl_xor(tmax, 32));
            const float dm = fmaxf(tmax, 0.f); const bool grow = __any(tmax > 0.f) != 0; float alpha = 1.f;
            float ls = 0.f;
            if (grow) { alpha = __builtin_amdgcn_exp2f(-dm); m_run += dm;
#pragma unroll
                for (int i = 0; i < 16; ++i) { s0[i] = __builtin_amdgcn_exp2f(s0[i] - dm); s1[i] = __builtin_amdgcn_exp2f(s1[i] - dm); ls += s0[i] + s1[i]; } }
            else {
#pragma unroll
                for (int i = 0; i < 16; ++i) { s0[i] = __builtin_amdgcn_exp2f(s0[i]); s1[i] = __builtin_amdgcn_exp2f(s1[i]); ls += s0[i] + s1[i]; } }
            l_run = l_run * alpha + ls;
            if (grow) {
#pragma unroll
                for (int i = 0; i < 16; ++i) { o0[i] *= alpha; o1[i] *= alpha; } }
#pragma unroll
            for (int s2 = 0; s2 < 4; ++s2) {
                union { bf16x8 v; unsigned w[4]; } pf;
#pragma unroll
                for (int j = 0; j < 4; ++j) { const int ri = 8 * (s2 & 1) + 2 * j; pf.w[j] = (s2 < 2) ? pack2(s0[ri], s0[ri + 1]) : pack2(s1[ri], s1[ri + 1]); }
                o0 = __builtin_amdgcn_mfma_f32_32x32x16_bf16(vf[s2][0].v, pf.v, o0, 0, 0, 0); o1 = __builtin_amdgcn_mfma_f32_32x32x16_bf16(vf[s2][1].v, pf.v, o1, 0, 0, 0);
            }
            if (more) ATT_WRITE(buf ^ 1);
            __syncthreads();
            if (more) ATT_KFRAGS(buf ^ 1);
        }
#undef ATT_KFRAGS
#undef ATT_KIDX
#undef ATT_LOAD
#undef ATT_WRITE
        const float inv = 1.f / (l_run + __shfl_xor(l_run, 32));
        bf16_t* op = A + (size_t)(b * SEQ + qpos) * 1024 + ocol + 4 * hh;
#pragma unroll
        for (int t4 = 0; t4 < 4; ++t4) { uint2 p;
            p.x = pack2(o0[4 * t4] * inv, o0[4 * t4 + 1] * inv); p.y = pack2(o0[4 * t4 + 2] * inv, o0[4 * t4 + 3] * inv); *(uint2*)(op + 8 * t4) = p;
            p.x = pack2(o1[4 * t4] * inv, o1[4 * t4 + 1] * inv); p.y = pack2(o1[4 * t4 + 2] * inv, o1[4 * t4 + 3] * inv); *(uint2*)(op + 32 + 8 * t4) = p; }
    }
    __syncthreads();
}

template <class Epi>
__device__ __forceinline__ void run_gemm(const Fr& F, const bf16_t* A, int lda, const bf16_t* Bt, int ldb, int M, int N, int K, const Epi& E) {
    pg8::Gemm g{A, Bt, M, N, K, lda, ldb, 0}; pg8::StaticOrder S; S.init(M, N, F.G, F.bid);
    pg8::gemm_phase<Epi, pg8::StaticOrder>((LAS unsigned char*)F.lds, g, S, E);
}

__global__ void __launch_bounds__(NTHR, 2) fwd(Args args) {
    extern __shared__ __attribute__((aligned(16))) unsigned char lds[];
    Fr F; F.in = args.in; F.out = args.out; F.ws = args.ws; F.lds = lds; F.tid = threadIdx.x; F.lane = F.tid & 63; F.wave = __builtin_amdgcn_readfirstlane(F.tid >> 6); F.G = gridDim.x; F.bid = blockIdx.x;
    const int lo = args.ph_lo, hi = args.ph_hi;
#ifndef PHMASK
#define PHMASK 0xFFFFFFFFu
#endif
#define IN(k) (((PHMASK >> (k)) & 1u) && lo <= (k) && (k) < hi)
    const float* MOD0 = F.w<float>(WS_MOD); const float* MOD1 = MOD0 + 9 * 6144;
    const bool multi_phase = (hi - lo) > 1;
    if (F.tid == 0) *(uint4*)(lds + LDS_BYTES - 16) = make_uint4(0u, 0u, 0u, 0u);
    __syncthreads();
    XcdBarrier bar; bar.bar = F.w<unsigned>(WS_CTL); bar.x = 0; bar.st = (volatile LAS unsigned*)(LAS unsigned char*)(lds + LDS_BYTES - 16);
    if (multi_phase) bar = xcd_barrier_post(F.w<unsigned>(WS_CTL), (volatile LAS unsigned*)(LAS unsigned char*)(lds + LDS_BYTES - 16));
#define SEAM(k) do { if (IN(k) && IN((k) + 1)) xcd_barrier(bar); } while (0)
    bf16_t* ABUF = F.w<bf16_t>(WS_ABUF);

#ifndef DUPMASK
#define DUPMASK 0u
#endif
#define PHASE(k, ...) if (IN(k)) { __VA_ARGS__ } if (IN(k) && ((DUPMASK >> (k)) & 1u)) { xcd_barrier(bar); __VA_ARGS__ } SEAM(k);
    PHASE(0,
        ph_ada(F);
        cvt_job(F, F.in[I_EVWIN], nullptr, nullptr, F.w<bf16_t>(W_IN0), EVEN_PAD, 1024, 1024, EVEN_IN, EVEN_IN, 0, 1, 0);
        cvt_job(F, F.in[I_EVWOUT], nullptr, nullptr, F.w<bf16_t>(W_OUT0), 1024, 1024, 1024, 1024, 1024, 0, 1, 208);
        cvt_job(F, F.in[I_FFNG], F.in[I_FFNU], nullptr, F.w<bf16_t>(W_GU0), 2 * DFF, 1024, 1024, DFF, DFF, 1, 1, 272);
        cvt_job(F, F.in[I_FFND], nullptr, nullptr, F.w<bf16_t>(W_DN0), 1024, DFF, DFF, 1024, 1024, 0, 1, 624);
        cvt_job(F, F.in[I_ODWIN], nullptr, nullptr, F.w<bf16_t>(W_IN1), ODD_PAD, 1024, 1024, 1184, 1184, 0, 1, 800);
        cvt_job(F, F.in[I_QUP], nullptr, F.in[I_QNG], F.w<bf16_t>(W_QUP), 768, 256, 256, 768, 768, 0, 0, 880);
        cvt_job(F, F.in[I_KVUP], nullptr, F.in[I_KVNG], F.w<bf16_t>(W_KUP), 512, 256, 128, 1024, 1024, 2, 1, 892);
        cvt_job(F, F.in[I_KVUP], nullptr, F.in[I_KVNG], F.w<bf16_t>(W_VUP), 512, 256, 128, 1024, 1024, 3, 0, 900);
        cvt_job(F, F.in[I_ODWOUT], nullptr, nullptr, F.w<bf16_t>(W_OUT1), 1024, 1024, 1024, 1024, 1024, 0, 1, 908);
        ph_filters(F); ph_rope_tables(F);)
    PHASE(1, ph_norm0(F);)
    PHASE(2, run_gemm(F, ABUF, 1024, F.w<bf16_t>(W_IN0), 1024, TT, EVEN_PAD, 1024, pg8::EpiBf16Plain{F.w<bf16_t>(L0_PROJ), EVEN_PAD});)
    PHASE(3, ph_convpass(F);)
    PHASE(4, ph_ssd_a(F); ph_hyena_mfma(F);)
    PHASE(6, ph_ssd_b(F);)
    PHASE(7, ph_ssd_c(F); ph_hyena_post(F);)
    PHASE(8,
        run_gemm(F, ABUF, 1024, F.w<bf16_t>(W_OUT0), 1024, TL, 1024, 1024, pg8::EpiBf16Plain{F.w<bf16_t>(L0_MBUF), 1024});
        { pg8::Gemm g{ABUF, F.w<bf16_t>(W_OUT0), TT, 1024, 1024, 1024, 1024, 0}; pg8::DenseTailOrder<8> S; S.init(TL / 256, TC / 256, 1024 / 64, F.G, F.bid);
          pg8::gemm_phase<pg8::EpiTailBf16, pg8::DenseTailOrder<8>>((LAS unsigned char*)F.lds, g, S, pg8::EpiTailBf16{F.w<bf16_t>(L0_MBUF), 1024, F.w<bf16_t>(L0_XT), TL / 256, 8}); }
        cvt_fill(F, NWG8, CVQ8, cvt_g0(F.G, 8));)
    PHASE(9, ph_thin<0, true, false>(F, (const float*)F.w<bf16_t>(L0_MBUF), TT, F.in[I_X], F.in[I_CTX], nullptr, nullptr, F.in[I_MIXPOST], MOD0, 2048, F.in[I_FFNPRE], MOD0, 3072, 4096, ABUF, 0, 1, F.w<bf16_t>(L0_XT), 8);)
    PHASE(10, run_gemm(F, ABUF, 1024, F.w<bf16_t>(W_GU0), 1024, TT, 2 * DFF, 1024, pg8::EpiSwiglu{F.w<bf16_t>(L0_HMID), DFF}); cvt_fill(F, NWG10, CVQ10, cvt_g0(F.G, 10));)
    PHASE(11,
        run_gemm(F, F.w<bf16_t>(L0_HMID), DFF, F.w<bf16_t>(W_DN0), DFF, TL, 1024, DFF, pg8::EpiBf16Plain{F.w<bf16_t>(L0_MBUF), 1024});
        { pg8::Gemm g{F.w<bf16_t>(L0_HMID), F.w<bf16_t>(W_DN0), TT, 1024, DFF, DFF, DFF, 0}; pg8::DenseTailOrder<11> S; S.init(TL / 256, TC / 256, DFF / 64, F.G, F.bid);
          pg8::gemm_phase<pg8::EpiTailBf16, pg8::DenseTailOrder<11>>((LAS unsigned char*)F.lds, g, S, pg8::EpiTailBf16{F.w<bf16_t>(L0_MBUF), 1024, F.w<bf16_t>(L0_XT), TL / 256, 11}); }
        cvt_fill(F, NWG11, CVQ11, cvt_g0(F.G, 11));)
    PHASE(12, ph_thin<0, false, false>(F, (const float*)F.w<bf16_t>(L0_MBUF), TT, nullptr, nullptr, nullptr, nullptr, F.in[I_FFNPOST], MOD0, 5120, F.in[I_MIXPRE] + 1024, MOD1, 0, 1024, ABUF, 0, 1, F.w<bf16_t>(L0_XT), 11);)
    PHASE(13, run_gemm(F, ABUF, 1024, F.w<bf16_t>(W_IN1), 1024, TT, ODD_PAD, 1024, pg8::EpiBf16Plain{F.w<bf16_t>(L1_PROJ), ODD_PAD}); cvt_fill(F, NWG13, CVQ13, cvt_g0(F.G, 13));)
    PHASE(14, ph_attn_prep(F);)
    PHASE(15,
        run_gemm(F, F.w<bf16_t>(L1_PROJ), ODD_PAD, F.w<bf16_t>(W_QUP), 256, TL, 768, 256, pg8::EpiQ{F.w<bf16_t>(L1_QM), F.w<float>(WS_SQ), F.w<float>(WS_ROPEM), F.w<float>(WS_ROPEM) + 2048 * 16, 0.10206207261596575f * LOG2E});
        run_gemm(F, F.w<bf16_t>(L1_PROJ) + 256, ODD_PAD, F.w<bf16_t>(W_KUP), 256, TT, 512, 256, pg8::EpiK{F.w<bf16_t>(L1_KM), F.w<float>(WS_SKV)});
        run_gemm(F, F.w<bf16_t>(W_VUP), 256, F.w<bf16_t>(L1_PROJ) + 256, ODD_PAD, 512, TT, 256, pg8::EpiVT{F.w<bf16_t>(L1_VT), F.w<float>(WS_SKV)});)
    PHASE(16, ph_attn_mfma<false>(F); ph_attn_mfma<true>(F);)
    PHASE(17, run_gemm(F, ABUF, 1024, F.w<bf16_t>(W_OUT1), 1024, TL, 1024, 1024, pg8::EpiBf16Plain{F.w<bf16_t>(L1_MBUF), 1024});)
    PHASE(18, ph_thin<1, false, false>(F, (const float*)F.w<bf16_t>(L1_MBUF), TL, nullptr, nullptr, nullptr, nullptr, F.in[I_MIXPOST] + 1024, MOD1, 2048, F.in[I_FFNPRE] + 1024, MOD1, 3072, 4096, F.w<bf16_t>(L1_A2TMP));)
    PHASE(19,
        ph_moe_gather(F);
        cvt_moe_range(F, cvt_g0(F.G, 19), CVT_T_ALL, F.bid, F.G);)
    PHASE(20,
        if (MOE_FP8) { pg8::Gemm g{F.w<bf16_t>(WS_AG), F.w<bf16_t>(WM_GU), 0, 2 * DFE, 512, 512, 512, (size_t)2 * DFE * 1024}; pg8::GroupedOrder S; S.init(F.w<unsigned>(WS_CNT), 2 * DFE / 256, F.G, F.bid);
            pg8::gemm_phase<pg8::EpiSwigluF8, pg8::GroupedOrder, true>((LAS unsigned char*)F.lds, g, S, pg8::EpiSwigluF8{F.w<unsigned char>(L1_HMID), DFE}); }
        else { pg8::Gemm g{F.w<bf16_t>(WS_AG), F.w<bf16_t>(WM_GU), 0, 2 * DFE, 1024, 1024, 1024, (size_t)2 * DFE * 1024 * 2}; pg8::GroupedOrder S; S.init(F.w<unsigned>(WS_CNT), 2 * DFE / 256, F.G, F.bid);
            pg8::gemm_phase<pg8::EpiSwiglu, pg8::GroupedOrder>((LAS unsigned char*)F.lds, g, S, pg8::EpiSwiglu{F.w<bf16_t>(L1_HMID), DFE}); })
    PHASE(21,
        constexpr int KE = MOE_FP8 ? DFE / 2 : DFE;
        constexpr float osc = MOE_FP8 ? 1.f / (F8_WSCALE * F8_HSCALE) : 1.f;
        pg8::Gemm g{F.w<bf16_t>(L1_HMID), F.w<bf16_t>(WM_DN), 0, 1024, KE, KE, KE, (size_t)1024 * KE * 2};
        { pg8::GroupedOrder S; S.init(F.w<unsigned>(WS_CNT), 4, F.G, F.bid, KE / 64, true);
          pg8::gemm_phase<pg8::EpiMoeOut, pg8::GroupedOrder, MOE_FP8 != 0>((LAS unsigned char*)F.lds, g, S, pg8::EpiMoeOut{F.w<bf16_t>(WS_MOUT), F.w<uint2>(WS_ROWINFO), osc}); }
        { pg8::TailOrder S; S.init(F.w<unsigned>(WS_CNT), F.G, F.bid, KE / 64);
          pg8::gemm_phase<pg8::EpiXtr, pg8::TailOrder, MOE_FP8 != 0>((LAS unsigned char*)F.lds, g, S, pg8::EpiXtr{F.w<bf16_t>(WS_MOUT), F.w<uint2>(WS_ROWINFO), F.w<bf16_t>(WS_XTR), S.NTF, 7, osc}); })
    PHASE(22,
        pg8::TailOrder S; S.init(F.w<unsigned>(WS_CNT), F.G, F.bid, (MOE_FP8 ? DFE / 2 : DFE) / 64);
        ph_thin<2, false, true>(F, (const float*)F.w<bf16_t>(WS_MOUT), TL, nullptr, nullptr, F.out, nullptr, F.in[I_FFNPOST] + 1024, MOD1, 5120, nullptr, nullptr, 0, 0, nullptr, S.NTF, S.nsub > 0 ? 7 : 1);)
#undef IN
}

extern "C" void kernel_launch(void* const* d_in, const int* in_sizes, int n_in, void* d_out, int out_size, void* d_ws, size_t ws_size, hipStream_t stream) {
    static int grid = 0;
    if (grid == 0) {
        if (n_in != 41 || out_size != TL * DM || ws_size < WS_END) { fprintf(stderr, "kernel_launch: unexpected shapes (n_in %d, out %d, ws %zu < %zu)\n", n_in, out_size, ws_size, (size_t)WS_END); grid = -1; return; }
        int dev = 0, cus = 0;
        if (hipGetDevice(&dev) != hipSuccess || hipDeviceGetAttribute(&cus, hipDeviceAttributeMultiprocessorCount, dev) != hipSuccess) { grid = -1; return; }
        if (hipFuncSetAttribute((const void*)fwd, hipFuncAttributeMaxDynamicSharedMemorySize, LDS_BYTES) != hipSuccess) { fprintf(stderr, "kernel_launch: hipFuncSetAttribute failed\n"); grid = -1; return; }
        int per_cu = 0;
        if (hipOccupancyMaxActiveBlocksPerMultiprocessor(&per_cu, (const void*)fwd, NTHR, LDS_BYTES) != hipSuccess || per_cu < 1) fprintf(stderr, "kernel_launch: occupancy query says %d\n", per_cu);
        (void)hipGetLastError();
        grid = cus;
        if (grid % 4 != 0) { fprintf(stderr, "kernel_launch: the kernel needs a grid size that is a multiple of 4 (got %d CUs)\n", grid); grid = -1; return; }
    }
    if (grid < 0) return;
    (void)hipMemsetAsync((char*)d_ws + WS_CTL, 0, 65536, stream);
    Args a{};
    for (int i = 0; i < 41; ++i) a.in[i] = (const float*)d_in[i];
    a.out = (float*)d_out; a.ws = (unsigned char*)d_ws;
    auto launch = [&](int lo, int hi, int ex) { a.ph_lo = lo; a.ph_hi = hi; a.ex = ex; hipLaunchKernelGGL(fwd, dim3(grid), dim3(NTHR), LDS_BYTES, stream, a); };
#if defined(MULTI)
    for (int p = 0; p <= 22; ++p) launch(p, p + 1, 0);
#else
    launch(0, 23, 0);
#endif
}
```

```cpp
#include <hip/hip_runtime.h>
#include <cstdio>
#include <cstdint>

typedef unsigned short bf16_t;
typedef short bf16x8 __attribute__((ext_vector_type(8)));
typedef float f32x4 __attribute__((ext_vector_type(4)));
#define LAS __attribute__((address_space(3)))

constexpr int NB = 8, SEQ = 2048, DM = 1024, CTXL = 256;
constexpr int TL = NB * SEQ, TC = NB * CTXL, TT = TL + TC, NKEY = SEQ + CTXL;
constexpr int EVEN_IN = 3088, EVEN_PAD = 3328, ODD_PAD = 1280, DFF = 2816, DFE = 3584, NEXP = 8;
constexpr float EPS = 1e-6f;
constexpr float LOG2E = 1.4426950408889634f;
constexpr int NTHR = 512;
constexpr int LDS_BYTES = 147456;

constexpr size_t al256(size_t x) { return (x + 255) & ~(size_t)255; }
constexpr size_t WS_CTL = 0;
constexpr size_t WS_CNT = 16384;
constexpr size_t WS_MOD = 65536;
constexpr size_t WS_ROPEM = WS_MOD + al256((size_t)2 * 9 * 6144 * 4);
constexpr size_t WS_ROPEG = WS_ROPEM + (size_t)2 * 2048 * 16 * 4;
constexpr size_t WS_SQ = WS_ROPEG + (size_t)2 * 2048 * 32 * 4;
constexpr size_t WS_SKV = WS_SQ + al256((size_t)TT * 4);
constexpr size_t WS_TOPW = WS_SKV + al256((size_t)TT * 4);
constexpr size_t WS_LISTE = WS_TOPW + (size_t)TL * 2 * 4;
constexpr int MAXROWS = 34816;
constexpr size_t WS_ROWINFO = WS_LISTE + (size_t)NEXP * TL * 4;
constexpr size_t WS_ROWW = WS_ROWINFO + (size_t)MAXROWS * 4;
constexpr size_t WS_SROW = WS_ROWW + (size_t)MAXROWS * 4;
constexpr size_t WS_W0 = WS_SROW + (size_t)TL * 2 * 4;
constexpr size_t W_IN0 = WS_W0;
constexpr size_t W_OUT0 = W_IN0 + (size_t)EVEN_PAD * 1024 * 2;
constexpr size_t W_GU0 = W_OUT0 + (size_t)1024 * 1024 * 2;
constexpr size_t W_DN0 = W_GU0 + (size_t)2 * DFF * 1024 * 2;
constexpr size_t W_IN1 = W_DN0 + (size_t)1024 * DFF * 2;
constexpr size_t W_QUP = W_IN1 + (size_t)ODD_PAD * 1024 * 2;
constexpr size_t W_KUP = W_QUP + (size_t)768 * 256 * 2;
constexpr size_t W_VUP = W_KUP + (size_t)512 * 256 * 2;
constexpr size_t W_OUT1 = W_VUP + (size_t)512 * 256 * 2;
constexpr size_t WS_ABUF = W_OUT1 + (size_t)1024 * 1024 * 2;
constexpr size_t WS_AG = WS_W0;
constexpr size_t WS_MOUT = WS_W0;
constexpr size_t XG_END0 = WS_ABUF + (size_t)TT * DM * 2, XG_END1 = WS_AG + (size_t)MAXROWS * DM * 2;
constexpr size_t WS_R1 = al256(XG_END0 > XG_END1 ? XG_END0 : XG_END1);
constexpr size_t R1_BYTES = (size_t)MAXROWS * DFE * 2;
constexpr size_t WS_R2 = WS_R1 + R1_BYTES;
constexpr size_t R2_BYTES = (size_t)132 * 1024 * 1024;
constexpr size_t WS_XTR = WS_R2 + R2_BYTES;
constexpr size_t WS_HB = WS_XTR + (size_t)32 * 6 * 65536 * 2;
constexpr size_t WS_END = WS_HB + (size_t)TT * DM * 2;
static_assert(WS_END <= (size_t)536000000, "workspace budget");
constexpr size_t L0_PROJ = WS_R1;
constexpr size_t L0_HMID = WS_R1;
constexpr size_t L0_XBC = L0_PROJ + (size_t)TT * EVEN_PAD * 2;
constexpr size_t L0_U = L0_XBC + (size_t)TT * 1024 * 2;
constexpr size_t L0_X0 = L0_U + (size_t)TT * 512 * 2;
constexpr size_t L0_DT = L0_X0 + (size_t)TT * 512 * 2;
constexpr size_t L0_YF = L0_DT + (size_t)TT * 16 * 4;
constexpr size_t L0_YB = L0_YF + (size_t)TT * 512 * 2;
static_assert(L0_YB + (size_t)TT * 512 * 2 <= WS_R1 + R1_BYTES, "R1 layer 0");
constexpr size_t L0_MBUF = WS_R1 + (size_t)128 * 1024 * 1024;
static_assert(L0_MBUF >= L0_HMID + (size_t)TT * DFF * 2 && L0_MBUF + (size_t)TT * DM * 2 <= WS_R1 + R1_BYTES, "MBUF0 placement");
constexpr size_t L0_XT = WS_R1 + (size_t)176 * 1024 * 1024;
static_assert(L0_XT >= L0_MBUF + (size_t)TT * DM * 2 && L0_XT + (size_t)32 * 10 * 65536 * 2 <= WS_R1 + R1_BYTES, "XT0 placement");
constexpr size_t L0_FL = WS_R2 + (size_t)TT * DM * 2;
constexpr size_t L0_FC = L0_FL + (size_t)512 * 4096 * 2;
constexpr size_t L0_YT = L0_FC + (size_t)512 * 512 * 2;
constexpr size_t L0_ST = L0_YT + (size_t)512 * 8 * NKEY * 2;
constexpr size_t L0_ACS = L0_ST + (size_t)2304 * 8192 * 4;
constexpr size_t L0_ATOT = L0_ACS + (size_t)2304 * 128 * 4;
constexpr size_t L0_STIN = WS_R2;
static_assert(L0_ATOT + (size_t)2304 * 4 <= WS_R2 + R2_BYTES, "R2 layer 0");
constexpr size_t L1_HMID = WS_R1;
constexpr size_t L1_A2TMP = WS_R1;
constexpr size_t L1_PROJ = WS_R1;
constexpr size_t L1_QM = L1_PROJ + (size_t)TT * ODD_PAD * 2;
constexpr size_t L1_KM = L1_QM + (size_t)TL * 768 * 2;
constexpr size_t L1_VT = L1_KM + (size_t)NB * NKEY * 768 * 2;
constexpr size_t L1_QG = L1_VT + (size_t)NB * 512 * NKEY * 2;
constexpr size_t L1_KG = L1_QG + (size_t)TL * 512 * 2;
constexpr size_t L1_VGT = L1_KG + (size_t)NB * NKEY * 128 * 2;
constexpr size_t L1_MBUF = L1_VGT + (size_t)NB * 128 * NKEY * 2;
static_assert(L1_MBUF + (size_t)TL * DM * 4 <= WS_R1 + R1_BYTES, "R1 layer 1");
static_assert(L1_A2TMP + (size_t)TL * DM * 2 <= L1_MBUF, "a2tmp vs mbuf1");
constexpr size_t WM_GU = WS_R2;
constexpr size_t WM_DN = WM_GU + (size_t)NEXP * 2 * DFE * 1024;
static_assert(WM_DN + (size_t)NEXP * 1024 * DFE <= WS_R2 + R2_BYTES, "fp8 expert weights vs R2");

typedef __bf16 bf16v2 __attribute__((ext_vector_type(2)));
typedef float f32v2 __attribute__((ext_vector_type(2)));
__device__ __forceinline__ bf16_t f2bf(float f) { return __builtin_bit_cast(unsigned short, (__bf16)f); }
__device__ __forceinline__ float bf2f(bf16_t b) { return __uint_as_float(((unsigned)b) << 16); }
__device__ __forceinline__ unsigned pack2(float lo, float hi) { f32v2 v = {lo, hi}; return __builtin_bit_cast(unsigned, __builtin_convertvector(v, bf16v2)); }
#ifndef MOE_FP8
#define MOE_FP8 1
#endif
constexpr float F8_WSCALE = 64.f, F8_HSCALE = 8.f;
__device__ __forceinline__ unsigned pack4_fp8(float a, float b, float c, float d) { unsigned r = 0u; r = __builtin_amdgcn_cvt_pk_fp8_f32(a, b, r, false); r = __builtin_amdgcn_cvt_pk_fp8_f32(c, d, r, true); return r; }
__device__ __forceinline__ float bflo(unsigned u) { return __uint_as_float(u << 16); }
__device__ __forceinline__ float bfhi(unsigned u) { return __uint_as_float(u & 0xFFFF0000u); }
__device__ __forceinline__ float wave_sum(float v) {
#pragma unroll
    for (int o = 32; o > 0; o >>= 1) v += __shfl_xor(v, o);
    return v;
}
__device__ __forceinline__ float silu_f(float x) { return x * __builtin_amdgcn_rcpf(1.f + __builtin_amdgcn_exp2f(-x * LOG2E)); }
__device__ __forceinline__ float softplus_f(float x) { return x > 20.f ? x : log1pf(expf(x)); }

namespace pg8 {
constexpr int BM = 256, BK = 64, HALF = 128, HTB = HALF * BK * 2, STAGE_BYTES = 8 * HTB, NXCD = 8, WGM = 8;
__host__ __device__ __forceinline__ int lds_byte(int r, int c) { const int st = (r >> 4) * 2 + (c >> 5), rr = r & 15, cc = c & 31, ob = rr * 64 + cc * 2; return st * 1024 + (ob ^ (((ob >> 9) & 1) << 5)); }
__host__ __device__ __forceinline__ void stage_rc(int b, int& R, int& C) { const int st = b / 1024, sb = b % 1024, swz = sb ^ (((sb >> 9) & 1) << 5); R = (st >> 1) * 16 + swz / 64; C = (st & 1) * 32 + (swz % 64) / 2; }

struct Unit { int pm, pn, e, kt0, nkt, ks; };
struct Gemm { const bf16_t* A; const bf16_t* Bt; int M, N, K, lda, ldb; size_t bstride; };

struct StaticOrder {
    int nM, nN, nwg, G, c;
    __device__ __forceinline__ void init(int M, int N, int G_, int c_) { nM = M / BM; nN = N / BM; nwg = nM * nN; G = G_; c = c_; }
    __device__ __forceinline__ bool next(int i, Unit& u) const {
        const long L = (long)i * G + c; if (L >= nwg) return false;
        int wgid = (int)L; { const int q = nwg / NXCD, r = nwg % NXCD, xcd = wgid % NXCD, off = wgid / NXCD; wgid = (xcd < r ? xcd * (q + 1) : r * (q + 1) + (xcd - r) * q) + off; }
        const int nig = WGM * nN, gid = wgid / nig, fm = gid * WGM, gsz = (nM - fm) < WGM ? (nM - fm) : WGM;
        u.pm = fm + ((wgid % nig) % gsz); u.pn = (wgid % nig) / gsz; u.e = 0; u.kt0 = 0; u.nkt = 0; u.ks = 0; return true;
    }
};


struct GroupedOrder {
    int ts1, ts2, ts3, ts4, ts5, ts6, ts7, NT, nrow, nN, G, c;
    __device__ __forceinline__ static void tail_of(int NT, int nN, int G, int nkt_full, int& NTF, int& S) {
        NTF = NT; S = 1;
        if (nN == 4 && (G % 4) == 0) { const int ntf = ((NT * 4) / G) * (G / 4); const int R = (NT - ntf) * 4; if (R > 0 && ntf > 0 && R * 7 <= G && nkt_full % 14 == 0) { NTF = ntf; S = 7; } }
    }
    __device__ __forceinline__ void init(const unsigned* cnt, int nN_, int G_, int c_, int nkt_full = 0, bool head_only = false) {
        int t[9]; t[0] = 0;
#pragma unroll
        for (int e = 0; e < 8; ++e) t[e + 1] = t[e] + __builtin_amdgcn_readfirstlane((int)((__hip_atomic_load(cnt + e, __ATOMIC_RELAXED, __HIP_MEMORY_SCOPE_AGENT) + 255u) >> 8));
        ts1 = t[1]; ts2 = t[2]; ts3 = t[3]; ts4 = t[4]; ts5 = t[5]; ts6 = t[6]; ts7 = t[7]; NT = t[8]; nN = nN_; G = G_; c = c_; nrow = NT;
        if (head_only) { int ntf, s; tail_of(NT, nN, G, nkt_full, ntf, s); nrow = ntf; }
    }
    __device__ __forceinline__ int expert_of(int j) const { return (j >= ts1) + (j >= ts2) + (j >= ts3) + (j >= ts4) + (j >= ts5) + (j >= ts6) + (j >= ts7); }
    __device__ __forceinline__ bool next(int i, Unit& u) const {
        const int nwg = nrow * nN; const long L = (long)i * G + c; u.kt0 = 0; u.nkt = 0; u.ks = 0; if (L >= nwg) return false;
        int wgid = (int)L; { const int q = nwg / NXCD, r = nwg % NXCD, xcd = wgid % NXCD, off = wgid / NXCD; wgid = (xcd < r ? xcd * (q + 1) : r * (q + 1) + (xcd - r) * q) + off; }
        const int nig = WGM * nN, gid = wgid / nig, fm = gid * WGM, gsz = (nrow - fm) < WGM ? (nrow - fm) : WGM;
        const int j = fm + ((wgid % nig) % gsz); u.pm = j; u.pn = (wgid % nig) / gsz; u.e = expert_of(j); return true;
    }
};
struct TailOrder {
    int ts1, ts2, ts3, ts4, ts5, ts6, ts7, nsub, NTF, nkt, c;
    __device__ __forceinline__ void init(const unsigned* cnt, int G, int c_, int nkt_full) {
        int t[9]; t[0] = 0;
#pragma unroll
        for (int e = 0; e < 8; ++e) t[e + 1] = t[e] + __builtin_amdgcn_readfirstlane((int)((__hip_atomic_load(cnt + e, __ATOMIC_RELAXED, __HIP_MEMORY_SCOPE_AGENT) + 255u) >> 8));
        ts1 = t[1]; ts2 = t[2]; ts3 = t[3]; ts4 = t[4]; ts5 = t[5]; ts6 = t[6]; ts7 = t[7]; int s; GroupedOrder::tail_of(t[8], 4, G, nkt_full, NTF, s);
        nsub = (s == 7) ? (t[8] - NTF) * 28 : 0; nkt = nkt_full / 7; c = c_;
    }
    __device__ __forceinline__ bool next(int i, Unit& u) const {
        if (i > 0 || c >= nsub) return false;
        const int tu = c / 7, ks = c - tu * 7, j = NTF + (tu >> 2); u.pm = j; u.pn = tu & 3; u.e = (j >= ts1) + (j >= ts2) + (j >= ts3) + (j >= ts4) + (j >= ts5) + (j >= ts6) + (j >= ts7);
        u.nkt = nkt; u.kt0 = ks * nkt; u.ks = ks; return true;
    }
};

typedef int i32x4v __attribute__((ext_vector_type(4)));
typedef int i32x8v __attribute__((ext_vector_type(8)));
template <class Epi, class Sched, bool FP8 = false>
__device__ __forceinline__ void gemm_phase(LAS unsigned char* lds, const Gemm g, const Sched& S, const Epi& E) {
    const int tid = threadIdx.x, wid = __builtin_amdgcn_readfirstlane(tid >> 6), lane = tid & 63, wr = wid >> 2, wc = wid & 3, fr = lane & 15, fq = lane >> 4;
    int Kop = g.K; asm volatile("" : "+s"(Kop));
    const int K = Kop, nt = K / BK;
    unsigned voffA[2], voffB[2];
#pragma unroll
    for (int i = 0; i < 2; ++i) { int R, C; stage_rc(tid * 16 + i * 8192, R, C); voffA[i] = (unsigned)(R * g.lda + C) * 2u; voffB[i] = (unsigned)(R * g.ldb + C) * 2u; }
    const size_t kstep = (size_t)(BK * 2);
    const size_t hstepA = (size_t)HALF * g.lda * 2, hstepB = (size_t)HALF * g.ldb * 2;
    const size_t tstepA = 2 * hstepA, tstepB = 2 * hstepB;
    const unsigned ldsw = (unsigned)wid * 1024u;
    const int aoff = lds_byte(wr * 64 + fr, fq * 8), boff = lds_byte(wc * 32 + fr, fq * 8);
#define PG8_SA(b, h) (((b) * 2 + (h)) * HTB)
#define PG8_SB(b, h) ((4 + (b) * 2 + (h)) * HTB)
#define PG8_STAGE(bufoff, gbase, voff) do { _Pragma("unroll") for (int _i = 0; _i < 2; ++_i) \
        __builtin_amdgcn_global_load_lds((const unsigned*)((const char*)(gbase) + (voff)[_i]), (LAS unsigned*)(lds + (bufoff) + ldsw + _i * 8192), 16, 0, 0); } while (0)
#define PG8_LDA(dst, b, h) do { if constexpr (FP8) { _Pragma("unroll") for (int m = 0; m < 4; ++m) dst##8[m] = __builtin_shufflevector(*(const LAS i32x4v*)(lds + PG8_SA(b, h) + aoff + m * 2048), *(const LAS i32x4v*)(lds + PG8_SA(b, h) + aoff + m * 2048 + 1024), 0, 1, 2, 3, 4, 5, 6, 7); } \
        else { _Pragma("unroll") for (int m = 0; m < 4; ++m) _Pragma("unroll") for (int k = 0; k < 2; ++k) dst[m][k] = *(const LAS bf16x8*)(lds + PG8_SA(b, h) + aoff + m * 2048 + k * 1024); } } while (0)
#define PG8_LDB(dst, b, h) do { if constexpr (FP8) { _Pragma("unroll") for (int n = 0; n < 2; ++n) dst##8[n] = __builtin_shufflevector(*(const LAS i32x4v*)(lds + PG8_SB(b, h) + boff + n * 2048), *(const LAS i32x4v*)(lds + PG8_SB(b, h) + boff + n * 2048 + 1024), 0, 1, 2, 3, 4, 5, 6, 7); } \
        else { _Pragma("unroll") for (int n = 0; n < 2; ++n) _Pragma("unroll") for (int k = 0; k < 2; ++k) dst[n][k] = *(const LAS bf16x8*)(lds + PG8_SB(b, h) + boff + n * 2048 + k * 1024); } } while (0)
#define PG8_MMA(ai, bj, At, Bt) do { __builtin_amdgcn_s_setprio(1); \
        if constexpr (FP8) { _Pragma("unroll") for (int m = 0; m < 4; ++m) _Pragma("unroll") for (int n = 0; n < 2; ++n) \
            asm volatile("v_mfma_scale_f32_16x16x128_f8f6f4 %0, %1, %2, %0, %3, %3 op_sel_hi:[0,0,0]" : "+v"(acc[ai][bj][m][n]) : "v"(Bt##8[n]), "v"(At##8[m]), "v"(f8one)); } \
        else { _Pragma("unroll") for (int m = 0; m < 4; ++m) _Pragma("unroll") for (int n = 0; n < 2; ++n) _Pragma("unroll") for (int k = 0; k < 2; ++k) \
            acc[ai][bj][m][n] = __builtin_amdgcn_mfma_f32_16x16x32_bf16(Bt[n][k], At[m][k], acc[ai][bj][m][n], 0, 0, 0); } \
        __builtin_amdgcn_s_setprio(0); } while (0)
#define PG8_WAIT_V(n) asm volatile("s_waitcnt vmcnt(" #n ")" ::: "memory")
#define PG8_WAIT_L(n) asm volatile("s_waitcnt lgkmcnt(" #n ")" ::: "memory")
#define PG8_BAR __builtin_amdgcn_s_barrier()
#define PG8_SCHED __builtin_amdgcn_sched_barrier(0)
    Unit cur, nxt; int ui = 0;
    if (!S.next(0, cur)) return;
    f32x4 acc[2][2][4][2];
#pragma unroll
    for (int a = 0; a < 2; ++a)
#pragma unroll
        for (int b = 0; b < 2; ++b)
#pragma unroll
            for (int m = 0; m < 4; ++m)
#pragma unroll
                for (int n = 0; n < 2; ++n) acc[a][b][m][n] = (f32x4){0.f, 0.f, 0.f, 0.f};
    bf16x8 At[4][2], B0[2][2], B1[2][2];
    i32x8v At8[4], B08[2], B18[2];
    const int f8one = 0x7f7f7f7f;
    const char* cA = (const char*)g.A + (size_t)cur.pm * tstepA + (size_t)cur.kt0 * kstep; const char* cB = (const char*)g.Bt + (size_t)cur.e * g.bstride + (size_t)cur.pn * tstepB + (size_t)cur.kt0 * kstep;
    PG8_STAGE(PG8_SB(0, 0), cB, voffB); PG8_STAGE(PG8_SA(0, 0), cA, voffA); PG8_STAGE(PG8_SB(0, 1), cB + hstepB, voffB); PG8_STAGE(PG8_SA(0, 1), cA + hstepA, voffA);
    if (wr == 1) PG8_BAR;
    PG8_WAIT_V(4); PG8_BAR;
    PG8_STAGE(PG8_SB(1, 0), cB + kstep, voffB); PG8_STAGE(PG8_SA(1, 0), cA + kstep, voffA); PG8_STAGE(PG8_SB(1, 1), cB + hstepB + kstep, voffB);
    PG8_WAIT_V(6); PG8_BAR;
    for (;;) {
        const bool has_next = S.next(ui + 1, nxt);
        const char* nA = has_next ? (const char*)g.A + (size_t)nxt.pm * tstepA + (size_t)nxt.kt0 * kstep : cA; const char* nB = has_next ? (const char*)g.Bt + (size_t)nxt.e * g.bstride + (size_t)nxt.pn * tstepB + (size_t)nxt.kt0 * kstep : cB;
        const int ntc = cur.nkt ? cur.nkt : nt;
        for (int t = 0; t < ntc; t += 2) {
            const bool last = (t == ntc - 2);
            const char* a1 = cA + (size_t)(t + 1) * kstep;
            const char* a2 = last ? nA : cA + (size_t)(t + 2) * kstep; const char* b2 = last ? nB : cB + (size_t)(t + 2) * kstep;
            const char* a3 = a2 + kstep; const char* b3 = b2 + kstep;
            PG8_LDB(B0, 0, 0); PG8_SCHED; PG8_LDA(At, 0, 0); PG8_STAGE(PG8_SA(1, 1), a1 + hstepA, voffA);
            PG8_WAIT_L(8); PG8_BAR; PG8_WAIT_L(0); PG8_MMA(0, 0, At, B0); PG8_BAR; PG8_SCHED;
            PG8_LDB(B1, 0, 1); PG8_STAGE(PG8_SB(0, 0), b2, voffB);
            PG8_BAR; PG8_WAIT_L(0); PG8_MMA(0, 1, At, B1); PG8_BAR;
            PG8_LDA(At, 0, 1); PG8_STAGE(PG8_SA(0, 0), a2, voffA);
            PG8_BAR; PG8_WAIT_L(0); PG8_MMA(1, 0, At, B0); PG8_BAR; PG8_SCHED;
            PG8_STAGE(PG8_SB(0, 1), b2 + hstepB, voffB);
            PG8_WAIT_V(6); PG8_BAR; PG8_MMA(1, 1, At, B1); PG8_BAR;
            PG8_LDB(B0, 1, 0); PG8_SCHED; PG8_LDA(At, 1, 0); PG8_STAGE(PG8_SA(0, 1), a2 + hstepA, voffA);
            PG8_WAIT_L(8); PG8_BAR; PG8_WAIT_L(0); PG8_MMA(0, 0, At, B0); PG8_BAR; PG8_SCHED;
            PG8_LDB(B1, 1, 1); PG8_STAGE(PG8_SB(1, 0), b3, voffB);
            PG8_BAR; PG8_WAIT_L(0); PG8_MMA(0, 1, At, B1); PG8_BAR;
            PG8_LDA(At, 1, 1); PG8_STAGE(PG8_SA(1, 0), a3, voffA);
            PG8_BAR; PG8_WAIT_L(0); PG8_MMA(1, 0, At, B0); PG8_BAR; PG8_SCHED;
            PG8_STAGE(PG8_SB(1, 1), b3 + hstepB, voffB);
            PG8_WAIT_V(6); PG8_BAR; PG8_MMA(1, 1, At, B1); PG8_BAR;
        }
        if constexpr (FP8) asm volatile("s_nop 15\n\ts_nop 15\n\ts_nop 15\n\ts_nop 15" ::: "memory");
        E(acc, cur, wr, wc, fr, fq);
        if (!has_next) break;
#pragma unroll
        for (int a = 0; a < 2; ++a)
#pragma unroll
            for (int b = 0; b < 2; ++b)
#pragma unroll
                for (int m = 0; m < 4; ++m)
#pragma unroll
                    for (int n = 0; n < 2; ++n) acc[a][b][m][n] = (f32x4){0.f, 0.f, 0.f, 0.f};
        cur = nxt; cA = nA; cB = nB; ++ui;
    }
    PG8_WAIT_V(0);
    if (wr == 0) PG8_BAR;
    PG8_BAR;
#undef PG8_SA
#undef PG8_SB
#undef PG8_STAGE
#undef PG8_LDA
#undef PG8_LDB
#undef PG8_MMA
#undef PG8_WAIT_V
#undef PG8_WAIT_L
#undef PG8_BAR
#undef PG8_SCHED
}

__host__ __device__ __forceinline__ int perm256(int rho) { return 64 * ((rho >> 5) & 3) + 16 * ((rho >> 2) & 3) + 8 * (rho >> 7) + 4 * ((rho >> 4) & 1) + (rho & 3); }
#define EPI_ROWS_BEGIN _Pragma("unroll") for (int ai = 0; ai < 2; ++ai) _Pragma("unroll") for (int m = 0; m < 4; ++m) { asm volatile("" ::: "memory"); const int row = u.pm * BM + ai * HALF + wr * 64 + m * 16 + fr;
#define EPI_ROWS_END }
#define EPI_LOOP_BEGIN EPI_ROWS_BEGIN _Pragma("unroll") for (int bj = 0; bj < 2; ++bj) { const int cg = u.pn * BM + bj * HALF + wc * 32;
#define EPI_LOOP_END } }
__device__ __forceinline__ uint4 pack8(const f32x4 a, const f32x4 b) { uint4 p; p.x = pack2(a[0], a[1]); p.y = pack2(a[2], a[3]); p.z = pack2(b[0], b[1]); p.w = pack2(b[2], b[3]); return p; }

struct EpiBf16Plain {
    bf16_t* O; int ldo;
    __device__ __forceinline__ void operator()(const f32x4 (&acc)[2][2][4][2], const Unit& u, int wr, int wc, int fr, int fq) const {
        EPI_ROWS_BEGIN
            uint4* p = (uint4*)(O + (size_t)row * ldo + u.pn * BM + 64 * wc + 16 * fq);
            p[0] = pack8(acc[ai][0][m][0], acc[ai][0][m][1]); p[1] = pack8(acc[ai][1][m][0], acc[ai][1][m][1]);
        EPI_ROWS_END
    }
};
struct EpiSwiglu {
    bf16_t* O; int ldo;
    __device__ __forceinline__ void operator()(const f32x4 (&acc)[2][2][4][2], const Unit& u, int wr, int wc, int fr, int fq) const {
        EPI_ROWS_BEGIN
            f32x4 h0, h1;
#pragma unroll
            for (int i = 0; i < 4; ++i) { h0[i] = silu_f(acc[ai][0][m][0][i]) * acc[ai][0][m][1][i]; h1[i] = silu_f(acc[ai][1][m][0][i]) * acc[ai][1][m][1][i]; }
            *(uint4*)(O + (size_t)row * ldo + u.pn * 128 + 32 * wc + 8 * fq) = pack8(h0, h1);
        EPI_ROWS_END
    }
};
struct EpiSwigluF8 {
    unsigned char* O; int ldo;
    __device__ __forceinline__ void operator()(const f32x4 (&acc)[2][2][4][2], const Unit& u, int wr, int wc, int fr, int fq) const {
        constexpr float inv = 1.f / F8_WSCALE;
        EPI_ROWS_BEGIN
            float h[8];
#pragma unroll
            for (int i = 0; i < 4; ++i) { h[i] = silu_f(acc[ai][0][m][0][i] * inv) * (acc[ai][0][m][1][i] * (inv * F8_HSCALE)); h[4 + i] = silu_f(acc[ai][1][m][0][i] * inv) * (acc[ai][1][m][1][i] * (inv * F8_HSCALE)); }
#pragma unroll
            for (int i = 0; i < 8; ++i) h[i] = __builtin_amdgcn_fmed3f(h[i], -448.f, 448.f);
            uint2 p; p.x = pack4_fp8(h[0], h[1], h[2], h[3]); p.y = pack4_fp8(h[4], h[5], h[6], h[7]);
            *(uint2*)(O + (size_t)row * ldo + u.pn * 128 + 32 * wc + 8 * fq) = p;
        EPI_ROWS_END
    }
};
struct EpiMoeOut {
    bf16_t* MOUT; const uint2* RIW; float oscale;
    __device__ __forceinline__ void operator()(const f32x4 (&acc)[2][2][4][2], const Unit& u, int wr, int wc, int fr, int fq) const {
        EPI_ROWS_BEGIN
            const uint2 iw = RIW[row]; const int info = (int)iw.x; const float gw = __uint_as_float(iw.y) * oscale;
            if (info >= 0) { uint4* p = (uint4*)(MOUT + ((size_t)(info & 1) * TL + (size_t)(info >> 1)) * 1024 + u.pn * BM + 64 * wc + 16 * fq);
                p[0] = pack8(acc[ai][0][m][0] * gw, acc[ai][0][m][1] * gw); p[1] = pack8(acc[ai][1][m][0] * gw, acc[ai][1][m][1] * gw); }
        EPI_ROWS_END
    }
};
struct EpiXtr {
    bf16_t* MOUT; const uint2* RIW; bf16_t* XTR; int NTF, S; float oscale;
    __device__ __forceinline__ void operator()(const f32x4 (&acc)[2][2][4][2], const Unit& u, int wr, int wc, int fr, int fq) const {
        const bool k0 = (u.ks == 0); const int stride = k0 ? 1024 : 256;
        bf16_t* base = (k0 ? MOUT + u.pn * BM : XTR + (size_t)(((u.pm - NTF) * 4 + u.pn) * (S - 1) + (u.ks - 1)) * 65536) + 64 * wc + 16 * fq;
        EPI_ROWS_BEGIN
            const uint2 iw = RIW[row]; const int info = (int)iw.x; const float gw = __uint_as_float(iw.y) * oscale;
            const int ridx = k0 ? ((info & 1) * TL + (info >> 1)) : (row & 255);
            if (info >= 0 || !k0) { uint4* p = (uint4*)(base + (size_t)ridx * stride); p[0] = pack8(acc[ai][0][m][0] * gw, acc[ai][0][m][1] * gw); p[1] = pack8(acc[ai][1][m][0] * gw, acc[ai][1][m][1] * gw); }
        EPI_ROWS_END
    }
};
struct EpiTailBf16 {
    bf16_t* O; int ldo; bf16_t* XT; int NTF, S;
    __device__ __forceinline__ void operator()(const f32x4 (&acc)[2][2][4][2], const Unit& u, int wr, int wc, int fr, int fq) const {
        const bool k0 = (u.ks == 0); const int stride = k0 ? ldo : 256;
        bf16_t* base = (k0 ? O + u.pn * BM : XT + (size_t)(((u.pm - NTF) * 4 + u.pn) * (S - 1) + (u.ks - 1)) * 65536) + 64 * wc + 16 * fq;
        EPI_ROWS_BEGIN
            uint4* p = (uint4*)(base + (size_t)(k0 ? row : (row & 255)) * stride);
            p[0] = pack8(acc[ai][0][m][0], acc[ai][0][m][1]); p[1] = pack8(acc[ai][1][m][0], acc[ai][1][m][1]);
        EPI_ROWS_END
    }
};
template <int S> struct DenseTailOrder {
    int NTF, nsub, nkt, G, c;
    __device__ __forceinline__ void init(int NTF_, int NTT, int nkt_full, int G_, int c_) { NTF = NTF_; nsub = NTT * 4 * S; int k = nkt_full / S; asm volatile("" : "+s"(k)); nkt = k; G = G_; c = c_; }
    __device__ __forceinline__ bool next(int i, Unit& u) const {
        const int L = i * G + c; if (L >= nsub) return false;
        const int tu = L / S, ks = L - tu * S; u.pm = NTF + (tu >> 2); u.pn = tu & 3; u.e = 0; u.nkt = nkt; u.kt0 = ks * nkt; u.ks = ks; return true;
    }
};
struct EpiQ {
    bf16_t* QM; const float* SQ; const float* cosT; const float* sinT; float qscale;
    __device__ __forceinline__ void operator()(const f32x4 (&acc)[2][2][4][2], const Unit& u, int wr, int wc, int fr, int fq) const {
        EPI_LOOP_BEGIN
            const float s = SQ[row] * qscale; f32x4 v0 = acc[ai][bj][m][0] * s, v1 = acc[ai][bj][m][1] * s;
            if ((cg % 96) == 64) { const int pos = row & (SEQ - 1); const f32x4 c = *(const f32x4*)(cosT + pos * 16 + 4 * fq), sn = *(const f32x4*)(sinT + pos * 16 + 4 * fq);
                const f32x4 o0 = v0 * c - v1 * sn, o1 = v1 * c + v0 * sn; v0 = o0; v1 = o1; }
            uint2 p; p.x = pack2(v0[0], v0[1]); p.y = pack2(v0[2], v0[3]); *(uint2*)(QM + (size_t)row * 768 + cg + 4 * fq) = p;
            p.x = pack2(v1[0], v1[1]); p.y = pack2(v1[2], v1[3]); *(uint2*)(QM + (size_t)row * 768 + cg + 16 + 4 * fq) = p;
        EPI_LOOP_END
    }
};
struct EpiK {
    bf16_t* KM; const float* SKV;
    __device__ __forceinline__ void operator()(const f32x4 (&acc)[2][2][4][2], const Unit& u, int wr, int wc, int fr, int fq) const {
        EPI_ROWS_BEGIN
            const float s = SKV[row]; const int b = row < TL ? (row >> 11) : ((row - TL) >> 8), key = row < TL ? CTXL + (row & (SEQ - 1)) : ((row - TL) & (CTXL - 1));
            const int c = u.pn * BM + 64 * wc + 16 * fq, h = c >> 6, d = c & 63;
            uint4* p = (uint4*)(KM + ((size_t)b * NKEY + key) * 768 + h * 96 + d);
            p[0] = pack8(acc[ai][0][m][0] * s, acc[ai][0][m][1] * s); p[1] = pack8(acc[ai][1][m][0] * s, acc[ai][1][m][1] * s);
        EPI_ROWS_END
    }
};
struct EpiVT {
    bf16_t* VT; const float* SKV;
    __device__ __forceinline__ void operator()(const f32x4 (&acc)[2][2][4][2], const Unit& u, int wr, int wc, int fr, int fq) const {
        EPI_LOOP_BEGIN
#pragma unroll
            for (int n = 0; n < 2; ++n) { const int tok = cg + 16 * n + 4 * fq; const f32x4 s = *(const f32x4*)(SKV + tok); const f32x4 v = acc[ai][bj][m][n] * s;
                const int b = tok < TL ? (tok >> 11) : ((tok - TL) >> 8), key = tok < TL ? CTXL + (tok & (SEQ - 1)) : ((tok - TL) & (CTXL - 1));
                uint2 p; p.x = pack2(v[0], v[1]); p.y = pack2(v[2], v[3]); *(uint2*)(VT + ((size_t)b * 512 + row) * NKEY + key) = p; }
        EPI_LOOP_END
    }
};
}


#define XB_TMO      128
#define XB_XCNT(j)  (256  + 64 * (j))
#define XB_XSUB(j)  (1280 + 64 * (j))
#define XB_XGEN(j)  (2304 + 64 * (j))
#define XB_TOP      3328
#define XB_TOPGEN   3392
#define XCD_BAR_WORDS 3456
#define XB_SPIN_CAP (1u << 18)
__device__ __forceinline__ unsigned xb_ld(unsigned* p)              { return __hip_atomic_load(p, __ATOMIC_RELAXED, __HIP_MEMORY_SCOPE_AGENT); }
__device__ __forceinline__ unsigned xb_add(unsigned* p, unsigned v) { return __hip_atomic_fetch_add(p, v, __ATOMIC_RELAXED, __HIP_MEMORY_SCOPE_AGENT); }
__device__ __forceinline__ unsigned xb_xcc_id() { return (unsigned)__builtin_amdgcn_s_getreg((3 << 11) | 20) & 0xFu; }
#define XB_SPIN(cond, bar) do { unsigned _sp = 0; while (cond) { __builtin_amdgcn_s_sleep(1); \
    if ((++_sp & 255u) == 0u) { if (xb_ld(&(bar)[XB_TMO])) break; if (_sp > XB_SPIN_CAP) { atomicAdd(&(bar)[XB_TMO], 1u); break; } } } } while (0)
struct XcdBarrier { unsigned* bar; unsigned x; volatile LAS unsigned* st; };
__device__ __forceinline__ XcdBarrier xcd_barrier_post(unsigned* bar, volatile LAS unsigned* st) {
    XcdBarrier b; b.bar = bar; b.x = xb_xcc_id(); b.st = st;
    if (threadIdx.x == 0) (void)xb_add(&bar[XB_XCNT(b.x)], 1u);
    return b;
}
__device__ __forceinline__ void xcd_barrier_complete(unsigned* bar, unsigned x, unsigned& nloc, unsigned& nx) {
    const unsigned G = gridDim.x * gridDim.y * gridDim.z;
    unsigned sum, cnt, mine, sp = 0u;
    for (;;) {
        sum = 0u; cnt = 0u; mine = 0u;
#pragma unroll
        for (unsigned j = 0; j < 16; ++j) { const unsigned c = xb_ld(&bar[XB_XCNT(j)]); sum += c; cnt += (c > 0u) ? 1u : 0u; mine = (j == x) ? c : mine; }
        if (sum == G) break;
        __builtin_amdgcn_s_sleep(1);
        if ((++sp & 255u) == 0u) { if (xb_ld(&bar[XB_TMO])) break; if (sp > XB_SPIN_CAP) { atomicAdd(&bar[XB_TMO], 1u); break; } }
    }
    nloc = mine > 0u ? mine : 1u; nx = cnt > 0u ? cnt : 1u;
}
__device__ __forceinline__ void xcd_barrier(const XcdBarrier& b) {
    asm volatile("s_waitcnt vmcnt(0)" ::: "memory");
    __syncthreads();
    if (threadIdx.x == 0) {
        unsigned* bar = b.bar;
        __builtin_amdgcn_s_waitcnt(0);
        unsigned nloc = b.st[0], nx = b.st[1];
        if (nloc == 0u) { xcd_barrier_complete(bar, b.x, nloc, nx); b.st[0] = nloc; b.st[1] = nx; }
        const unsigned old = xb_add(&bar[XB_XSUB(b.x)], 1u);
        const unsigned gen = old / nloc;
        if (old + 1u == (gen + 1u) * nloc) {
            __builtin_amdgcn_fence(__ATOMIC_RELEASE, "agent");
            asm volatile("s_waitcnt vmcnt(0)" ::: "memory");
            const unsigned og = xb_add(&bar[XB_TOP], 1u);
            const unsigned tg = og / nx;
            if (og + 1u == (tg + 1u) * nx) xb_add(&bar[XB_TOPGEN], 1u);
            else XB_SPIN(xb_ld(&bar[XB_TOPGEN]) == tg, bar);
            __builtin_amdgcn_fence(__ATOMIC_ACQUIRE, "agent");
            xb_add(&bar[XB_XGEN(b.x)], 1u);
            asm volatile("s_waitcnt vmcnt(0)" ::: "memory");
        } else {
            XB_SPIN(xb_ld(&bar[XB_XGEN(b.x)]) == gen, bar);
            __builtin_amdgcn_fence(__ATOMIC_ACQUIRE, "agent");
            asm volatile("s_waitcnt vmcnt(0)" ::: "memory");
        }
    }
    __syncthreads();
}
#define XB_OVERLAP_ARRIVE(b, gen) do { \
    asm volatile("s_waitcnt vmcnt(0)" ::: "memory"); \
    __syncthreads(); \
    if (threadIdx.x == 0) { \
        unsigned* bar_ = (b).bar; \
        __builtin_amdgcn_s_waitcnt(0); \
        unsigned nloc = (b).st[0], nx = (b).st[1]; \
        if (nloc == 0u) { xcd_barrier_complete(bar_, (b).x, nloc, nx); (b).st[0] = nloc; (b).st[1] = nx; } \
        const unsigned old = xb_add(&bar_[XB_XSUB((b).x)], 1u); \
        gen = old / nloc; \
        if (old + 1u == (gen + 1u) * nloc) { \
            __builtin_amdgcn_fence(__ATOMIC_RELEASE, "agent"); \
            asm volatile("s_waitcnt vmcnt(0)" ::: "memory"); \
            const unsigned og = xb_add(&bar_[XB_TOP], 1u); \
            const unsigned tg = og / nx; \
            xb_add(&bar_[XB_XGEN((b).x)], 1u); \
            if (og + 1u == (tg + 1u) * nx) xb_add(&bar_[XB_TOPGEN], 1u); \
        } \
    } } while (0)
#define XB_OVERLAP_WAIT(b, gen) do { \
    if (threadIdx.x == 0) { \
        unsigned* bar_ = (b).bar; \
        XB_SPIN(xb_ld(&bar_[XB_TOPGEN]) == gen, bar_); \
        __builtin_amdgcn_fence(__ATOMIC_ACQUIRE, "agent"); \
        asm volatile("s_waitcnt vmcnt(0)" ::: "memory"); \
    } \
    __syncthreads(); } while (0)

struct Args { const float* in[41]; float* out; unsigned char* ws; int ph_lo, ph_hi, ex, pad; };
enum { I_X = 0, I_C, I_CTX, I_CCTX, I_ADAW, I_ADAB, I_MIXPRE, I_MIXPOST, I_FFNPRE, I_FFNPOST, I_EVWIN, I_HYCW, I_HYCB, I_FW1, I_FB1, I_FW2, I_FB2, I_FW3, I_FREQ, I_HYBIAS,
       I_SCW, I_SCB, I_DTB, I_ALOG, I_SSMD, I_SSMNG, I_EVWOUT, I_FFNG, I_FFNU, I_FFND, I_ODWIN, I_QNG, I_QUP, I_KVNG, I_KVUP, I_SINK, I_ODWOUT, I_ROUTER, I_MOEG, I_MOEU, I_MOED };

struct Fr {
    const float* const* in; float* out; unsigned char* ws; unsigned char* lds; int tid, lane, wave, G, bid;
    template <class T> __device__ __forceinline__ T* w(size_t off) const { return (T*)(ws + off); }
};

__device__ __forceinline__ int colmap(int mode, int perm, int r, int nsrc, int& which) {
    which = 0;
    if (mode == 1) { const int tile = r >> 8, rho = r & 255, bj = rho >> 7, wc = (rho >> 5) & 3, n = (rho >> 4) & 1, fq = (rho >> 2) & 3, i = rho & 3; which = n; return 128 * tile + 32 * wc + 8 * fq + 4 * bj + i; }
    const int c = perm ? ((r & ~255) + pg8::perm256(r & 255)) : r;
    if (mode == 0) return c < nsrc ? c : -1;
    return (c >> 6) * 128 + (c & 63) + (mode == 3 ? 64 : 0);
}
__device__ __forceinline__ void cvt_job(const Fr& F, const float* srcA, const float* srcB, const float* kscale, bf16_t* dst, int nrows, int kdst, int ksrc, int ldsrc, int nsrc, int mode, int perm, int boff) {
    float* tile = (float*)F.lds;
    const int nrt = nrows / 256, ntiles = nrt * (kdst / 64);
    const int kk = F.tid >> 6, rq = F.tid & 63;
    float4 v[8];
#define CVT_LOAD(t) do { const int r0 = ((t) % nrt) * 256, k0 = ((t) / nrt) * 64; int which; const int col = colmap(mode, perm, r0 + rq * 4, nsrc, which); const float* src = which ? srcB : srcA; \
        _Pragma("unroll") for (int p = 0; p < 8; ++p) { const int k = k0 + p * 8 + kk; v[p] = make_float4(0.f, 0.f, 0.f, 0.f); \
            if (col >= 0 && k < ksrc) { v[p] = *(const float4*)(src + (size_t)k * ldsrc + col); if (kscale) { const float ks = kscale[k]; v[p].x *= ks; v[p].y *= ks; v[p].z *= ks; v[p].w *= ks; } } } } while (0)
    int t = (F.bid + F.G - (boff % F.G)) % F.G;
    if (t < ntiles) CVT_LOAD(t);
    while (t < ntiles) {
        const int r0 = (t % nrt) * 256, k0 = (t / nrt) * 64;
        __syncthreads();
#pragma unroll
        for (int p = 0; p < 8; ++p) *(float4*)(tile + (p * 8 + kk) * 260 + rq * 4) = v[p];
        const int tn = t + F.G;
        if (tn < ntiles) CVT_LOAD(tn);
        __syncthreads();
        { const int r2 = F.tid >> 1, kq = F.tid & 1; const float* tp = tile + (kq * 32) * 260 + r2; uint4* dp = (uint4*)(dst + (size_t)(r0 + r2) * kdst + k0 + kq * 32);
#pragma unroll
          for (int q = 0; q < 4; ++q) { uint4 o; o.x = pack2(tp[(8 * q + 0) * 260], tp[(8 * q + 1) * 260]); o.y = pack2(tp[(8 * q + 2) * 260], tp[(8 * q + 3) * 260]);
              o.z = pack2(tp[(8 * q + 4) * 260], tp[(8 * q + 5) * 260]); o.w = pack2(tp[(8 * q + 6) * 260], tp[(8 * q + 7) * 260]); dp[q] = o; } }
        t = tn;
    }
#undef CVT_LOAD
    __syncthreads();
}

constexpr int CVT_T_GU = 28 * 16, CVT_T_DN = 4 * 56, CVT_T_E = CVT_T_GU + CVT_T_DN, CVT_T_ALL = NEXP * CVT_T_E;
__device__ __forceinline__ int cvt_wmap(int w) { return w < NEXP * CVT_T_GU ? (w / CVT_T_GU) * CVT_T_E + w % CVT_T_GU : ((w - NEXP * CVT_T_GU) / CVT_T_DN) * CVT_T_E + CVT_T_GU + (w - NEXP * CVT_T_GU) % CVT_T_DN; }
template <bool WMAP> __device__ __forceinline__ void cvt_moe_range(const Fr& F, int g_begin, int g_end, int rank, int stride) {
    float* tile = (float*)F.lds;
    const int kk = F.tid >> 6, rq = F.tid & 63;
    float4 va[8], vb[8];
#define CVM_DECODE(g) const int _g = WMAP ? cvt_wmap(g) : (g); const int _e = _g / CVT_T_E, _r = _g % CVT_T_E; const bool _gu = _r < CVT_T_GU; const int _rr = _gu ? _r : _r - CVT_T_GU; \
        const int _nkt = _gu ? 16 : 56; const int k0 = (_rr % _nkt) * 64, r0 = (_rr / _nkt) * 256;     const int ldsrc = _gu ? DFE : 1024, kdst = _gu ? 1024 : DFE; \
        const float* srcA = _gu ? F.in[I_MOEG] + (size_t)_e * 1024 * DFE : F.in[I_MOED] + (size_t)_e * DFE * 1024; const float* srcB = F.in[I_MOEU] + (size_t)_e * 1024 * DFE; \
        unsigned char* dst = _gu ? F.w<unsigned char>(WM_GU) + (size_t)_e * 2 * DFE * 1024 * (MOE_FP8 ? 1 : 2) : F.w<unsigned char>(WM_DN) + (size_t)_e * 1024 * DFE * (MOE_FP8 ? 1 : 2);
#define CVM_LOAD(g, v) do { CVM_DECODE(g) (void)dst; (void)kdst; int which; const int col = colmap(_gu ? 1 : 0, 1, r0 + rq * 4, _gu ? DFE : 1024, which); const float* src = which ? srcB : srcA; \
        _Pragma("unroll") for (int p = 0; p < 8; ++p) { const int k = k0 + p * 8 + kk; v[p] = *(const float4*)(src + (size_t)k * ldsrc + col); } } while (0)
#define CVM_STEP(g, v) do { __syncthreads(); \
        _Pragma("unroll") for (int p = 0; p < 8; ++p) { float4 _t; _t.x = v[p].x; _t.y = v[p].y; _t.z = v[p].z; _t.w = v[p].w; *(float4*)(tile + (p * 8 + kk) * 260 + rq * 4) = _t; } \
        if ((g) + 2 * stride < g_end) CVM_LOAD((g) + 2 * stride, v); \
        __syncthreads(); \
        { CVM_DECODE(g) (void)srcA; (void)srcB; (void)ldsrc; const int r2 = F.tid >> 1, kq = F.tid & 1; const float* tp = tile + (kq * 32) * 260 + r2; \
          if (MOE_FP8) { uint4* dp = (uint4*)(dst + (size_t)(r0 + r2) * kdst + k0 + kq * 32); \
            _Pragma("unroll") for (int q = 0; q < 2; ++q) { uint4 o; \
              o.x = pack4_fp8(tp[(16 * q + 0) * 260] * F8_WSCALE, tp[(16 * q + 1) * 260] * F8_WSCALE, tp[(16 * q + 2) * 260] * F8_WSCALE, tp[(16 * q + 3) * 260] * F8_WSCALE); \
              o.y = pack4_fp8(tp[(16 * q + 4) * 260] * F8_WSCALE, tp[(16 * q + 5) * 260] * F8_WSCALE, tp[(16 * q + 6) * 260] * F8_WSCALE, tp[(16 * q + 7) * 260] * F8_WSCALE); \
              o.z = pack4_fp8(tp[(16 * q + 8) * 260] * F8_WSCALE, tp[(16 * q + 9) * 260] * F8_WSCALE, tp[(16 * q + 10) * 260] * F8_WSCALE, tp[(16 * q + 11) * 260] * F8_WSCALE); \
              o.w = pack4_fp8(tp[(16 * q + 12) * 260] * F8_WSCALE, tp[(16 * q + 13) * 260] * F8_WSCALE, tp[(16 * q + 14) * 260] * F8_WSCALE, tp[(16 * q + 15) * 260] * F8_WSCALE); dp[q] = o; } } \
          else { uint4* dp = (uint4*)(dst + ((size_t)(r0 + r2) * kdst + k0 + kq * 32) * 2); \
          _Pragma("unroll") for (int q = 0; q < 4; ++q) { uint4 o; o.x = pack2(tp[(8 * q + 0) * 260], tp[(8 * q + 1) * 260]); o.y = pack2(tp[(8 * q + 2) * 260], tp[(8 * q + 3) * 260]); \
              o.z = pack2(tp[(8 * q + 4) * 260], tp[(8 * q + 5) * 260]); o.w = pack2(tp[(8 * q + 6) * 260], tp[(8 * q + 7) * 260]); dp[q] = o; } } } } while (0)
    int g = g_begin + rank;
    if (g < g_end) CVM_LOAD(g, va);
    if (g + stride < g_end) CVM_LOAD(g + stride, vb);
    while (g < g_end) {
        CVM_STEP(g, va);
        g += stride; if (g >= g_end) break;
        CVM_STEP(g, vb);
        g += stride;
    }
#undef CVM_STEP
#undef CVM_LOAD
#undef CVM_DECODE
    __syncthreads();
}
constexpr int CVW_Q = 2, CVW_NWIN = 11;
__device__ __forceinline__ void cvt_window(const Fr& F, int win) {
    const int w0 = win * CVW_Q * F.G, w1 = w0 + CVW_Q * F.G;
    cvt_moe_range<true>(F, w0 < CVT_T_ALL ? w0 : CVT_T_ALL, w1 < CVT_T_ALL ? w1 : CVT_T_ALL, F.bid, F.G);
}

__device__ __forceinline__ void ph_ada(const Fr& F) {
    float* sc = (float*)F.lds;
    float* part = sc + 9 * 1024;
    for (int i = F.tid; i < 9 * 1024; i += NTHR) { const int r = i >> 10, k = i & 1023; const float v = r < 8 ? F.in[I_C][r * 1024 + k] : F.in[I_CCTX][k]; sc[i] = silu_f(v); }
    __syncthreads();
    float* MOD = F.w<float>(WS_MOD);
    for (int un = F.bid; un < 2 * 6144 / 64; un += F.G) {
        const int j = un * 64 + F.lane, l = j / 6144, jj = j % 6144; const float* wp = F.in[I_ADAW] + (size_t)l * 1024 * 6144 + (size_t)(F.wave * 128) * 6144 + jj;
        float acc[9];
#pragma unroll
        for (int r = 0; r < 9; ++r) acc[r] = 0.f;
#pragma unroll 16
        for (int k = 0; k < 128; ++k) { const float wv = wp[(size_t)k * 6144];
#pragma unroll
            for (int r = 0; r < 9; ++r) acc[r] += sc[r * 1024 + F.wave * 128 + k] * wv; }
#pragma unroll
        for (int r = 0; r < 9; ++r) part[(F.wave * 9 + r) * 64 + F.lane] = acc[r];
        __syncthreads();
        for (int o = F.tid; o < 9 * 64; o += NTHR) { const int r = o >> 6, cix = o & 63; float sum = 0.f;
#pragma unroll
            for (int w2 = 0; w2 < 8; ++w2) sum += part[(w2 * 9 + r) * 64 + cix];
            const int j2 = un * 64 + cix, l2 = j2 / 6144, jj2 = j2 % 6144; MOD[(size_t)(l2 * 9 + r) * 6144 + jj2] = sum + F.in[I_ADAB][l2 * 6144 + jj2]; }
        __syncthreads();
    }
}
__device__ __forceinline__ void ph_filters(const Fr& F) {
    constexpr int NPB = 12;
    float* w1s = (float*)F.lds;
    float* w2s = w1s + 33 * 64;
    float* zs = w2s + 64 * 64;
    float* h1 = zs + NPB * 36;
    float* h2 = h1 + NPB * 64;
    const float* w3 = F.in[I_FW3]; const float* fqv = F.in[I_FREQ]; const float* hb = F.in[I_HYBIAS];
    for (int i = F.tid; i < 33 * 64; i += NTHR) w1s[i] = F.in[I_FW1][i];
    for (int i = F.tid; i < 64 * 64; i += NTHR) w2s[i] = F.in[I_FW2][i];
    const int total = SEQ + CTXL; int np = 0; for (int it = F.bid; it < total && np < NPB; it += F.G) ++np;
    for (int i = F.tid; i < np * 33; i += NTHR) { const int pi = i / 33, zi = i % 33, item = F.bid + pi * F.G; const int n = item < SEQ ? SEQ : CTXL, pos = item < SEQ ? item : item - SEQ;
        const float fpos = (float)pos, t = fpos / (float)(n - 1), omega = (6.283185307179586f * fpos) / (float)n; float v;
        if (zi == 0) v = t; else { const int bi = (zi - 1) & 15; const float band = 1e-4f + (float)bi * ((15.f - 1e-4f) / 15.f); const float a = omega * band; v = (zi <= 16) ? cosf(a) : -sinf(a); }
        zs[pi * 36 + zi] = v; }
    __syncthreads();
    for (int i = F.tid; i < np * 64; i += NTHR) { const int pi = i >> 6, j = i & 63; float a = F.in[I_FB1][j]; for (int k = 0; k < 33; ++k) a += zs[pi * 36 + k] * w1s[k * 64 + j]; h1[i] = sinf(fqv[j] * a); }
    __syncthreads();
    for (int i = F.tid; i < np * 64; i += NTHR) { const int pi = i >> 6, j = i & 63; float a = F.in[I_FB2][j]; for (int k = 0; k < 64; ++k) a += h1[pi * 64 + k] * w2s[k * 64 + j]; h2[i] = sinf(fqv[j] * a); }
    __syncthreads();
#pragma unroll 1
    for (int oo = 0; oo < 2; ++oo) { const int o = F.tid + 512 * oo; float acc[NPB];
#pragma unroll
        for (int pi = 0; pi < NPB; ++pi) acc[pi] = 0.f;
        for (int k = 0; k < 64; ++k) { const float wv = w3[k * 1024 + o];
#pragma unroll
            for (int pi = 0; pi < NPB; ++pi) acc[pi] += h2[pi * 64 + k] * wv; }
        const int dir = o >> 9, c = o & 511; const float a0 = -3.0701134573253945f, b0 = -15.350567286626973f; const float delta = fabsf(a0 + (float)c * ((b0 - a0) / 511.f));
#pragma unroll
        for (int pi = 0; pi < NPB; ++pi) if (pi < np) { const int item = F.bid + pi * F.G; const int n = item < SEQ ? SEQ : CTXL, pos = item < SEQ ? item : item - SEQ; const float t = (float)pos / (float)(n - 1);
            bf16_t* Rd = (n == SEQ) ? F.w<bf16_t>(L0_FL) : F.w<bf16_t>(L0_FC); const int n2 = 2 * n; const float val = acc[pi] * expf(-t * delta);
            if (dir == 0) Rd[(size_t)c * n2 + (n - pos)] = f2bf(val + (pos == 0 ? hb[c] : 0.f)); else if (pos > 0) Rd[(size_t)c * n2 + (n + pos)] = f2bf(val); }
    }
    __syncthreads();
}
__device__ __forceinline__ void ph_rope_tables(const Fr& F) {
    float* cm = F.w<float>(WS_ROPEM); float* sm = cm + 2048 * 16; float* cgq = F.w<float>(WS_ROPEG); float* sg = cgq + 2048 * 32;
    for (int idx = F.bid * NTHR + F.tid; idx < 2048 * 16; idx += F.G * NTHR) { const int pos = idx >> 4, i = idx & 15; const float inv = powf(10000.f, -(float)(i & 7) / 8.f);
        const float p = (i < 8) ? (float)(pos >> 6) : (float)(pos & 63); const float ang = p * inv; cm[idx] = cosf(ang); sm[idx] = sinf(ang); }
    for (int idx = F.bid * NTHR + F.tid; idx < 2048 * 32; idx += F.G * NTHR) { const int pos = idx >> 5, i = idx & 31; const float inv = powf(10000.f, -(float)(i & 15) / 16.f);
        const float p = (i < 16) ? (float)(pos >> 6) : (float)(pos & 63); const float ang = p * inv; cgq[idx] = cosf(ang); sg[idx] = sinf(ang); }
}

__device__ __forceinline__ void store_bf16x4(bf16_t* p, float4 v) { uint2 q; q.x = pack2(v.x, v.y); q.y = pack2(v.z, v.w); *(uint2*)p = q; }
__device__ __forceinline__ float4 ld4(const float* p) { return *(const float4*)p; }
__device__ __forceinline__ float sumsq4(const float4 (&v)[4]) { float s = 0.f;
#pragma unroll
    for (int i = 0; i < 4; ++i) s += v[i].x * v[i].x + v[i].y * v[i].y + v[i].z * v[i].z + v[i].w * v[i].w;
    return s; }

struct RowSched { int b, k0, WPB, NW, gw, nlat, ntot;
    __device__ __forceinline__ void init(int G, int bid, int wave, int nrows) { NW = G * 8; gw = bid * 8 + wave; WPB = NW / 8; b = gw / WPB; k0 = gw % WPB;
        nlat = (SEQ - k0 + WPB - 1) / WPB; const int nctx = (nrows > TL && gw < TC) ? (TC - gw + NW - 1) / NW : 0; ntot = nlat + nctx; }
    __device__ __forceinline__ int row_at(int s) const { return s < nlat ? b * SEQ + k0 + WPB * s : TL + gw + NW * (s - nlat); }
};
__device__ __forceinline__ void ph_norm0(const Fr& F) {
    const float* g = F.in[I_MIXPRE]; const float* MOD = F.w<float>(WS_MOD); bf16_t* A = F.w<bf16_t>(WS_ABUF);
    RowSched RS; RS.init(F.G, F.bid, F.wave, TT);
    float4 gv[4], shv[4], scv[4]; int mr_cur = -1;
#pragma unroll
    for (int i = 0; i < 4; ++i) gv[i] = ld4(g + 4 * (F.lane + 64 * i));
    for (int si = 0; si < RS.ntot; si += 2) {
        const int row0 = RS.row_at(si); const bool has1 = si + 1 < RS.ntot; const int row1 = has1 ? RS.row_at(si + 1) : row0; const int r1 = row1;
        const float* s0 = row0 < TL ? F.in[I_X] + (size_t)row0 * 1024 : F.in[I_CTX] + (size_t)(row0 - TL) * 1024; const float* s1 = r1 < TL ? F.in[I_X] + (size_t)r1 * 1024 : F.in[I_CTX] + (size_t)(r1 - TL) * 1024;
        float4 v0[4], v1[4];
#pragma unroll
        for (int i = 0; i < 4; ++i) { v0[i] = ld4(s0 + 4 * (F.lane + 64 * i)); v1[i] = ld4(s1 + 4 * (F.lane + 64 * i)); }
        const float q0 = rsqrtf(wave_sum(sumsq4(v0)) * (1.f / 1024.f) + EPS), q1 = rsqrtf(wave_sum(sumsq4(v1)) * (1.f / 1024.f) + EPS);
#pragma unroll
        for (int rr = 0; rr < 2; ++rr) { if (rr && !has1) break; const int row = rr ? row1 : row0; const int mr = row < TL ? (row >> 11) : 8; const float r = rr ? q1 : q0;
            if (mr != mr_cur) { mr_cur = mr;
#pragma unroll
                for (int i = 0; i < 4; ++i) { const int c = 4 * (F.lane + 64 * i); shv[i] = ld4(MOD + (size_t)mr * 6144 + c); scv[i] = ld4(MOD + (size_t)mr * 6144 + 1024 + c); } }
#pragma unroll
            for (int i = 0; i < 4; ++i) { const int c = 4 * (F.lane + 64 * i); const float4 gg = gv[i], sh = shv[i], sc = scv[i]; const float4 v = rr ? v1[i] : v0[i];
                float4 o; o.x = v.x * r * gg.x * (1.f + sc.x) + sh.x; o.y = v.y * r * gg.y * (1.f + sc.y) + sh.y; o.z = v.z * r * gg.z * (1.f + sc.z) + sh.z; o.w = v.w * r * gg.w * (1.f + sc.w) + sh.w;
                store_bf16x4(A + (size_t)row * 1024 + c, o); } }
    }
}
template <int MODE, bool SRCF32, bool DSTF32>
__device__ __forceinline__ void ph_thin(const Fr& F, const float* msrc, int nrows, const float* hs_lat, const float* hs_ctx, float* hd_lat, float* hd_ctx,
                        const float* postg, const float* MODg, int gate_off, const float* preg, const float* MODn, int sh_off, int sc_off, bf16_t* adst, int xNTF = 0, int xS = 1, const bf16_t* xt2 = nullptr, int xS2 = 1) {
    float* rt = (float*)F.lds;
    int* cntL = (int*)(F.lds + 32768);
    int* blkBase = cntL + 8;
    int* selInfo = cntL + 16;
    if (MODE == 1) { for (int i = F.tid; i < 1024 * 8; i += NTHR) rt[(i & 7) * 1024 + (i >> 3)] = F.in[I_ROUTER][i]; if (F.tid < 8) cntL[F.tid] = 0; __syncthreads(); }
    int li = F.wave;
#define THIN_LOAD(row, m, h) do { \
        const float* hs = SRCF32 ? ((row) < TL ? hs_lat + (size_t)(row) * 1024 : hs_ctx + (size_t)((row) - TL) * 1024) : nullptr; const bf16_t* hbs = F.w<bf16_t>(WS_HB) + (size_t)(row) * 1024; \
        int tail0 = -1, tail1 = -1; \
        if (MODE == 2 && xS > 1) { const int2 sr = *(const int2*)(F.w<int>(WS_SROW) + (size_t)(row) * 2); const int r0 = __builtin_amdgcn_readfirstlane(sr.x), r1 = __builtin_amdgcn_readfirstlane(sr.y); \
            if ((r0 >> 8) >= xNTF) tail0 = r0 - xNTF * 256; if ((r1 >> 8) >= xNTF) tail1 = r1 - xNTF * 256; } \
        _Pragma("unroll") for (int i = 0; i < 4; ++i) { const int c = 4 * (F.lane + 64 * i); \
            if (SRCF32) h[i] = ld4(hs + c); else { const uint2 hv = *(const uint2*)(hbs + c); h[i].x = bflo(hv.x); h[i].y = bfhi(hv.x); h[i].z = bflo(hv.y); h[i].w = bfhi(hv.y); } \
            if (MODE == 2) { const bf16_t* mo = (const bf16_t*)msrc; const uint2 a = *(const uint2*)(mo + (size_t)(row) * 1024 + c), b = *(const uint2*)(mo + ((size_t)TL + (row)) * 1024 + c); \
                m[i].x = bflo(a.x) + bflo(b.x); m[i].y = bfhi(a.x) + bfhi(b.x); m[i].z = bflo(a.y) + bflo(b.y); m[i].w = bfhi(a.y) + bfhi(b.y); \
                if (tail0 >= 0) { const bf16_t* xp = F.w<bf16_t>(WS_XTR) + ((size_t)((tail0 >> 8) * 4 + i) * (xS - 1) * 256 + (tail0 & 255)) * 256 + (c & 255); \
                    for (int s2 = 0; s2 < xS - 1; ++s2) { const uint2 e = *(const uint2*)(xp + (size_t)s2 * 65536); m[i].x += bflo(e.x); m[i].y += bfhi(e.x); m[i].z += bflo(e.y); m[i].w += bfhi(e.y); } } \
                if (tail1 >= 0) { const bf16_t* xp = F.w<bf16_t>(WS_XTR) + ((size_t)((tail1 >> 8) * 4 + i) * (xS - 1) * 256 + (tail1 & 255)) * 256 + (c & 255); \
                    for (int s2 = 0; s2 < xS - 1; ++s2) { const uint2 e = *(const uint2*)(xp + (size_t)s2 * 65536); m[i].x += bflo(e.x); m[i].y += bfhi(e.x); m[i].z += bflo(e.y); m[i].w += bfhi(e.y); } } } \
            else { const uint2 a = *(const uint2*)((const bf16_t*)msrc + (size_t)(row) * 1024 + c); m[i].x = bflo(a.x); m[i].y = bfhi(a.x); m[i].z = bflo(a.y); m[i].w = bfhi(a.y); \
                if (MODE == 0 && xS2 > 1 && (row) >= TL) { \
                    const bf16_t* xp = xt2 + ((size_t)(((((row) - TL) >> 8) * 4 + i) * (xS2 - 1)) * 256 + ((row) & 255)) * 256 + (c & 255); \
                    for (int s2 = 0; s2 < xS2 - 1; ++s2) { const uint2 e = *(const uint2*)(xp + (size_t)s2 * 65536); m[i].x += bflo(e.x); m[i].y += bfhi(e.x); m[i].z += bflo(e.y); m[i].w += bfhi(e.y); } } } } } while (0)
    RowSched RS; RS.init(F.G, F.bid, F.wave, nrows); const int RPW = 16;
    li = F.wave * RPW;
    float4 m[4], h[4], mN[4], hN[4], pgv[4], ggv[4], gtv[4], shv[4], scv[4]; int mr_cur = -1;
#pragma unroll
    for (int i = 0; i < 4; ++i) { const int c = 4 * (F.lane + 64 * i); pgv[i] = ld4(postg + c); if (MODE != 2) ggv[i] = ld4(preg + c); }
    if (RS.ntot > 0) { const int rw = RS.row_at(0); THIN_LOAD(rw, m, h); }
    for (int si = 0; si < RS.ntot; ++si, ++li) {
        const int row = RS.row_at(si);
        if (si + 1 < RS.ntot) { const int rown = RS.row_at(si + 1); THIN_LOAD(rown, mN, hN); }
        const int mr = row < TL ? (row >> 11) : 8;
        if (mr != mr_cur) { mr_cur = mr;
#pragma unroll
            for (int i = 0; i < 4; ++i) { const int c = 4 * (F.lane + 64 * i); gtv[i] = ld4(MODg + (size_t)mr * 6144 + gate_off + c);
                if (MODE != 2) { shv[i] = ld4(MODn + (size_t)mr * 6144 + sh_off + c); scv[i] = ld4(MODn + (size_t)mr * 6144 + sc_off + c); } } }
        float* hd = DSTF32 ? hd_lat + (size_t)row * 1024 : nullptr;
        bf16_t* hb = F.w<bf16_t>(WS_HB) + (size_t)row * 1024;
        const float r = rsqrtf(wave_sum(sumsq4(m)) * (1.f / 1024.f) + EPS);
#pragma unroll
        for (int i = 0; i < 4; ++i) { const int c = 4 * (F.lane + 64 * i); const float4 pg = pgv[i], gt = gtv[i];
            h[i].x += gt.x * (m[i].x * r * pg.x); h[i].y += gt.y * (m[i].y * r * pg.y); h[i].z += gt.z * (m[i].z * r * pg.z); h[i].w += gt.w * (m[i].w * r * pg.w);
            if (DSTF32) *(float4*)(hd + c) = h[i]; else store_bf16x4(hb + c, h[i]); }
        if (MODE != 2) {
        const float r2 = rsqrtf(wave_sum(sumsq4(h)) * (1.f / 1024.f) + EPS);
        float lg[8];
#pragma unroll
        for (int e = 0; e < 8; ++e) lg[e] = 0.f;
#pragma unroll
        for (int i = 0; i < 4; ++i) { const int c = 4 * (F.lane + 64 * i); const float4 gg = ggv[i], sh = shv[i], sc = scv[i];
            float4 o; o.x = h[i].x * r2 * gg.x * (1.f + sc.x) + sh.x; o.y = h[i].y * r2 * gg.y * (1.f + sc.y) + sh.y; o.z = h[i].z * r2 * gg.z * (1.f + sc.z) + sh.z; o.w = h[i].w * r2 * gg.w * (1.f + sc.w) + sh.w;
            store_bf16x4(adst + (size_t)row * 1024 + c, o);
            if (MODE == 1) {
#pragma unroll
                for (int e = 0; e < 8; ++e) { const float4 rv = *(const float4*)(rt + e * 1024 + c); lg[e] += o.x * rv.x + o.y * rv.y + o.z * rv.z + o.w * rv.w; } } }
        if (MODE == 1) {
#pragma unroll
            for (int e = 0; e < 8; ++e) lg[e] = wave_sum(lg[e]);
            int i1 = 0; float v1 = lg[0];
#pragma unroll
            for (int e = 1; e < 8; ++e) if (lg[e] > v1) { v1 = lg[e]; i1 = e; }
            int i2 = -1; float v2 = -3.0e38f;
#pragma unroll
            for (int e = 0; e < 8; ++e) if (e != i1 && lg[e] > v2) { v2 = lg[e]; i2 = e; }
            const float w1 = 1.f / (1.f + expf(v2 - v1)), w2 = 1.f - w1;
            if (F.lane == 0) { float* tw = F.w<float>(WS_TOPW) + (size_t)row * 2; tw[0] = w1; tw[1] = w2;
                const int r1 = atomicAdd(&cntL[i1], 1), r2i = atomicAdd(&cntL[i2], 1);
                selInfo[li * 2 + 0] = i1 | (r1 << 8); selInfo[li * 2 + 1] = i2 | (r2i << 8); }
        }
        }
#pragma unroll
        for (int i = 0; i < 4; ++i) { m[i] = mN[i]; h[i] = hN[i]; }
    }
#undef THIN_LOAD
    if (MODE == 1) {
        __syncthreads();
        if (F.tid < 8) blkBase[F.tid] = (int)__hip_atomic_fetch_add(F.w<unsigned>(WS_CNT) + F.tid, (unsigned)cntL[F.tid], __ATOMIC_RELAXED, __HIP_MEMORY_SCOPE_AGENT);
        __syncthreads();
        int* LISTE = F.w<int>(WS_LISTE);
        for (int idx = F.tid; idx < 16 * RPW; idx += NTHR) { const int l2 = idx >> 1, k = idx & 1; RowSched R2; R2.init(F.G, F.bid, l2 / RPW, nrows); const int it2 = l2 % RPW; const int row = it2 < R2.ntot ? R2.row_at(it2) : nrows;
            if (row < nrows) { const int si = selInfo[idx], e = si & 255, rk = si >> 8; LISTE[(size_t)e * TL + blkBase[e] + rk] = row * 2 + k; } }
        __syncthreads();
    }
}
__device__ __forceinline__ void ph_moe_gather(const Fr& F) {
    const unsigned* cnt = F.w<unsigned>(WS_CNT); int ts[9]; ts[0] = 0;
#pragma unroll
    for (int e = 0; e < 8; ++e) ts[e + 1] = ts[e] + (int)((__hip_atomic_load(cnt + e, __ATOMIC_RELAXED, __HIP_MEMORY_SCOPE_AGENT) + 255u) >> 8);
    const int nrows = ts[8] * 256; const int* LISTE = F.w<int>(WS_LISTE); const float* TOPW = F.w<float>(WS_TOPW);
    const bf16_t* a2 = F.w<bf16_t>(L1_A2TMP); bf16_t* AG = F.w<bf16_t>(WS_AG); uint2* RIW = F.w<uint2>(WS_ROWINFO);
    const int RPW = (nrows + F.G * 8 - 1) / (F.G * 8), rbeg = (F.bid * 8 + F.wave) * RPW, rend = (rbeg + RPW < nrows) ? rbeg + RPW : nrows;
    int my_info = -1;
    { const int r = rbeg + F.lane;
      if (F.lane < RPW && r < rend) { const int j = r >> 8; int e = 0;
#pragma unroll
          for (int k = 1; k < 8; ++k) e += (j >= ts[k]) ? 1 : 0;
          int tse = ts[0];
#pragma unroll
          for (int k = 1; k < 8; ++k) tse = (e == k) ? ts[k] : tse;
          const int i = r - tse * 256; const int ce = (int)__hip_atomic_load(cnt + e, __ATOMIC_RELAXED, __HIP_MEMORY_SCOPE_AGENT); float w = 0.f;
          if (i < ce) { my_info = LISTE[(size_t)e * TL + i]; w = TOPW[my_info]; F.w<int>(WS_SROW)[my_info] = r; }
          RIW[r] = make_uint2((unsigned)my_info, __float_as_uint(w)); } }
    static_assert(MOE_FP8, "the gather below writes e4m3 rows");
    uint4 v0 = make_uint4(0u, 0u, 0u, 0u), v1 = v0, n0 = v0, n1 = v0;
    if (rbeg < rend) { const int info = __builtin_amdgcn_readlane(my_info, 0); if (info >= 0) { const uint4* src = (const uint4*)(a2 + (size_t)(info >> 1) * 1024 + F.lane * 16); v0 = src[0]; v1 = src[1]; } }
    for (int r = rbeg; r < rend; ++r) {
        n0 = make_uint4(0u, 0u, 0u, 0u); n1 = n0;
        if (r + 1 < rend) { const int info = __builtin_amdgcn_readlane(my_info, r + 1 - rbeg); if (info >= 0) { const uint4* src = (const uint4*)(a2 + (size_t)(info >> 1) * 1024 + F.lane * 16); n0 = src[0]; n1 = src[1]; } }
        uint4 o; o.x = pack4_fp8(bflo(v0.x), bfhi(v0.x), bflo(v0.y), bfhi(v0.y)); o.y = pack4_fp8(bflo(v0.z), bfhi(v0.z), bflo(v0.w), bfhi(v0.w));
        o.z = pack4_fp8(bflo(v1.x), bfhi(v1.x), bflo(v1.y), bfhi(v1.y)); o.w = pack4_fp8(bflo(v1.z), bfhi(v1.z), bflo(v1.w), bfhi(v1.w));
        *(uint4*)((unsigned char*)AG + (size_t)r * 1024 + F.lane * 16) = o;
        v0 = n0; v1 = n1;
    }
}
__device__ __forceinline__ void ld8bf(const bf16_t* p, float (&o)[8]) { const uint4 q = *(const uint4*)p; o[0] = bflo(q.x); o[1] = bfhi(q.x); o[2] = bflo(q.y); o[3] = bfhi(q.y); o[4] = bflo(q.z); o[5] = bfhi(q.z); o[6] = bflo(q.w); o[7] = bfhi(q.w); }
__device__ __forceinline__ void st8bf(bf16_t* p, const float (&v)[8]) { uint4 q; q.x = pack2(v[0], v[1]); q.y = pack2(v[2], v[3]); q.z = pack2(v[4], v[5]); q.w = pack2(v[6], v[7]); *(uint4*)p = q; }
struct CW { float w0[8], w1[8], w2[8], bb[8]; };
__device__ __forceinline__ void cw_load(CW& c, const float* w, const float* b, int wc, int wld) {
    const float4 a0 = ld4(w + wc), a1 = ld4(w + wc + 4), b0 = ld4(w + wld + wc), b1 = ld4(w + wld + wc + 4), c0 = ld4(w + 2 * wld + wc), c1 = ld4(w + 2 * wld + wc + 4), d0 = ld4(b + wc), d1 = ld4(b + wc + 4);
    c.w0[0] = a0.x; c.w0[1] = a0.y; c.w0[2] = a0.z; c.w0[3] = a0.w; c.w0[4] = a1.x; c.w0[5] = a1.y; c.w0[6] = a1.z; c.w0[7] = a1.w;
    c.w1[0] = b0.x; c.w1[1] = b0.y; c.w1[2] = b0.z; c.w1[3] = b0.w; c.w1[4] = b1.x; c.w1[5] = b1.y; c.w1[6] = b1.z; c.w1[7] = b1.w;
    c.w2[0] = c0.x; c.w2[1] = c0.y; c.w2[2] = c0.z; c.w2[3] = c0.w; c.w2[4] = c1.x; c.w2[5] = c1.y; c.w2[6] = c1.z; c.w2[7] = c1.w;
    c.bb[0] = d0.x; c.bb[1] = d0.y; c.bb[2] = d0.z; c.bb[3] = d0.w; c.bb[4] = d1.x; c.bb[5] = d1.y; c.bb[6] = d1.z; c.bb[7] = d1.w;
}
__device__ __forceinline__ void conv8(const bf16_t* prow, bool hasp, bool hasn, int pc, const CW& c, float (&o)[8]) {
    float xm[8], x0[8], xp[8]; ld8bf(prow + pc, x0);
    if (hasp) ld8bf(prow - EVEN_PAD + pc, xm); else {
#pragma unroll
        for (int j = 0; j < 8; ++j) xm[j] = 0.f; }
    if (hasn) ld8bf(prow + EVEN_PAD + pc, xp); else {
#pragma unroll
        for (int j = 0; j < 8; ++j) xp[j] = 0.f; }
#pragma unroll
    for (int j = 0; j < 8; ++j) o[j] = c.w0[j] * xm[j] + c.w1[j] * x0[j] + c.w2[j] * xp[j] + c.bb[j];
}
__device__ __forceinline__ void ph_convpass(const Fr& F) {
    const bf16_t* PROJ = F.w<bf16_t>(L0_PROJ); bf16_t* U = F.w<bf16_t>(L0_U); bf16_t* X0 = F.w<bf16_t>(L0_X0); bf16_t* XBC = F.w<bf16_t>(L0_XBC); float* DT = F.w<float>(L0_DT);
    const float* hw = F.in[I_HYCW]; const float* hb = F.in[I_HYCB]; const float* sw = F.in[I_SCW]; const float* sb = F.in[I_SCB]; const float* dtb = F.in[I_DTB];
    {
        const int c = F.lane * 8; CW cx0, cb0, cb1; cw_load(cx0, hw, hb, c, 1536); cw_load(cb0, sw, sb, c, 1024); cw_load(cb1, sw, sb, c + 512, 1024);
        const float dtbv = F.lane < 16 ? dtb[F.lane] : 0.f;
        for (int row = F.bid * 8 + F.wave; row < TT; row += F.G * 8) {
            const int t = row < TL ? (row & (SEQ - 1)) : ((row - TL) & (CTXL - 1)), n = row < TL ? SEQ : CTXL; const bool hasp = t > 0, hasn = t < n - 1;
            const bf16_t* prow = PROJ + (size_t)row * EVEN_PAD;
            float a0[8];
            conv8(prow, hasp, hasn, c, cx0, a0);
            st8bf(X0 + (size_t)row * 512 + c, a0);
            conv8(prow, hasp, hasn, 2048 + c, cb0, a0);
#pragma unroll
            for (int j = 0; j < 8; ++j) a0[j] = silu_f(a0[j]);
            st8bf(XBC + (size_t)row * 1024 + c, a0);
            conv8(prow, hasp, hasn, 2048 + 512 + c, cb1, a0);
#pragma unroll
            for (int j = 0; j < 8; ++j) a0[j] = silu_f(a0[j]);
            st8bf(XBC + (size_t)row * 1024 + 512 + c, a0);
            if (F.lane < 16) DT[(size_t)row * 16 + F.lane] = softplus_f(bf2f(prow[3072 + F.lane]) + dtbv);
        }
    }
    bf16_t* ut = (bf16_t*)F.lds;
    {   const int tok = F.tid >> 3, cq = F.tid & 7; const int cgp = F.bid & 3;
        CW c1a, c1b, cva, cvb; { const int ch = cgp * 128 + cq * 16; cw_load(c1a, hw, hb, 512 + ch, 1536); cw_load(c1b, hw, hb, 512 + ch + 8, 1536); cw_load(cva, hw, hb, 1024 + ch, 1536); cw_load(cvb, hw, hb, 1024 + ch + 8, 1536); }
        for (int un = F.bid; un < (TT / 64) * 4; un += F.G) {
            const int tile = un >> 2, row0 = tile * 64; const int row = row0 + tok;
            const int t = row < TL ? (row & (SEQ - 1)) : ((row - TL) & (CTXL - 1)), n = row < TL ? SEQ : CTXL; const bool hasp = t > 0, hasn = t < n - 1;
            const bf16_t* prow = PROJ + (size_t)row * EVEN_PAD; const int ch = cgp * 128 + cq * 16;
            { float a1[8], a2[8]; conv8(prow, hasp, hasn, 512 + ch, c1a, a1); conv8(prow, hasp, hasn, 1024 + ch, cva, a2);
#pragma unroll
              for (int j = 0; j < 8; ++j) ut[(cq * 16 + j) * 66 + tok] = f2bf(a1[j] * a2[j]);
              conv8(prow, hasp, hasn, 512 + ch + 8, c1b, a1); conv8(prow, hasp, hasn, 1024 + ch + 8, cvb, a2);
#pragma unroll
              for (int j = 0; j < 8; ++j) ut[(cq * 16 + 8 + j) * 66 + tok] = f2bf(a1[j] * a2[j]); }
            __syncthreads();
            { const int ch2 = F.tid >> 2, part = F.tid & 3; const int b = row0 < TL ? (row0 >> 11) : ((row0 - TL) >> 8), off = row0 < TL ? CTXL + (row0 & (SEQ - 1)) : ((row0 - TL) & (CTXL - 1));
              const unsigned* src = (const unsigned*)(ut + ch2 * 66 + part * 16); uint4 v0, v1; v0.x = src[0]; v0.y = src[1]; v0.z = src[2]; v0.w = src[3]; v1.x = src[4]; v1.y = src[5]; v1.z = src[6]; v1.w = src[7];
              uint4* dst = (uint4*)(U + ((size_t)(cgp * 128 + ch2) * 8 + b) * NKEY + off + part * 16); dst[0] = v0; dst[1] = v1; }
            __syncthreads();
        }
    }
}

__device__ __forceinline__ unsigned alignhalf(unsigned hi, unsigned lo) { return (lo >> 16) | (hi << 16); }
template <int RHO> __device__ __forceinline__ uint4 shift_copy(const uint4 prev, const uint4 cur) {
    const unsigned cc[8] = {prev.x, prev.y, prev.z, prev.w, cur.x, cur.y, cur.z, cur.w};
    constexpr int o = 16 - 2 * RHO, d0 = o / 4; uint4 r;
    if constexpr ((o & 3) == 0) { r.x = cc[d0]; r.y = cc[d0 + 1]; r.z = cc[d0 + 2]; r.w = cc[d0 + 3]; }
    else { r.x = alignhalf(cc[d0 + 1], cc[d0]); r.y = alignhalf(cc[d0 + 2], cc[d0 + 1]); r.z = alignhalf(cc[d0 + 3], cc[d0 + 2]); r.w = alignhalf(cc[d0 + 4], cc[d0 + 3]); }
    return r;
}
__device__ __forceinline__ void build_copies(unsigned char* cp, int cs, const bf16_t* R, int nch, int i) {
    if (i < nch) { const uint4 cur = *(const uint4*)(R + 8 * i); const uint4 prev = i > 0 ? *(const uint4*)(R + 8 * i - 8) : make_uint4(0u, 0u, 0u, 0u);
        *(uint4*)(cp + 0 * cs + i * 16) = cur;
        *(uint4*)(cp + 1 * cs + i * 16) = shift_copy<1>(prev, cur); *(uint4*)(cp + 2 * cs + i * 16) = shift_copy<2>(prev, cur); *(uint4*)(cp + 3 * cs + i * 16) = shift_copy<3>(prev, cur);
        *(uint4*)(cp + 4 * cs + i * 16) = shift_copy<4>(prev, cur); *(uint4*)(cp + 5 * cs + i * 16) = shift_copy<5>(prev, cur); *(uint4*)(cp + 6 * cs + i * 16) = shift_copy<6>(prev, cur);
        *(uint4*)(cp + 7 * cs + i * 16) = shift_copy<7>(prev, cur); }
}
__device__ __forceinline__ void ph_hyena_mfma(const Fr& F) {
    const bf16_t* U = F.w<bf16_t>(L0_U); bf16_t* YT = F.w<bf16_t>(L0_YT);
    const int w = F.wave, rr = F.lane & 15, g = F.lane >> 4;
    {   constexpr int CS = 8224, US = 4128;
        unsigned char* Cp = F.lds; unsigned char* Ub = F.lds + 8 * CS;
        const int p = w & 1, q = w >> 1;
        for (int c = F.bid; c < 512; c += F.G) {
            __syncthreads();
            build_copies(Cp, CS, F.w<bf16_t>(L0_FL) + (size_t)c * 4096, 512, F.tid);
#pragma unroll
            for (int k = 0; k < 4; ++k) { const int id = F.tid + 512 * k, b = id >> 8, ch = id & 255; *(uint4*)(Ub + b * US + ch * 16) = *(const uint4*)(U + ((size_t)c * 8 + b) * NKEY + CTXL + ch * 8); }
            __syncthreads();
            const unsigned char* abase = Cp + (rr & 7) * CS + (2048 - 16 * (32 * q + p) - 8 * (rr >> 3) + 8 * g) * 2;
            const unsigned char* ubase = Ub + (rr & 7) * US + 16 * g;
            f32x4 acc[16]; bf16x8 af[16];
#pragma unroll
            for (int i = 0; i < 16; ++i) { acc[i] = (f32x4){0.f, 0.f, 0.f, 0.f}; af[i] = *(const bf16x8*)(abase - 64 * i); }
            for (int jj = 0; jj < 4; ++jj) {
#pragma unroll
                for (int js = 0; js < 16; ++js) { const int J = 16 * jj + js;
                    af[(16 - js) & 15] = *(const bf16x8*)(abase + 64 * J);
                    const bf16x8 bfr = *(const bf16x8*)(ubase + 64 * J);
#pragma unroll
                    for (int i = 0; i < 16; ++i) acc[i] = __builtin_amdgcn_mfma_f32_16x16x32_bf16(af[(i - js) & 15], bfr, acc[i], 0, 0, 0);
                }
            }
            if (rr < 8) {
#pragma unroll
                for (int i = 0; i < 16; ++i) { const int t = 16 * (32 * q + p + 2 * i) + 4 * g; uint2 pk; pk.x = pack2(acc[i][0], acc[i][1]); pk.y = pack2(acc[i][2], acc[i][3]);
                    *(uint2*)(YT + ((size_t)c * 8 + rr) * NKEY + CTXL + t) = pk; }
            }
        }
    }
    {   constexpr int CS = 1056, US = 544;
        unsigned char* Cp = F.lds; unsigned char* Ub = F.lds + 8 * CS;
        for (int c = F.bid; c < 512; c += F.G) {
            __syncthreads();
            build_copies(Cp, CS, F.w<bf16_t>(L0_FC) + (size_t)c * 512, 64, F.tid);
            if (F.tid < 256) { const int b = F.tid >> 5, ch = F.tid & 31; *(uint4*)(Ub + b * US + ch * 16) = *(const uint4*)(U + ((size_t)c * 8 + b) * NKEY + ch * 8); }
            __syncthreads();
            f32x4 acc[2];
#pragma unroll
            for (int ii = 0; ii < 2; ++ii) acc[ii] = (f32x4){0.f, 0.f, 0.f, 0.f};
#pragma unroll
            for (int J = 0; J < 8; ++J) { const bf16x8 bfr = *(const bf16x8*)(Ub + (rr & 7) * US + 16 * g + 64 * J);
#pragma unroll
                for (int ii = 0; ii < 2; ++ii) { const int d = 2 * w + ii - 2 * J; const bf16x8 a = *(const bf16x8*)(Cp + (rr & 7) * CS + (256 - 16 * d - 8 * (rr >> 3) + 8 * g) * 2);
                    acc[ii] = __builtin_amdgcn_mfma_f32_16x16x32_bf16(a, bfr, acc[ii], 0, 0, 0); } }
            if (rr < 8) {
#pragma unroll
                for (int ii = 0; ii < 2; ++ii) { const int t = 16 * (2 * w + ii) + 4 * g; uint2 pk; pk.x = pack2(acc[ii][0], acc[ii][1]); pk.y = pack2(acc[ii][2], acc[ii][3]);
                    *(uint2*)(YT + ((size_t)c * 8 + rr) * NKEY + t) = pk; }
            }
        }
    }
    __syncthreads();
}
__device__ __forceinline__ void ph_hyena_post(const Fr& F) {
    const bf16_t* YT = F.w<bf16_t>(L0_YT); const bf16_t* X0 = F.w<bf16_t>(L0_X0); bf16_t* A = F.w<bf16_t>(WS_ABUF);
    bf16_t* yt = (bf16_t*)F.lds;
    for (int un = F.bid; un < (TT / 64) * 4; un += F.G) {
        const int tile = un >> 2, cgp = un & 3, row0 = tile * 64;
        { const int ch = F.tid >> 2, part = F.tid & 3; const int b = row0 < TL ? (row0 >> 11) : ((row0 - TL) >> 8), off = row0 < TL ? CTXL + (row0 & (SEQ - 1)) : ((row0 - TL) & (CTXL - 1));
          const uint4* src = (const uint4*)(YT + ((size_t)(cgp * 128 + ch) * 8 + b) * NKEY + off + part * 16); const uint4 v0 = src[0], v1 = src[1];
          unsigned* dst = (unsigned*)(yt + ch * 66 + part * 16); dst[0] = v0.x; dst[1] = v0.y; dst[2] = v0.z; dst[3] = v0.w; dst[4] = v1.x; dst[5] = v1.y; dst[6] = v1.z; dst[7] = v1.w; }
        __syncthreads();
        { const int tok = F.tid >> 3, cq = F.tid & 7, row = row0 + tok;
#pragma unroll
          for (int hf = 0; hf < 2; ++hf) { const int ch = cgp * 128 + cq * 16 + hf * 8; float x0[8], o[8]; ld8bf(X0 + (size_t)row * 512 + ch, x0);
#pragma unroll
              for (int j = 0; j < 8; ++j) o[j] = x0[j] * bf2f(yt[(cq * 16 + hf * 8 + j) * 66 + tok]);
              st8bf(A + (size_t)row * 1024 + ch, o); } }
        __syncthreads();
    }
}

__device__ __forceinline__ int ssd_rowbase(int b, int cpos) { return cpos < 2 ? TL + b * CTXL + cpos * 128 : b * SEQ + (cpos - 2) * 128; }
typedef short s16x4 __attribute__((ext_vector_type(4)));
__device__ __forceinline__ s16x4 tr_read16(const unsigned char* img, int P, int row0, int col0, int lane) {
    const int q4 = (lane & 15) >> 2, p4 = lane & 3;
    return __builtin_amdgcn_ds_read_tr16_b64_v4i16((LAS s16x4*)(LAS unsigned char*)(img + (row0 + q4) * P + (col0 + 4 * p4) * 2));
}
__device__ __forceinline__ bf16x8 tr_pair(const unsigned char* img, int P, int rowa, int rowb, int col0, int lane) {
    union { bf16x8 v; s16x4 h[2]; } u; u.h[0] = tr_read16(img, P, rowa, col0, lane); u.h[1] = tr_read16(img, P, rowb, col0, lane); return u.v;
}
__device__ __forceinline__ void ph_ssd_a(const Fr& F) {
    constexpr int PT = 272, PX = 144;
    unsigned char* XD = F.lds;
    unsigned char* Bn = XD + 128 * PX;
    unsigned char* Bd = Bn + 128 * PT;
    unsigned char* Cn = Bd + 128 * PT;
    float* acs = (float*)(Cn + 128 * PT);
    float* dts = acs + 128;
    const bf16_t* XBC = F.w<bf16_t>(L0_XBC); const float* DT = F.w<float>(L0_DT);
    const int w = F.wave, cl = F.lane & 15, g = F.lane >> 4;
    for (int u = F.bid; u < NB * 18 * 16; u += F.G) {
        const int b = u / 288, rem = u % 288, cpos = rem >> 4, h = (rem >> 1) & 7, dir = rem & 1, grp = h >> 2;
        const int rowbase = ssd_rowbase(b, cpos), su = ((b * 2 + dir) * 8 + h) * 18 + cpos;
        const float Aneg = -expf(F.in[I_ALOG][dir * 8 + h]);
        __syncthreads();
        if (w == 0) { const int q0 = 2 * F.lane, p0 = dir ? 127 - q0 : q0, p1 = dir ? 126 - q0 : q0 + 1;
            const float d0 = DT[(size_t)(rowbase + p0) * 16 + dir * 8 + h], d1 = DT[(size_t)(rowbase + p1) * 16 + dir * 8 + h]; const float a0 = d0 * Aneg, a1 = d1 * Aneg;
            float sc = a0 + a1;
#pragma unroll
            for (int o = 1; o < 64; o <<= 1) { const float t = __shfl_up(sc, o); if (F.lane >= o) sc += t; }
            const float ex = sc - (a0 + a1); acs[q0] = ex + a0; acs[q0 + 1] = ex + a0 + a1; dts[q0] = d0; dts[q0 + 1] = d1;
            float* ACS = F.w<float>(L0_ACS) + (size_t)su * 128; ACS[p0] = ex + a0; ACS[p1] = ex + a0 + a1;
            if (F.lane == 63) F.w<float>(L0_ATOT)[su] = ex + a0 + a1; }
        __syncthreads();
        const float atot = acs[127];
#pragma unroll
        for (int k = 0; k < 2; ++k) { const int id = F.tid + 512 * k, q = id >> 3, pc = id & 7, pos = dir ? 127 - q : q; float v[8]; ld8bf(XBC + (size_t)(rowbase + pos) * 1024 + h * 64 + pc * 8, v); const float dv = dts[q];
            uint4 o; o.x = pack2(v[0] * dv, v[1] * dv); o.y = pack2(v[2] * dv, v[3] * dv); o.z = pack2(v[4] * dv, v[5] * dv); o.w = pack2(v[6] * dv, v[7] * dv);
            *(uint4*)(XD + q * PX + pc * 16) = o; }
#pragma unroll
        for (int k = 0; k < 4; ++k) { const int id = F.tid + 512 * k, q = id >> 4, nc = id & 15, pos = dir ? 127 - q : q; const bf16_t* src = XBC + (size_t)(rowbase + pos) * 1024 + 512 + grp * 128 + nc * 8;
            const uint4 bv = *(const uint4*)src, cv = *(const uint4*)(src + 256);
            *(uint4*)(Bn + q * PT + nc * 16) = bv; *(uint4*)(Cn + q * PT + nc * 16) = cv;
            const float dec = __expf(atot - acs[q]); uint4 o;
            o.x = pack2(bflo(bv.x) * dec, bfhi(bv.x) * dec); o.y = pack2(bflo(bv.y) * dec, bfhi(bv.y) * dec); o.z = pack2(bflo(bv.z) * dec, bfhi(bv.z) * dec); o.w = pack2(bflo(bv.w) * dec, bfhi(bv.w) * dec);
            *(uint4*)(Bd + q * PT + nc * 16) = o; }
        __syncthreads();
        const int q = 16 * w + cl; const float aq = acs[q];
        bf16x8 cf[4];
#pragma unroll
        for (int ks = 0; ks < 4; ++ks) cf[ks] = *(const bf16x8*)(Cn + q * PT + (32 * ks + 8 * g) * 2);
        unsigned pk[8][2];
#pragma unroll
        for (int sb = 0; sb < 8; ++sb) { pk[sb][0] = 0u; pk[sb][1] = 0u;
            if (sb <= w) { f32x4 gacc = (f32x4){0.f, 0.f, 0.f, 0.f};
#pragma unroll
                for (int ks = 0; ks < 4; ++ks) { const bf16x8 bf = *(const bf16x8*)(Bn + (16 * sb + cl) * PT + (32 * ks + 8 * g) * 2); gacc = __builtin_amdgcn_mfma_f32_16x16x32_bf16(bf, cf[ks], gacc, 0, 0, 0); }
                const f32x4 as = *(const f32x4*)(acs + 16 * sb + 4 * g); float sv[4];
#pragma unroll
                for (int e = 0; e < 4; ++e) { const int sI = 16 * sb + 4 * g + e; sv[e] = (sI <= q) ? gacc[e] * __expf(aq - as[e]) : 0.f; }
                pk[sb][0] = pack2(sv[0], sv[1]); pk[sb][1] = pack2(sv[2], sv[3]); } }
        f32x4 yacc[4];
#pragma unroll
        for (int pb = 0; pb < 4; ++pb) yacc[pb] = (f32x4){0.f, 0.f, 0.f, 0.f};
#pragma unroll
        for (int k2 = 0; k2 < 4; ++k2) if (2 * k2 <= w) {
            union { bf16x8 v; unsigned wd[4]; } pf; pf.wd[0] = pk[2 * k2][0]; pf.wd[1] = pk[2 * k2][1]; pf.wd[2] = pk[2 * k2 + 1][0]; pf.wd[3] = pk[2 * k2 + 1][1];
#pragma unroll
            for (int pb = 0; pb < 4; ++pb) { const bf16x8 xa = tr_pair(XD, PX, 32 * k2 + 4 * g, 32 * k2 + 16 + 4 * g, 16 * pb, F.lane);
                yacc[pb] = __builtin_amdgcn_mfma_f32_16x16x32_bf16(xa, pf.v, yacc[pb], 0, 0, 0); } }
        { bf16_t* Y = (dir ? F.w<bf16_t>(L0_YB) : F.w<bf16_t>(L0_YF)) + (size_t)(rowbase + (dir ? 127 - q : q)) * 512 + h * 64 + 4 * g;
#pragma unroll
          for (int pb = 0; pb < 4; ++pb) { uint2 o; o.x = pack2(yacc[pb][0], yacc[pb][1]); o.y = pack2(yacc[pb][2], yacc[pb][3]); *(uint2*)(Y + 16 * pb) = o; } }
        { float* ST = F.w<float>(L0_ST) + (size_t)su * 8192;
          bf16x8 af[4];
#pragma unroll
          for (int ks = 0; ks < 4; ++ks) af[ks] = tr_pair(Bd, PT, 32 * ks + 8 * g, 32 * ks + 8 * g + 4, 16 * w, F.lane);
#pragma unroll
          for (int pb = 0; pb < 4; ++pb) { f32x4 sacc = (f32x4){0.f, 0.f, 0.f, 0.f};
#pragma unroll
              for (int ks = 0; ks < 4; ++ks) { const bf16x8 xb = tr_pair(XD, PX, 32 * ks + 8 * g, 32 * ks + 8 * g + 4, 16 * pb, F.lane); sacc = __builtin_amdgcn_mfma_f32_16x16x32_bf16(af[ks], xb, sacc, 0, 0, 0); }
              *(f32x4*)(ST + (size_t)(16 * pb + cl) * 128 + 16 * w + 4 * g) = sacc; } }
    }
    __syncthreads();
}
__device__ __forceinline__ void ph_ssd_b(const Fr& F) {
    const float* ST = F.w<float>(L0_ST); const float* ATOT = F.w<float>(L0_ATOT); bf16_t* STIN = F.w<bf16_t>(L0_STIN);
    for (int idx = F.bid * NTHR + F.tid; idx < 128 * 2048; idx += F.G * NTHR) {
        const int chain = idx >> 11, e4 = idx & 2047, dir = (chain >> 3) & 1;
        f32x4 run = (f32x4){0.f, 0.f, 0.f, 0.f};
        for (int k = 0; k < 18; ++k) { const int cpos = dir ? (k < 2 ? 1 - k : 19 - k) : k; const size_t su = (size_t)chain * 18 + cpos;
            uint2 o; o.x = pack2(run[0], run[1]); o.y = pack2(run[2], run[3]); *(uint2*)(STIN + su * 8192 + e4 * 4) = o;
            const f32x4 st = *(const f32x4*)(ST + su * 8192 + e4 * 4); const float dc = __expf(ATOT[su]); run = run * dc + st; }
    }
}
__device__ __forceinline__ void ph_ssd_c(const Fr& F) {
    constexpr int PT = 272;
    unsigned char* Cn = F.lds;
    unsigned char* Sin = Cn + 64 * PT;
    float* ssx = (float*)(Sin + 4 * 64 * PT);
    const bf16_t* XBC = F.w<bf16_t>(L0_XBC); const bf16_t* PROJ = F.w<bf16_t>(L0_PROJ); const bf16_t* STIN = F.w<bf16_t>(L0_STIN); const float* ACS = F.w<float>(L0_ACS);
    const bf16_t* YF = F.w<bf16_t>(L0_YF); const bf16_t* YB = F.w<bf16_t>(L0_YB); bf16_t* A = F.w<bf16_t>(WS_ABUF);
    const float* dsk = F.in[I_SSMD]; const float* ng = F.in[I_SSMNG];
    const int w = F.wave, pw = w & 3, hp = w >> 2;
    for (int u = F.bid; u < NB * 18 * 4; u += F.G) {
        int tz = threadIdx.x; asm volatile("" : "+v"(tz));
        const int cl = tz & 15, g = (tz >> 4) & 3;
        const int b = u / 72, rem = u % 72, cpos = rem >> 2, grp = (rem >> 1) & 1, ph = rem & 1; const int rowbase = ssd_rowbase(b, cpos);
        const int lpos = 16 * pw + cl, pos = ph * 64 + lpos; const size_t row = (size_t)(rowbase + pos);
        __syncthreads();
#pragma unroll
        for (int k = 0; k < 2; ++k) { const int id = tz + 512 * k, q = id >> 4, nc = id & 15; *(uint4*)(Cn + q * PT + nc * 16) = *(const uint4*)(XBC + (size_t)(rowbase + ph * 64 + q) * 1024 + 768 + grp * 128 + nc * 8); }
        float ss = 0.f;
        uint4 sreg0, sreg1, sreg2, sreg3, sreg4, sreg5, sreg6, sreg7;
#define SSDC_SRC(k, it) (STIN + ((size_t)(b * 16 + (((tz + 512 * (k)) >> 10) & 1) * 8 + grp * 4 + 2 * ((tz + 512 * (k)) >> 11) + (it)) * 18 + cpos) * 8192 + (((tz + 512 * (k)) >> 4) & 63) * 128 + ((tz + 512 * (k)) & 15) * 8)
#define SSDC_SLOAD(it) do { sreg0 = *(const uint4*)SSDC_SRC(0, it); sreg1 = *(const uint4*)SSDC_SRC(1, it); sreg2 = *(const uint4*)SSDC_SRC(2, it); sreg3 = *(const uint4*)SSDC_SRC(3, it); \
            sreg4 = *(const uint4*)SSDC_SRC(4, it); sreg5 = *(const uint4*)SSDC_SRC(5, it); sreg6 = *(const uint4*)SSDC_SRC(6, it); sreg7 = *(const uint4*)SSDC_SRC(7, it); } while (0)
#define SSDC_LDSW(k, v) *(uint4*)(Sin + ((tz + 512 * (k)) >> 10) * 64 * PT + (((tz + 512 * (k)) >> 4) & 63) * PT + ((tz + 512 * (k)) & 15) * 16) = v
        SSDC_SLOAD(0);
#pragma unroll 1
        for (int it = 0; it < 2; ++it) {
            const int h = grp * 4 + 2 * hp + it; const size_t su0 = (size_t)(b * 16 + h) * 18 + cpos, su1 = (size_t)(b * 16 + 8 + h) * 18 + cpos;
            uint2 eyf[4], eyb[4], exv[4], ezv[4];
#pragma unroll
            for (int pb = 0; pb < 4; ++pb) { const int ch = h * 64 + 16 * pb + 4 * g;
                eyf[pb] = *(const uint2*)(YF + row * 512 + ch); eyb[pb] = *(const uint2*)(YB + row * 512 + ch); exv[pb] = *(const uint2*)(XBC + row * 1024 + ch); ezv[pb] = *(const uint2*)(PROJ + row * EVEN_PAD + 1536 + ch); }
            const float a0 = ACS[su0 * 128 + pos], a1 = ACS[su1 * 128 + pos];
            __syncthreads();
            SSDC_LDSW(0, sreg0); SSDC_LDSW(1, sreg1); SSDC_LDSW(2, sreg2); SSDC_LDSW(3, sreg3); SSDC_LDSW(4, sreg4); SSDC_LDSW(5, sreg5); SSDC_LDSW(6, sreg6); SSDC_LDSW(7, sreg7);
            if (it < 1) SSDC_SLOAD(it + 1);
            __syncthreads();
            const float sc0 = __expf(a0), sc1 = __expf(a1);
            const unsigned char* S0 = Sin + (hp * 2) * 64 * PT; const unsigned char* S1 = S0 + 64 * PT;
            f32x4 t0[4], t1[4];
#pragma unroll
            for (int pb = 0; pb < 4; ++pb) { t0[pb] = (f32x4){0.f, 0.f, 0.f, 0.f}; t1[pb] = (f32x4){0.f, 0.f, 0.f, 0.f}; }
#pragma unroll
            for (int ks = 0; ks < 4; ++ks) { const bf16x8 cf = *(const bf16x8*)(Cn + lpos * PT + (32 * ks + 8 * g) * 2);
#pragma unroll
                for (int pb = 0; pb < 4; ++pb) { const bf16x8 s0 = *(const bf16x8*)(S0 + (16 * pb + cl) * PT + (32 * ks + 8 * g) * 2), s1 = *(const bf16x8*)(S1 + (16 * pb + cl) * PT + (32 * ks + 8 * g) * 2);
                    t0[pb] = __builtin_amdgcn_mfma_f32_16x16x32_bf16(s0, cf, t0[pb], 0, 0, 0); t1[pb] = __builtin_amdgcn_mfma_f32_16x16x32_bf16(s1, cf, t1[pb], 0, 0, 0); } }
            const float dd = dsk[h];
#pragma unroll
            for (int pb = 0; pb < 4; ++pb) { const int ch = h * 64 + 16 * pb + 4 * g;
                const uint2 yf = eyf[pb], yb = eyb[pb], xv = exv[pb], zv = ezv[pb];
                f32x4 y = t0[pb] * sc0 + t1[pb] * sc1;
                y[0] = (y[0] + bflo(yf.x) + bflo(yb.x) + bflo(xv.x) * dd) * silu_f(bflo(zv.x)); y[1] = (y[1] + bfhi(yf.x) + bfhi(yb.x) + bfhi(xv.x) * dd) * silu_f(bfhi(zv.x));
                y[2] = (y[2] + bflo(yf.y) + bflo(yb.y) + bflo(xv.y) * dd) * silu_f(bflo(zv.y)); y[3] = (y[3] + bfhi(yf.y) + bfhi(yb.y) + bfhi(xv.y) * dd) * silu_f(bfhi(zv.y));
                uint2 o; o.x = pack2(y[0], y[1]); o.y = pack2(y[2], y[3]);
                const float r0 = bflo(o.x), r1 = bfhi(o.x), r2 = bflo(o.y), r3 = bfhi(o.y); ss += r0 * r0 + r1 * r1 + r2 * r2 + r3 * r3;
                *(uint2*)(A + row * 1024 + 512 + ch) = o; }
        }
#undef SSDC_SLOAD
#undef SSDC_SRC
#undef SSDC_LDSW
        ss += __shfl_xor(ss, 16); ss += __shfl_xor(ss, 32);
        if (g == 0) ssx[hp * 64 + lpos] = ss;
        __syncthreads();
        const float rn = rsqrtf((ssx[lpos] + ssx[64 + lpos]) * (1.f / 256.f) + EPS);
#pragma unroll 4
        for (int i = 0; i < 8; ++i) { const int ch = grp * 256 + (2 * hp + (i >> 2)) * 64 + 16 * (i & 3) + 4 * g; bf16_t* ap = A + row * 1024 + 512 + ch; const uint2 v = *(const uint2*)ap; const f32x4 gg = *(const f32x4*)(ng + ch);
            uint2 o; o.x = pack2(bflo(v.x) * rn * gg[0], bfhi(v.x) * rn * gg[1]); o.y = pack2(bflo(v.y) * rn * gg[2], bfhi(v.y) * rn * gg[3]); *(uint2*)ap = o; }
    }
    __syncthreads();
}

__device__ __forceinline__ uint4 rope8(const uint4 mine, const uint4 other, const float* ct, const float* st, bool upper, bool apply, float scale) {
    float m[8], o[8], r[8]; const unsigned mw[4] = {mine.x, mine.y, mine.z, mine.w}, ow[4] = {other.x, other.y, other.z, other.w};
#pragma unroll
    for (int j = 0; j < 4; ++j) { m[2 * j] = bflo(mw[j]); m[2 * j + 1] = bfhi(mw[j]); o[2 * j] = bflo(ow[j]); o[2 * j + 1] = bfhi(ow[j]); }
    if (apply) { const float4 c0 = ld4(ct), c1 = ld4(ct + 4), s0 = ld4(st), s1 = ld4(st + 4); const float c[8] = {c0.x, c0.y, c0.z, c0.w, c1.x, c1.y, c1.z, c1.w}, sn[8] = {s0.x, s0.y, s0.z, s0.w, s1.x, s1.y, s1.z, s1.w};
#pragma unroll
        for (int j = 0; j < 8; ++j) r[j] = (upper ? (m[j] * c[j] + o[j] * sn[j]) : (m[j] * c[j] - o[j] * sn[j])) * scale; }
    else {
#pragma unroll
        for (int j = 0; j < 8; ++j) r[j] = m[j] * scale; }
    uint4 q; q.x = pack2(r[0], r[1]); q.y = pack2(r[2], r[3]); q.z = pack2(r[4], r[5]); q.w = pack2(r[6], r[7]); return q;
}
__device__ __forceinline__ uint4 shfl_xor_u4(const uint4 v, int m) { uint4 r; r.x = __shfl_xor(v.x, m); r.y = __shfl_xor(v.y, m); r.z = __shfl_xor(v.z, m); r.w = __shfl_xor(v.w, m); return r; }
__device__ __forceinline__ void ph_attn_prep(const Fr& F) {
    const bf16_t* P = F.w<bf16_t>(L1_PROJ); float* SQ = F.w<float>(WS_SQ); float* SKV = F.w<float>(WS_SKV);
    bf16_t* KM = F.w<bf16_t>(L1_KM); bf16_t* QG = F.w<bf16_t>(L1_QG); bf16_t* KG = F.w<bf16_t>(L1_KG); bf16_t* VGT = F.w<bf16_t>(L1_VGT);
    const float* cm = F.w<float>(WS_ROPEM); const float* sm = cm + 2048 * 16; const float* cg = F.w<float>(WS_ROPEG); const float* sg = cg + 2048 * 32;
    const float gscale = 0.125f * LOG2E;
    for (int row = F.bid * 8 + F.wave; row < TT; row += F.G * 8) {
        const bf16_t* pr = P + (size_t)row * ODD_PAD; const bool lat = row < TL; const int pos = row & (SEQ - 1), l = F.lane;
        const int b = lat ? (row >> 11) : ((row - TL) >> 8), key = lat ? CTXL + pos : ((row - TL) & (CTXL - 1));
        { float s = 0.f; if (l < 48) { float v[8]; ld8bf(pr + l * 8, v);
#pragma unroll
              for (int j = 0; j < 8; ++j) s += v[j] * v[j]; }
          const float sq = wave_sum(l < 32 ? s : 0.f), skv = wave_sum(l >= 32 ? s : 0.f);
          if (l == 0) { SQ[row] = rsqrtf(sq * (1.f / 256.f) + EPS); SKV[row] = rsqrtf(skv * (1.f / 128.f) + EPS); } }
        { const uint4 mine = *(const uint4*)(pr + 416 + l * 8); const uint4 other = shfl_xor_u4(mine, 4); const int sub = l & 7, i0 = (sub & 3) * 8;
          if (lat) *(uint4*)(QG + (size_t)row * 512 + l * 8) = rope8(mine, other, cg + pos * 32 + i0, sg + pos * 32 + i0, sub >= 4, true, gscale); }
        { const int lk = l & 15; const uint4 mine = *(const uint4*)(pr + 928 + lk * 8); const uint4 other = shfl_xor_u4(mine, 4); const int sub = lk & 7, i0 = (sub & 3) * 8;
          const uint4 r = rope8(mine, other, cg + pos * 32 + i0, sg + pos * 32 + i0, sub >= 4, lat, 1.f);
          if (l < 16) *(uint4*)(KG + ((size_t)b * NKEY + key) * 128 + lk * 8) = r; }
        { const int lr = l & 3; const uint4 mine = *(const uint4*)(pr + 384 + lr * 8); const uint4 other = shfl_xor_u4(mine, 2); const int i0 = (lr & 1) * 8;
          const uint4 r = rope8(mine, other, cm + pos * 16 + i0, sm + pos * 16 + i0, lr >= 2, lat, 1.f);
          if (l < 4) { bf16_t* kb = KM + ((size_t)b * NKEY + key) * 768 + 64 + lr * 8;
#pragma unroll
              for (int h = 0; h < 8; ++h) *(uint4*)(kb + h * 96) = r; } }
    }
    bf16_t* vt = (bf16_t*)F.lds;
    for (int un = F.bid; un < TT / 64; un += F.G) {
        const int row0 = un * 64; const int b = row0 < TL ? (row0 >> 11) : ((row0 - TL) >> 8), key0 = row0 < TL ? CTXL + (row0 & (SEQ - 1)) : ((row0 - TL) & (CTXL - 1));
        { const int tok = F.tid >> 3, cq = F.tid & 7; const uint4 a = *(const uint4*)(P + (size_t)(row0 + tok) * ODD_PAD + 1056 + cq * 16), c2 = *(const uint4*)(P + (size_t)(row0 + tok) * ODD_PAD + 1056 + cq * 16 + 8);
          const unsigned wv[8] = {a.x, a.y, a.z, a.w, c2.x, c2.y, c2.z, c2.w};
#pragma unroll
          for (int j = 0; j < 8; ++j) { vt[(cq * 16 + 2 * j) * 66 + tok] = (bf16_t)(wv[j] & 0xFFFFu); vt[(cq * 16 + 2 * j + 1) * 66 + tok] = (bf16_t)(wv[j] >> 16); } }
        __syncthreads();
        { const int ch = F.tid >> 2, part = F.tid & 3; const unsigned* src = (const unsigned*)(vt + ch * 66 + part * 16); uint4 v0, v1; v0.x = src[0]; v0.y = src[1]; v0.z = src[2]; v0.w = src[3]; v1.x = src[4]; v1.y = src[5]; v1.z = src[6]; v1.w = src[7];
          uint4* dst = (uint4*)(VGT + ((size_t)(b * 2 + (ch >> 6)) * 64 + (ch & 63)) * NKEY + key0 + part * 16); dst[0] = v0; dst[1] = v1; }
        __syncthreads();
    }
}

typedef float f32x16 __attribute__((ext_vector_type(16)));
template <bool GQA>
__device__ __forceinline__ void ph_attn_mfma(const Fr& F) {
    constexpr int DQK = GQA ? 64 : 96, NKS = DQK / 16, KP = GQA ? 144 : 208, VP = 136, KCH = DQK / 8, NKCH = 64 * KCH;
    constexpr int KBYTES = 64 * KP, VBYTES = 64 * VP;
    unsigned char* Kb = F.lds; unsigned char* Vb = F.lds + 2 * KBYTES;
    bf16_t* A = F.w<bf16_t>(WS_ABUF);
    const int r = F.lane & 31, hh = F.lane >> 5;
    for (int u = F.bid; u < 512; u += F.G) {
        int b, ntile, lat_lo = 0, qpos, ocol; const bf16_t* qp; const bf16_t* kbase; const bf16_t* vtb; int kstride; float m_run, l_run;
        if (!GQA) { b = u >> 6; const int h = (u >> 3) & 7, qb = u & 7; qpos = qb * 256 + F.wave * 32 + r; ntile = NKEY / 64;
            qp = F.w<bf16_t>(L1_QM) + (size_t)(b * SEQ + qpos) * 768 + h * 96; kbase = F.w<bf16_t>(L1_KM) + (size_t)b * NKEY * 768 + h * 96; kstride = 768;
            vtb = F.w<bf16_t>(L1_VT) + (size_t)(b * 8 + h) * 64 * NKEY; m_run = 0.f; l_run = 0.f; ocol = h * 64; }
        else { b = u >> 6; const int kv = (u >> 5) & 1, qb = (u >> 1) & 15, pr = u & 1; const int head = kv * 4 + pr * 2 + (F.wave >> 2); qpos = qb * 128 + (F.wave & 3) * 32 + r;
            lat_lo = qb * 128 - 128 > 0 ? qb * 128 - 128 : 0; const int lat_hi = qb * 128 + 256 < SEQ ? qb * 128 + 256 : SEQ; ntile = 4 + (lat_hi - lat_lo) / 64;
            qp = F.w<bf16_t>(L1_QG) + (size_t)(b * SEQ + qpos) * 512 + head * 64; kbase = F.w<bf16_t>(L1_KG) + (size_t)b * NKEY * 128 + kv * 64; kstride = 128;
            vtb = F.w<bf16_t>(L1_VGT) + (size_t)(b * 2 + kv) * 64 * NKEY; m_run = F.in[I_SINK][head] * LOG2E; l_run = hh ? 0.f : 1.f; ocol = 512 + head * 64; }
        bf16x8 qf[NKS];
#pragma unroll
        for (int ks = 0; ks < NKS; ++ks) qf[ks] = *(const bf16x8*)(qp + 16 * ks + 8 * hh);
        f32x16 o0, o1;
#pragma unroll
        for (int i = 0; i < 16; ++i) { o0[i] = 0.f; o1[i] = 0.f; }
        const int kr0 = F.tid / KCH, kc0 = F.tid % KCH, kr1 = (F.tid + 512) / KCH, kc1 = (F.tid + 512) % KCH; const bool has2 = (F.tid + 512) < NKCH;
        const int vr = F.tid >> 3, vc = F.tid & 7;
        uint4 kreg0, kreg1 = make_uint4(0u, 0u, 0u, 0u), vreg;
        bf16x8 kf[NKS][2];
#define ATT_KIDX(t) ((!GQA || (t) < 4) ? (t) * 64 : CTXL + lat_lo + ((t) - 4) * 64)
#define ATT_LOAD(t) do { const int _k0 = ATT_KIDX(t); kreg0 = *(const uint4*)(kbase + (size_t)(_k0 + kr0) * kstride + kc0 * 8); \
            if (has2) kreg1 = *(const uint4*)(kbase + (size_t)(_k0 + kr1) * kstride + kc1 * 8); vreg = *(const uint4*)(vtb + (size_t)vr * NKEY + _k0 + vc * 8); } while (0)
#define ATT_WRITE(buf) do { *(uint4*)(Kb + (buf) * KBYTES + kr0 * KP + kc0 * 16) = kreg0; if (has2) *(uint4*)(Kb + (buf) * KBYTES + kr1 * KP + kc1 * 16) = kreg1; \
            *(uint2*)(Vb + (buf) * VBYTES + vr * VP + vc * 16) = make_uint2(vreg.x, vreg.y); *(uint2*)(Vb + (buf) * VBYTES + vr * VP + vc * 16 + 8) = make_uint2(vreg.z, vreg.w); } while (0)
#define ATT_KFRAGS(buf) do { const unsigned char* kb = Kb + (buf) * KBYTES; \
            _Pragma("unroll") for (int ks = 0; ks < NKS; ++ks) { kf[ks][0] = *(const bf16x8*)(kb + r * KP + (16 * ks + 8 * hh) * 2); kf[ks][1] = *(const bf16x8*)(kb + (32 + r) * KP + (16 * ks + 8 * hh) * 2); } } while (0)
        __syncthreads();
        ATT_LOAD(0); ATT_WRITE(0);
        __syncthreads();
        ATT_KFRAGS(0);
        for (int t = 0; t < ntile; ++t) {
            const int buf = t & 1; const bool more = (t + 1) < ntile;
            if (more) ATT_LOAD(t + 1);
            const unsigned char* vb = Vb + buf * VBYTES;
            f32x16 s0, s1;
#pragma unroll
            for (int i = 0; i < 16; ++i) { s0[i] = -m_run; s1[i] = -m_run; }
#pragma unroll
            for (int ks = 0; ks < NKS; ++ks) { s0 = __builtin_amdgcn_mfma_f32_32x32x16_bf16(kf[ks][0], qf[ks], s0, 0, 0, 0); s1 = __builtin_amdgcn_mfma_f32_32x32x16_bf16(kf[ks][1], qf[ks], s1, 0, 0, 0); }
            union { bf16x8 v; uint2 h2[2]; } vf[4][2];
#pragma unroll
            for (int s2 = 0; s2 < 4; ++s2) { vf[s2][0].h2[0] = *(const uint2*)(vb + r * VP + (16 * s2 + 4 * hh) * 2); vf[s2][0].h2[1] = *(const uint2*)(vb + r * VP + (16 * s2 + 8 + 4 * hh) * 2);
                vf[s2][1].h2[0] = *(const uint2*)(vb + (32 + r) * VP + (16 * s2 + 4 * hh) * 2); vf[s2][1].h2[1] = *(const uint2*)(vb + (32 + r) * VP + (16 * s2 + 8 + 4 * hh) * 2); }
            __builtin_amdgcn_sched_barrier(0);
            if (GQA && t >= 4) { const int kp0 = lat_lo + (t - 4) * 64 + 4 * hh - qpos;
#pragma unroll
                for (int i = 0; i < 16; ++i) { const int rel = kp0 + (i & 3) + 8 * (i >> 2); if (rel > 128 || rel < -128) s0[i] = -1.0e30f; if (rel + 32 > 128 || rel + 32 < -128) s1[i] = -1.0e30f; } }
            float tmax = s0[0];
#pragma unroll
            for (int i = 1; i < 16; ++i) tmax = fmaxf(tmax, s0[i]);
#pragma unroll
            for (int i = 0; i < 16; ++i) tmax = fmaxf(tmax, s1[i]);
            tmax = fmaxf(tmax, __shfl_xor(tmax, 32));
            const float dm = fmaxf(tmax, 0.f); const bool grow = __any(tmax > 0.f) != 0; float alpha = 1.f;
            float ls = 0.f;
            if (grow) { alpha = __builtin_amdgcn_exp2f(-dm); m_run += dm;
#pragma unroll
                for (int i = 0; i < 16; ++i) { s0[i] = __builtin_amdgcn_exp2f(s0[i] - dm); s1[i] = __builtin_amdgcn_exp2f(s1[i] - dm); ls += s0[i] + s1[i]; } }
            else {
#pragma unroll
                for (int i = 0; i < 16; ++i) { s0[i] = __builtin_amdgcn_exp2f(s0[i]); s1[i] = __builtin_amdgcn_exp2f(s1[i]); ls += s0[i] + s1[i]; } }
            l_run = l_run * alpha + ls;
            if (grow) {
#pragma unroll
                for (int i = 0; i < 16; ++i) { o0[i] *= alpha; o1[i] *= alpha; } }
#pragma unroll
            for (int s2 = 0; s2 < 4; ++s2) {
                union { bf16x8 v; unsigned w[4]; } pf;
#pragma unroll
                for (int j = 0; j < 4; ++j) { const int ri = 8 * (s2 & 1) + 2 * j; pf.w[j] = (s2 < 2) ? pack2(s0[ri], s0[ri + 1]) : pack2(s1[ri], s1[ri + 1]); }
                o0 = __builtin_amdgcn_mfma_f32_32x32x16_bf16(vf[s2][0].v, pf.v, o0, 0, 0, 0); o1 = __builtin_amdgcn_mfma_f32_32x32x16_bf16(vf[s2][1].v, pf.v, o1, 0, 0, 0);
            }
            if (more) ATT_WRITE(buf ^ 1);
            __syncthreads();
            if (more) ATT_KFRAGS(buf ^ 1);
        }
#undef ATT_KFRAGS
#undef ATT_KIDX
#undef ATT_LOAD
#undef ATT_WRITE
        const float inv = 1.f / (l_run + __shfl_xor(l_run, 32));
        bf16_t* op = A + (size_t)(b * SEQ + qpos) * 1024 + ocol + 4 * hh;
#pragma unroll
        for (int t4 = 0; t4 < 4; ++t4) { uint2 p;
            p.x = pack2(o0[4 * t4] * inv, o0[4 * t4 + 1] * inv); p.y = pack2(o0[4 * t4 + 2] * inv, o0[4 * t4 + 3] * inv); *(uint2*)(op + 8 * t4) = p;
            p.x = pack2(o1[4 * t4] * inv, o1[4 * t4 + 1] * inv); p.y = pack2(o1[4 * t4 + 2] * inv, o1[4 * t4 + 3] * inv); *(uint2*)(op + 32 + 8 * t4) = p; }
    }
    __syncthreads();
}

template <class Epi>
__device__ __forceinline__ void run_gemm(const Fr& F, const bf16_t* A, int lda, const bf16_t* Bt, int ldb, int M, int N, int K, const Epi& E) {
    pg8::Gemm g{A, Bt, M, N, K, lda, ldb, 0}; pg8::StaticOrder S; S.init(M, N, F.G, F.bid);
    pg8::gemm_phase<Epi, pg8::StaticOrder>((LAS unsigned char*)F.lds, g, S, E);
}

__global__ void __launch_bounds__(NTHR, 2) fwd(Args args) {
    extern __shared__ __attribute__((aligned(16))) unsigned char lds[];
    Fr F; F.in = args.in; F.out = args.out; F.ws = args.ws; F.lds = lds; F.tid = threadIdx.x; F.lane = F.tid & 63; F.wave = __builtin_amdgcn_readfirstlane(F.tid >> 6); F.G = gridDim.x; F.bid = blockIdx.x;
    const int lo = args.ph_lo, hi = args.ph_hi;
#ifndef PHMASK
#define PHMASK 0xFFFFFFFFu
#endif
#define IN(k) (((PHMASK >> (k)) & 1u) && lo <= (k) && (k) < hi)
    const float* MOD0 = F.w<float>(WS_MOD); const float* MOD1 = MOD0 + 9 * 6144;
    const bool multi_phase = (hi - lo) > 1;
    if (F.tid == 0) *(uint4*)(lds + LDS_BYTES - 16) = make_uint4(0u, 0u, 0u, 0u);
    __syncthreads();
    XcdBarrier bar; bar.bar = F.w<unsigned>(WS_CTL); bar.x = 0; bar.st = (volatile LAS unsigned*)(LAS unsigned char*)(lds + LDS_BYTES - 16);
    if (multi_phase) bar = xcd_barrier_post(F.w<unsigned>(WS_CTL), (volatile LAS unsigned*)(LAS unsigned char*)(lds + LDS_BYTES - 16));
#define SEAM(k) do { if (IN(k) && IN((k) + 1)) xcd_barrier(bar); } while (0)
    bf16_t* ABUF = F.w<bf16_t>(WS_ABUF);

#ifndef DUPMASK
#define DUPMASK 0u
#endif
#define PHASE(k, ...) if (IN(k)) { __VA_ARGS__ } if (IN(k) && ((DUPMASK >> (k)) & 1u)) { xcd_barrier(bar); __VA_ARGS__ } SEAM(k);
#define PHASEW(k, ...) if (IN(k)) { __VA_ARGS__ } if (IN(k) && ((DUPMASK >> (k)) & 1u)) { xcd_barrier(bar); __VA_ARGS__ } \
    if (IN(k) && IN((k) + 1)) { unsigned gen_ = 0u; XB_OVERLAP_ARRIVE(bar, gen_); cvt_window(F, (k) - 8); XB_OVERLAP_WAIT(bar, gen_); }
    PHASE(0,
        ph_ada(F);
        cvt_job(F, F.in[I_EVWIN], nullptr, nullptr, F.w<bf16_t>(W_IN0), EVEN_PAD, 1024, 1024, EVEN_IN, EVEN_IN, 0, 1, 0);
        cvt_job(F, F.in[I_EVWOUT], nullptr, nullptr, F.w<bf16_t>(W_OUT0), 1024, 1024, 1024, 1024, 1024, 0, 1, 208);
        cvt_job(F, F.in[I_FFNG], F.in[I_FFNU], nullptr, F.w<bf16_t>(W_GU0), 2 * DFF, 1024, 1024, DFF, DFF, 1, 1, 272);
        cvt_job(F, F.in[I_FFND], nullptr, nullptr, F.w<bf16_t>(W_DN0), 1024, DFF, DFF, 1024, 1024, 0, 1, 624);
        cvt_job(F, F.in[I_ODWIN], nullptr, nullptr, F.w<bf16_t>(W_IN1), ODD_PAD, 1024, 1024, 1184, 1184, 0, 1, 800);
        cvt_job(F, F.in[I_QUP], nullptr, F.in[I_QNG], F.w<bf16_t>(W_QUP), 768, 256, 256, 768, 768, 0, 0, 880);
        cvt_job(F, F.in[I_KVUP], nullptr, F.in[I_KVNG], F.w<bf16_t>(W_KUP), 512, 256, 128, 1024, 1024, 2, 1, 892);
        cvt_job(F, F.in[I_KVUP], nullptr, F.in[I_KVNG], F.w<bf16_t>(W_VUP), 512, 256, 128, 1024, 1024, 3, 0, 900);
        cvt_job(F, F.in[I_ODWOUT], nullptr, nullptr, F.w<bf16_t>(W_OUT1), 1024, 1024, 1024, 1024, 1024, 0, 1, 908);
        ph_filters(F); ph_rope_tables(F);)
    PHASE(1, ph_norm0(F);)
    PHASE(2, run_gemm(F, ABUF, 1024, F.w<bf16_t>(W_IN0), 1024, TT, EVEN_PAD, 1024, pg8::EpiBf16Plain{F.w<bf16_t>(L0_PROJ), EVEN_PAD});)
    PHASE(3, ph_convpass(F);)
    PHASE(4, ph_ssd_a(F); ph_hyena_mfma(F);)
    PHASE(6, ph_ssd_b(F);)
    PHASE(7, ph_ssd_c(F); ph_hyena_post(F);)
    PHASEW(8,
        run_gemm(F, ABUF, 1024, F.w<bf16_t>(W_OUT0), 1024, TL, 1024, 1024, pg8::EpiBf16Plain{F.w<bf16_t>(L0_MBUF), 1024});
        { pg8::Gemm g{ABUF, F.w<bf16_t>(W_OUT0), TT, 1024, 1024, 1024, 1024, 0}; pg8::DenseTailOrder<8> S; S.init(TL / 256, TC / 256, 1024 / 64, F.G, F.bid);
          pg8::gemm_phase<pg8::EpiTailBf16, pg8::DenseTailOrder<8>>((LAS unsigned char*)F.lds, g, S, pg8::EpiTailBf16{F.w<bf16_t>(L0_MBUF), 1024, F.w<bf16_t>(L0_XT), TL / 256, 8}); }
        )
    PHASEW(9, ph_thin<0, true, false>(F, (const float*)F.w<bf16_t>(L0_MBUF), TT, F.in[I_X], F.in[I_CTX], nullptr, nullptr, F.in[I_MIXPOST], MOD0, 2048, F.in[I_FFNPRE], MOD0, 3072, 4096, ABUF, 0, 1, F.w<bf16_t>(L0_XT), 8);)
    PHASEW(10, run_gemm(F, ABUF, 1024, F.w<bf16_t>(W_GU0), 1024, TT, 2 * DFF, 1024, pg8::EpiSwiglu{F.w<bf16_t>(L0_HMID), DFF});)
    PHASEW(11,
        run_gemm(F, F.w<bf16_t>(L0_HMID), DFF, F.w<bf16_t>(W_DN0), DFF, TL, 1024, DFF, pg8::EpiBf16Plain{F.w<bf16_t>(L0_MBUF), 1024});
        { pg8::Gemm g{F.w<bf16_t>(L0_HMID), F.w<bf16_t>(W_DN0), TT, 1024, DFF, DFF, DFF, 0}; pg8::DenseTailOrder<11> S; S.init(TL / 256, TC / 256, DFF / 64, F.G, F.bid);
          pg8::gemm_phase<pg8::EpiTailBf16, pg8::DenseTailOrder<11>>((LAS unsigned char*)F.lds, g, S, pg8::EpiTailBf16{F.w<bf16_t>(L0_MBUF), 1024, F.w<bf16_t>(L0_XT), TL / 256, 11}); }
        )
    PHASEW(12, ph_thin<0, false, false>(F, (const float*)F.w<bf16_t>(L0_MBUF), TT, nullptr, nullptr, nullptr, nullptr, F.in[I_FFNPOST], MOD0, 5120, F.in[I_MIXPRE] + 1024, MOD1, 0, 1024, ABUF, 0, 1, F.w<bf16_t>(L0_XT), 11);)
    PHASEW(13, run_gemm(F, ABUF, 1024, F.w<bf16_t>(W_IN1), 1024, TT, ODD_PAD, 1024, pg8::EpiBf16Plain{F.w<bf16_t>(L1_PROJ), ODD_PAD});)
    PHASEW(14, ph_attn_prep(F);)
    PHASEW(15,
        run_gemm(F, F.w<bf16_t>(L1_PROJ), ODD_PAD, F.w<bf16_t>(W_QUP), 256, TL, 768, 256, pg8::EpiQ{F.w<bf16_t>(L1_QM), F.w<float>(WS_SQ), F.w<float>(WS_ROPEM), F.w<float>(WS_ROPEM) + 2048 * 16, 0.10206207261596575f * LOG2E});
        run_gemm(F, F.w<bf16_t>(L1_PROJ) + 256, ODD_PAD, F.w<bf16_t>(W_KUP), 256, TT, 512, 256, pg8::EpiK{F.w<bf16_t>(L1_KM), F.w<float>(WS_SKV)});
        run_gemm(F, F.w<bf16_t>(W_VUP), 256, F.w<bf16_t>(L1_PROJ) + 256, ODD_PAD, 512, TT, 256, pg8::EpiVT{F.w<bf16_t>(L1_VT), F.w<float>(WS_SKV)});)
    PHASEW(16, ph_attn_mfma<false>(F); ph_attn_mfma<true>(F);)
    PHASEW(17, run_gemm(F, ABUF, 1024, F.w<bf16_t>(W_OUT1), 1024, TL, 1024, 1024, pg8::EpiBf16Plain{F.w<bf16_t>(L1_MBUF), 1024});)
    PHASEW(18, ph_thin<1, false, false>(F, (const float*)F.w<bf16_t>(L1_MBUF), TL, nullptr, nullptr, nullptr, nullptr, F.in[I_MIXPOST] + 1024, MOD1, 2048, F.in[I_FFNPRE] + 1024, MOD1, 3072, 4096, F.w<bf16_t>(L1_A2TMP));)
    PHASE(19,
        ph_moe_gather(F);
        { const int w0 = multi_phase ? CVW_NWIN * CVW_Q * F.G : 0; cvt_moe_range<true>(F, w0 < CVT_T_ALL ? w0 : CVT_T_ALL, CVT_T_ALL, F.bid, F.G); })
    PHASE(20,
        if (MOE_FP8) { pg8::Gemm g{F.w<bf16_t>(WS_AG), F.w<bf16_t>(WM_GU), 0, 2 * DFE, 512, 512, 512, (size_t)2 * DFE * 1024}; pg8::GroupedOrder S; S.init(F.w<unsigned>(WS_CNT), 2 * DFE / 256, F.G, F.bid);
            pg8::gemm_phase<pg8::EpiSwigluF8, pg8::GroupedOrder, true>((LAS unsigned char*)F.lds, g, S, pg8::EpiSwigluF8{F.w<unsigned char>(L1_HMID), DFE}); }
        else { pg8::Gemm g{F.w<bf16_t>(WS_AG), F.w<bf16_t>(WM_GU), 0, 2 * DFE, 1024, 1024, 1024, (size_t)2 * DFE * 1024 * 2}; pg8::GroupedOrder S; S.init(F.w<unsigned>(WS_CNT), 2 * DFE / 256, F.G, F.bid);
            pg8::gemm_phase<pg8::EpiSwiglu, pg8::GroupedOrder>((LAS unsigned char*)F.lds, g, S, pg8::EpiSwiglu{F.w<bf16_t>(L1_HMID), DFE}); })
    PHASE(21,
        constexpr int KE = MOE_FP8 ? DFE / 2 : DFE;
        constexpr float osc = MOE_FP8 ? 1.f / (F8_WSCALE * F8_HSCALE) : 1.f;
        pg8::Gemm g{F.w<bf16_t>(L1_HMID), F.w<bf16_t>(WM_DN), 0, 1024, KE, KE, KE, (size_t)1024 * KE * 2};
        { pg8::GroupedOrder S; S.init(F.w<unsigned>(WS_CNT), 4, F.G, F.bid, KE / 64, true);
          pg8::gemm_phase<pg8::EpiMoeOut, pg8::GroupedOrder, MOE_FP8 != 0>((LAS unsigned char*)F.lds, g, S, pg8::EpiMoeOut{F.w<bf16_t>(WS_MOUT), F.w<uint2>(WS_ROWINFO), osc}); }
        { pg8::TailOrder S; S.init(F.w<unsigned>(WS_CNT), F.G, F.bid, KE / 64);
          pg8::gemm_phase<pg8::EpiXtr, pg8::TailOrder, MOE_FP8 != 0>((LAS unsigned char*)F.lds, g, S, pg8::EpiXtr{F.w<bf16_t>(WS_MOUT), F.w<uint2>(WS_ROWINFO), F.w<bf16_t>(WS_XTR), S.NTF, 7, osc}); })
    PHASE(22,
        pg8::TailOrder S; S.init(F.w<unsigned>(WS_CNT), F.G, F.bid, (MOE_FP8 ? DFE / 2 : DFE) / 64);
        ph_thin<2, false, true>(F, (const float*)F.w<bf16_t>(WS_MOUT), TL, nullptr, nullptr, F.out, nullptr, F.in[I_FFNPOST] + 1024, MOD1, 5120, nullptr, nullptr, 0, 0, nullptr, S.NTF, S.nsub > 0 ? 7 : 1);)
#undef IN
}

extern "C" void kernel_launch(void* const* d_in, const int* in_sizes, int n_in, void* d_out, int out_size, void* d_ws, size_t ws_size, hipStream_t stream) {
    static int grid = 0;
    if (grid == 0) {
        if (n_in != 41 || out_size != TL * DM || ws_size < WS_END) { fprintf(stderr, "kernel_launch: unexpected shapes (n_in %d, out %d, ws %zu < %zu)\n", n_in, out_size, ws_size, (size_t)WS_END); grid = -1; return; }
        int dev = 0, cus = 0;
        if (hipGetDevice(&dev) != hipSuccess || hipDeviceGetAttribute(&cus, hipDeviceAttributeMultiprocessorCount, dev) != hipSuccess) { grid = -1; return; }
        if (hipFuncSetAttribute((const void*)fwd, hipFuncAttributeMaxDynamicSharedMemorySize, LDS_BYTES) != hipSuccess) { fprintf(stderr, "kernel_launch: hipFuncSetAttribute failed\n"); grid = -1; return; }
        int per_cu = 0;
        if (hipOccupancyMaxActiveBlocksPerMultiprocessor(&per_cu, (const void*)fwd, NTHR, LDS_BYTES) != hipSuccess || per_cu < 1) fprintf(stderr, "kernel_launch: occupancy query says %d\n", per_cu);
        (void)hipGetLastError();
        grid = cus;
        if (grid % 4 != 0) { fprintf(stderr, "kernel_launch: the kernel needs a grid size that is a multiple of 4 (got %d CUs)\n", grid); grid = -1; return; }
    }
    if (grid < 0) return;
    (void)hipMemsetAsync((char*)d_ws + WS_CTL, 0, 65536, stream);
    Args a{};
    for (int i = 0; i < 41; ++i) a.in[i] = (const float*)d_in[i];
    a.out = (float*)d_out; a.ws = (unsigned char*)d_ws;
    auto launch = [&](int lo, int hi, int ex) { a.ph_lo = lo; a.ph_hi = hi; a.ex = ex; hipLaunchKernelGGL(fwd, dim3(grid), dim3(NTHR), LDS_BYTES, stream, a); };
#if defined(MULTI)
    for (int p = 0; p <= 22; ++p) launch(p, p + 1, 0);
#else
    launch(0, 23, 0);
#endif
}
```

```cpp
#include <hip/hip_runtime.h>
#include <cstdio>
#include <cstdint>

typedef unsigned short bf16_t;
typedef short bf16x8 __attribute__((ext_vector_type(8)));
typedef float f32x4 __attribute__((ext_vector_type(4)));
#define LAS __attribute__((address_space(3)))

constexpr int NB = 8, SEQ = 2048, DM = 1024, CTXL = 256;
constexpr int TL = NB * SEQ, TC = NB * CTXL, TT = TL + TC, NKEY = SEQ + CTXL;
constexpr int EVEN_IN = 3088, EVEN_PAD = 3328, ODD_PAD = 1280, DFF = 2816, DFE = 3584, NEXP = 8;
constexpr float EPS = 1e-6f;
constexpr float LOG2E = 1.4426950408889634f;
constexpr int NTHR = 512;
constexpr int LDS_BYTES = 147456;

constexpr size_t al256(size_t x) { return (x + 255) & ~(size_t)255; }
constexpr size_t WS_CTL = 0;
constexpr size_t WS_CNT = 16384;
constexpr size_t WS_MOD = 65536;
constexpr size_t WS_ROPEM = WS_MOD + al256((size_t)2 * 9 * 6144 * 4);
constexpr size_t WS_ROPEG = WS_ROPEM + (size_t)2 * 2048 * 16 * 4;
constexpr size_t WS_SQ = WS_ROPEG + (size_t)2 * 2048 * 32 * 4;
constexpr size_t WS_SKV = WS_SQ + al256((size_t)TT * 4);
constexpr size_t WS_TOPW = WS_SKV + al256((size_t)TT * 4);
constexpr size_t WS_LISTE = WS_TOPW + (size_t)TL * 2 * 4;
constexpr int MAXROWS = 34816;
constexpr size_t WS_ROWINFO = WS_LISTE + (size_t)NEXP * TL * 4;
constexpr size_t WS_ROWW = WS_ROWINFO + (size_t)MAXROWS * 4;
constexpr size_t WS_SROW = WS_ROWW + (size_t)MAXROWS * 4;
constexpr size_t WS_W0 = WS_SROW + (size_t)TL * 2 * 4;
constexpr size_t W_IN0 = WS_W0;
constexpr size_t W_OUT0 = W_IN0 + (size_t)EVEN_PAD * 1024 * 2;
constexpr size_t W_GU0 = W_OUT0 + (size_t)1024 * 1024 * 2;
constexpr size_t W_DN0 = W_GU0 + (size_t)2 * DFF * 1024 * 2;
constexpr size_t W_IN1 = W_DN0 + (size_t)1024 * DFF * 2;
constexpr size_t W_QUP = W_IN1 + (size_t)ODD_PAD * 1024 * 2;
constexpr size_t W_KUP = W_QUP + (size_t)768 * 256 * 2;
constexpr size_t W_VUP = W_KUP + (size_t)512 * 256 * 2;
constexpr size_t W_OUT1 = W_VUP + (size_t)512 * 256 * 2;
constexpr size_t WS_ABUF = W_OUT1 + (size_t)1024 * 1024 * 2;
constexpr size_t WS_AG = WS_W0;
constexpr size_t WS_MOUT = WS_W0;
constexpr size_t XG_END0 = WS_ABUF + (size_t)TT * DM * 2, XG_END1 = WS_AG + (size_t)MAXROWS * DM * 2;
constexpr size_t WS_R1 = al256(XG_END0 > XG_END1 ? XG_END0 : XG_END1);
constexpr size_t R1_BYTES = (size_t)MAXROWS * DFE * 2;
constexpr size_t WS_R2 = WS_R1 + R1_BYTES;
constexpr size_t R2_BYTES = (size_t)132 * 1024 * 1024;
constexpr size_t WS_XTR = WS_R2 + R2_BYTES;
constexpr size_t WS_HB = WS_XTR + (size_t)32 * 6 * 65536 * 2;
constexpr size_t WS_END = WS_HB + (size_t)TT * DM * 2;
static_assert(WS_END <= (size_t)536000000, "workspace budget");
constexpr size_t L0_PROJ = WS_R1;
constexpr size_t L0_HMID = WS_R1;
constexpr size_t L0_XBC = L0_PROJ + (size_t)TT * EVEN_PAD * 2;
constexpr size_t L0_U = L0_XBC + (size_t)TT * 1024 * 2;
constexpr size_t L0_X0 = L0_U + (size_t)TT * 512 * 2;
constexpr size_t L0_DT = L0_X0 + (size_t)TT * 512 * 2;
constexpr size_t L0_YF = L0_DT + (size_t)TT * 16 * 4;
constexpr size_t L0_YB = L0_YF + (size_t)TT * 512 * 2;
static_assert(L0_YB + (size_t)TT * 512 * 2 <= WS_R1 + R1_BYTES, "R1 layer 0");
constexpr size_t L0_MBUF = WS_R1 + (size_t)128 * 1024 * 1024;
static_assert(L0_MBUF >= L0_HMID + (size_t)TT * DFF * 2 && L0_MBUF + (size_t)TT * DM * 2 <= WS_R1 + R1_BYTES, "MBUF0 placement");
constexpr size_t L0_XT = WS_R1 + (size_t)176 * 1024 * 1024;
static_assert(L0_XT >= L0_MBUF + (size_t)TT * DM * 2 && L0_XT + (size_t)32 * 10 * 65536 * 2 <= WS_R1 + R1_BYTES, "XT0 placement");
constexpr size_t L0_FL = WS_R2 + (size_t)TT * DM * 2;
constexpr size_t L0_FC = L0_FL + (size_t)512 * 4096 * 2;
constexpr size_t L0_YT = L0_FC + (size_t)512 * 512 * 2;
constexpr size_t L0_ST = L0_YT + (size_t)512 * 8 * NKEY * 2;
constexpr size_t L0_ACS = L0_ST + (size_t)2304 * 8192 * 4;
constexpr size_t L0_ATOT = L0_ACS + (size_t)2304 * 128 * 4;
constexpr size_t L0_STIN = WS_R2;
static_assert(L0_ATOT + (size_t)2304 * 4 <= WS_R2 + R2_BYTES, "R2 layer 0");
constexpr size_t L1_HMID = WS_R1;
constexpr size_t L1_A2TMP = WS_R1;
constexpr size_t L1_PROJ = WS_R1;
constexpr size_t L1_QM = L1_PROJ + (size_t)TT * ODD_PAD * 2;
constexpr size_t L1_KM = L1_QM + (size_t)TL * 768 * 2;
constexpr size_t L1_VT = L1_KM + (size_t)NB * NKEY * 768 * 2;
constexpr size_t L1_QG = L1_VT + (size_t)NB * 512 * NKEY * 2;
constexpr size_t L1_KG = L1_QG + (size_t)TL * 512 * 2;
constexpr size_t L1_VGT = L1_KG + (size_t)NB * NKEY * 128 * 2;
constexpr size_t L1_MBUF = L1_VGT + (size_t)NB * 128 * NKEY * 2;
static_assert(L1_MBUF + (size_t)TL * DM * 4 <= WS_R1 + R1_BYTES, "R1 layer 1");
static_assert(L1_A2TMP + (size_t)TL * DM * 2 <= L1_MBUF, "a2tmp vs mbuf1");
constexpr size_t WM_GU = WS_R2;
constexpr size_t WM_DN = WM_GU + (size_t)NEXP * 2 * DFE * 1024;
static_assert(WM_DN + (size_t)NEXP * 1024 * DFE <= WS_R2 + R2_BYTES, "fp8 expert weights vs R2");

typedef __bf16 bf16v2 __attribute__((ext_vector_type(2)));
typedef float f32v2 __attribute__((ext_vector_type(2)));
__device__ __forceinline__ bf16_t f2bf(float f) { return __builtin_bit_cast(unsigned short, (__bf16)f); }
__device__ __forceinline__ float bf2f(bf16_t b) { return __uint_as_float(((unsigned)b) << 16); }
__device__ __forceinline__ unsigned pack2(float lo, float hi) { f32v2 v = {lo, hi}; return __builtin_bit_cast(unsigned, __builtin_convertvector(v, bf16v2)); }
#ifndef MOE_FP8
#define MOE_FP8 1
#endif
constexpr float F8_WSCALE = 64.f, F8_HSCALE = 8.f;
__device__ __forceinline__ unsigned pack4_fp8(float a, float b, float c, float d) { unsigned r = 0u; r = __builtin_amdgcn_cvt_pk_fp8_f32(a, b, r, false); r = __builtin_amdgcn_cvt_pk_fp8_f32(c, d, r, true); return r; }
__device__ __forceinline__ float bflo(unsigned u) { return __uint_as_float(u << 16); }
__device__ __forceinline__ float bfhi(unsigned u) { return __uint_as_float(u & 0xFFFF0000u); }
__device__ __forceinline__ float wave_sum(float v) {
#pragma unroll
    for (int o = 32; o > 0; o >>= 1) v += __shfl_xor(v, o);
    return v;
}
__device__ __forceinline__ float silu_f(float x) { return x * __builtin_amdgcn_rcpf(1.f + __builtin_amdgcn_exp2f(-x * LOG2E)); }
__device__ __forceinline__ float softplus_f(float x) { return x > 20.f ? x : log1pf(expf(x)); }

namespace pg8 {
constexpr int BM = 256, BK = 64, HALF = 128, HTB = HALF * BK * 2, STAGE_BYTES = 8 * HTB, NXCD = 8, WGM = 8;
__host__ __device__ __forceinline__ int lds_byte(int r, int c) { const int st = (r >> 4) * 2 + (c >> 5), rr = r & 15, cc = c & 31, ob = rr * 64 + cc * 2; return st * 1024 + (ob ^ (((ob >> 9) & 1) << 5)); }
__host__ __device__ __forceinline__ void stage_rc(int b, int& R, int& C) { const int st = b / 1024, sb = b % 1024, swz = sb ^ (((sb >> 9) & 1) << 5); R = (st >> 1) * 16 + swz / 64; C = (st & 1) * 32 + (swz % 64) / 2; }

struct Unit { int pm, pn, e, kt0, nkt, ks; };
struct Gemm { const bf16_t* A; const bf16_t* Bt; int M, N, K, lda, ldb; size_t bstride; };

struct StaticOrder {
    int nM, nN, nwg, G, c;
    __device__ __forceinline__ void init(int M, int N, int G_, int c_) { nM = M / BM; nN = N / BM; nwg = nM * nN; G = G_; c = c_; }
    __device__ __forceinline__ bool next(int i, Unit& u) const {
        const long L = (long)i * G + c; if (L >= nwg) return false;
        int wgid = (int)L; { const int q = nwg / NXCD, r = nwg % NXCD, xcd = wgid % NXCD, off = wgid / NXCD; wgid = (xcd < r ? xcd * (q + 1) : r * (q + 1) + (xcd - r) * q) + off; }
        const int nig = WGM * nN, gid = wgid / nig, fm = gid * WGM, gsz = (nM - fm) < WGM ? (nM - fm) : WGM;
        u.pm = fm + ((wgid % nig) % gsz); u.pn = (wgid % nig) / gsz; u.e = 0; u.kt0 = 0; u.nkt = 0; u.ks = 0; return true;
    }
};


struct GroupedOrder {
    int ts1, ts2, ts3, ts4, ts5, ts6, ts7, NT, nrow, nN, G, c;
    __device__ __forceinline__ static void tail_of(int NT, int nN, int G, int nkt_full, int& NTF, int& S) {
        NTF = NT; S = 1;
        if (nN == 4 && (G % 4) == 0) { const int ntf = ((NT * 4) / G) * (G / 4); const int R = (NT - ntf) * 4; if (R > 0 && ntf > 0 && R * 7 <= G && nkt_full % 14 == 0) { NTF = ntf; S = 7; } }
    }
    __device__ __forceinline__ void init(const unsigned* cnt, int nN_, int G_, int c_, int nkt_full = 0, bool head_only = false) {
        int t[9]; t[0] = 0;
#pragma unroll
        for (int e = 0; e < 8; ++e) t[e + 1] = t[e] + __builtin_amdgcn_readfirstlane((int)((__hip_atomic_load(cnt + e, __ATOMIC_RELAXED, __HIP_MEMORY_SCOPE_AGENT) + 255u) >> 8));
        ts1 = t[1]; ts2 = t[2]; ts3 = t[3]; ts4 = t[4]; ts5 = t[5]; ts6 = t[6]; ts7 = t[7]; NT = t[8]; nN = nN_; G = G_; c = c_; nrow = NT;
        if (head_only) { int ntf, s; tail_of(NT, nN, G, nkt_full, ntf, s); nrow = ntf; }
    }
    __device__ __forceinline__ int expert_of(int j) const { return (j >= ts1) + (j >= ts2) + (j >= ts3) + (j >= ts4) + (j >= ts5) + (j >= ts6) + (j >= ts7); }
    __device__ __forceinline__ bool next(int i, Unit& u) const {
        const int nwg = nrow * nN; const long L = (long)i * G + c; u.kt0 = 0; u.nkt = 0; u.ks = 0; if (L >= nwg) return false;
        int wgid = (int)L; { const int q = nwg / NXCD, r = nwg % NXCD, xcd = wgid % NXCD, off = wgid / NXCD; wgid = (xcd < r ? xcd * (q + 1) : r * (q + 1) + (xcd - r) * q) + off; }
        const int nig = WGM * nN, gid = wgid / nig, fm = gid * WGM, gsz = (nrow - fm) < WGM ? (nrow - fm) : WGM;
        const int j = fm + ((wgid % nig) % gsz); u.pm = j; u.pn = (wgid % nig) / gsz; u.e = expert_of(j); return true;
    }
};
struct TailOrder {
    int ts1, ts2, ts3, ts4, ts5, ts6, ts7, nsub, NTF, nkt, c;
    __device__ __forceinline__ void init(const unsigned* cnt, int G, int c_, int nkt_full) {
        int t[9]; t[0] = 0;
#pragma unroll
        for (int e = 0; e < 8; ++e) t[e + 1] = t[e] + __builtin_amdgcn_readfirstlane((int)((__hip_atomic_load(cnt + e, __ATOMIC_RELAXED, __HIP_MEMORY_SCOPE_AGENT) + 255u) >> 8));
        ts1 = t[1]; ts2 = t[2]; ts3 = t[3]; ts4 = t[4]; ts5 = t[5]; ts6 = t[6]; ts7 = t[7]; int s; GroupedOrder::tail_of(t[8], 4, G, nkt_full, NTF, s);
        nsub = (s == 7) ? (t[8] - NTF) * 28 : 0; nkt = nkt_full / 7; c = c_;
    }
    __device__ __forceinline__ bool next(int i, Unit& u) const {
        if (i > 0 || c >= nsub) return false;
        const int tu = c / 7, ks = c - tu * 7, j = NTF + (tu >> 2); u.pm = j; u.pn = tu & 3; u.e = (j >= ts1) + (j >= ts2) + (j >= ts3) + (j >= ts4) + (j >= ts5) + (j >= ts6) + (j >= ts7);
        u.nkt = nkt; u.kt0 = ks * nkt; u.ks = ks; return true;
    }
};

typedef int i32x4v __attribute__((ext_vector_type(4)));
typedef int i32x8v __attribute__((ext_vector_type(8)));
template <class Epi, class Sched, bool FP8 = false>
__device__ __forceinline__ void gemm_phase(LAS unsigned char* lds, const Gemm g, const Sched& S, const Epi& E) {
    const int tid = threadIdx.x, wid = __builtin_amdgcn_readfirstlane(tid >> 6), lane = tid & 63, wr = wid >> 2, wc = wid & 3, fr = lane & 15, fq = lane >> 4;
    int Kop = g.K; asm volatile("" : "+s"(Kop));
    const int K = Kop, nt = K / BK;
    unsigned voffA[2], voffB[2];
#pragma unroll
    for (int i = 0; i < 2; ++i) { int R, C; stage_rc(tid * 16 + i * 8192, R, C); voffA[i] = (unsigned)(R * g.lda + C) * 2u; voffB[i] = (unsigned)(R * g.ldb + C) * 2u; }
    const size_t kstep = (size_t)(BK * 2);
    const size_t hstepA = (size_t)HALF * g.lda * 2, hstepB = (size_t)HALF * g.ldb * 2;
    const size_t tstepA = 2 * hstepA, tstepB = 2 * hstepB;
    const unsigned ldsw = (unsigned)wid * 1024u;
    const int aoff = lds_byte(wr * 64 + fr, fq * 8), boff = lds_byte(wc * 32 + fr, fq * 8);
#define PG8_SA(b, h) (((b) * 2 + (h)) * HTB)
#define PG8_SB(b, h) ((4 + (b) * 2 + (h)) * HTB)
#define PG8_STAGE(bufoff, gbase, voff) do { _Pragma("unroll") for (int _i = 0; _i < 2; ++_i) \
        __builtin_amdgcn_global_load_lds((const unsigned*)((const char*)(gbase) + (voff)[_i]), (LAS unsigned*)(lds + (bufoff) + ldsw + _i * 8192), 16, 0, 0); } while (0)
#define PG8_LDA(dst, b, h) do { if constexpr (FP8) { _Pragma("unroll") for (int m = 0; m < 4; ++m) dst##8[m] = __builtin_shufflevector(*(const LAS i32x4v*)(lds + PG8_SA(b, h) + aoff + m * 2048), *(const LAS i32x4v*)(lds + PG8_SA(b, h) + aoff + m * 2048 + 1024), 0, 1, 2, 3, 4, 5, 6, 7); } \
        else { _Pragma("unroll") for (int m = 0; m < 4; ++m) _Pragma("unroll") for (int k = 0; k < 2; ++k) dst[m][k] = *(const LAS bf16x8*)(lds + PG8_SA(b, h) + aoff + m * 2048 + k * 1024); } } while (0)
#define PG8_LDB(dst, b, h) do { if constexpr (FP8) { _Pragma("unroll") for (int n = 0; n < 2; ++n) dst##8[n] = __builtin_shufflevector(*(const LAS i32x4v*)(lds + PG8_SB(b, h) + boff + n * 2048), *(const LAS i32x4v*)(lds + PG8_SB(b, h) + boff + n * 2048 + 1024), 0, 1, 2, 3, 4, 5, 6, 7); } \
        else { _Pragma("unroll") for (int n = 0; n < 2; ++n) _Pragma("unroll") for (int k = 0; k < 2; ++k) dst[n][k] = *(const LAS bf16x8*)(lds + PG8_SB(b, h) + boff + n * 2048 + k * 1024); } } while (0)
#define PG8_MMA(ai, bj, At, Bt) do { __builtin_amdgcn_s_setprio(1); \
        if constexpr (FP8) { _Pragma("unroll") for (int m = 0; m < 4; ++m) _Pragma("unroll") for (int n = 0; n < 2; ++n) \
            asm volatile("v_mfma_scale_f32_16x16x128_f8f6f4 %0, %1, %2, %0, %3, %3 op_sel_hi:[0,0,0]" : "+v"(acc[ai][bj][m][n]) : "v"(Bt##8[n]), "v"(At##8[m]), "v"(f8one)); } \
        else { _Pragma("unroll") for (int m = 0; m < 4; ++m) _Pragma("unroll") for (int n = 0; n < 2; ++n) _Pragma("unroll") for (int k = 0; k < 2; ++k) \
            acc[ai][bj][m][n] = __builtin_amdgcn_mfma_f32_16x16x32_bf16(Bt[n][k], At[m][k], acc[ai][bj][m][n], 0, 0, 0); } \
        __builtin_amdgcn_s_setprio(0); } while (0)
#define PG8_WAIT_V(n) asm volatile("s_waitcnt vmcnt(" #n ")" ::: "memory")
#define PG8_WAIT_L(n) asm volatile("s_waitcnt lgkmcnt(" #n ")" ::: "memory")
#define PG8_BAR __builtin_amdgcn_s_barrier()
#define PG8_SCHED __builtin_amdgcn_sched_barrier(0)
    Unit cur, nxt; int ui = 0;
    if (!S.next(0, cur)) return;
    f32x4 acc[2][2][4][2];
#pragma unroll
    for (int a = 0; a < 2; ++a)
#pragma unroll
        for (int b = 0; b < 2; ++b)
#pragma unroll
            for (int m = 0; m < 4; ++m)
#pragma unroll
                for (int n = 0; n < 2; ++n) acc[a][b][m][n] = (f32x4){0.f, 0.f, 0.f, 0.f};
    bf16x8 At[4][2], B0[2][2], B1[2][2];
    i32x8v At8[4], B08[2], B18[2];
    const int f8one = 0x7f7f7f7f;
    const char* cA = (const char*)g.A + (size_t)cur.pm * tstepA + (size_t)cur.kt0 * kstep; const char* cB = (const char*)g.Bt + (size_t)cur.e * g.bstride + (size_t)cur.pn * tstepB + (size_t)cur.kt0 * kstep;
    PG8_STAGE(PG8_SB(0, 0), cB, voffB); PG8_STAGE(PG8_SA(0, 0), cA, voffA); PG8_STAGE(PG8_SB(0, 1), cB + hstepB, voffB); PG8_STAGE(PG8_SA(0, 1), cA + hstepA, voffA);
    if (wr == 1) PG8_BAR;
    PG8_WAIT_V(4); PG8_BAR;
    PG8_STAGE(PG8_SB(1, 0), cB + kstep, voffB); PG8_STAGE(PG8_SA(1, 0), cA + kstep, voffA); PG8_STAGE(PG8_SB(1, 1), cB + hstepB + kstep, voffB);
    PG8_WAIT_V(6); PG8_BAR;
    for (;;) {
        const bool has_next = S.next(ui + 1, nxt);
        const char* nA = has_next ? (const char*)g.A + (size_t)nxt.pm * tstepA + (size_t)nxt.kt0 * kstep : cA; const char* nB = has_next ? (const char*)g.Bt + (size_t)nxt.e * g.bstride + (size_t)nxt.pn * tstepB + (size_t)nxt.kt0 * kstep : cB;
        const int ntc = cur.nkt ? cur.nkt : nt;
        for (int t = 0; t < ntc; t += 2) {
            const bool last = (t == ntc - 2);
            const char* a1 = cA + (size_t)(t + 1) * kstep;
            const char* a2 = last ? nA : cA + (size_t)(t + 2) * kstep; const char* b2 = last ? nB : cB + (size_t)(t + 2) * kstep;
            const char* a3 = a2 + kstep; const char* b3 = b2 + kstep;
            PG8_LDB(B0, 0, 0); PG8_SCHED; PG8_LDA(At, 0, 0); PG8_STAGE(PG8_SA(1, 1), a1 + hstepA, voffA);
            PG8_WAIT_L(8); PG8_BAR; PG8_WAIT_L(0); PG8_MMA(0, 0, At, B0); PG8_BAR; PG8_SCHED;
            PG8_LDB(B1, 0, 1); PG8_STAGE(PG8_SB(0, 0), b2, voffB);
            PG8_BAR; PG8_WAIT_L(0); PG8_MMA(0, 1, At, B1); PG8_BAR;
            PG8_LDA(At, 0, 1); PG8_STAGE(PG8_SA(0, 0), a2, voffA);
            PG8_BAR; PG8_WAIT_L(0); PG8_MMA(1, 0, At, B0); PG8_BAR; PG8_SCHED;
            PG8_STAGE(PG8_SB(0, 1), b2 + hstepB, voffB);
            PG8_WAIT_V(6); PG8_BAR; PG8_MMA(1, 1, At, B1); PG8_BAR;
            PG8_LDB(B0, 1, 0); PG8_SCHED; PG8_LDA(At, 1, 0); PG8_STAGE(PG8_SA(0, 1), a2 + hstepA, voffA);
            PG8_WAIT_L(8); PG8_BAR; PG8_WAIT_L(0); PG8_MMA(0, 0, At, B0); PG8_BAR; PG8_SCHED;
            PG8_LDB(B1, 1, 1); PG8_STAGE(PG8_SB(1, 0), b3, voffB);
            PG8_BAR; PG8_WAIT_L(0); PG8_MMA(0, 1, At, B1); PG8_BAR;
            PG8_LDA(At, 1, 1); PG8_STAGE(PG8_SA(1, 0), a3, voffA);
            PG8_BAR; PG8_WAIT_L(0); PG8_MMA(1, 0, At, B0); PG8_BAR; PG8_SCHED;
            PG8_STAGE(PG8_SB(1, 1), b3 + hstepB, voffB);
            PG8_WAIT_V(6); PG8_BAR; PG8_MMA(1, 1, At, B1); PG8_BAR;
        }
        if constexpr (FP8) asm volatile("s_nop 15\n\ts_nop 15\n\ts_nop 15\n\ts_nop 15" ::: "memory");
        E(acc, cur, wr, wc, fr, fq);
        if (!has_next) break;
#pragma unroll
        for (int a = 0; a < 2; ++a)
#pragma unroll
            for (int b = 0; b < 2; ++b)
#pragma unroll
                for (int m = 0; m < 4; ++m)
#pragma unroll
                    for (int n = 0; n < 2; ++n) acc[a][b][m][n] = (f32x4){0.f, 0.f, 0.f, 0.f};
        cur = nxt; cA = nA; cB = nB; ++ui;
    }
    PG8_WAIT_V(0);
    if (wr == 0) PG8_BAR;
    PG8_BAR;
#undef PG8_SA
#undef PG8_SB
#undef PG8_STAGE
#undef PG8_LDA
#undef PG8_LDB
#undef PG8_MMA
#undef PG8_WAIT_V
#undef PG8_WAIT_L
#undef PG8_BAR
#undef PG8_SCHED
}

__host__ __device__ __forceinline__ int perm256(int rho) { return 64 * ((rho >> 5) & 3) + 16 * ((rho >> 2) & 3) + 8 * (rho >> 7) + 4 * ((rho >> 4) & 1) + (rho & 3); }
#define EPI_ROWS_BEGIN _Pragma("unroll") for (int ai = 0; ai < 2; ++ai) _Pragma("unroll") for (int m = 0; m < 4; ++m) { asm volatile("" ::: "memory"); const int row = u.pm * BM + ai * HALF + wr * 64 + m * 16 + fr;
#define EPI_ROWS_END }
#define EPI_LOOP_BEGIN EPI_ROWS_BEGIN _Pragma("unroll") for (int bj = 0; bj < 2; ++bj) { const int cg = u.pn * BM + bj * HALF + wc * 32;
#define EPI_LOOP_END } }
__device__ __forceinline__ uint4 pack8(const f32x4 a, const f32x4 b) { uint4 p; p.x = pack2(a[0], a[1]); p.y = pack2(a[2], a[3]); p.z = pack2(b[0], b[1]); p.w = pack2(b[2], b[3]); return p; }

struct EpiBf16Plain {
    bf16_t* O; int ldo;
    __device__ __forceinline__ void operator()(const f32x4 (&acc)[2][2][4][2], const Unit& u, int wr, int wc, int fr, int fq) const {
        EPI_ROWS_BEGIN
            uint4* p = (uint4*)(O + (size_t)row * ldo + u.pn * BM + 64 * wc + 16 * fq);
            p[0] = pack8(acc[ai][0][m][0], acc[ai][0][m][1]); p[1] = pack8(acc[ai][1][m][0], acc[ai][1][m][1]);
        EPI_ROWS_END
    }
};
struct EpiSwiglu {
    bf16_t* O; int ldo;
    __device__ __forceinline__ void operator()(const f32x4 (&acc)[2][2][4][2], const Unit& u, int wr, int wc, int fr, int fq) const {
        EPI_ROWS_BEGIN
            f32x4 h0, h1;
#pragma unroll
            for (int i = 0; i < 4; ++i) { h0[i] = silu_f(acc[ai][0][m][0][i]) * acc[ai][0][m][1][i]; h1[i] = silu_f(acc[ai][1][m][0][i]) * acc[ai][1][m][1][i]; }
            *(uint4*)(O + (size_t)row * ldo + u.pn * 128 + 32 * wc + 8 * fq) = pack8(h0, h1);
        EPI_ROWS_END
    }
};
struct EpiSwigluF8 {
    unsigned char* O; int ldo;
    __device__ __forceinline__ void operator()(const f32x4 (&acc)[2][2][4][2], const Unit& u, int wr, int wc, int fr, int fq) const {
        constexpr float inv = 1.f / F8_WSCALE;
        EPI_ROWS_BEGIN
            float h[8];
#pragma unroll
            for (int i = 0; i < 4; ++i) { h[i] = silu_f(acc[ai][0][m][0][i] * inv) * (acc[ai][0][m][1][i] * (inv * F8_HSCALE)); h[4 + i] = silu_f(acc[ai][1][m][0][i] * inv) * (acc[ai][1][m][1][i] * (inv * F8_HSCALE)); }
#pragma unroll
            for (int i = 0; i < 8; ++i) h[i] = __builtin_amdgcn_fmed3f(h[i], -448.f, 448.f);
            uint2 p; p.x = pack4_fp8(h[0], h[1], h[2], h[3]); p.y = pack4_fp8(h[4], h[5], h[6], h[7]);
            *(uint2*)(O + (size_t)row * ldo + u.pn * 128 + 32 * wc + 8 * fq) = p;
        EPI_ROWS_END
    }
};
struct EpiMoeOut {
    bf16_t* MOUT; const uint2* RIW; float oscale;
    __device__ __forceinline__ void operator()(const f32x4 (&acc)[2][2][4][2], const Unit& u, int wr, int wc, int fr, int fq) const {
        EPI_ROWS_BEGIN
            const uint2 iw = RIW[row]; const int info = (int)iw.x; const float gw = __uint_as_float(iw.y) * oscale;
            if (info >= 0) { uint4* p = (uint4*)(MOUT + ((size_t)(info & 1) * TL + (size_t)(info >> 1)) * 1024 + u.pn * BM + 64 * wc + 16 * fq);
                p[0] = pack8(acc[ai][0][m][0] * gw, acc[ai][0][m][1] * gw); p[1] = pack8(acc[ai][1][m][0] * gw, acc[ai][1][m][1] * gw); }
        EPI_ROWS_END
    }
};
struct EpiXtr {
    bf16_t* MOUT; const uint2* RIW; bf16_t* XTR; int NTF, S; float oscale;
    __device__ __forceinline__ void operator()(const f32x4 (&acc)[2][2][4][2], const Unit& u, int wr, int wc, int fr, int fq) const {
        const bool k0 = (u.ks == 0); const int stride = k0 ? 1024 : 256;
        bf16_t* base = (k0 ? MOUT + u.pn * BM : XTR + (size_t)(((u.pm - NTF) * 4 + u.pn) * (S - 1) + (u.ks - 1)) * 65536) + 64 * wc + 16 * fq;
        EPI_ROWS_BEGIN
            const uint2 iw = RIW[row]; const int info = (int)iw.x; const float gw = __uint_as_float(iw.y) * oscale;
            const int ridx = k0 ? ((info & 1) * TL + (info >> 1)) : (row & 255);
            if (info >= 0 || !k0) { uint4* p = (uint4*)(base + (size_t)ridx * stride); p[0] = pack8(acc[ai][0][m][0] * gw, acc[ai][0][m][1] * gw); p[1] = pack8(acc[ai][1][m][0] * gw, acc[ai][1][m][1] * gw); }
        EPI_ROWS_END
    }
};
struct EpiTailBf16 {
    bf16_t* O; int ldo; bf16_t* XT; int NTF, S;
    __device__ __forceinline__ void operator()(const f32x4 (&acc)[2][2][4][2], const Unit& u, int wr, int wc, int fr, int fq) const {
        const bool k0 = (u.ks == 0); const int stride = k0 ? ldo : 256;
        bf16_t* base = (k0 ? O + u.pn * BM : XT + (size_t)(((u.pm - NTF) * 4 + u.pn) * (S - 1) + (u.ks - 1)) * 65536) + 64 * wc + 16 * fq;
        EPI_ROWS_BEGIN
            uint4* p = (uint4*)(base + (size_t)(k0 ? row : (row & 255)) * stride);
            p[0] = pack8(acc[ai][0][m][0], acc[ai][0][m][1]); p[1] = pack8(acc[ai][1][m][0], acc[ai][1][m][1]);
        EPI_ROWS_END
    }
};
template <int S> struct DenseTailOrder {
    int NTF, nsub, nkt, G, c;
    __device__ __forceinline__ void init(int NTF_, int NTT, int nkt_full, int G_, int c_) { NTF = NTF_; nsub = NTT * 4 * S; int k = nkt_full / S; asm volatile("" : "+s"(k)); nkt = k; G = G_; c = c_; }
    __device__ __forceinline__ bool next(int i, Unit& u) const {
        const int L = i * G + c; if (L >= nsub) return false;
        const int tu = L / S, ks = L - tu * S; u.pm = NTF + (tu >> 2); u.pn = tu & 3; u.e = 0; u.nkt = nkt; u.kt0 = ks * nkt; u.ks = ks; return true;
    }
};
struct EpiQ {
    bf16_t* QM; const float* SQ; const float* cosT; const float* sinT; float qscale;
    __device__ __forceinline__ void operator()(const f32x4 (&acc)[2][2][4][2], const Unit& u, int wr, int wc, int fr, int fq) const {
        EPI_LOOP_BEGIN
            const float s = SQ[row] * qscale; f32x4 v0 = acc[ai][bj][m][0] * s, v1 = acc[ai][bj][m][1] * s;
            if ((cg % 96) == 64) { const int pos = row & (SEQ - 1); const f32x4 c = *(const f32x4*)(cosT + pos * 16 + 4 * fq), sn = *(const f32x4*)(sinT + pos * 16 + 4 * fq);
                const f32x4 o0 = v0 * c - v1 * sn, o1 = v1 * c + v0 * sn; v0 = o0; v1 = o1; }
            uint2 p; p.x = pack2(v0[0], v0[1]); p.y = pack2(v0[2], v0[3]); *(uint2*)(QM + (size_t)row * 768 + cg + 4 * fq) = p;
            p.x = pack2(v1[0], v1[1]); p.y = pack2(v1[2], v1[3]); *(uint2*)(QM + (size_t)row * 768 + cg + 16 + 4 * fq) = p;
        EPI_LOOP_END
    }
};
struct EpiK {
    bf16_t* KM; const float* SKV;
    __device__ __forceinline__ void operator()(const f32x4 (&acc)[2][2][4][2], const Unit& u, int wr, int wc, int fr, int fq) const {
        EPI_ROWS_BEGIN
            const float s = SKV[row]; const int b = row < TL ? (row >> 11) : ((row - TL) >> 8), key = row < TL ? CTXL + (row & (SEQ - 1)) : ((row - TL) & (CTXL - 1));
            const int c = u.pn * BM + 64 * wc + 16 * fq, h = c >> 6, d = c & 63;
            uint4* p = (uint4*)(KM + ((size_t)b * NKEY + key) * 768 + h * 96 + d);
            p[0] = pack8(acc[ai][0][m][0] * s, acc[ai][0][m][1] * s); p[1] = pack8(acc[ai][1][m][0] * s, acc[ai][1][m][1] * s);
        EPI_ROWS_END
    }
};
struct EpiVT {
    bf16_t* VT; const float* SKV;
    __device__ __forceinline__ void operator()(const f32x4 (&acc)[2][2][4][2], const Unit& u, int wr, int wc, int fr, int fq) const {
        EPI_LOOP_BEGIN
#pragma unroll
            for (int n = 0; n < 2; ++n) { const int tok = cg + 16 * n + 4 * fq; const f32x4 s = *(const f32x4*)(SKV + tok); const f32x4 v = acc[ai][bj][m][n] * s;
                const int b = tok < TL ? (tok >> 11) : ((tok - TL) >> 8), key = tok < TL ? CTXL + (tok & (SEQ - 1)) : ((tok - TL) & (CTXL - 1));
                uint2 p; p.x = pack2(v[0], v[1]); p.y = pack2(v[2], v[3]); *(uint2*)(VT + ((size_t)b * 512 + row) * NKEY + key) = p; }
        EPI_LOOP_END
    }
};
}


#define XB_TMO      128
#define XB_XCNT(j)  (256  + 64 * (j))
#define XB_XSUB(j)  (1280 + 64 * (j))
#define XB_XGEN(j)  (2304 + 64 * (j))
#define XB_TOP      3328
#define XB_TOPGEN   3392
#define XCD_BAR_WORDS 3456
#define XB_SPIN_CAP (1u << 18)
__device__ __forceinline__ unsigned xb_ld(unsigned* p)              { return __hip_atomic_load(p, __ATOMIC_RELAXED, __HIP_MEMORY_SCOPE_AGENT); }
__device__ __forceinline__ unsigned xb_add(unsigned* p, unsigned v) { return __hip_atomic_fetch_add(p, v, __ATOMIC_RELAXED, __HIP_MEMORY_SCOPE_AGENT); }
__device__ __forceinline__ unsigned xb_xcc_id() { return (unsigned)__builtin_amdgcn_s_getreg((3 << 11) | 20) & 0xFu; }
#define XB_SPIN(cond, bar) do { unsigned _sp = 0; while (cond) { __builtin_amdgcn_s_sleep(1); \
    if ((++_sp & 255u) == 0u) { if (xb_ld(&(bar)[XB_TMO])) break; if (_sp > XB_SPIN_CAP) { atomicAdd(&(bar)[XB_TMO], 1u); break; } } } } while (0)
struct XcdBarrier { unsigned* bar; unsigned x; volatile LAS unsigned* st; };
__device__ __forceinline__ XcdBarrier xcd_barrier_post(unsigned* bar, volatile LAS unsigned* st) {
    XcdBarrier b; b.bar = bar; b.x = xb_xcc_id(); b.st = st;
    if (threadIdx.x == 0) (void)xb_add(&bar[XB_XCNT(b.x)], 1u);
    return b;
}
__device__ __forceinline__ void xcd_barrier_complete(unsigned* bar, unsigned x, unsigned& nloc, unsigned& nx) {
    const unsigned G = gridDim.x * gridDim.y * gridDim.z;
    unsigned sum, cnt, mine, sp = 0u;
    for (;;) {
        sum = 0u; cnt = 0u; mine = 0u;
#pragma unroll
        for (unsigned j = 0; j < 16; ++j) { const unsigned c = xb_ld(&bar[XB_XCNT(j)]); sum += c; cnt += (c > 0u) ? 1u : 0u; mine = (j == x) ? c : mine; }
        if (sum == G) break;
        __builtin_amdgcn_s_sleep(1);
        if ((++sp & 255u) == 0u) { if (xb_ld(&bar[XB_TMO])) break; if (sp > XB_SPIN_CAP) { atomicAdd(&bar[XB_TMO], 1u); break; } }
    }
    nloc = mine > 0u ? mine : 1u; nx = cnt > 0u ? cnt : 1u;
}
__device__ __forceinline__ void xcd_barrier(const XcdBarrier& b) {
    asm volatile("s_waitcnt vmcnt(0)" ::: "memory");
    __syncthreads();
    if (threadIdx.x == 0) {
        unsigned* bar = b.bar;
        __builtin_amdgcn_s_waitcnt(0);
        unsigned nloc = b.st[0], nx = b.st[1];
        if (nloc == 0u) { xcd_barrier_complete(bar, b.x, nloc, nx); b.st[0] = nloc; b.st[1] = nx; }
        const unsigned old = xb_add(&bar[XB_XSUB(b.x)], 1u);
        const unsigned gen = old / nloc;
        if (old + 1u == (gen + 1u) * nloc) {
            __builtin_amdgcn_fence(__ATOMIC_RELEASE, "agent");
            asm volatile("s_waitcnt vmcnt(0)" ::: "memory");
            const unsigned og = xb_add(&bar[XB_TOP], 1u);
            const unsigned tg = og / nx;
            if (og + 1u == (tg + 1u) * nx) xb_add(&bar[XB_TOPGEN], 1u);
            else XB_SPIN(xb_ld(&bar[XB_TOPGEN]) == tg, bar);
            __builtin_amdgcn_fence(__ATOMIC_ACQUIRE, "agent");
            xb_add(&bar[XB_XGEN(b.x)], 1u);
            asm volatile("s_waitcnt vmcnt(0)" ::: "memory");
        } else {
            XB_SPIN(xb_ld(&bar[XB_XGEN(b.x)]) == gen, bar);
            __builtin_amdgcn_fence(__ATOMIC_ACQUIRE, "agent");
            asm volatile("s_waitcnt vmcnt(0)" ::: "memory");
        }
    }
    __syncthreads();
}
#define XB_OVERLAP_ARRIVE(b, gen) do { \
    asm volatile("s_waitcnt vmcnt(0)" ::: "memory"); \
    __syncthreads(); \
    if (threadIdx.x == 0) { \
        unsigned* bar_ = (b).bar; \
        __builtin_amdgcn_s_waitcnt(0); \
        unsigned nloc = (b).st[0], nx = (b).st[1]; \
        if (nloc == 0u) { xcd_barrier_complete(bar_, (b).x, nloc, nx); (b).st[0] = nloc; (b).st[1] = nx; } \
        const unsigned old = xb_add(&bar_[XB_XSUB((b).x)], 1u); \
        gen = old / nloc; \
        if (old + 1u == (gen + 1u) * nloc) { \
            __builtin_amdgcn_fence(__ATOMIC_RELEASE, "agent"); \
            asm volatile("s_waitcnt vmcnt(0)" ::: "memory"); \
            const unsigned og = xb_add(&bar_[XB_TOP], 1u); \
            const unsigned tg = og / nx; \
            xb_add(&bar_[XB_XGEN((b).x)], 1u); \
            if (og + 1u == (tg + 1u) * nx) xb_add(&bar_[XB_TOPGEN], 1u); \
        } \
    } } while (0)
#define XB_OVERLAP_WAIT(b, gen) do { \
    if (threadIdx.x == 0) { \
        unsigned* bar_ = (b).bar; \
        XB_SPIN(xb_ld(&bar_[XB_TOPGEN]) == gen, bar_); \
        __builtin_amdgcn_fence(__ATOMIC_ACQUIRE, "agent"); \
        asm volatile("s_waitcnt vmcnt(0)" ::: "memory"); \
    } \
    __syncthreads(); } while (0)

struct Args { const float* in[41]; float* out; unsigned char* ws; int ph_lo, ph_hi, ex, pad; };
enum { I_X = 0, I_C, I_CTX, I_CCTX, I_ADAW, I_ADAB, I_MIXPRE, I_MIXPOST, I_FFNPRE, I_FFNPOST, I_EVWIN, I_HYCW, I_HYCB, I_FW1, I_FB1, I_FW2, I_FB2, I_FW3, I_FREQ, I_HYBIAS,
       I_SCW, I_SCB, I_DTB, I_ALOG, I_SSMD, I_SSMNG, I_EVWOUT, I_FFNG, I_FFNU, I_FFND, I_ODWIN, I_QNG, I_QUP, I_KVNG, I_KVUP, I_SINK, I_ODWOUT, I_ROUTER, I_MOEG, I_MOEU, I_MOED };

struct Fr {
    const float* const* in; float* out; unsigned char* ws; unsigned char* lds; int tid, lane, wave, G, bid;
    template <class T> __device__ __forceinline__ T* w(size_t off) const { return (T*)(ws + off); }
};

__device__ __forceinline__ int colmap(int mode, int perm, int r, int nsrc, int& which) {
    which = 0;
    if (mode == 1) { const int tile = r >> 8, rho = r & 255, bj = rho >> 7, wc = (rho >> 5) & 3, n = (rho >> 4) & 1, fq = (rho >> 2) & 3, i = rho & 3; which = n; return 128 * tile + 32 * wc + 8 * fq + 4 * bj + i; }
    const int c = perm ? ((r & ~255) + pg8::perm256(r & 255)) : r;
    if (mode == 0) return c < nsrc ? c : -1;
    return (c >> 6) * 128 + (c & 63) + (mode == 3 ? 64 : 0);
}
__device__ __forceinline__ void cvt_job(const Fr& F, const float* srcA, const float* srcB, const float* kscale, bf16_t* dst, int nrows, int kdst, int ksrc, int ldsrc, int nsrc, int mode, int perm, int t0, int tstride) {
    float* tile = (float*)F.lds;
    const int nrt = nrows / 256, ntiles = nrt * (kdst / 64);
    const int kk = F.tid >> 6, rq = F.tid & 63;
    float4 v[8];
#define CVT_LOAD(t) do { const int r0 = ((t) % nrt) * 256, k0 = ((t) / nrt) * 64; int which; const int col = colmap(mode, perm, r0 + rq * 4, nsrc, which); const float* src = which ? srcB : srcA; \
        _Pragma("unroll") for (int p = 0; p < 8; ++p) { const int k = k0 + p * 8 + kk; v[p] = make_float4(0.f, 0.f, 0.f, 0.f); \
            if (col >= 0 && k < ksrc) { v[p] = *(const float4*)(src + (size_t)k * ldsrc + col); if (kscale) { const float ks = kscale[k]; v[p].x *= ks; v[p].y *= ks; v[p].z *= ks; v[p].w *= ks; } } } } while (0)
    int t = t0;
    if (t < ntiles) CVT_LOAD(t);
    while (t < ntiles) {
        const int r0 = (t % nrt) * 256, k0 = (t / nrt) * 64;
        __syncthreads();
#pragma unroll
        for (int p = 0; p < 8; ++p) *(float4*)(tile + (p * 8 + kk) * 260 + rq * 4) = v[p];
        const int tn = t + tstride;
        if (tn < ntiles) CVT_LOAD(tn);
        __syncthreads();
        { const int r2 = F.tid >> 1, kq = F.tid & 1; const float* tp = tile + (kq * 32) * 260 + r2; uint4* dp = (uint4*)(dst + (size_t)(r0 + r2) * kdst + k0 + kq * 32);
#pragma unroll
          for (int q = 0; q < 4; ++q) { uint4 o; o.x = pack2(tp[(8 * q + 0) * 260], tp[(8 * q + 1) * 260]); o.y = pack2(tp[(8 * q + 2) * 260], tp[(8 * q + 3) * 260]);
              o.z = pack2(tp[(8 * q + 4) * 260], tp[(8 * q + 5) * 260]); o.w = pack2(tp[(8 * q + 6) * 260], tp[(8 * q + 7) * 260]); dp[q] = o; } }
        t = tn;
    }
#undef CVT_LOAD
    __syncthreads();
}

constexpr int CVT_T_GU = 28 * 16, CVT_T_DN = 4 * 56, CVT_T_E = CVT_T_GU + CVT_T_DN, CVT_T_ALL = NEXP * CVT_T_E;
__device__ __forceinline__ int cvt_wmap(int w) { return w < NEXP * CVT_T_GU ? (w / CVT_T_GU) * CVT_T_E + w % CVT_T_GU : ((w - NEXP * CVT_T_GU) / CVT_T_DN) * CVT_T_E + CVT_T_GU + (w - NEXP * CVT_T_GU) % CVT_T_DN; }
template <bool WMAP> __device__ __forceinline__ void cvt_moe_range(const Fr& F, int g_begin, int g_end, int rank, int stride) {
    float* tile = (float*)F.lds;
    const int kk = F.tid >> 6, rq = F.tid & 63;
    float4 va[8], vb[8];
#define CVM_DECODE(g) const int _g = WMAP ? cvt_wmap(g) : (g); const int _e = _g / CVT_T_E, _r = _g % CVT_T_E; const bool _gu = _r < CVT_T_GU; const int _rr = _gu ? _r : _r - CVT_T_GU; \
        const int _nkt = _gu ? 16 : 56; const int k0 = (_rr % _nkt) * 64, r0 = (_rr / _nkt) * 256;     const int ldsrc = _gu ? DFE : 1024, kdst = _gu ? 1024 : DFE; \
        const float* srcA = _gu ? F.in[I_MOEG] + (size_t)_e * 1024 * DFE : F.in[I_MOED] + (size_t)_e * DFE * 1024; const float* srcB = F.in[I_MOEU] + (size_t)_e * 1024 * DFE; \
        unsigned char* dst = _gu ? F.w<unsigned char>(WM_GU) + (size_t)_e * 2 * DFE * 1024 * (MOE_FP8 ? 1 : 2) : F.w<unsigned char>(WM_DN) + (size_t)_e * 1024 * DFE * (MOE_FP8 ? 1 : 2);
#define CVM_LOAD(g, v) do { CVM_DECODE(g) (void)dst; (void)kdst; int which; const int col = colmap(_gu ? 1 : 0, 1, r0 + rq * 4, _gu ? DFE : 1024, which); const float* src = which ? srcB : srcA; \
        _Pragma("unroll") for (int p = 0; p < 8; ++p) { const int k = k0 + p * 8 + kk; v[p] = *(const float4*)(src + (size_t)k * ldsrc + col); } } while (0)
#define CVM_STEP(g, v) do { __syncthreads(); \
        _Pragma("unroll") for (int p = 0; p < 8; ++p) { float4 _t; _t.x = v[p].x; _t.y = v[p].y; _t.z = v[p].z; _t.w = v[p].w; *(float4*)(tile + (p * 8 + kk) * 260 + rq * 4) = _t; } \
        if ((g) + 2 * stride < g_end) CVM_LOAD((g) + 2 * stride, v); \
        __syncthreads(); \
        { CVM_DECODE(g) (void)srcA; (void)srcB; (void)ldsrc; const int r2 = F.tid >> 1, kq = F.tid & 1; const float* tp = tile + (kq * 32) * 260 + r2; \
          if (MOE_FP8) { uint4* dp = (uint4*)(dst + (size_t)(r0 + r2) * kdst + k0 + kq * 32); \
            _Pragma("unroll") for (int q = 0; q < 2; ++q) { uint4 o; \
              o.x = pack4_fp8(tp[(16 * q + 0) * 260] * F8_WSCALE, tp[(16 * q + 1) * 260] * F8_WSCALE, tp[(16 * q + 2) * 260] * F8_WSCALE, tp[(16 * q + 3) * 260] * F8_WSCALE); \
              o.y = pack4_fp8(tp[(16 * q + 4) * 260] * F8_WSCALE, tp[(16 * q + 5) * 260] * F8_WSCALE, tp[(16 * q + 6) * 260] * F8_WSCALE, tp[(16 * q + 7) * 260] * F8_WSCALE); \
              o.z = pack4_fp8(tp[(16 * q + 8) * 260] * F8_WSCALE, tp[(16 * q + 9) * 260] * F8_WSCALE, tp[(16 * q + 10) * 260] * F8_WSCALE, tp[(16 * q + 11) * 260] * F8_WSCALE); \
              o.w = pack4_fp8(tp[(16 * q + 12) * 260] * F8_WSCALE, tp[(16 * q + 13) * 260] * F8_WSCALE, tp[(16 * q + 14) * 260] * F8_WSCALE, tp[(16 * q + 15) * 260] * F8_WSCALE); dp[q] = o; } } \
          else { uint4* dp = (uint4*)(dst + ((size_t)(r0 + r2) * kdst + k0 + kq * 32) * 2); \
          _Pragma("unroll") for (int q = 0; q < 4; ++q) { uint4 o; o.x = pack2(tp[(8 * q + 0) * 260], tp[(8 * q + 1) * 260]); o.y = pack2(tp[(8 * q + 2) * 260], tp[(8 * q + 3) * 260]); \
              o.z = pack2(tp[(8 * q + 4) * 260], tp[(8 * q + 5) * 260]); o.w = pack2(tp[(8 * q + 6) * 260], tp[(8 * q + 7) * 260]); dp[q] = o; } } } } while (0)
    int g = g_begin + rank;
    if (g < g_end) CVM_LOAD(g, va);
    if (g + stride < g_end) CVM_LOAD(g + stride, vb);
    while (g < g_end) {
        CVM_STEP(g, va);
        g += stride; if (g >= g_end) break;
        CVM_STEP(g, vb);
        g += stride;
    }
#undef CVM_STEP
#undef CVM_LOAD
#undef CVM_DECODE
    __syncthreads();
}
constexpr int CVW_Q = 2, CVW_NWIN = 11;
__device__ __forceinline__ void cvt_window(const Fr& F, int win) {
    const int w0 = win * CVW_Q * F.G, w1 = w0 + CVW_Q * F.G;
    cvt_moe_range<true>(F, w0 < CVT_T_ALL ? w0 : CVT_T_ALL, w1 < CVT_T_ALL ? w1 : CVT_T_ALL, F.bid, F.G);
}

constexpr int CVD_T_ALL = 64 + 512 + 256 + 80 + 12 + 8 + 8 + 64, CVD_NWIN = 4;
__device__ __forceinline__ void cvt_dense_tile(const Fr& F, int d) {
    if (d < 64) { cvt_job(F, F.in[I_EVWOUT], nullptr, nullptr, F.w<bf16_t>(W_OUT0), 1024, 1024, 1024, 1024, 1024, 0, 1, d, 1 << 20); return; } d -= 64;
    if (d < 512) { cvt_job(F, F.in[I_FFNG], F.in[I_FFNU], nullptr, F.w<bf16_t>(W_GU0), 2 * DFF, 1024, 1024, DFF, DFF, 1, 1, d, 1 << 20); return; } d -= 512;
    if (d < 256) { cvt_job(F, F.in[I_FFND], nullptr, nullptr, F.w<bf16_t>(W_DN0), 1024, DFF, DFF, 1024, 1024, 0, 1, d, 1 << 20); return; } d -= 256;
    if (d < 80) { cvt_job(F, F.in[I_ODWIN], nullptr, nullptr, F.w<bf16_t>(W_IN1), ODD_PAD, 1024, 1024, 1184, 1184, 0, 1, d, 1 << 20); return; } d -= 80;
    if (d < 12) { cvt_job(F, F.in[I_QUP], nullptr, F.in[I_QNG], F.w<bf16_t>(W_QUP), 768, 256, 256, 768, 768, 0, 0, d, 1 << 20); return; } d -= 12;
    if (d < 8) { cvt_job(F, F.in[I_KVUP], nullptr, F.in[I_KVNG], F.w<bf16_t>(W_KUP), 512, 256, 128, 1024, 1024, 2, 1, d, 1 << 20); return; } d -= 8;
    if (d < 8) { cvt_job(F, F.in[I_KVUP], nullptr, F.in[I_KVNG], F.w<bf16_t>(W_VUP), 512, 256, 128, 1024, 1024, 3, 0, d, 1 << 20); return; } d -= 8;
    if (d < 64) cvt_job(F, F.in[I_ODWOUT], nullptr, nullptr, F.w<bf16_t>(W_OUT1), 1024, 1024, 1024, 1024, 1024, 0, 1, d, 1 << 20);
}
__device__ __forceinline__ void cvt_dense_range(const Fr& F, int d0, int d1) { for (int d = d0 + F.bid; d < d1; d += F.G) cvt_dense_tile(F, d); }
__device__ __forceinline__ void cvt_dense_window(const Fr& F, int win) {
    const int q = (CVD_T_ALL + CVD_NWIN * F.G - 1) / (CVD_NWIN * F.G), d0 = win * q * F.G, d1 = d0 + q * F.G;
    cvt_dense_range(F, d0 < CVD_T_ALL ? d0 : CVD_T_ALL, d1 < CVD_T_ALL ? d1 : CVD_T_ALL);
}

__device__ __forceinline__ void ph_ada(const Fr& F) {
    float* sc = (float*)F.lds;
    float* part = sc + 9 * 1024;
    for (int i = F.tid; i < 9 * 1024; i += NTHR) { const int r = i >> 10, k = i & 1023; const float v = r < 8 ? F.in[I_C][r * 1024 + k] : F.in[I_CCTX][k]; sc[i] = silu_f(v); }
    __syncthreads();
    float* MOD = F.w<float>(WS_MOD);
    for (int un = F.bid; un < 2 * 6144 / 64; un += F.G) {
        const int j = un * 64 + F.lane, l = j / 6144, jj = j % 6144; const float* wp = F.in[I_ADAW] + (size_t)l * 1024 * 6144 + (size_t)(F.wave * 128) * 6144 + jj;
        float acc[9];
#pragma unroll
        for (int r = 0; r < 9; ++r) acc[r] = 0.f;
#pragma unroll 16
        for (int k = 0; k < 128; ++k) { const float wv = wp[(size_t)k * 6144];
#pragma unroll
            for (int r = 0; r < 9; ++r) acc[r] += sc[r * 1024 + F.wave * 128 + k] * wv; }
#pragma unroll
        for (int r = 0; r < 9; ++r) part[(F.wave * 9 + r) * 64 + F.lane] = acc[r];
        __syncthreads();
        for (int o = F.tid; o < 9 * 64; o += NTHR) { const int r = o >> 6, cix = o & 63; float sum = 0.f;
#pragma unroll
            for (int w2 = 0; w2 < 8; ++w2) sum += part[(w2 * 9 + r) * 64 + cix];
            const int j2 = un * 64 + cix, l2 = j2 / 6144, jj2 = j2 % 6144; MOD[(size_t)(l2 * 9 + r) * 6144 + jj2] = sum + F.in[I_ADAB][l2 * 6144 + jj2]; }
        __syncthreads();
    }
}
__device__ __forceinline__ void ph_filters(const Fr& F) {
    constexpr int NPB = 12;
    float* w1s = (float*)F.lds;
    float* w2s = w1s + 33 * 64;
    float* zs = w2s + 64 * 64;
    float* h1 = zs + NPB * 36;
    float* h2 = h1 + NPB * 64;
    const float* w3 = F.in[I_FW3]; const float* fqv = F.in[I_FREQ]; const float* hb = F.in[I_HYBIAS];
    for (int i = F.tid; i < 33 * 64; i += NTHR) w1s[i] = F.in[I_FW1][i];
    for (int i = F.tid; i < 64 * 64; i += NTHR) w2s[i] = F.in[I_FW2][i];
    const int total = SEQ + CTXL; int np = 0; for (int it = F.bid; it < total && np < NPB; it += F.G) ++np;
    for (int i = F.tid; i < np * 33; i += NTHR) { const int pi = i / 33, zi = i % 33, item = F.bid + pi * F.G; const int n = item < SEQ ? SEQ : CTXL, pos = item < SEQ ? item : item - SEQ;
        const float fpos = (float)pos, t = fpos / (float)(n - 1), omega = (6.283185307179586f * fpos) / (float)n; float v;
        if (zi == 0) v = t; else { const int bi = (zi - 1) & 15; const float band = 1e-4f + (float)bi * ((15.f - 1e-4f) / 15.f); const float a = omega * band; v = (zi <= 16) ? cosf(a) : -sinf(a); }
        zs[pi * 36 + zi] = v; }
    __syncthreads();
    for (int i = F.tid; i < np * 64; i += NTHR) { const int pi = i >> 6, j = i & 63; float a = F.in[I_FB1][j]; for (int k = 0; k < 33; ++k) a += zs[pi * 36 + k] * w1s[k * 64 + j]; h1[i] = sinf(fqv[j] * a); }
    __syncthreads();
    for (int i = F.tid; i < np * 64; i += NTHR) { const int pi = i >> 6, j = i & 63; float a = F.in[I_FB2][j]; for (int k = 0; k < 64; ++k) a += h1[pi * 64 + k] * w2s[k * 64 + j]; h2[i] = sinf(fqv[j] * a); }
    __syncthreads();
#pragma unroll 1
    for (int oo = 0; oo < 2; ++oo) { const int o = F.tid + 512 * oo; float acc[NPB];
#pragma unroll
        for (int pi = 0; pi < NPB; ++pi) acc[pi] = 0.f;
        for (int k = 0; k < 64; ++k) { const float wv = w3[k * 1024 + o];
#pragma unroll
            for (int pi = 0; pi < NPB; ++pi) acc[pi] += h2[pi * 64 + k] * wv; }
        const int dir = o >> 9, c = o & 511; const float a0 = -3.0701134573253945f, b0 = -15.350567286626973f; const float delta = fabsf(a0 + (float)c * ((b0 - a0) / 511.f));
#pragma unroll
        for (int pi = 0; pi < NPB; ++pi) if (pi < np) { const int item = F.bid + pi * F.G; const int n = item < SEQ ? SEQ : CTXL, pos = item < SEQ ? item : item - SEQ; const float t = (float)pos / (float)(n - 1);
            bf16_t* Rd = (n == SEQ) ? F.w<bf16_t>(L0_FL) : F.w<bf16_t>(L0_FC); const int n2 = 2 * n; const float val = acc[pi] * expf(-t * delta);
            if (dir == 0) Rd[(size_t)c * n2 + (n - pos)] = f2bf(val + (pos == 0 ? hb[c] : 0.f)); else if (pos > 0) Rd[(size_t)c * n2 + (n + pos)] = f2bf(val); }
    }
    __syncthreads();
}
__device__ __forceinline__ void ph_rope_tables(const Fr& F) {
    float* cm = F.w<float>(WS_ROPEM); float* sm = cm + 2048 * 16; float* cgq = F.w<float>(WS_ROPEG); float* sg = cgq + 2048 * 32;
    for (int idx = F.bid * NTHR + F.tid; idx < 2048 * 16; idx += F.G * NTHR) { const int pos = idx >> 4, i = idx & 15; const float inv = powf(10000.f, -(float)(i & 7) / 8.f);
        const float p = (i < 8) ? (float)(pos >> 6) : (float)(pos & 63); const float ang = p * inv; cm[idx] = cosf(ang); sm[idx] = sinf(ang); }
    for (int idx = F.bid * NTHR + F.tid; idx < 2048 * 32; idx += F.G * NTHR) { const int pos = idx >> 5, i = idx & 31; const float inv = powf(10000.f, -(float)(i & 15) / 16.f);
        const float p = (i < 16) ? (float)(pos >> 6) : (float)(pos & 63); const float ang = p * inv; cgq[idx] = cosf(ang); sg[idx] = sinf(ang); }
}

__device__ __forceinline__ void store_bf16x4(bf16_t* p, float4 v) { uint2 q; q.x = pack2(v.x, v.y); q.y = pack2(v.z, v.w); *(uint2*)p = q; }
__device__ __forceinline__ float4 ld4(const float* p) { return *(const float4*)p; }
__device__ __forceinline__ float sumsq4(const float4 (&v)[4]) { float s = 0.f;
#pragma unroll
    for (int i = 0; i < 4; ++i) s += v[i].x * v[i].x + v[i].y * v[i].y + v[i].z * v[i].z + v[i].w * v[i].w;
    return s; }

struct RowSched { int b, k0, WPB, NW, gw, nlat, ntot;
    __device__ __forceinline__ void init(int G, int bid, int wave, int nrows) { NW = G * 8; gw = bid * 8 + wave; WPB = NW / 8; b = gw / WPB; k0 = gw % WPB;
        nlat = (SEQ - k0 + WPB - 1) / WPB; const int nctx = (nrows > TL && gw < TC) ? (TC - gw + NW - 1) / NW : 0; ntot = nlat + nctx; }
    __device__ __forceinline__ int row_at(int s) const { return s < nlat ? b * SEQ + k0 + WPB * s : TL + gw + NW * (s - nlat); }
};
__device__ __forceinline__ void ph_norm0(const Fr& F) {
    const float* g = F.in[I_MIXPRE]; const float* MOD = F.w<float>(WS_MOD); bf16_t* A = F.w<bf16_t>(WS_ABUF);
    RowSched RS; RS.init(F.G, F.bid, F.wave, TT);
    float4 gv[4], shv[4], scv[4]; int mr_cur = -1;
#pragma unroll
    for (int i = 0; i < 4; ++i) gv[i] = ld4(g + 4 * (F.lane + 64 * i));
    for (int si = 0; si < RS.ntot; si += 2) {
        const int row0 = RS.row_at(si); const bool has1 = si + 1 < RS.ntot; const int row1 = has1 ? RS.row_at(si + 1) : row0; const int r1 = row1;
        const float* s0 = row0 < TL ? F.in[I_X] + (size_t)row0 * 1024 : F.in[I_CTX] + (size_t)(row0 - TL) * 1024; const float* s1 = r1 < TL ? F.in[I_X] + (size_t)r1 * 1024 : F.in[I_CTX] + (size_t)(r1 - TL) * 1024;
        float4 v0[4], v1[4];
#pragma unroll
        for (int i = 0; i < 4; ++i) { v0[i] = ld4(s0 + 4 * (F.lane + 64 * i)); v1[i] = ld4(s1 + 4 * (F.lane + 64 * i)); }
        const float q0 = rsqrtf(wave_sum(sumsq4(v0)) * (1.f / 1024.f) + EPS), q1 = rsqrtf(wave_sum(sumsq4(v1)) * (1.f / 1024.f) + EPS);
#pragma unroll
        for (int rr = 0; rr < 2; ++rr) { if (rr && !has1) break; const int row = rr ? row1 : row0; const int mr = row < TL ? (row >> 11) : 8; const float r = rr ? q1 : q0;
            if (mr != mr_cur) { mr_cur = mr;
#pragma unroll
                for (int i = 0; i < 4; ++i) { const int c = 4 * (F.lane + 64 * i); shv[i] = ld4(MOD + (size_t)mr * 6144 + c); scv[i] = ld4(MOD + (size_t)mr * 6144 + 1024 + c); } }
#pragma unroll
            for (int i = 0; i < 4; ++i) { const int c = 4 * (F.lane + 64 * i); const float4 gg = gv[i], sh = shv[i], sc = scv[i]; const float4 v = rr ? v1[i] : v0[i];
                float4 o; o.x = v.x * r * gg.x * (1.f + sc.x) + sh.x; o.y = v.y * r * gg.y * (1.f + sc.y) + sh.y; o.z = v.z * r * gg.z * (1.f + sc.z) + sh.z; o.w = v.w * r * gg.w * (1.f + sc.w) + sh.w;
                store_bf16x4(A + (size_t)row * 1024 + c, o); } }
    }
}
template <int MODE, bool SRCF32, bool DSTF32>
__device__ __forceinline__ void ph_thin(const Fr& F, const float* msrc, int nrows, const float* hs_lat, const float* hs_ctx, float* hd_lat, float* hd_ctx,
                        const float* postg, const float* MODg, int gate_off, const float* preg, const float* MODn, int sh_off, int sc_off, bf16_t* adst, int xNTF = 0, int xS = 1, const bf16_t* xt2 = nullptr, int xS2 = 1) {
    float* rt = (float*)F.lds;
    int* cntL = (int*)(F.lds + 32768);
    int* blkBase = cntL + 8;
    int* selInfo = cntL + 16;
    if (MODE == 1) { for (int i = F.tid; i < 1024 * 8; i += NTHR) rt[(i & 7) * 1024 + (i >> 3)] = F.in[I_ROUTER][i]; if (F.tid < 8) cntL[F.tid] = 0; __syncthreads(); }
    int li = F.wave;
#define THIN_LOAD(row, m, h) do { \
        const float* hs = SRCF32 ? ((row) < TL ? hs_lat + (size_t)(row) * 1024 : hs_ctx + (size_t)((row) - TL) * 1024) : nullptr; const bf16_t* hbs = F.w<bf16_t>(WS_HB) + (size_t)(row) * 1024; \
        int tail0 = -1, tail1 = -1; \
        if (MODE == 2 && xS > 1) { const int2 sr = *(const int2*)(F.w<int>(WS_SROW) + (size_t)(row) * 2); const int r0 = __builtin_amdgcn_readfirstlane(sr.x), r1 = __builtin_amdgcn_readfirstlane(sr.y); \
            if ((r0 >> 8) >= xNTF) tail0 = r0 - xNTF * 256; if ((r1 >> 8) >= xNTF) tail1 = r1 - xNTF * 256; } \
        _Pragma("unroll") for (int i = 0; i < 4; ++i) { const int c = 4 * (F.lane + 64 * i); \
            if (SRCF32) h[i] = ld4(hs + c); else { const uint2 hv = *(const uint2*)(hbs + c); h[i].x = bflo(hv.x); h[i].y = bfhi(hv.x); h[i].z = bflo(hv.y); h[i].w = bfhi(hv.y); } \
            if (MODE == 2) { const bf16_t* mo = (const bf16_t*)msrc; const uint2 a = *(const uint2*)(mo + (size_t)(row) * 1024 + c), b = *(const uint2*)(mo + ((size_t)TL + (row)) * 1024 + c); \
                m[i].x = bflo(a.x) + bflo(b.x); m[i].y = bfhi(a.x) + bfhi(b.x); m[i].z = bflo(a.y) + bflo(b.y); m[i].w = bfhi(a.y) + bfhi(b.y); \
                if (tail0 >= 0) { const bf16_t* xp = F.w<bf16_t>(WS_XTR) + ((size_t)((tail0 >> 8) * 4 + i) * (xS - 1) * 256 + (tail0 & 255)) * 256 + (c & 255); \
                    for (int s2 = 0; s2 < xS - 1; ++s2) { const uint2 e = *(const uint2*)(xp + (size_t)s2 * 65536); m[i].x += bflo(e.x); m[i].y += bfhi(e.x); m[i].z += bflo(e.y); m[i].w += bfhi(e.y); } } \
                if (tail1 >= 0) { const bf16_t* xp = F.w<bf16_t>(WS_XTR) + ((size_t)((tail1 >> 8) * 4 + i) * (xS - 1) * 256 + (tail1 & 255)) * 256 + (c & 255); \
                    for (int s2 = 0; s2 < xS - 1; ++s2) { const uint2 e = *(const uint2*)(xp + (size_t)s2 * 65536); m[i].x += bflo(e.x); m[i].y += bfhi(e.x); m[i].z += bflo(e.y); m[i].w += bfhi(e.y); } } } \
            else { const uint2 a = *(const uint2*)((const bf16_t*)msrc + (size_t)(row) * 1024 + c); m[i].x = bflo(a.x); m[i].y = bfhi(a.x); m[i].z = bflo(a.y); m[i].w = bfhi(a.y); \
                if (MODE == 0 && xS2 > 1 && (row) >= TL) { \
                    const bf16_t* xp = xt2 + ((size_t)(((((row) - TL) >> 8) * 4 + i) * (xS2 - 1)) * 256 + ((row) & 255)) * 256 + (c & 255); \
                    for (int s2 = 0; s2 < xS2 - 1; ++s2) { const uint2 e = *(const uint2*)(xp + (size_t)s2 * 65536); m[i].x += bflo(e.x); m[i].y += bfhi(e.x); m[i].z += bflo(e.y); m[i].w += bfhi(e.y); } } } } } while (0)
    RowSched RS; RS.init(F.G, F.bid, F.wave, nrows); const int RPW = 16;
    li = F.wave * RPW;
    float4 m[4], h[4], mN[4], hN[4], pgv[4], ggv[4], gtv[4], shv[4], scv[4]; int mr_cur = -1;
#pragma unroll
    for (int i = 0; i < 4; ++i) { const int c = 4 * (F.lane + 64 * i); pgv[i] = ld4(postg + c); if (MODE != 2) ggv[i] = ld4(preg + c); }
    if (RS.ntot > 0) { const int rw = RS.row_at(0); THIN_LOAD(rw, m, h); }
    for (int si = 0; si < RS.ntot; ++si, ++li) {
        const int row = RS.row_at(si);
        if (si + 1 < RS.ntot) { const int rown = RS.row_at(si + 1); THIN_LOAD(rown, mN, hN); }
        const int mr = row < TL ? (row >> 11) : 8;
        if (mr != mr_cur) { mr_cur = mr;
#pragma unroll
            for (int i = 0; i < 4; ++i) { const int c = 4 * (F.lane + 64 * i); gtv[i] = ld4(MODg + (size_t)mr * 6144 + gate_off + c);
                if (MODE != 2) { shv[i] = ld4(MODn + (size_t)mr * 6144 + sh_off + c); scv[i] = ld4(MODn + (size_t)mr * 6144 + sc_off + c); } } }
        float* hd = DSTF32 ? hd_lat + (size_t)row * 1024 : nullptr;
        bf16_t* hb = F.w<bf16_t>(WS_HB) + (size_t)row * 1024;
        const float r = rsqrtf(wave_sum(sumsq4(m)) * (1.f / 1024.f) + EPS);
#pragma unroll
        for (int i = 0; i < 4; ++i) { const int c = 4 * (F.lane + 64 * i); const float4 pg = pgv[i], gt = gtv[i];
            h[i].x += gt.x * (m[i].x * r * pg.x); h[i].y += gt.y * (m[i].y * r * pg.y); h[i].z += gt.z * (m[i].z * r * pg.z); h[i].w += gt.w * (m[i].w * r * pg.w);
            if (DSTF32) *(float4*)(hd + c) = h[i]; else store_bf16x4(hb + c, h[i]); }
        if (MODE != 2) {
        const float r2 = rsqrtf(wave_sum(sumsq4(h)) * (1.f / 1024.f) + EPS);
        float lg[8];
#pragma unroll
        for (int e = 0; e < 8; ++e) lg[e] = 0.f;
#pragma unroll
        for (int i = 0; i < 4; ++i) { const int c = 4 * (F.lane + 64 * i); const float4 gg = ggv[i], sh = shv[i], sc = scv[i];
            float4 o; o.x = h[i].x * r2 * gg.x * (1.f + sc.x) + sh.x; o.y = h[i].y * r2 * gg.y * (1.f + sc.y) + sh.y; o.z = h[i].z * r2 * gg.z * (1.f + sc.z) + sh.z; o.w = h[i].w * r2 * gg.w * (1.f + sc.w) + sh.w;
            store_bf16x4(adst + (size_t)row * 1024 + c, o);
            if (MODE == 1) {
#pragma unroll
                for (int e = 0; e < 8; ++e) { const float4 rv = *(const float4*)(rt + e * 1024 + c); lg[e] += o.x * rv.x + o.y * rv.y + o.z * rv.z + o.w * rv.w; } } }
        if (MODE == 1) {
#pragma unroll
            for (int e = 0; e < 8; ++e) lg[e] = wave_sum(lg[e]);
            int i1 = 0; float v1 = lg[0];
#pragma unroll
            for (int e = 1; e < 8; ++e) if (lg[e] > v1) { v1 = lg[e]; i1 = e; }
            int i2 = -1; float v2 = -3.0e38f;
#pragma unroll
            for (int e = 0; e < 8; ++e) if (e != i1 && lg[e] > v2) { v2 = lg[e]; i2 = e; }
            const float w1 = 1.f / (1.f + expf(v2 - v1)), w2 = 1.f - w1;
            if (F.lane == 0) { float* tw = F.w<float>(WS_TOPW) + (size_t)row * 2; tw[0] = w1; tw[1] = w2;
                const int r1 = atomicAdd(&cntL[i1], 1), r2i = atomicAdd(&cntL[i2], 1);
                selInfo[li * 2 + 0] = i1 | (r1 << 8); selInfo[li * 2 + 1] = i2 | (r2i << 8); }
        }
        }
#pragma unroll
        for (int i = 0; i < 4; ++i) { m[i] = mN[i]; h[i] = hN[i]; }
    }
#undef THIN_LOAD
    if (MODE == 1) {
        __syncthreads();
        if (F.tid < 8) blkBase[F.tid] = (int)__hip_atomic_fetch_add(F.w<unsigned>(WS_CNT) + F.tid, (unsigned)cntL[F.tid], __ATOMIC_RELAXED, __HIP_MEMORY_SCOPE_AGENT);
        __syncthreads();
        int* LISTE = F.w<int>(WS_LISTE);
        for (int idx = F.tid; idx < 16 * RPW; idx += NTHR) { const int l2 = idx >> 1, k = idx & 1; RowSched R2; R2.init(F.G, F.bid, l2 / RPW, nrows); const int it2 = l2 % RPW; const int row = it2 < R2.ntot ? R2.row_at(it2) : nrows;
            if (row < nrows) { const int si = selInfo[idx], e = si & 255, rk = si >> 8; LISTE[(size_t)e * TL + blkBase[e] + rk] = row * 2 + k; } }
        __syncthreads();
    }
}
__device__ __forceinline__ void ph_moe_gather(const Fr& F) {
    const unsigned* cnt = F.w<unsigned>(WS_CNT); int ts[9]; ts[0] = 0;
#pragma unroll
    for (int e = 0; e < 8; ++e) ts[e + 1] = ts[e] + (int)((__hip_atomic_load(cnt + e, __ATOMIC_RELAXED, __HIP_MEMORY_SCOPE_AGENT) + 255u) >> 8);
    const int nrows = ts[8] * 256; const int* LISTE = F.w<int>(WS_LISTE); const float* TOPW = F.w<float>(WS_TOPW);
    const bf16_t* a2 = F.w<bf16_t>(L1_A2TMP); bf16_t* AG = F.w<bf16_t>(WS_AG); uint2* RIW = F.w<uint2>(WS_ROWINFO);
    const int RPW = (nrows + F.G * 8 - 1) / (F.G * 8), rbeg = (F.bid * 8 + F.wave) * RPW, rend = (rbeg + RPW < nrows) ? rbeg + RPW : nrows;
    int my_info = -1;
    { const int r = rbeg + F.lane;
      if (F.lane < RPW && r < rend) { const int j = r >> 8; int e = 0;
#pragma unroll
          for (int k = 1; k < 8; ++k) e += (j >= ts[k]) ? 1 : 0;
          int tse = ts[0];
#pragma unroll
          for (int k = 1; k < 8; ++k) tse = (e == k) ? ts[k] : tse;
          const int i = r - tse * 256; const int ce = (int)__hip_atomic_load(cnt + e, __ATOMIC_RELAXED, __HIP_MEMORY_SCOPE_AGENT); float w = 0.f;
          if (i < ce) { my_info = LISTE[(size_t)e * TL + i]; w = TOPW[my_info]; F.w<int>(WS_SROW)[my_info] = r; }
          RIW[r] = make_uint2((unsigned)my_info, __float_as_uint(w)); } }
    static_assert(MOE_FP8, "the gather below writes e4m3 rows");
    uint4 v0 = make_uint4(0u, 0u, 0u, 0u), v1 = v0, n0 = v0, n1 = v0;
    if (rbeg < rend) { const int info = __builtin_amdgcn_readlane(my_info, 0); if (info >= 0) { const uint4* src = (const uint4*)(a2 + (size_t)(info >> 1) * 1024 + F.lane * 16); v0 = src[0]; v1 = src[1]; } }
    for (int r = rbeg; r < rend; ++r) {
        n0 = make_uint4(0u, 0u, 0u, 0u); n1 = n0;
        if (r + 1 < rend) { const int info = __builtin_amdgcn_readlane(my_info, r + 1 - rbeg); if (info >= 0) { const uint4* src = (const uint4*)(a2 + (size_t)(info >> 1) * 1024 + F.lane * 16); n0 = src[0]; n1 = src[1]; } }
        uint4 o; o.x = pack4_fp8(bflo(v0.x), bfhi(v0.x), bflo(v0.y), bfhi(v0.y)); o.y = pack4_fp8(bflo(v0.z), bfhi(v0.z), bflo(v0.w), bfhi(v0.w));
        o.z = pack4_fp8(bflo(v1.x), bfhi(v1.x), bflo(v1.y), bfhi(v1.y)); o.w = pack4_fp8(bflo(v1.z), bfhi(v1.z), bflo(v1.w), bfhi(v1.w));
        *(uint4*)((unsigned char*)AG + (size_t)r * 1024 + F.lane * 16) = o;
        v0 = n0; v1 = n1;
    }
}
__device__ __forceinline__ void ld8bf(const bf16_t* p, float (&o)[8]) { const uint4 q = *(const uint4*)p; o[0] = bflo(q.x); o[1] = bfhi(q.x); o[2] = bflo(q.y); o[3] = bfhi(q.y); o[4] = bflo(q.z); o[5] = bfhi(q.z); o[6] = bflo(q.w); o[7] = bfhi(q.w); }
__device__ __forceinline__ void st8bf(bf16_t* p, const float (&v)[8]) { uint4 q; q.x = pack2(v[0], v[1]); q.y = pack2(v[2], v[3]); q.z = pack2(v[4], v[5]); q.w = pack2(v[6], v[7]); *(uint4*)p = q; }
struct CW { float w0[8], w1[8], w2[8], bb[8]; };
__device__ __forceinline__ void cw_load(CW& c, const float* w, const float* b, int wc, int wld) {
    const float4 a0 = ld4(w + wc), a1 = ld4(w + wc + 4), b0 = ld4(w + wld + wc), b1 = ld4(w + wld + wc + 4), c0 = ld4(w + 2 * wld + wc), c1 = ld4(w + 2 * wld + wc + 4), d0 = ld4(b + wc), d1 = ld4(b + wc + 4);
    c.w0[0] = a0.x; c.w0[1] = a0.y; c.w0[2] = a0.z; c.w0[3] = a0.w; c.w0[4] = a1.x; c.w0[5] = a1.y; c.w0[6] = a1.z; c.w0[7] = a1.w;
    c.w1[0] = b0.x; c.w1[1] = b0.y; c.w1[2] = b0.z; c.w1[3] = b0.w; c.w1[4] = b1.x; c.w1[5] = b1.y; c.w1[6] = b1.z; c.w1[7] = b1.w;
    c.w2[0] = c0.x; c.w2[1] = c0.y; c.w2[2] = c0.z; c.w2[3] = c0.w; c.w2[4] = c1.x; c.w2[5] = c1.y; c.w2[6] = c1.z; c.w2[7] = c1.w;
    c.bb[0] = d0.x; c.bb[1] = d0.y; c.bb[2] = d0.z; c.bb[3] = d0.w; c.bb[4] = d1.x; c.bb[5] = d1.y; c.bb[6] = d1.z; c.bb[7] = d1.w;
}
__device__ __forceinline__ void conv8(const bf16_t* prow, bool hasp, bool hasn, int pc, const CW& c, float (&o)[8]) {
    float xm[8], x0[8], xp[8]; ld8bf(prow + pc, x0);
    if (hasp) ld8bf(prow - EVEN_PAD + pc, xm); else {
#pragma unroll
        for (int j = 0; j < 8; ++j) xm[j] = 0.f; }
    if (hasn) ld8bf(prow + EVEN_PAD + pc, xp); else {
#pragma unroll
        for (int j = 0; j < 8; ++j) xp[j] = 0.f; }
#pragma unroll
    for (int j = 0; j < 8; ++j) o[j] = c.w0[j] * xm[j] + c.w1[j] * x0[j] + c.w2[j] * xp[j] + c.bb[j];
}
__device__ __forceinline__ void ph_convpass(const Fr& F) {
    const bf16_t* PROJ = F.w<bf16_t>(L0_PROJ); bf16_t* U = F.w<bf16_t>(L0_U); bf16_t* X0 = F.w<bf16_t>(L0_X0); bf16_t* XBC = F.w<bf16_t>(L0_XBC); float* DT = F.w<float>(L0_DT);
    const float* hw = F.in[I_HYCW]; const float* hb = F.in[I_HYCB]; const float* sw = F.in[I_SCW]; const float* sb = F.in[I_SCB]; const float* dtb = F.in[I_DTB];
    {
        const int c = F.lane * 8; CW cx0, cb0, cb1; cw_load(cx0, hw, hb, c, 1536); cw_load(cb0, sw, sb, c, 1024); cw_load(cb1, sw, sb, c + 512, 1024);
        const float dtbv = F.lane < 16 ? dtb[F.lane] : 0.f;
        for (int row = F.bid * 8 + F.wave; row < TT; row += F.G * 8) {
            const int t = row < TL ? (row & (SEQ - 1)) : ((row - TL) & (CTXL - 1)), n = row < TL ? SEQ : CTXL; const bool hasp = t > 0, hasn = t < n - 1;
            const bf16_t* prow = PROJ + (size_t)row * EVEN_PAD;
            float a0[8];
            conv8(prow, hasp, hasn, c, cx0, a0);
            st8bf(X0 + (size_t)row * 512 + c, a0);
            conv8(prow, hasp, hasn, 2048 + c, cb0, a0);
#pragma unroll
            for (int j = 0; j < 8; ++j) a0[j] = silu_f(a0[j]);
            st8bf(XBC + (size_t)row * 1024 + c, a0);
            conv8(prow, hasp, hasn, 2048 + 512 + c, cb1, a0);
#pragma unroll
            for (int j = 0; j < 8; ++j) a0[j] = silu_f(a0[j]);
            st8bf(XBC + (size_t)row * 1024 + 512 + c, a0);
            if (F.lane < 16) DT[(size_t)row * 16 + F.lane] = softplus_f(bf2f(prow[3072 + F.lane]) + dtbv);
        }
    }
    bf16_t* ut = (bf16_t*)F.lds;
    {   const int tok = F.tid >> 3, cq = F.tid & 7; const int cgp = F.bid & 3;
        CW c1a, c1b, cva, cvb; { const int ch = cgp * 128 + cq * 16; cw_load(c1a, hw, hb, 512 + ch, 1536); cw_load(c1b, hw, hb, 512 + ch + 8, 1536); cw_load(cva, hw, hb, 1024 + ch, 1536); cw_load(cvb, hw, hb, 1024 + ch + 8, 1536); }
        for (int un = F.bid; un < (TT / 64) * 4; un += F.G) {
            const int tile = un >> 2, row0 = tile * 64; const int row = row0 + tok;
            const int t = row < TL ? (row & (SEQ - 1)) : ((row - TL) & (CTXL - 1)), n = row < TL ? SEQ : CTXL; const bool hasp = t > 0, hasn = t < n - 1;
            const bf16_t* prow = PROJ + (size_t)row * EVEN_PAD; const int ch = cgp * 128 + cq * 16;
            { float a1[8], a2[8]; conv8(prow, hasp, hasn, 512 + ch, c1a, a1); conv8(prow, hasp, hasn, 1024 + ch, cva, a2);
#pragma unroll
              for (int j = 0; j < 8; ++j) ut[(cq * 16 + j) * 66 + tok] = f2bf(a1[j] * a2[j]);
              conv8(prow, hasp, hasn, 512 + ch + 8, c1b, a1); conv8(prow, hasp, hasn, 1024 + ch + 8, cvb, a2);
#pragma unroll
              for (int j = 0; j < 8; ++j) ut[(cq * 16 + 8 + j) * 66 + tok] = f2bf(a1[j] * a2[j]); }
            __syncthreads();
            { const int ch2 = F.tid >> 2, part = F.tid & 3; const int b = row0 < TL ? (row0 >> 11) : ((row0 - TL) >> 8), off = row0 < TL ? CTXL + (row0 & (SEQ - 1)) : ((row0 - TL) & (CTXL - 1));
              const unsigned* src = (const unsigned*)(ut + ch2 * 66 + part * 16); uint4 v0, v1; v0.x = src[0]; v0.y = src[1]; v0.z = src[2]; v0.w = src[3]; v1.x = src[4]; v1.y = src[5]; v1.z = src[6]; v1.w = src[7];
              uint4* dst = (uint4*)(U + ((size_t)(cgp * 128 + ch2) * 8 + b) * NKEY + off + part * 16); dst[0] = v0; dst[1] = v1; }
            __syncthreads();
        }
    }
}

__device__ __forceinline__ unsigned alignhalf(unsigned hi, unsigned lo) { return (lo >> 16) | (hi << 16); }
template <int RHO> __device__ __forceinline__ uint4 shift_copy(const uint4 prev, const uint4 cur) {
    const unsigned cc[8] = {prev.x, prev.y, prev.z, prev.w, cur.x, cur.y, cur.z, cur.w};
    constexpr int o = 16 - 2 * RHO, d0 = o / 4; uint4 r;
    if constexpr ((o & 3) == 0) { r.x = cc[d0]; r.y = cc[d0 + 1]; r.z = cc[d0 + 2]; r.w = cc[d0 + 3]; }
    else { r.x = alignhalf(cc[d0 + 1], cc[d0]); r.y = alignhalf(cc[d0 + 2], cc[d0 + 1]); r.z = alignhalf(cc[d0 + 3], cc[d0 + 2]); r.w = alignhalf(cc[d0 + 4], cc[d0 + 3]); }
    return r;
}
__device__ __forceinline__ void build_copies(unsigned char* cp, int cs, const bf16_t* R, int nch, int i) {
    if (i < nch) { const uint4 cur = *(const uint4*)(R + 8 * i); const uint4 prev = i > 0 ? *(const uint4*)(R + 8 * i - 8) : make_uint4(0u, 0u, 0u, 0u);
        *(uint4*)(cp + 0 * cs + i * 16) = cur;
        *(uint4*)(cp + 1 * cs + i * 16) = shift_copy<1>(prev, cur); *(uint4*)(cp + 2 * cs + i * 16) = shift_copy<2>(prev, cur); *(uint4*)(cp + 3 * cs + i * 16) = shift_copy<3>(prev, cur);
        *(uint4*)(cp + 4 * cs + i * 16) = shift_copy<4>(prev, cur); *(uint4*)(cp + 5 * cs + i * 16) = shift_copy<5>(prev, cur); *(uint4*)(cp + 6 * cs + i * 16) = shift_copy<6>(prev, cur);
        *(uint4*)(cp + 7 * cs + i * 16) = shift_copy<7>(prev, cur); }
}
__device__ __forceinline__ void ph_hyena_mfma(const Fr& F) {
    const bf16_t* U = F.w<bf16_t>(L0_U); bf16_t* YT = F.w<bf16_t>(L0_YT);
    const int w = F.wave, rr = F.lane & 15, g = F.lane >> 4;
    {   constexpr int CS = 8224, US = 4128;
        unsigned char* Cp = F.lds; unsigned char* Ub = F.lds + 8 * CS;
        const int p = w & 1, q = w >> 1;
        for (int c = F.bid; c < 512; c += F.G) {
            __syncthreads();
            build_copies(Cp, CS, F.w<bf16_t>(L0_FL) + (size_t)c * 4096, 512, F.tid);
#pragma unroll
            for (int k = 0; k < 4; ++k) { const int id = F.tid + 512 * k, b = id >> 8, ch = id & 255; *(uint4*)(Ub + b * US + ch * 16) = *(const uint4*)(U + ((size_t)c * 8 + b) * NKEY + CTXL + ch * 8); }
            __syncthreads();
            const unsigned char* abase = Cp + (rr & 7) * CS + (2048 - 16 * (32 * q + p) - 8 * (rr >> 3) + 8 * g) * 2;
            const unsigned char* ubase = Ub + (rr & 7) * US + 16 * g;
            f32x4 acc[16]; bf16x8 af[16];
#pragma unroll
            for (int i = 0; i < 16; ++i) { acc[i] = (f32x4){0.f, 0.f, 0.f, 0.f}; af[i] = *(const bf16x8*)(abase - 64 * i); }
            for (int jj = 0; jj < 4; ++jj) {
#pragma unroll
                for (int js = 0; js < 16; ++js) { const int J = 16 * jj + js;
                    af[(16 - js) & 15] = *(const bf16x8*)(abase + 64 * J);
                    const bf16x8 bfr = *(const bf16x8*)(ubase + 64 * J);
#pragma unroll
                    for (int i = 0; i < 16; ++i) acc[i] = __builtin_amdgcn_mfma_f32_16x16x32_bf16(af[(i - js) & 15], bfr, acc[i], 0, 0, 0);
                }
            }
            if (rr < 8) {
#pragma unroll
                for (int i = 0; i < 16; ++i) { const int t = 16 * (32 * q + p + 2 * i) + 4 * g; uint2 pk; pk.x = pack2(acc[i][0], acc[i][1]); pk.y = pack2(acc[i][2], acc[i][3]);
                    *(uint2*)(YT + ((size_t)c * 8 + rr) * NKEY + CTXL + t) = pk; }
            }
        }
    }
    {   constexpr int CS = 1056, US = 544;
        unsigned char* Cp = F.lds; unsigned char* Ub = F.lds + 8 * CS;
        for (int c = F.bid; c < 512; c += F.G) {
            __syncthreads();
            build_copies(Cp, CS, F.w<bf16_t>(L0_FC) + (size_t)c * 512, 64, F.tid);
            if (F.tid < 256) { const int b = F.tid >> 5, ch = F.tid & 31; *(uint4*)(Ub + b * US + ch * 16) = *(const uint4*)(U + ((size_t)c * 8 + b) * NKEY + ch * 8); }
            __syncthreads();
            f32x4 acc[2];
#pragma unroll
            for (int ii = 0; ii < 2; ++ii) acc[ii] = (f32x4){0.f, 0.f, 0.f, 0.f};
#pragma unroll
            for (int J = 0; J < 8; ++J) { const bf16x8 bfr = *(const bf16x8*)(Ub + (rr & 7) * US + 16 * g + 64 * J);
#pragma unroll
                for (int ii = 0; ii < 2; ++ii) { const int d = 2 * w + ii - 2 * J; const bf16x8 a = *(const bf16x8*)(Cp + (rr & 7) * CS + (256 - 16 * d - 8 * (rr >> 3) + 8 * g) * 2);
                    acc[ii] = __builtin_amdgcn_mfma_f32_16x16x32_bf16(a, bfr, acc[ii], 0, 0, 0); } }
            if (rr < 8) {
#pragma unroll
                for (int ii = 0; ii < 2; ++ii) { const int t = 16 * (2 * w + ii) + 4 * g; uint2 pk; pk.x = pack2(acc[ii][0], acc[ii][1]); pk.y = pack2(acc[ii][2], acc[ii][3]);
                    *(uint2*)(YT + ((size_t)c * 8 + rr) * NKEY + t) = pk; }
            }
        }
    }
    __syncthreads();
}
__device__ __forceinline__ void ph_hyena_post(const Fr& F) {
    const bf16_t* YT = F.w<bf16_t>(L0_YT); const bf16_t* X0 = F.w<bf16_t>(L0_X0); bf16_t* A = F.w<bf16_t>(WS_ABUF);
    bf16_t* yt = (bf16_t*)F.lds;
    for (int un = F.bid; un < (TT / 64) * 4; un += F.G) {
        const int tile = un >> 2, cgp = un & 3, row0 = tile * 64;
        { const int ch = F.tid >> 2, part = F.tid & 3; const int b = row0 < TL ? (row0 >> 11) : ((row0 - TL) >> 8), off = row0 < TL ? CTXL + (row0 & (SEQ - 1)) : ((row0 - TL) & (CTXL - 1));
          const uint4* src = (const uint4*)(YT + ((size_t)(cgp * 128 + ch) * 8 + b) * NKEY + off + part * 16); const uint4 v0 = src[0], v1 = src[1];
          unsigned* dst = (unsigned*)(yt + ch * 66 + part * 16); dst[0] = v0.x; dst[1] = v0.y; dst[2] = v0.z; dst[3] = v0.w; dst[4] = v1.x; dst[5] = v1.y; dst[6] = v1.z; dst[7] = v1.w; }
        __syncthreads();
        { const int tok = F.tid >> 3, cq = F.tid & 7, row = row0 + tok;
#pragma unroll
          for (int hf = 0; hf < 2; ++hf) { const int ch = cgp * 128 + cq * 16 + hf * 8; float x0[8], o[8]; ld8bf(X0 + (size_t)row * 512 + ch, x0);
#pragma unroll
              for (int j = 0; j < 8; ++j) o[j] = x0[j] * bf2f(yt[(cq * 16 + hf * 8 + j) * 66 + tok]);
              st8bf(A + (size_t)row * 1024 + ch, o); } }
        __syncthreads();
    }
}

__device__ __forceinline__ int ssd_rowbase(int b, int cpos) { return cpos < 2 ? TL + b * CTXL + cpos * 128 : b * SEQ + (cpos - 2) * 128; }
typedef short s16x4 __attribute__((ext_vector_type(4)));
__device__ __forceinline__ s16x4 tr_read16(const unsigned char* img, int P, int row0, int col0, int lane) {
    const int q4 = (lane & 15) >> 2, p4 = lane & 3;
    return __builtin_amdgcn_ds_read_tr16_b64_v4i16((LAS s16x4*)(LAS unsigned char*)(img + (row0 + q4) * P + (col0 + 4 * p4) * 2));
}
__device__ __forceinline__ bf16x8 tr_pair(const unsigned char* img, int P, int rowa, int rowb, int col0, int lane) {
    union { bf16x8 v; s16x4 h[2]; } u; u.h[0] = tr_read16(img, P, rowa, col0, lane); u.h[1] = tr_read16(img, P, rowb, col0, lane); return u.v;
}
__device__ __forceinline__ void ph_ssd_a(const Fr& F) {
    constexpr int PT = 272, PX = 144;
    unsigned char* XD = F.lds;
    unsigned char* Bn = XD + 128 * PX;
    unsigned char* Bd = Bn + 128 * PT;
    unsigned char* Cn = Bd + 128 * PT;
    float* acs = (float*)(Cn + 128 * PT);
    float* dts = acs + 128;
    const bf16_t* XBC = F.w<bf16_t>(L0_XBC); const float* DT = F.w<float>(L0_DT);
    const int w = F.wave, cl = F.lane & 15, g = F.lane >> 4;
    for (int u = F.bid; u < NB * 18 * 16; u += F.G) {
        const int b = u / 288, rem = u % 288, cpos = rem >> 4, h = (rem >> 1) & 7, dir = rem & 1, grp = h >> 2;
        const int rowbase = ssd_rowbase(b, cpos), su = ((b * 2 + dir) * 8 + h) * 18 + cpos;
        const float Aneg = -expf(F.in[I_ALOG][dir * 8 + h]);
        __syncthreads();
        if (w == 0) { const int q0 = 2 * F.lane, p0 = dir ? 127 - q0 : q0, p1 = dir ? 126 - q0 : q0 + 1;
            const float d0 = DT[(size_t)(rowbase + p0) * 16 + dir * 8 + h], d1 = DT[(size_t)(rowbase + p1) * 16 + dir * 8 + h]; const float a0 = d0 * Aneg, a1 = d1 * Aneg;
            float sc = a0 + a1;
#pragma unroll
            for (int o = 1; o < 64; o <<= 1) { const float t = __shfl_up(sc, o); if (F.lane >= o) sc += t; }
            const float ex = sc - (a0 + a1); acs[q0] = ex + a0; acs[q0 + 1] = ex + a0 + a1; dts[q0] = d0; dts[q0 + 1] = d1;
            float* ACS = F.w<float>(L0_ACS) + (size_t)su * 128; ACS[p0] = ex + a0; ACS[p1] = ex + a0 + a1;
            if (F.lane == 63) F.w<float>(L0_ATOT)[su] = ex + a0 + a1; }
        __syncthreads();
        const float atot = acs[127];
#pragma unroll
        for (int k = 0; k < 2; ++k) { const int id = F.tid + 512 * k, q = id >> 3, pc = id & 7, pos = dir ? 127 - q : q; float v[8]; ld8bf(XBC + (size_t)(rowbase + pos) * 1024 + h * 64 + pc * 8, v); const float dv = dts[q];
            uint4 o; o.x = pack2(v[0] * dv, v[1] * dv); o.y = pack2(v[2] * dv, v[3] * dv); o.z = pack2(v[4] * dv, v[5] * dv); o.w = pack2(v[6] * dv, v[7] * dv);
            *(uint4*)(XD + q * PX + pc * 16) = o; }
#pragma unroll
        for (int k = 0; k < 4; ++k) { const int id = F.tid + 512 * k, q = id >> 4, nc = id & 15, pos = dir ? 127 - q : q; const bf16_t* src = XBC + (size_t)(rowbase + pos) * 1024 + 512 + grp * 128 + nc * 8;
            const uint4 bv = *(const uint4*)src, cv = *(const uint4*)(src + 256);
            *(uint4*)(Bn + q * PT + nc * 16) = bv; *(uint4*)(Cn + q * PT + nc * 16) = cv;
            const float dec = __expf(atot - acs[q]); uint4 o;
            o.x = pack2(bflo(bv.x) * dec, bfhi(bv.x) * dec); o.y = pack2(bflo(bv.y) * dec, bfhi(bv.y) * dec); o.z = pack2(bflo(bv.z) * dec, bfhi(bv.z) * dec); o.w = pack2(bflo(bv.w) * dec, bfhi(bv.w) * dec);
            *(uint4*)(Bd + q * PT + nc * 16) = o; }
        __syncthreads();
        const int q = 16 * w + cl; const float aq = acs[q];
        bf16x8 cf[4];
#pragma unroll
        for (int ks = 0; ks < 4; ++ks) cf[ks] = *(const bf16x8*)(Cn + q * PT + (32 * ks + 8 * g) * 2);
        unsigned pk[8][2];
#pragma unroll
        for (int sb = 0; sb < 8; ++sb) { pk[sb][0] = 0u; pk[sb][1] = 0u;
            if (sb <= w) { f32x4 gacc = (f32x4){0.f, 0.f, 0.f, 0.f};
#pragma unroll
                for (int ks = 0; ks < 4; ++ks) { const bf16x8 bf = *(const bf16x8*)(Bn + (16 * sb + cl) * PT + (32 * ks + 8 * g) * 2); gacc = __builtin_amdgcn_mfma_f32_16x16x32_bf16(bf, cf[ks], gacc, 0, 0, 0); }
                const f32x4 as = *(const f32x4*)(acs + 16 * sb + 4 * g); float sv[4];
#pragma unroll
                for (int e = 0; e < 4; ++e) { const int sI = 16 * sb + 4 * g + e; sv[e] = (sI <= q) ? gacc[e] * __expf(aq - as[e]) : 0.f; }
                pk[sb][0] = pack2(sv[0], sv[1]); pk[sb][1] = pack2(sv[2], sv[3]); } }
        f32x4 yacc[4];
#pragma unroll
        for (int pb = 0; pb < 4; ++pb) yacc[pb] = (f32x4){0.f, 0.f, 0.f, 0.f};
#pragma unroll
        for (int k2 = 0; k2 < 4; ++k2) if (2 * k2 <= w) {
            union { bf16x8 v; unsigned wd[4]; } pf; pf.wd[0] = pk[2 * k2][0]; pf.wd[1] = pk[2 * k2][1]; pf.wd[2] = pk[2 * k2 + 1][0]; pf.wd[3] = pk[2 * k2 + 1][1];
#pragma unroll
            for (int pb = 0; pb < 4; ++pb) { const bf16x8 xa = tr_pair(XD, PX, 32 * k2 + 4 * g, 32 * k2 + 16 + 4 * g, 16 * pb, F.lane);
                yacc[pb] = __builtin_amdgcn_mfma_f32_16x16x32_bf16(xa, pf.v, yacc[pb], 0, 0, 0); } }
        { bf16_t* Y = (dir ? F.w<bf16_t>(L0_YB) : F.w<bf16_t>(L0_YF)) + (size_t)(rowbase + (dir ? 127 - q : q)) * 512 + h * 64 + 4 * g;
#pragma unroll
          for (int pb = 0; pb < 4; ++pb) { uint2 o; o.x = pack2(yacc[pb][0], yacc[pb][1]); o.y = pack2(yacc[pb][2], yacc[pb][3]); *(uint2*)(Y + 16 * pb) = o; } }
        { float* ST = F.w<float>(L0_ST) + (size_t)su * 8192;
          bf16x8 af[4];
#pragma unroll
          for (int ks = 0; ks < 4; ++ks) af[ks] = tr_pair(Bd, PT, 32 * ks + 8 * g, 32 * ks + 8 * g + 4, 16 * w, F.lane);
#pragma unroll
          for (int pb = 0; pb < 4; ++pb) { f32x4 sacc = (f32x4){0.f, 0.f, 0.f, 0.f};
#pragma unroll
              for (int ks = 0; ks < 4; ++ks) { const bf16x8 xb = tr_pair(XD, PX, 32 * ks + 8 * g, 32 * ks + 8 * g + 4, 16 * pb, F.lane); sacc = __builtin_amdgcn_mfma_f32_16x16x32_bf16(af[ks], xb, sacc, 0, 0, 0); }
              *(f32x4*)(ST + (size_t)(16 * pb + cl) * 128 + 16 * w + 4 * g) = sacc; } }
    }
    __syncthreads();
}
__device__ __forceinline__ void ph_ssd_b(const Fr& F) {
    const float* ST = F.w<float>(L0_ST); const float* ATOT = F.w<float>(L0_ATOT); bf16_t* STIN = F.w<bf16_t>(L0_STIN);
    for (int idx = F.bid * NTHR + F.tid; idx < 128 * 2048; idx += F.G * NTHR) {
        const int chain = idx >> 11, e4 = idx & 2047, dir = (chain >> 3) & 1;
        f32x4 run = (f32x4){0.f, 0.f, 0.f, 0.f};
        for (int k = 0; k < 18; ++k) { const int cpos = dir ? (k < 2 ? 1 - k : 19 - k) : k; const size_t su = (size_t)chain * 18 + cpos;
            uint2 o; o.x = pack2(run[0], run[1]); o.y = pack2(run[2], run[3]); *(uint2*)(STIN + su * 8192 + e4 * 4) = o;
            const f32x4 st = *(const f32x4*)(ST + su * 8192 + e4 * 4); const float dc = __expf(ATOT[su]); run = run * dc + st; }
    }
}
__device__ __forceinline__ void ph_ssd_c(const Fr& F) {
    constexpr int PT = 272;
    unsigned char* Cn = F.lds;
    unsigned char* Sin = Cn + 64 * PT;
    float* ssx = (float*)(Sin + 4 * 64 * PT);
    const bf16_t* XBC = F.w<bf16_t>(L0_XBC); const bf16_t* PROJ = F.w<bf16_t>(L0_PROJ); const bf16_t* STIN = F.w<bf16_t>(L0_STIN); const float* ACS = F.w<float>(L0_ACS);
    const bf16_t* YF = F.w<bf16_t>(L0_YF); const bf16_t* YB = F.w<bf16_t>(L0_YB); bf16_t* A = F.w<bf16_t>(WS_ABUF);
    const float* dsk = F.in[I_SSMD]; const float* ng = F.in[I_SSMNG];
    const int w = F.wave, pw = w & 3, hp = w >> 2;
    for (int u = F.bid; u < NB * 18 * 4; u += F.G) {
        int tz = threadIdx.x; asm volatile("" : "+v"(tz));
        const int cl = tz & 15, g = (tz >> 4) & 3;
        const int b = u / 72, rem = u % 72, cpos = rem >> 2, grp = (rem >> 1) & 1, ph = rem & 1; const int rowbase = ssd_rowbase(b, cpos);
        const int lpos = 16 * pw + cl, pos = ph * 64 + lpos; const size_t row = (size_t)(rowbase + pos);
        __syncthreads();
#pragma unroll
        for (int k = 0; k < 2; ++k) { const int id = tz + 512 * k, q = id >> 4, nc = id & 15; *(uint4*)(Cn + q * PT + nc * 16) = *(const uint4*)(XBC + (size_t)(rowbase + ph * 64 + q) * 1024 + 768 + grp * 128 + nc * 8); }
        float ss = 0.f;
        uint4 sreg0, sreg1, sreg2, sreg3, sreg4, sreg5, sreg6, sreg7;
#define SSDC_SRC(k, it) (STIN + ((size_t)(b * 16 + (((tz + 512 * (k)) >> 10) & 1) * 8 + grp * 4 + 2 * ((tz + 512 * (k)) >> 11) + (it)) * 18 + cpos) * 8192 + (((tz + 512 * (k)) >> 4) & 63) * 128 + ((tz + 512 * (k)) & 15) * 8)
#define SSDC_SLOAD(it) do { sreg0 = *(const uint4*)SSDC_SRC(0, it); sreg1 = *(const uint4*)SSDC_SRC(1, it); sreg2 = *(const uint4*)SSDC_SRC(2, it); sreg3 = *(const uint4*)SSDC_SRC(3, it); \
            sreg4 = *(const uint4*)SSDC_SRC(4, it); sreg5 = *(const uint4*)SSDC_SRC(5, it); sreg6 = *(const uint4*)SSDC_SRC(6, it); sreg7 = *(const uint4*)SSDC_SRC(7, it); } while (0)
#define SSDC_LDSW(k, v) *(uint4*)(Sin + ((tz + 512 * (k)) >> 10) * 64 * PT + (((tz + 512 * (k)) >> 4) & 63) * PT + ((tz + 512 * (k)) & 15) * 16) = v
        SSDC_SLOAD(0);
#pragma unroll 1
        for (int it = 0; it < 2; ++it) {
            const int h = grp * 4 + 2 * hp + it; const size_t su0 = (size_t)(b * 16 + h) * 18 + cpos, su1 = (size_t)(b * 16 + 8 + h) * 18 + cpos;
            uint2 eyf[4], eyb[4], exv[4], ezv[4];
#pragma unroll
            for (int pb = 0; pb < 4; ++pb) { const int ch = h * 64 + 16 * pb + 4 * g;
                eyf[pb] = *(const uint2*)(YF + row * 512 + ch); eyb[pb] = *(const uint2*)(YB + row * 512 + ch); exv[pb] = *(const uint2*)(XBC + row * 1024 + ch); ezv[pb] = *(const uint2*)(PROJ + row * EVEN_PAD + 1536 + ch); }
            const float a0 = ACS[su0 * 128 + pos], a1 = ACS[su1 * 128 + pos];
            __syncthreads();
            SSDC_LDSW(0, sreg0); SSDC_LDSW(1, sreg1); SSDC_LDSW(2, sreg2); SSDC_LDSW(3, sreg3); SSDC_LDSW(4, sreg4); SSDC_LDSW(5, sreg5); SSDC_LDSW(6, sreg6); SSDC_LDSW(7, sreg7);
            if (it < 1) SSDC_SLOAD(it + 1);
            __syncthreads();
            const float sc0 = __expf(a0), sc1 = __expf(a1);
            const unsigned char* S0 = Sin + (hp * 2) * 64 * PT; const unsigned char* S1 = S0 + 64 * PT;
            f32x4 t0[4], t1[4];
#pragma unroll
            for (int pb = 0; pb < 4; ++pb) { t0[pb] = (f32x4){0.f, 0.f, 0.f, 0.f}; t1[pb] = (f32x4){0.f, 0.f, 0.f, 0.f}; }
#pragma unroll
            for (int ks = 0; ks < 4; ++ks) { const bf16x8 cf = *(const bf16x8*)(Cn + lpos * PT + (32 * ks + 8 * g) * 2);
#pragma unroll
                for (int pb = 0; pb < 4; ++pb) { const bf16x8 s0 = *(const bf16x8*)(S0 + (16 * pb + cl) * PT + (32 * ks + 8 * g) * 2), s1 = *(const bf16x8*)(S1 + (16 * pb + cl) * PT + (32 * ks + 8 * g) * 2);
                    t0[pb] = __builtin_amdgcn_mfma_f32_16x16x32_bf16(s0, cf, t0[pb], 0, 0, 0); t1[pb] = __builtin_amdgcn_mfma_f32_16x16x32_bf16(s1, cf, t1[pb], 0, 0, 0); } }
            const float dd = dsk[h];
#pragma unroll
            for (int pb = 0; pb < 4; ++pb) { const int ch = h * 64 + 16 * pb + 4 * g;
                const uint2 yf = eyf[pb], yb = eyb[pb], xv = exv[pb], zv = ezv[pb];
                f32x4 y = t0[pb] * sc0 + t1[pb] * sc1;
                y[0] = (y[0] + bflo(yf.x) + bflo(yb.x) + bflo(xv.x) * dd) * silu_f(bflo(zv.x)); y[1] = (y[1] + bfhi(yf.x) + bfhi(yb.x) + bfhi(xv.x) * dd) * silu_f(bfhi(zv.x));
                y[2] = (y[2] + bflo(yf.y) + bflo(yb.y) + bflo(xv.y) * dd) * silu_f(bflo(zv.y)); y[3] = (y[3] + bfhi(yf.y) + bfhi(yb.y) + bfhi(xv.y) * dd) * silu_f(bfhi(zv.y));
                uint2 o; o.x = pack2(y[0], y[1]); o.y = pack2(y[2], y[3]);
                const float r0 = bflo(o.x), r1 = bfhi(o.x), r2 = bflo(o.y), r3 = bfhi(o.y); ss += r0 * r0 + r1 * r1 + r2 * r2 + r3 * r3;
                *(uint2*)(A + row * 1024 + 512 + ch) = o; }
        }
#undef SSDC_SLOAD
#undef SSDC_SRC
#undef SSDC_LDSW
        ss += __shfl_xor(ss, 16); ss += __shfl_xor(ss, 32);
        if (g == 0) ssx[hp * 64 + lpos] = ss;
        __syncthreads();
        const float rn = rsqrtf((ssx[lpos] + ssx[64 + lpos]) * (1.f / 256.f) + EPS);
#pragma unroll 4
        for (int i = 0; i < 8; ++i) { const int ch = grp * 256 + (2 * hp + (i >> 2)) * 64 + 16 * (i & 3) + 4 * g; bf16_t* ap = A + row * 1024 + 512 + ch; const uint2 v = *(const uint2*)ap; const f32x4 gg = *(const f32x4*)(ng + ch);
            uint2 o; o.x = pack2(bflo(v.x) * rn * gg[0], bfhi(v.x) * rn * gg[1]); o.y = pack2(bflo(v.y) * rn * gg[2], bfhi(v.y) * rn * gg[3]); *(uint2*)ap = o; }
    }
    __syncthreads();
}

__device__ __forceinline__ uint4 rope8(const uint4 mine, const uint4 other, const float* ct, const float* st, bool upper, bool apply, float scale) {
    float m[8], o[8], r[8]; const unsigned mw[4] = {mine.x, mine.y, mine.z, mine.w}, ow[4] = {other.x, other.y, other.z, other.w};
#pragma unroll
    for (int j = 0; j < 4; ++j) { m[2 * j] = bflo(mw[j]); m[2 * j + 1] = bfhi(mw[j]); o[2 * j] = bflo(ow[j]); o[2 * j + 1] = bfhi(ow[j]); }
    if (apply) { const float4 c0 = ld4(ct), c1 = ld4(ct + 4), s0 = ld4(st), s1 = ld4(st + 4); const float c[8] = {c0.x, c0.y, c0.z, c0.w, c1.x, c1.y, c1.z, c1.w}, sn[8] = {s0.x, s0.y, s0.z, s0.w, s1.x, s1.y, s1.z, s1.w};
#pragma unroll
        for (int j = 0; j < 8; ++j) r[j] = (upper ? (m[j] * c[j] + o[j] * sn[j]) : (m[j] * c[j] - o[j] * sn[j])) * scale; }
    else {
#pragma unroll
        for (int j = 0; j < 8; ++j) r[j] = m[j] * scale; }
    uint4 q; q.x = pack2(r[0], r[1]); q.y = pack2(r[2], r[3]); q.z = pack2(r[4], r[5]); q.w = pack2(r[6], r[7]); return q;
}
__device__ __forceinline__ uint4 shfl_xor_u4(const uint4 v, int m) { uint4 r; r.x = __shfl_xor(v.x, m); r.y = __shfl_xor(v.y, m); r.z = __shfl_xor(v.z, m); r.w = __shfl_xor(v.w, m); return r; }
__device__ __forceinline__ void ph_attn_prep(const Fr& F) {
    const bf16_t* P = F.w<bf16_t>(L1_PROJ); float* SQ = F.w<float>(WS_SQ); float* SKV = F.w<float>(WS_SKV);
    bf16_t* KM = F.w<bf16_t>(L1_KM); bf16_t* QG = F.w<bf16_t>(L1_QG); bf16_t* KG = F.w<bf16_t>(L1_KG); bf16_t* VGT = F.w<bf16_t>(L1_VGT);
    const float* cm = F.w<float>(WS_ROPEM); const float* sm = cm + 2048 * 16; const float* cg = F.w<float>(WS_ROPEG); const float* sg = cg + 2048 * 32;
    const float gscale = 0.125f * LOG2E;
    for (int row = F.bid * 8 + F.wave; row < TT; row += F.G * 8) {
        const bf16_t* pr = P + (size_t)row * ODD_PAD; const bool lat = row < TL; const int pos = row & (SEQ - 1), l = F.lane;
        const int b = lat ? (row >> 11) : ((row - TL) >> 8), key = lat ? CTXL + pos : ((row - TL) & (CTXL - 1));
        { float s = 0.f; if (l < 48) { float v[8]; ld8bf(pr + l * 8, v);
#pragma unroll
              for (int j = 0; j < 8; ++j) s += v[j] * v[j]; }
          const float sq = wave_sum(l < 32 ? s : 0.f), skv = wave_sum(l >= 32 ? s : 0.f);
          if (l == 0) { SQ[row] = rsqrtf(sq * (1.f / 256.f) + EPS); SKV[row] = rsqrtf(skv * (1.f / 128.f) + EPS); } }
        { const uint4 mine = *(const uint4*)(pr + 416 + l * 8); const uint4 other = shfl_xor_u4(mine, 4); const int sub = l & 7, i0 = (sub & 3) * 8;
          if (lat) *(uint4*)(QG + (size_t)row * 512 + l * 8) = rope8(mine, other, cg + pos * 32 + i0, sg + pos * 32 + i0, sub >= 4, true, gscale); }
        { const int lk = l & 15; const uint4 mine = *(const uint4*)(pr + 928 + lk * 8); const uint4 other = shfl_xor_u4(mine, 4); const int sub = lk & 7, i0 = (sub & 3) * 8;
          const uint4 r = rope8(mine, other, cg + pos * 32 + i0, sg + pos * 32 + i0, sub >= 4, lat, 1.f);
          if (l < 16) *(uint4*)(KG + ((size_t)b * NKEY + key) * 128 + lk * 8) = r; }
        { const int lr = l & 3; const uint4 mine = *(const uint4*)(pr + 384 + lr * 8); const uint4 other = shfl_xor_u4(mine, 2); const int i0 = (lr & 1) * 8;
          const uint4 r = rope8(mine, other, cm + pos * 16 + i0, sm + pos * 16 + i0, lr >= 2, lat, 1.f);
          if (l < 4) { bf16_t* kb = KM + ((size_t)b * NKEY + key) * 768 + 64 + lr * 8;
#pragma unroll
              for (int h = 0; h < 8; ++h) *(uint4*)(kb + h * 96) = r; } }
    }
    bf16_t* vt = (bf16_t*)F.lds;
    for (int un = F.bid; un < TT / 64; un += F.G) {
        const int row0 = un * 64; const int b = row0 < TL ? (row0 >> 11) : ((row0 - TL) >> 8), key0 = row0 < TL ? CTXL + (row0 & (SEQ - 1)) : ((row0 - TL) & (CTXL - 1));
        { const int tok = F.tid >> 3, cq = F.tid & 7; const uint4 a = *(const uint4*)(P + (size_t)(row0 + tok) * ODD_PAD + 1056 + cq * 16), c2 = *(const uint4*)(P + (size_t)(row0 + tok) * ODD_PAD + 1056 + cq * 16 + 8);
          const unsigned wv[8] = {a.x, a.y, a.z, a.w, c2.x, c2.y, c2.z, c2.w};
#pragma unroll
          for (int j = 0; j < 8; ++j) { vt[(cq * 16 + 2 * j) * 66 + tok] = (bf16_t)(wv[j] & 0xFFFFu); vt[(cq * 16 + 2 * j + 1) * 66 + tok] = (bf16_t)(wv[j] >> 16); } }
        __syncthreads();
        { const int ch = F.tid >> 2, part = F.tid & 3; const unsigned* src = (const unsigned*)(vt + ch * 66 + part * 16); uint4 v0, v1; v0.x = src[0]; v0.y = src[1]; v0.z = src[2]; v0.w = src[3]; v1.x = src[4]; v1.y = src[5]; v1.z = src[6]; v1.w = src[7];
          uint4* dst = (uint4*)(VGT + ((size_t)(b * 2 + (ch >> 6)) * 64 + (ch & 63)) * NKEY + key0 + part * 16); dst[0] = v0; dst[1] = v1; }
        __syncthreads();
    }
}

typedef float f32x16 __attribute__((ext_vector_type(16)));
template <bool GQA>
__device__ __forceinline__ void ph_attn_mfma(const Fr& F) {
    constexpr int DQK = GQA ? 64 : 96, NKS = DQK / 16, KP = GQA ? 144 : 208, VP = 136, KCH = DQK / 8, NKCH = 64 * KCH;
    constexpr int KBYTES = 64 * KP, VBYTES = 64 * VP;
    unsigned char* Kb = F.lds; unsigned char* Vb = F.lds + 2 * KBYTES;
    bf16_t* A = F.w<bf16_t>(WS_ABUF);
    const int r = F.lane & 31, hh = F.lane >> 5;
    for (int u = F.bid; u < 512; u += F.G) {
        int b, ntile, lat_lo = 0, qpos, ocol; const bf16_t* qp; const bf16_t* kbase; const bf16_t* vtb; int kstride; float m_run, l_run;
        if (!GQA) { b = u >> 6; const int h = (u >> 3) & 7, qb = u & 7; qpos = qb * 256 + F.wave * 32 + r; ntile = NKEY / 64;
            qp = F.w<bf16_t>(L1_QM) + (size_t)(b * SEQ + qpos) * 768 + h * 96; kbase = F.w<bf16_t>(L1_KM) + (size_t)b * NKEY * 768 + h * 96; kstride = 768;
            vtb = F.w<bf16_t>(L1_VT) + (size_t)(b * 8 + h) * 64 * NKEY; m_run = 0.f; l_run = 0.f; ocol = h * 64; }
        else { b = u >> 6; const int kv = (u >> 5) & 1, qb = (u >> 1) & 15, pr = u & 1; const int head = kv * 4 + pr * 2 + (F.wave >> 2); qpos = qb * 128 + (F.wave & 3) * 32 + r;
            lat_lo = qb * 128 - 128 > 0 ? qb * 128 - 128 : 0; const int lat_hi = qb * 128 + 256 < SEQ ? qb * 128 + 256 : SEQ; ntile = 4 + (lat_hi - lat_lo) / 64;
            qp = F.w<bf16_t>(L1_QG) + (size_t)(b * SEQ + qpos) * 512 + head * 64; kbase = F.w<bf16_t>(L1_KG) + (size_t)b * NKEY * 128 + kv * 64; kstride = 128;
            vtb = F.w<bf16_t>(L1_VGT) + (size_t)(b * 2 + kv) * 64 * NKEY; m_run = F.in[I_SINK][head] * LOG2E; l_run = hh ? 0.f : 1.f; ocol = 512 + head * 64; }
        bf16x8 qf[NKS];
#pragma unroll
        for (int ks = 0; ks < NKS; ++ks) qf[ks] = *(const bf16x8*)(qp + 16 * ks + 8 * hh);
        f32x16 o0, o1;
#pragma unroll
        for (int i = 0; i < 16; ++i) { o0[i] = 0.f; o1[i] = 0.f; }
        const int kr0 = F.tid / KCH, kc0 = F.tid % KCH, kr1 = (F.tid + 512) / KCH, kc1 = (F.tid + 512) % KCH; const bool has2 = (F.tid + 512) < NKCH;
        const int vr = F.tid >> 3, vc = F.tid & 7;
        uint4 kreg0, kreg1 = make_uint4(0u, 0u, 0u, 0u), vreg;
        bf16x8 kf[NKS][2];
#define ATT_KIDX(t) ((!GQA || (t) < 4) ? (t) * 64 : CTXL + lat_lo + ((t) - 4) * 64)
#define ATT_LOAD(t) do { const int _k0 = ATT_KIDX(t); kreg0 = *(const uint4*)(kbase + (size_t)(_k0 + kr0) * kstride + kc0 * 8); \
            if (has2) kreg1 = *(const uint4*)(kbase + (size_t)(_k0 + kr1) * kstride + kc1 * 8); vreg = *(const uint4*)(vtb + (size_t)vr * NKEY + _k0 + vc * 8); } while (0)
#define ATT_WRITE(buf) do { *(uint4*)(Kb + (buf) * KBYTES + kr0 * KP + kc0 * 16) = kreg0; if (has2) *(uint4*)(Kb + (buf) * KBYTES + kr1 * KP + kc1 * 16) = kreg1; \
            *(uint2*)(Vb + (buf) * VBYTES + vr * VP + vc * 16) = make_uint2(vreg.x, vreg.y); *(uint2*)(Vb + (buf) * VBYTES + vr * VP + vc * 16 + 8) = make_uint2(vreg.z, vreg.w); } while (0)
#define ATT_KFRAGS(buf) do { const unsigned char* kb = Kb + (buf) * KBYTES; \
            _Pragma("unroll") for (int ks = 0; ks < NKS; ++ks) { kf[ks][0] = *(const bf16x8*)(kb + r * KP + (16 * ks + 8 * hh) * 2); kf[ks][1] = *(const bf16x8*)(kb + (32 + r) * KP + (16 * ks + 8 * hh) * 2); } } while (0)
        __syncthreads();
        ATT_LOAD(0); ATT_WRITE(0);
        __syncthreads();
        ATT_KFRAGS(0);
        for (int t = 0; t < ntile; ++t) {
            const int buf = t & 1; const bool more = (t + 1) < ntile;
            if (more) ATT_LOAD(t + 1);
            const unsigned char* vb = Vb + buf * VBYTES;
            f32x16 s0, s1;
#pragma unroll
            for (int i = 0; i < 16; ++i) { s0[i] = -m_run; s1[i] = -m_run; }
#pragma unroll
            for (int ks = 0; ks < NKS; ++ks) { s0 = __builtin_amdgcn_mfma_f32_32x32x16_bf16(kf[ks][0], qf[ks], s0, 0, 0, 0); s1 = __builtin_amdgcn_mfma_f32_32x32x16_bf16(kf[ks][1], qf[ks], s1, 0, 0, 0); }
            union { bf16x8 v; uint2 h2[2]; } vf[4][2];
#pragma unroll
            for (int s2 = 0; s2 < 4; ++s2) { vf[s2][0].h2[0] = *(const uint2*)(vb + r * VP + (16 * s2 + 4 * hh) * 2); vf[s2][0].h2[1] = *(const uint2*)(vb + r * VP + (16 * s2 + 8 + 4 * hh) * 2);
                vf[s2][1].h2[0] = *(const uint2*)(vb + (32 + r) * VP + (16 * s2 + 4 * hh) * 2); vf[s2][1].h2[1] = *(const uint2*)(vb + (32 + r) * VP + (16 * s2 + 8 + 4 * hh) * 2); }
            __builtin_amdgcn_sched_barrier(0);
            if (GQA && t >= 4) { const int kp0 = lat_lo + (t - 4) * 64 + 4 * hh - qpos;
#pragma unroll
                for (int i = 0; i < 16; ++i) { const int rel = kp0 + (i & 3) + 8 * (i >> 2); if (rel > 128 || rel < -128) s0[i] = -1.0e30f; if (rel + 32 > 128 || rel + 32 < -128) s1[i] = -1.0e30f; } }
            float tmax = s0[0];
#pragma unroll
            for (int i = 1; i < 16; ++i) tmax = fmaxf(tmax, s0[i]);
#pragma unroll
            for (int i = 0; i < 16; ++i) tmax = fmaxf(tmax, s1[i]);
            tmax = fmaxf(tmax, __shfl_xor(tmax, 32));
            const float dm = fmaxf(tmax, 0.f); const bool grow = __any(tmax > 0.f) != 0; float alpha = 1.f;
            float ls = 0.f;
            if (grow) { alpha = __builtin_amdgcn_exp2f(-dm); m_run += dm;
#pragma unroll
                for (int i = 0; i < 16; ++i) { s0[i] = __builtin_amdgcn_exp2f(s0[i] - dm); s1[i] = __builtin_amdgcn_exp2f(s1[i] - dm); ls += s0[i] + s1[i]; } }
            else {
#pragma unroll
                for (int i = 0; i < 16; ++i) { s0[i] = __builtin_amdgcn_exp2f(s0[i]); s1[i] = __builtin_amdgcn_exp2f(s1[i]); ls += s0[i] + s1[i]; } }
            l_run = l_run * alpha + ls;
            if (grow) {
#pragma unroll
                for (int i = 0; i < 16; ++i) { o0[i] *= alpha; o1[i] *= alpha; } }
#pragma unroll
            for (int s2 = 0; s2 < 4; ++s2) {
                union { bf16x8 v; unsigned w[4]; } pf;
#pragma unroll
                for (int j = 0; j < 4; ++j) { const int ri = 8 * (s2 & 1) + 2 * j; pf.w[j] = (s2 < 2) ? pack2(s0[ri], s0[ri + 1]) : pack2(s1[ri], s1[ri + 1]); }
                o0 = __builtin_amdgcn_mfma_f32_32x32x16_bf16(vf[s2][0].v, pf.v, o0, 0, 0, 0); o1 = __builtin_amdgcn_mfma_f32_32x32x16_bf16(vf[s2][1].v, pf.v, o1, 0, 0, 0);
            }
            if (more) ATT_WRITE(buf ^ 1);
            __syncthreads();
            if (more) ATT_KFRAGS(buf ^ 1);
        }
#undef ATT_KFRAGS
#undef ATT_KIDX
#undef ATT_LOAD
#undef ATT_WRITE
        const float inv = 1.f / (l_run + __shfl_xor(l_run, 32));
        bf16_t* op = A + (size_t)(b * SEQ + qpos) * 1024 + ocol + 4 * hh;
#pragma unroll
        for (int t4 = 0; t4 < 4; ++t4) { uint2 p;
            p.x = pack2(o0[4 * t4] * inv, o0[4 * t4 + 1] * inv); p.y = pack2(o0[4 * t4 + 2] * inv, o0[4 * t4 + 3] * inv); *(uint2*)(op + 8 * t4) = p;
            p.x = pack2(o1[4 * t4] * inv, o1[4 * t4 + 1] * inv); p.y = pack2(o1[4 * t4 + 2] * inv, o1[4 * t4 + 3] * inv); *(uint2*)(op + 32 + 8 * t4) = p; }
    }
    __syncthreads();
}

template <class Epi>
__device__ __forceinline__ void run_gemm(const Fr& F, const bf16_t* A, int lda, const bf16_t* Bt, int ldb, int M, int N, int K, const Epi& E) {
    pg8::Gemm g{A, Bt, M, N, K, lda, ldb, 0}; pg8::StaticOrder S; S.init(M, N, F.G, F.bid);
    pg8::gemm_phase<Epi, pg8::StaticOrder>((LAS unsigned char*)F.lds, g, S, E);
}

__global__ void __launch_bounds__(NTHR, 2) fwd(Args args) {
    extern __shared__ __attribute__((aligned(16))) unsigned char lds[];
    Fr F; F.in = args.in; F.out = args.out; F.ws = args.ws; F.lds = lds; F.tid = threadIdx.x; F.lane = F.tid & 63; F.wave = __builtin_amdgcn_readfirstlane(F.tid >> 6); F.G = gridDim.x; F.bid = blockIdx.x;
    const int lo = args.ph_lo, hi = args.ph_hi;
#ifndef PHMASK
#define PHMASK 0xFFFFFFFFu
#endif
#define IN(k) (((PHMASK >> (k)) & 1u) && lo <= (k) && (k) < hi)
    const float* MOD0 = F.w<float>(WS_MOD); const float* MOD1 = MOD0 + 9 * 6144;
    const bool multi_phase = (hi - lo) > 1;
    if (F.tid == 0) *(uint4*)(lds + LDS_BYTES - 16) = make_uint4(0u, 0u, 0u, 0u);
    __syncthreads();
    XcdBarrier bar; bar.bar = F.w<unsigned>(WS_CTL); bar.x = 0; bar.st = (volatile LAS unsigned*)(LAS unsigned char*)(lds + LDS_BYTES - 16);
    if (multi_phase) bar = xcd_barrier_post(F.w<unsigned>(WS_CTL), (volatile LAS unsigned*)(LAS unsigned char*)(lds + LDS_BYTES - 16));
#define SEAM(k) do { if (IN(k) && IN((k) + 1)) xcd_barrier(bar); } while (0)
    bf16_t* ABUF = F.w<bf16_t>(WS_ABUF);

#ifndef DUPMASK
#define DUPMASK 0u
#endif
#define PHASE(k, ...) if (IN(k)) { __VA_ARGS__ } if (IN(k) && ((DUPMASK >> (k)) & 1u)) { xcd_barrier(bar); __VA_ARGS__ } SEAM(k);
#define PHASED(k, ...) if (IN(k)) { __VA_ARGS__ } if (IN(k) && ((DUPMASK >> (k)) & 1u)) { xcd_barrier(bar); __VA_ARGS__ } \
    if (IN(k) && IN((k) + 1)) { unsigned gen_ = 0u; XB_OVERLAP_ARRIVE(bar, gen_); cvt_dense_window(F, (k) - 1); XB_OVERLAP_WAIT(bar, gen_); }
#define PHASEW(k, ...) if (IN(k)) { __VA_ARGS__ } if (IN(k) && ((DUPMASK >> (k)) & 1u)) { xcd_barrier(bar); __VA_ARGS__ } \
    if (IN(k) && IN((k) + 1)) { unsigned gen_ = 0u; XB_OVERLAP_ARRIVE(bar, gen_); cvt_window(F, (k) - 8); XB_OVERLAP_WAIT(bar, gen_); }
    PHASE(0,
        ph_ada(F);
        cvt_job(F, F.in[I_EVWIN], nullptr, nullptr, F.w<bf16_t>(W_IN0), EVEN_PAD, 1024, 1024, EVEN_IN, EVEN_IN, 0, 1, (F.bid + 64) % F.G, F.G);
        if (!multi_phase) cvt_dense_range(F, 0, CVD_T_ALL);
        ph_filters(F); ph_rope_tables(F);)
    PHASED(1, ph_norm0(F);)
    PHASED(2, run_gemm(F, ABUF, 1024, F.w<bf16_t>(W_IN0), 1024, TT, EVEN_PAD, 1024, pg8::EpiBf16Plain{F.w<bf16_t>(L0_PROJ), EVEN_PAD});)
    PHASED(3, ph_convpass(F);)
    PHASED(4, ph_ssd_a(F); ph_hyena_mfma(F);)
    PHASE(6, ph_ssd_b(F);)
    PHASE(7, ph_ssd_c(F); ph_hyena_post(F);)
    PHASEW(8,
        run_gemm(F, ABUF, 1024, F.w<bf16_t>(W_OUT0), 1024, TL, 1024, 1024, pg8::EpiBf16Plain{F.w<bf16_t>(L0_MBUF), 1024});
        { pg8::Gemm g{ABUF, F.w<bf16_t>(W_OUT0), TT, 1024, 1024, 1024, 1024, 0}; pg8::DenseTailOrder<8> S; S.init(TL / 256, TC / 256, 1024 / 64, F.G, F.bid);
          pg8::gemm_phase<pg8::EpiTailBf16, pg8::DenseTailOrder<8>>((LAS unsigned char*)F.lds, g, S, pg8::EpiTailBf16{F.w<bf16_t>(L0_MBUF), 1024, F.w<bf16_t>(L0_XT), TL / 256, 8}); }
        )
    PHASEW(9, ph_thin<0, true, false>(F, (const float*)F.w<bf16_t>(L0_MBUF), TT, F.in[I_X], F.in[I_CTX], nullptr, nullptr, F.in[I_MIXPOST], MOD0, 2048, F.in[I_FFNPRE], MOD0, 3072, 4096, ABUF, 0, 1, F.w<bf16_t>(L0_XT), 8);)
    PHASEW(10, run_gemm(F, ABUF, 1024, F.w<bf16_t>(W_GU0), 1024, TT, 2 * DFF, 1024, pg8::EpiSwiglu{F.w<bf16_t>(L0_HMID), DFF});)
    PHASEW(11,
        run_gemm(F, F.w<bf16_t>(L0_HMID), DFF, F.w<bf16_t>(W_DN0), DFF, TL, 1024, DFF, pg8::EpiBf16Plain{F.w<bf16_t>(L0_MBUF), 1024});
        { pg8::Gemm g{F.w<bf16_t>(L0_HMID), F.w<bf16_t>(W_DN0), TT, 1024, DFF, DFF, DFF, 0}; pg8::DenseTailOrder<11> S; S.init(TL / 256, TC / 256, DFF / 64, F.G, F.bid);
          pg8::gemm_phase<pg8::EpiTailBf16, pg8::DenseTailOrder<11>>((LAS unsigned char*)F.lds, g, S, pg8::EpiTailBf16{F.w<bf16_t>(L0_MBUF), 1024, F.w<bf16_t>(L0_XT), TL / 256, 11}); }
        )
    PHASEW(12, ph_thin<0, false, false>(F, (const float*)F.w<bf16_t>(L0_MBUF), TT, nullptr, nullptr, nullptr, nullptr, F.in[I_FFNPOST], MOD0, 5120, F.in[I_MIXPRE] + 1024, MOD1, 0, 1024, ABUF, 0, 1, F.w<bf16_t>(L0_XT), 11);)
    PHASEW(13, run_gemm(F, ABUF, 1024, F.w<bf16_t>(W_IN1), 1024, TT, ODD_PAD, 1024, pg8::EpiBf16Plain{F.w<bf16_t>(L1_PROJ), ODD_PAD});)
    PHASEW(14, ph_attn_prep(F);)
    PHASEW(15,
        run_gemm(F, F.w<bf16_t>(L1_PROJ), ODD_PAD, F.w<bf16_t>(W_QUP), 256, TL, 768, 256, pg8::EpiQ{F.w<bf16_t>(L1_QM), F.w<float>(WS_SQ), F.w<float>(WS_ROPEM), F.w<float>(WS_ROPEM) + 2048 * 16, 0.10206207261596575f * LOG2E});
        run_gemm(F, F.w<bf16_t>(L1_PROJ) + 256, ODD_PAD, F.w<bf16_t>(W_KUP), 256, TT, 512, 256, pg8::EpiK{F.w<bf16_t>(L1_KM), F.w<float>(WS_SKV)});
        run_gemm(F, F.w<bf16_t>(W_VUP), 256, F.w<bf16_t>(L1_PROJ) + 256, ODD_PAD, 512, TT, 256, pg8::EpiVT{F.w<bf16_t>(L1_VT), F.w<float>(WS_SKV)});)
    PHASEW(16, ph_attn_mfma<false>(F); ph_attn_mfma<true>(F);)
    PHASEW(17, run_gemm(F, ABUF, 1024, F.w<bf16_t>(W_OUT1), 1024, TL, 1024, 1024, pg8::EpiBf16Plain{F.w<bf16_t>(L1_MBUF), 1024});)
    PHASEW(18, ph_thin<1, false, false>(F, (const float*)F.w<bf16_t>(L1_MBUF), TL, nullptr, nullptr, nullptr, nullptr, F.in[I_MIXPOST] + 1024, MOD1, 2048, F.in[I_FFNPRE] + 1024, MOD1, 3072, 4096, F.w<bf16_t>(L1_A2TMP));)
    PHASE(19,
        ph_moe_gather(F);
        { const int w0 = multi_phase ? CVW_NWIN * CVW_Q * F.G : 0; cvt_moe_range<true>(F, w0 < CVT_T_ALL ? w0 : CVT_T_ALL, CVT_T_ALL, F.bid, F.G); })
    PHASE(20,
        if (MOE_FP8) { pg8::Gemm g{F.w<bf16_t>(WS_AG), F.w<bf16_t>(WM_GU), 0, 2 * DFE, 512, 512, 512, (size_t)2 * DFE * 1024}; pg8::GroupedOrder S; S.init(F.w<unsigned>(WS_CNT), 2 * DFE / 256, F.G, F.bid);
            pg8::gemm_phase<pg8::EpiSwigluF8, pg8::GroupedOrder, true>((LAS unsigned char*)F.lds, g, S, pg8::EpiSwigluF8{F.w<unsigned char>(L1_HMID), DFE}); }
        else { pg8::Gemm g{F.w<bf16_t>(WS_AG), F.w<bf16_t>(WM_GU), 0, 2 * DFE, 1024, 1024, 1024, (size_t)2 * DFE * 1024 * 2}; pg8::GroupedOrder S; S.init(F.w<unsigned>(WS_CNT), 2 * DFE / 256, F.G, F.bid);
            pg8::gemm_phase<pg8::EpiSwiglu, pg8::GroupedOrder>((LAS unsigned char*)F.lds, g, S, pg8::EpiSwiglu{F.w<bf16_t>(L1_HMID), DFE}); })
    PHASE(21,
        constexpr int KE = MOE_FP8 ? DFE / 2 : DFE;
        constexpr float osc = MOE_FP8 ? 1.f / (F8_WSCALE * F8_HSCALE) : 1.f;
        pg8::Gemm g{F.w<bf16_t>(L1_HMID), F.w<bf16_t>(WM_DN), 0, 1024, KE, KE, KE, (size_t)1024 * KE * 2};
        { pg8::GroupedOrder S; S.init(F.w<unsigned>(WS_CNT), 4, F.G, F.bid, KE / 64, true);
          pg8::gemm_phase<pg8::EpiMoeOut, pg8::GroupedOrder, MOE_FP8 != 0>((LAS unsigned char*)F.lds, g, S, pg8::EpiMoeOut{F.w<bf16_t>(WS_MOUT), F.w<uint2>(WS_ROWINFO), osc}); }
        { pg8::TailOrder S; S.init(F.w<unsigned>(WS_CNT), F.G, F.bid, KE / 64);
          pg8::gemm_phase<pg8::EpiXtr, pg8::TailOrder, MOE_FP8 != 0>((LAS unsigned char*)F.lds, g, S, pg8::EpiXtr{F.w<bf16_t>(WS_MOUT), F.w<uint2>(WS_ROWINFO), F.w<bf16_t>(WS_XTR), S.NTF, 7, osc}); })
    PHASE(22,
        pg8::TailOrder S; S.init(F.w<unsigned>(WS_CNT), F.G, F.bid, (MOE_FP8 ? DFE / 2 : DFE) / 64);
        ph_thin<2, false, true>(F, (const float*)F.w<bf16_t>(WS_MOUT), TL, nullptr, nullptr, F.out, nullptr, F.in[I_FFNPOST] + 1024, MOD1, 5120, nullptr, nullptr, 0, 0, nullptr, S.NTF, S.nsub > 0 ? 7 : 1);)
#undef IN
}

extern "C" void kernel_launch(void* const* d_in, const int* in_sizes, int n_in, void* d_out, int out_size, void* d_ws, size_t ws_size, hipStream_t stream) {
    static int grid = 0;
    if (grid == 0) {
        if (n_in != 41 || out_size != TL * DM || ws_size < WS_END) { fprintf(stderr, "kernel_launch: unexpected shapes (n_in %d, out %d, ws %zu < %zu)\n", n_in, out_size, ws_size, (size_t)WS_END); grid = -1; return; }
        int dev = 0, cus = 0;
        if (hipGetDevice(&dev) != hipSuccess || hipDeviceGetAttribute(&cus, hipDeviceAttributeMultiprocessorCount, dev) != hipSuccess) { grid = -1; return; }
        if (hipFuncSetAttribute((const void*)fwd, hipFuncAttributeMaxDynamicSharedMemorySize, LDS_BYTES) != hipSuccess) { fprintf(stderr, "kernel_launch: hipFuncSetAttribute failed\n"); grid = -1; return; }
        int per_cu = 0;
        if (hipOccupancyMaxActiveBlocksPerMultiprocessor(&per_cu, (const void*)fwd, NTHR, LDS_BYTES) != hipSuccess || per_cu < 1) fprintf(stderr, "kernel_launch: occupancy query says %d\n", per_cu);
        (void)hipGetLastError();
        grid = cus;
        if (grid % 4 != 0) { fprintf(stderr, "kernel_launch: the kernel needs a grid size that is a multiple of 4 (got %d CUs)\n", grid); grid = -1; return; }
    }
    if (grid < 0) return;
    (void)hipMemsetAsync((char*)d_ws + WS_CTL, 0, 65536, stream);
    Args a{};
    for (int i = 0; i < 41; ++i) a.in[i] = (const float*)d_in[i];
    a.out = (float*)d_out; a.ws = (unsigned char*)d_ws;
    auto launch = [&](int lo, int hi, int ex) { a.ph_lo = lo; a.ph_hi = hi; a.ex = ex; hipLaunchKernelGGL(fwd, dim3(grid), dim3(NTHR), LDS_BYTES, stream, a); };
#if defined(MULTI)
    for (int p = 0; p <= 22; ++p) launch(p, p + 1, 0);
#else
    launch(0, 23, 0);
#endif
}
```

```cpp
#include <hip/hip_runtime.h>
#include <cstdio>
#include <cstdint>

typedef unsigned short bf16_t;
typedef short bf16x8 __attribute__((ext_vector_type(8)));
typedef float f32x4 __attribute__((ext_vector_type(4)));
#define LAS __attribute__((address_space(3)))

constexpr int NB = 8, SEQ = 2048, DM = 1024, CTXL = 256;
constexpr int TL = NB * SEQ, TC = NB * CTXL, TT = TL + TC, NKEY = SEQ + CTXL;
constexpr int EVEN_IN = 3088, EVEN_PAD = 3328, ODD_PAD = 1280, DFF = 2816, DFE = 3584, NEXP = 8;
constexpr float EPS = 1e-6f;
constexpr float LOG2E = 1.4426950408889634f;
constexpr int NTHR = 512;
constexpr int LDS_BYTES = 147456;

constexpr size_t al256(size_t x) { return (x + 255) & ~(size_t)255; }
constexpr size_t WS_CTL = 0;
constexpr size_t WS_CNT = 16384;
constexpr size_t WS_MOD = 65536;
constexpr size_t WS_ROPEM = WS_MOD + al256((size_t)2 * 9 * 6144 * 4);
constexpr size_t WS_ROPEG = WS_ROPEM + (size_t)2 * 2048 * 16 * 4;
constexpr size_t WS_SQ = WS_ROPEG + (size_t)2 * 2048 * 32 * 4;
constexpr size_t WS_SKV = WS_SQ + al256((size_t)TT * 4);
constexpr size_t WS_TOPW = WS_SKV + al256((size_t)TT * 4);
constexpr size_t WS_LISTE = WS_TOPW + (size_t)TL * 2 * 4;
constexpr int MAXROWS = 34816;
constexpr size_t WS_ROWINFO = WS_LISTE + (size_t)NEXP * TL * 4;
constexpr size_t WS_ROWW = WS_ROWINFO + (size_t)MAXROWS * 4;
constexpr size_t WS_SROW = WS_ROWW + (size_t)MAXROWS * 4;
constexpr size_t WS_W0 = WS_SROW + (size_t)TL * 2 * 4;
constexpr size_t W_IN0 = WS_W0;
constexpr size_t W_OUT0 = W_IN0 + (size_t)EVEN_PAD * 1024 * 2;
constexpr size_t W_GU0 = W_OUT0 + (size_t)1024 * 1024 * 2;
constexpr size_t W_DN0 = W_GU0 + (size_t)2 * DFF * 1024 * 2;
constexpr size_t W_IN1 = W_DN0 + (size_t)1024 * DFF * 2;
constexpr size_t W_QUP = W_IN1 + (size_t)ODD_PAD * 1024 * 2;
constexpr size_t W_KUP = W_QUP + (size_t)768 * 256 * 2;
constexpr size_t W_VUP = W_KUP + (size_t)512 * 256 * 2;
constexpr size_t W_OUT1 = W_VUP + (size_t)512 * 256 * 2;
constexpr size_t WS_ABUF = W_OUT1 + (size_t)1024 * 1024 * 2;
constexpr size_t WS_AG = WS_W0;
constexpr size_t WS_MOUT = WS_W0;
constexpr size_t XG_END0 = WS_ABUF + (size_t)TT * DM * 2, XG_END1 = WS_AG + (size_t)MAXROWS * DM * 2;
constexpr size_t WS_R1 = al256(XG_END0 > XG_END1 ? XG_END0 : XG_END1);
constexpr size_t R1_BYTES = (size_t)MAXROWS * DFE * 2;
constexpr size_t WS_R2 = WS_R1 + R1_BYTES;
constexpr size_t R2_BYTES = (size_t)132 * 1024 * 1024;
constexpr size_t WS_XTR = WS_R2 + R2_BYTES;
constexpr size_t WS_HB = WS_XTR + (size_t)32 * 6 * 65536 * 2;
constexpr size_t WS_END = WS_HB + (size_t)TT * DM * 2;
static_assert(WS_END <= (size_t)536000000, "workspace budget");
constexpr size_t L0_PROJ = WS_R1;
constexpr size_t L0_HMID = WS_R1;
constexpr size_t L0_XBC = L0_PROJ + (size_t)TT * EVEN_PAD * 2;
constexpr size_t L0_U = L0_XBC + (size_t)TT * 1024 * 2;
constexpr size_t L0_X0 = L0_U + (size_t)TT * 512 * 2;
constexpr size_t L0_DT = L0_X0 + (size_t)TT * 512 * 2;
constexpr size_t L0_YF = L0_DT + (size_t)TT * 16 * 4;
constexpr size_t L0_YB = L0_YF + (size_t)TT * 512 * 2;
static_assert(L0_YB + (size_t)TT * 512 * 2 <= WS_R1 + R1_BYTES, "R1 layer 0");
constexpr size_t L0_MBUF = WS_R1 + (size_t)128 * 1024 * 1024;
static_assert(L0_MBUF >= L0_HMID + (size_t)TT * DFF * 2 && L0_MBUF + (size_t)TT * DM * 2 <= WS_R1 + R1_BYTES, "MBUF0 placement");
constexpr size_t L0_XT = WS_R1 + (size_t)176 * 1024 * 1024;
static_assert(L0_XT >= L0_MBUF + (size_t)TT * DM * 2 && L0_XT + (size_t)32 * 10 * 65536 * 2 <= WS_R1 + R1_BYTES, "XT0 placement");
constexpr size_t L0_FL = WS_R2 + (size_t)TT * DM * 2;
constexpr size_t L0_FC = L0_FL + (size_t)512 * 4096 * 2;
constexpr size_t L0_YT = L0_FC + (size_t)512 * 512 * 2;
constexpr size_t L0_ST = L0_YT + (size_t)512 * 8 * NKEY * 2;
constexpr size_t L0_ACS = L0_ST + (size_t)2304 * 8192 * 4;
constexpr size_t L0_ATOT = L0_ACS + (size_t)2304 * 128 * 4;
constexpr size_t L0_STIN = WS_R2;
static_assert(L0_ATOT + (size_t)2304 * 4 <= WS_R2 + R2_BYTES, "R2 layer 0");
constexpr size_t L1_HMID = WS_R1;
constexpr size_t L1_A2TMP = WS_R1;
constexpr size_t L1_PROJ = WS_R1;
constexpr size_t L1_QM = L1_PROJ + (size_t)TT * ODD_PAD * 2;
constexpr size_t L1_KM = L1_QM + (size_t)TL * 768 * 2;
constexpr size_t L1_VT = L1_KM + (size_t)NB * NKEY * 768 * 2;
constexpr size_t L1_QG = L1_VT + (size_t)NB * 512 * NKEY * 2;
constexpr size_t L1_KG = L1_QG + (size_t)TL * 512 * 2;
constexpr size_t L1_VGT = L1_KG + (size_t)NB * NKEY * 128 * 2;
constexpr size_t L1_MBUF = L1_VGT + (size_t)NB * 128 * NKEY * 2;
static_assert(L1_MBUF + (size_t)TL * DM * 4 <= WS_R1 + R1_BYTES, "R1 layer 1");
static_assert(L1_A2TMP + (size_t)TL * DM * 2 <= L1_MBUF, "a2tmp vs mbuf1");
constexpr size_t WM_GU = WS_R2;
constexpr size_t WM_DN = WM_GU + (size_t)NEXP * 2 * DFE * 1024;
static_assert(WM_DN + (size_t)NEXP * 1024 * DFE <= WS_R2 + R2_BYTES, "fp8 expert weights vs R2");

typedef __bf16 bf16v2 __attribute__((ext_vector_type(2)));
typedef float f32v2 __attribute__((ext_vector_type(2)));
__device__ __forceinline__ bf16_t f2bf(float f) { return __builtin_bit_cast(unsigned short, (__bf16)f); }
__device__ __forceinline__ float bf2f(bf16_t b) { return __uint_as_float(((unsigned)b) << 16); }
__device__ __forceinline__ unsigned pack2(float lo, float hi) { f32v2 v = {lo, hi}; return __builtin_bit_cast(unsigned, __builtin_convertvector(v, bf16v2)); }
#ifndef MOE_FP8
#define MOE_FP8 1
#endif
constexpr float F8_WSCALE = 64.f, F8_HSCALE = 8.f;
__device__ __forceinline__ unsigned pack4_fp8(float a, float b, float c, float d) { unsigned r = 0u; r = __builtin_amdgcn_cvt_pk_fp8_f32(a, b, r, false); r = __builtin_amdgcn_cvt_pk_fp8_f32(c, d, r, true); return r; }
__device__ __forceinline__ float bflo(unsigned u) { return __uint_as_float(u << 16); }
__device__ __forceinline__ float bfhi(unsigned u) { return __uint_as_float(u & 0xFFFF0000u); }
__device__ __forceinline__ float wave_sum(float v) {
#pragma unroll
    for (int o = 32; o > 0; o >>= 1) v += __shfl_xor(v, o);
    return v;
}
__device__ __forceinline__ float silu_f(float x) { return x * __builtin_amdgcn_rcpf(1.f + __builtin_amdgcn_exp2f(-x * LOG2E)); }
__device__ __forceinline__ float softplus_f(float x) { return x > 20.f ? x : log1pf(expf(x)); }

namespace pg8 {
constexpr int BM = 256, BK = 64, HALF = 128, HTB = HALF * BK * 2, STAGE_BYTES = 8 * HTB, NXCD = 8, WGM = 8;
__host__ __device__ __forceinline__ int lds_byte(int r, int c) { const int st = (r >> 4) * 2 + (c >> 5), rr = r & 15, cc = c & 31, ob = rr * 64 + cc * 2; return st * 1024 + (ob ^ (((ob >> 9) & 1) << 5)); }
__host__ __device__ __forceinline__ void stage_rc(int b, int& R, int& C) { const int st = b / 1024, sb = b % 1024, swz = sb ^ (((sb >> 9) & 1) << 5); R = (st >> 1) * 16 + swz / 64; C = (st & 1) * 32 + (swz % 64) / 2; }

struct Unit { int pm, pn, e, kt0, nkt, ks; };
struct Gemm { const bf16_t* A; const bf16_t* Bt; int M, N, K, lda, ldb; size_t bstride; };

struct StaticOrder {
    int nM, nN, nwg, G, c;
    __device__ __forceinline__ void init(int M, int N, int G_, int c_) { nM = M / BM; nN = N / BM; nwg = nM * nN; G = G_; c = c_; }
    __device__ __forceinline__ bool next(int i, Unit& u) const {
        const long L = (long)i * G + c; if (L >= nwg) return false;
        int wgid = (int)L; { const int q = nwg / NXCD, r = nwg % NXCD, xcd = wgid % NXCD, off = wgid / NXCD; wgid = (xcd < r ? xcd * (q + 1) : r * (q + 1) + (xcd - r) * q) + off; }
        const int nig = WGM * nN, gid = wgid / nig, fm = gid * WGM, gsz = (nM - fm) < WGM ? (nM - fm) : WGM;
        u.pm = fm + ((wgid % nig) % gsz); u.pn = (wgid % nig) / gsz; u.e = 0; u.kt0 = 0; u.nkt = 0; u.ks = 0; return true;
    }
};


struct GroupedOrder {
    int ts1, ts2, ts3, ts4, ts5, ts6, ts7, NT, nrow, nN, G, c;
    __device__ __forceinline__ static void tail_of(int NT, int nN, int G, int nkt_full, int& NTF, int& S) {
        NTF = NT; S = 1;
        if (nN == 4 && (G % 4) == 0) { const int ntf = ((NT * 4) / G) * (G / 4); const int R = (NT - ntf) * 4; if (R > 0 && ntf > 0 && R * 7 <= G && nkt_full % 14 == 0) { NTF = ntf; S = 7; } }
    }
    __device__ __forceinline__ void init(const unsigned* cnt, int nN_, int G_, int c_, int nkt_full = 0, bool head_only = false) {
        int t[9]; t[0] = 0;
#pragma unroll
        for (int e = 0; e < 8; ++e) t[e + 1] = t[e] + __builtin_amdgcn_readfirstlane((int)((__hip_atomic_load(cnt + e, __ATOMIC_RELAXED, __HIP_MEMORY_SCOPE_AGENT) + 255u) >> 8));
        ts1 = t[1]; ts2 = t[2]; ts3 = t[3]; ts4 = t[4]; ts5 = t[5]; ts6 = t[6]; ts7 = t[7]; NT = t[8]; nN = nN_; G = G_; c = c_; nrow = NT;
        if (head_only) { int ntf, s; tail_of(NT, nN, G, nkt_full, ntf, s); nrow = ntf; }
    }
    __device__ __forceinline__ int expert_of(int j) const { return (j >= ts1) + (j >= ts2) + (j >= ts3) + (j >= ts4) + (j >= ts5) + (j >= ts6) + (j >= ts7); }
    __device__ __forceinline__ bool next(int i, Unit& u) const {
        const int nwg = nrow * nN; const long L = (long)i * G + c; u.kt0 = 0; u.nkt = 0; u.ks = 0; if (L >= nwg) return false;
        int wgid = (int)L; { const int q = nwg / NXCD, r = nwg % NXCD, xcd = wgid % NXCD, off = wgid / NXCD; wgid = (xcd < r ? xcd * (q + 1) : r * (q + 1) + (xcd - r) * q) + off; }
        const int nig = WGM * nN, gid = wgid / nig, fm = gid * WGM, gsz = (nrow - fm) < WGM ? (nrow - fm) : WGM;
        const int j = fm + ((wgid % nig) % gsz); u.pm = j; u.pn = (wgid % nig) / gsz; u.e = expert_of(j); return true;
    }
};
struct TailOrder {
    int ts1, ts2, ts3, ts4, ts5, ts6, ts7, nsub, NTF, nkt, c;
    __device__ __forceinline__ void init(const unsigned* cnt, int G, int c_, int nkt_full) {
        int t[9]; t[0] = 0;
#pragma unroll
        for (int e = 0; e < 8; ++e) t[e + 1] = t[e] + __builtin_amdgcn_readfirstlane((int)((__hip_atomic_load(cnt + e, __ATOMIC_RELAXED, __HIP_MEMORY_SCOPE_AGENT) + 255u) >> 8));
        ts1 = t[1]; ts2 = t[2]; ts3 = t[3]; ts4 = t[4]; ts5 = t[5]; ts6 = t[6]; ts7 = t[7]; int s; GroupedOrder::tail_of(t[8], 4, G, nkt_full, NTF, s);
        nsub = (s == 7) ? (t[8] - NTF) * 28 : 0; nkt = nkt_full / 7; c = c_;
    }
    __device__ __forceinline__ bool next(int i, Unit& u) const {
        if (i > 0 || c >= nsub) return false;
        const int tu = c / 7, ks = c - tu * 7, j = NTF + (tu >> 2); u.pm = j; u.pn = tu & 3; u.e = (j >= ts1) + (j >= ts2) + (j >= ts3) + (j >= ts4) + (j >= ts5) + (j >= ts6) + (j >= ts7);
        u.nkt = nkt; u.kt0 = ks * nkt; u.ks = ks; return true;
    }
};

typedef int i32x4v __attribute__((ext_vector_type(4)));
typedef int i32x8v __attribute__((ext_vector_type(8)));
template <class Epi, class Sched, bool FP8 = false>
__device__ __forceinline__ void gemm_phase(LAS unsigned char* lds, const Gemm g, const Sched& S, const Epi& E) {
    const int tid = threadIdx.x, wid = __builtin_amdgcn_readfirstlane(tid >> 6), lane = tid & 63, wr = wid >> 2, wc = wid & 3, fr = lane & 15, fq = lane >> 4;
    int Kop = g.K; asm volatile("" : "+s"(Kop));
    const int K = Kop, nt = K / BK;
    unsigned voffA[2], voffB[2];
#pragma unroll
    for (int i = 0; i < 2; ++i) { int R, C; stage_rc(tid * 16 + i * 8192, R, C); voffA[i] = (unsigned)(R * g.lda + C) * 2u; voffB[i] = (unsigned)(R * g.ldb + C) * 2u; }
    const size_t kstep = (size_t)(BK * 2);
    const size_t hstepA = (size_t)HALF * g.lda * 2, hstepB = (size_t)HALF * g.ldb * 2;
    const size_t tstepA = 2 * hstepA, tstepB = 2 * hstepB;
    const unsigned ldsw = (unsigned)wid * 1024u;
    const int aoff = lds_byte(wr * 64 + fr, fq * 8), boff = lds_byte(wc * 32 + fr, fq * 8);
#define PG8_SA(b, h) (((b) * 2 + (h)) * HTB)
#define PG8_SB(b, h) ((4 + (b) * 2 + (h)) * HTB)
#define PG8_STAGE(bufoff, gbase, voff) do { _Pragma("unroll") for (int _i = 0; _i < 2; ++_i) \
        __builtin_amdgcn_global_load_lds((const unsigned*)((const char*)(gbase) + (voff)[_i]), (LAS unsigned*)(lds + (bufoff) + ldsw + _i * 8192), 16, 0, 0); } while (0)
#define PG8_LDA(dst, b, h) do { if constexpr (FP8) { _Pragma("unroll") for (int m = 0; m < 4; ++m) dst##8[m] = __builtin_shufflevector(*(const LAS i32x4v*)(lds + PG8_SA(b, h) + aoff + m * 2048), *(const LAS i32x4v*)(lds + PG8_SA(b, h) + aoff + m * 2048 + 1024), 0, 1, 2, 3, 4, 5, 6, 7); } \
        else { _Pragma("unroll") for (int m = 0; m < 4; ++m) _Pragma("unroll") for (int k = 0; k < 2; ++k) dst[m][k] = *(const LAS bf16x8*)(lds + PG8_SA(b, h) + aoff + m * 2048 + k * 1024); } } while (0)
#define PG8_LDB(dst, b, h) do { if constexpr (FP8) { _Pragma("unroll") for (int n = 0; n < 2; ++n) dst##8[n] = __builtin_shufflevector(*(const LAS i32x4v*)(lds + PG8_SB(b, h) + boff + n * 2048), *(const LAS i32x4v*)(lds + PG8_SB(b, h) + boff + n * 2048 + 1024), 0, 1, 2, 3, 4, 5, 6, 7); } \
        else { _Pragma("unroll") for (int n = 0; n < 2; ++n) _Pragma("unroll") for (int k = 0; k < 2; ++k) dst[n][k] = *(const LAS bf16x8*)(lds + PG8_SB(b, h) + boff + n * 2048 + k * 1024); } } while (0)
#define PG8_MMA(ai, bj, At, Bt) do { __builtin_amdgcn_s_setprio(1); \
        if constexpr (FP8) { _Pragma("unroll") for (int m = 0; m < 4; ++m) _Pragma("unroll") for (int n = 0; n < 2; ++n) \
            asm volatile("v_mfma_scale_f32_16x16x128_f8f6f4 %0, %1, %2, %0, %3, %3 op_sel_hi:[0,0,0]" : "+v"(acc[ai][bj][m][n]) : "v"(Bt##8[n]), "v"(At##8[m]), "v"(f8one)); } \
        else { _Pragma("unroll") for (int m = 0; m < 4; ++m) _Pragma("unroll") for (int n = 0; n < 2; ++n) _Pragma("unroll") for (int k = 0; k < 2; ++k) \
            acc[ai][bj][m][n] = __builtin_amdgcn_mfma_f32_16x16x32_bf16(Bt[n][k], At[m][k], acc[ai][bj][m][n], 0, 0, 0); } \
        __builtin_amdgcn_s_setprio(0); } while (0)
#define PG8_WAIT_V(n) asm volatile("s_waitcnt vmcnt(" #n ")" ::: "memory")
#define PG8_WAIT_L(n) asm volatile("s_waitcnt lgkmcnt(" #n ")" ::: "memory")
#define PG8_BAR __builtin_amdgcn_s_barrier()
#define PG8_SCHED __builtin_amdgcn_sched_barrier(0)
    Unit cur, nxt; int ui = 0;
    if (!S.next(0, cur)) return;
    f32x4 acc[2][2][4][2];
#pragma unroll
    for (int a = 0; a < 2; ++a)
#pragma unroll
        for (int b = 0; b < 2; ++b)
#pragma unroll
            for (int m = 0; m < 4; ++m)
#pragma unroll
                for (int n = 0; n < 2; ++n) acc[a][b][m][n] = (f32x4){0.f, 0.f, 0.f, 0.f};
    bf16x8 At[4][2], B0[2][2], B1[2][2];
    i32x8v At8[4], B08[2], B18[2];
    const int f8one = 0x7f7f7f7f;
    const char* cA = (const char*)g.A + (size_t)cur.pm * tstepA + (size_t)cur.kt0 * kstep; const char* cB = (const char*)g.Bt + (size_t)cur.e * g.bstride + (size_t)cur.pn * tstepB + (size_t)cur.kt0 * kstep;
    PG8_STAGE(PG8_SB(0, 0), cB, voffB); PG8_STAGE(PG8_SA(0, 0), cA, voffA); PG8_STAGE(PG8_SB(0, 1), cB + hstepB, voffB); PG8_STAGE(PG8_SA(0, 1), cA + hstepA, voffA);
    if (wr == 1) PG8_BAR;
    PG8_WAIT_V(4); PG8_BAR;
    PG8_STAGE(PG8_SB(1, 0), cB + kstep, voffB); PG8_STAGE(PG8_SA(1, 0), cA + kstep, voffA); PG8_STAGE(PG8_SB(1, 1), cB + hstepB + kstep, voffB);
    PG8_WAIT_V(6); PG8_BAR;
    for (;;) {
        const bool has_next = S.next(ui + 1, nxt);
        const char* nA = has_next ? (const char*)g.A + (size_t)nxt.pm * tstepA + (size_t)nxt.kt0 * kstep : cA; const char* nB = has_next ? (const char*)g.Bt + (size_t)nxt.e * g.bstride + (size_t)nxt.pn * tstepB + (size_t)nxt.kt0 * kstep : cB;
        const int ntc = cur.nkt ? cur.nkt : nt;
        for (int t = 0; t < ntc; t += 2) {
            const bool last = (t == ntc - 2);
            const char* a1 = cA + (size_t)(t + 1) * kstep;
            const char* a2 = last ? nA : cA + (size_t)(t + 2) * kstep; const char* b2 = last ? nB : cB + (size_t)(t + 2) * kstep;
            const char* a3 = a2 + kstep; const char* b3 = b2 + kstep;
            PG8_LDB(B0, 0, 0); PG8_SCHED; PG8_LDA(At, 0, 0); PG8_STAGE(PG8_SA(1, 1), a1 + hstepA, voffA);
            PG8_WAIT_L(8); PG8_BAR; PG8_WAIT_L(0); PG8_MMA(0, 0, At, B0); PG8_BAR; PG8_SCHED;
            PG8_LDB(B1, 0, 1); PG8_STAGE(PG8_SB(0, 0), b2, voffB);
            PG8_BAR; PG8_WAIT_L(0); PG8_MMA(0, 1, At, B1); PG8_BAR;
            PG8_LDA(At, 0, 1); PG8_STAGE(PG8_SA(0, 0), a2, voffA);
            PG8_BAR; PG8_WAIT_L(0); PG8_MMA(1, 0, At, B0); PG8_BAR; PG8_SCHED;
            PG8_STAGE(PG8_SB(0, 1), b2 + hstepB, voffB);
            PG8_WAIT_V(6); PG8_BAR; PG8_MMA(1, 1, At, B1); PG8_BAR;
            PG8_LDB(B0, 1, 0); PG8_SCHED; PG8_LDA(At, 1, 0); PG8_STAGE(PG8_SA(0, 1), a2 + hstepA, voffA);
            PG8_WAIT_L(8); PG8_BAR; PG8_WAIT_L(0); PG8_MMA(0, 0, At, B0); PG8_BAR; PG8_SCHED;
            PG8_LDB(B1, 1, 1); PG8_STAGE(PG8_SB(1, 0), b3, voffB);
            PG8_BAR; PG8_WAIT_L(0); PG8_MMA(0, 1, At, B1); PG8_BAR;
            PG8_LDA(At, 1, 1); PG8_STAGE(PG8_SA(1, 0), a3, voffA);
            PG8_BAR; PG8_WAIT_L(0); PG8_MMA(1, 0, At, B0); PG8_BAR; PG8_SCHED;
            PG8_STAGE(PG8_SB(1, 1), b3 + hstepB, voffB);
            PG8_WAIT_V(6); PG8_BAR; PG8_MMA(1, 1, At, B1); PG8_BAR;
        }
        if constexpr (FP8) asm volatile("s_nop 15\n\ts_nop 15\n\ts_nop 15\n\ts_nop 15" ::: "memory");
        E(acc, cur, wr, wc, fr, fq);
        if (!has_next) break;
#pragma unroll
        for (int a = 0; a < 2; ++a)
#pragma unroll
            for (int b = 0; b < 2; ++b)
#pragma unroll
                for (int m = 0; m < 4; ++m)
#pragma unroll
                    for (int n = 0; n < 2; ++n) acc[a][b][m][n] = (f32x4){0.f, 0.f, 0.f, 0.f};
        cur = nxt; cA = nA; cB = nB; ++ui;
    }
    PG8_WAIT_V(0);
    if (wr == 0) PG8_BAR;
    PG8_BAR;
#undef PG8_SA
#undef PG8_SB
#undef PG8_STAGE
#undef PG8_LDA
#undef PG8_LDB
#undef PG8_MMA
#undef PG8_WAIT_V
#undef PG8_WAIT_L
#undef PG8_BAR
#undef PG8_SCHED
}

__host__ __device__ __forceinline__ int perm256(int rho) { return 64 * ((rho >> 5) & 3) + 16 * ((rho >> 2) & 3) + 8 * (rho >> 7) + 4 * ((rho >> 4) & 1) + (rho & 3); }
#define EPI_ROWS_BEGIN _Pragma("unroll") for (int ai = 0; ai < 2; ++ai) _Pragma("unroll") for (int m = 0; m < 4; ++m) { asm volatile("" ::: "memory"); const int row = u.pm * BM + ai * HALF + wr * 64 + m * 16 + fr;
#define EPI_ROWS_END }
#define EPI_LOOP_BEGIN EPI_ROWS_BEGIN _Pragma("unroll") for (int bj = 0; bj < 2; ++bj) { const int cg = u.pn * BM + bj * HALF + wc * 32;
#define EPI_LOOP_END } }
__device__ __forceinline__ uint4 pack8(const f32x4 a, const f32x4 b) { uint4 p; p.x = pack2(a[0], a[1]); p.y = pack2(a[2], a[3]); p.z = pack2(b[0], b[1]); p.w = pack2(b[2], b[3]); return p; }

struct EpiBf16Plain {
    bf16_t* O; int ldo;
    __device__ __forceinline__ void operator()(const f32x4 (&acc)[2][2][4][2], const Unit& u, int wr, int wc, int fr, int fq) const {
        EPI_ROWS_BEGIN
            uint4* p = (uint4*)(O + (size_t)row * ldo + u.pn * BM + 64 * wc + 16 * fq);
            p[0] = pack8(acc[ai][0][m][0], acc[ai][0][m][1]); p[1] = pack8(acc[ai][1][m][0], acc[ai][1][m][1]);
        EPI_ROWS_END
    }
};
__device__ __forceinline__ f32x4 swiglu4(const f32x4 g, const f32x4 u, const float ke, const float kc) {
    const f32x4 a = g * ke; f32x4 e, r;
#pragma unroll
    for (int i = 0; i < 4; ++i) e[i] = __builtin_amdgcn_exp2f(a[i]);
    const f32x4 d = e * kc + kc;
#pragma unroll
    for (int i = 0; i < 4; ++i) r[i] = __builtin_amdgcn_rcpf(d[i]);
    return (g * r) * u;
}
struct EpiSwiglu {
    bf16_t* O; int ldo;
    __device__ __forceinline__ void operator()(const f32x4 (&acc)[2][2][4][2], const Unit& u, int wr, int wc, int fr, int fq) const {
        EPI_ROWS_BEGIN
            const f32x4 h0 = swiglu4(acc[ai][0][m][0], acc[ai][0][m][1], -LOG2E, 1.f), h1 = swiglu4(acc[ai][1][m][0], acc[ai][1][m][1], -LOG2E, 1.f);
            *(uint4*)(O + (size_t)row * ldo + u.pn * 128 + 32 * wc + 8 * fq) = pack8(h0, h1);
        EPI_ROWS_END
    }
};
struct EpiSwigluF8 {
    unsigned char* O; int ldo;
    __device__ __forceinline__ void operator()(const f32x4 (&acc)[2][2][4][2], const Unit& u, int wr, int wc, int fr, int fq) const {
        constexpr float ke = -LOG2E / F8_WSCALE, kc = F8_WSCALE * F8_WSCALE / F8_HSCALE;
        EPI_ROWS_BEGIN
            f32x4 h0 = swiglu4(acc[ai][0][m][0], acc[ai][0][m][1], ke, kc), h1 = swiglu4(acc[ai][1][m][0], acc[ai][1][m][1], ke, kc);
#pragma unroll
            for (int i = 0; i < 4; ++i) { h0[i] = __builtin_amdgcn_fmed3f(h0[i], -448.f, 448.f); h1[i] = __builtin_amdgcn_fmed3f(h1[i], -448.f, 448.f); }
            uint2 p; p.x = pack4_fp8(h0[0], h0[1], h0[2], h0[3]); p.y = pack4_fp8(h1[0], h1[1], h1[2], h1[3]);
            *(uint2*)(O + (size_t)row * ldo + u.pn * 128 + 32 * wc + 8 * fq) = p;
        EPI_ROWS_END
    }
};
struct EpiMoeOut {
    bf16_t* MOUT; const uint2* RIW; float oscale;
    __device__ __forceinline__ void operator()(const f32x4 (&acc)[2][2][4][2], const Unit& u, int wr, int wc, int fr, int fq) const {
        EPI_ROWS_BEGIN
            const uint2 iw = RIW[row]; const int info = (int)iw.x; const float gw = __uint_as_float(iw.y) * oscale;
            if (info >= 0) { uint4* p = (uint4*)(MOUT + ((size_t)(info & 1) * TL + (size_t)(info >> 1)) * 1024 + u.pn * BM + 64 * wc + 16 * fq);
                p[0] = pack8(acc[ai][0][m][0] * gw, acc[ai][0][m][1] * gw); p[1] = pack8(acc[ai][1][m][0] * gw, acc[ai][1][m][1] * gw); }
        EPI_ROWS_END
    }
};
struct EpiXtr {
    bf16_t* MOUT; const uint2* RIW; bf16_t* XTR; int NTF, S; float oscale;
    __device__ __forceinline__ void operator()(const f32x4 (&acc)[2][2][4][2], const Unit& u, int wr, int wc, int fr, int fq) const {
        const bool k0 = (u.ks == 0); const int stride = k0 ? 1024 : 256;
        bf16_t* base = (k0 ? MOUT + u.pn * BM : XTR + (size_t)(((u.pm - NTF) * 4 + u.pn) * (S - 1) + (u.ks - 1)) * 65536) + 64 * wc + 16 * fq;
        EPI_ROWS_BEGIN
            const uint2 iw = RIW[row]; const int info = (int)iw.x; const float gw = __uint_as_float(iw.y) * oscale;
            const int ridx = k0 ? ((info & 1) * TL + (info >> 1)) : (row & 255);
            if (info >= 0 || !k0) { uint4* p = (uint4*)(base + (size_t)ridx * stride); p[0] = pack8(acc[ai][0][m][0] * gw, acc[ai][0][m][1] * gw); p[1] = pack8(acc[ai][1][m][0] * gw, acc[ai][1][m][1] * gw); }
        EPI_ROWS_END
    }
};
struct EpiTailBf16 {
    bf16_t* O; int ldo; bf16_t* XT; int NTF, S;
    __device__ __forceinline__ void operator()(const f32x4 (&acc)[2][2][4][2], const Unit& u, int wr, int wc, int fr, int fq) const {
        const bool k0 = (u.ks == 0); const int stride = k0 ? ldo : 256;
        bf16_t* base = (k0 ? O + u.pn * BM : XT + (size_t)(((u.pm - NTF) * 4 + u.pn) * (S - 1) + (u.ks - 1)) * 65536) + 64 * wc + 16 * fq;
        EPI_ROWS_BEGIN
            uint4* p = (uint4*)(base + (size_t)(k0 ? row : (row & 255)) * stride);
            p[0] = pack8(acc[ai][0][m][0], acc[ai][0][m][1]); p[1] = pack8(acc[ai][1][m][0], acc[ai][1][m][1]);
        EPI_ROWS_END
    }
};
template <int S> struct DenseTailOrder {
    int NTF, nsub, nkt, G, c;
    __device__ __forceinline__ void init(int NTF_, int NTT, int nkt_full, int G_, int c_) { NTF = NTF_; nsub = NTT * 4 * S; int k = nkt_full / S; asm volatile("" : "+s"(k)); nkt = k; G = G_; c = c_; }
    __device__ __forceinline__ bool next(int i, Unit& u) const {
        const int L = i * G + c; if (L >= nsub) return false;
        const int tu = L / S, ks = L - tu * S; u.pm = NTF + (tu >> 2); u.pn = tu & 3; u.e = 0; u.nkt = nkt; u.kt0 = ks * nkt; u.ks = ks; return true;
    }
};
struct EpiQ {
    bf16_t* QM; const float* SQ; const float* cosT; const float* sinT; float qscale;
    __device__ __forceinline__ void operator()(const f32x4 (&acc)[2][2][4][2], const Unit& u, int wr, int wc, int fr, int fq) const {
        EPI_LOOP_BEGIN
            const float s = SQ[row] * qscale; f32x4 v0 = acc[ai][bj][m][0] * s, v1 = acc[ai][bj][m][1] * s;
            if ((cg % 96) == 64) { const int pos = row & (SEQ - 1); const f32x4 c = *(const f32x4*)(cosT + pos * 16 + 4 * fq), sn = *(const f32x4*)(sinT + pos * 16 + 4 * fq);
                const f32x4 o0 = v0 * c - v1 * sn, o1 = v1 * c + v0 * sn; v0 = o0; v1 = o1; }
            uint2 p; p.x = pack2(v0[0], v0[1]); p.y = pack2(v0[2], v0[3]); *(uint2*)(QM + (size_t)row * 768 + cg + 4 * fq) = p;
            p.x = pack2(v1[0], v1[1]); p.y = pack2(v1[2], v1[3]); *(uint2*)(QM + (size_t)row * 768 + cg + 16 + 4 * fq) = p;
        EPI_LOOP_END
    }
};
struct EpiK {
    bf16_t* KM; const float* SKV;
    __device__ __forceinline__ void operator()(const f32x4 (&acc)[2][2][4][2], const Unit& u, int wr, int wc, int fr, int fq) const {
        EPI_ROWS_BEGIN
            const float s = SKV[row]; const int b = row < TL ? (row >> 11) : ((row - TL) >> 8), key = row < TL ? CTXL + (row & (SEQ - 1)) : ((row - TL) & (CTXL - 1));
            const int c = u.pn * BM + 64 * wc + 16 * fq, h = c >> 6, d = c & 63;
            uint4* p = (uint4*)(KM + ((size_t)b * NKEY + key) * 768 + h * 96 + d);
            p[0] = pack8(acc[ai][0][m][0] * s, acc[ai][0][m][1] * s); p[1] = pack8(acc[ai][1][m][0] * s, acc[ai][1][m][1] * s);
        EPI_ROWS_END
    }
};
struct EpiVT {
    bf16_t* VT; const float* SKV;
    __device__ __forceinline__ void operator()(const f32x4 (&acc)[2][2][4][2], const Unit& u, int wr, int wc, int fr, int fq) const {
        EPI_LOOP_BEGIN
#pragma unroll
            for (int n = 0; n < 2; ++n) { const int tok = cg + 16 * n + 4 * fq; const f32x4 s = *(const f32x4*)(SKV + tok); const f32x4 v = acc[ai][bj][m][n] * s;
                const int b = tok < TL ? (tok >> 11) : ((tok - TL) >> 8), key = tok < TL ? CTXL + (tok & (SEQ - 1)) : ((tok - TL) & (CTXL - 1));
                uint2 p; p.x = pack2(v[0], v[1]); p.y = pack2(v[2], v[3]); *(uint2*)(VT + ((size_t)b * 512 + row) * NKEY + key) = p; }
        EPI_LOOP_END
    }
};
}


#define XB_TMO      128
#define XB_XCNT(j)  (256  + 64 * (j))
#define XB_XSUB(j)  (1280 + 64 * (j))
#define XB_XGEN(j)  (2304 + 64 * (j))
#define XB_TOP      3328
#define XB_TOPGEN   3392
#define XCD_BAR_WORDS 3456
#define XB_SPIN_CAP (1u << 18)
__device__ __forceinline__ unsigned xb_ld(unsigned* p)              { return __hip_atomic_load(p, __ATOMIC_RELAXED, __HIP_MEMORY_SCOPE_AGENT); }
__device__ __forceinline__ unsigned xb_add(unsigned* p, unsigned v) { return __hip_atomic_fetch_add(p, v, __ATOMIC_RELAXED, __HIP_MEMORY_SCOPE_AGENT); }
__device__ __forceinline__ unsigned xb_xcc_id() { return (unsigned)__builtin_amdgcn_s_getreg((3 << 11) | 20) & 0xFu; }
#define XB_SPIN(cond, bar) do { unsigned _sp = 0; while (cond) { __builtin_amdgcn_s_sleep(1); \
    if ((++_sp & 255u) == 0u) { if (xb_ld(&(bar)[XB_TMO])) break; if (_sp > XB_SPIN_CAP) { atomicAdd(&(bar)[XB_TMO], 1u); break; } } } } while (0)
struct XcdBarrier { unsigned* bar; unsigned x; volatile LAS unsigned* st; };
__device__ __forceinline__ XcdBarrier xcd_barrier_post(unsigned* bar, volatile LAS unsigned* st) {
    XcdBarrier b; b.bar = bar; b.x = xb_xcc_id(); b.st = st;
    if (threadIdx.x == 0) (void)xb_add(&bar[XB_XCNT(b.x)], 1u);
    return b;
}
__device__ __forceinline__ void xcd_barrier_complete(unsigned* bar, unsigned x, unsigned& nloc, unsigned& nx) {
    const unsigned G = gridDim.x * gridDim.y * gridDim.z;
    unsigned sum, cnt, mine, sp = 0u;
    for (;;) {
        sum = 0u; cnt = 0u; mine = 0u;
#pragma unroll
        for (unsigned j = 0; j < 16; ++j) { const unsigned c = xb_ld(&bar[XB_XCNT(j)]); sum += c; cnt += (c > 0u) ? 1u : 0u; mine = (j == x) ? c : mine; }
        if (sum == G) break;
        __builtin_amdgcn_s_sleep(1);
        if ((++sp & 255u) == 0u) { if (xb_ld(&bar[XB_TMO])) break; if (sp > XB_SPIN_CAP) { atomicAdd(&bar[XB_TMO], 1u); break; } }
    }
    nloc = mine > 0u ? mine : 1u; nx = cnt > 0u ? cnt : 1u;
}
__device__ __forceinline__ void xcd_barrier(const XcdBarrier& b) {
    asm volatile("s_waitcnt vmcnt(0)" ::: "memory");
    __syncthreads();
    if (threadIdx.x == 0) {
        unsigned* bar = b.bar;
        __builtin_amdgcn_s_waitcnt(0);
        unsigned nloc = b.st[0], nx = b.st[1];
        if (nloc == 0u) { xcd_barrier_complete(bar, b.x, nloc, nx); b.st[0] = nloc; b.st[1] = nx; }
        const unsigned old = xb_add(&bar[XB_XSUB(b.x)], 1u);
        const unsigned gen = old / nloc;
        if (old + 1u == (gen + 1u) * nloc) {
            __builtin_amdgcn_fence(__ATOMIC_RELEASE, "agent");
            asm volatile("s_waitcnt vmcnt(0)" ::: "memory");
            const unsigned og = xb_add(&bar[XB_TOP], 1u);
            const unsigned tg = og / nx;
            if (og + 1u == (tg + 1u) * nx) xb_add(&bar[XB_TOPGEN], 1u);
            else XB_SPIN(xb_ld(&bar[XB_TOPGEN]) == tg, bar);
            __builtin_amdgcn_fence(__ATOMIC_ACQUIRE, "agent");
            xb_add(&bar[XB_XGEN(b.x)], 1u);
            asm volatile("s_waitcnt vmcnt(0)" ::: "memory");
        } else {
            XB_SPIN(xb_ld(&bar[XB_XGEN(b.x)]) == gen, bar);
            __builtin_amdgcn_fence(__ATOMIC_ACQUIRE, "agent");
            asm volatile("s_waitcnt vmcnt(0)" ::: "memory");
        }
    }
    __syncthreads();
}
#define XB_OVERLAP_ARRIVE(b, gen) do { \
    asm volatile("s_waitcnt vmcnt(0)" ::: "memory"); \
    __syncthreads(); \
    if (threadIdx.x == 0) { \
        unsigned* bar_ = (b).bar; \
        __builtin_amdgcn_s_waitcnt(0); \
        unsigned nloc = (b).st[0], nx = (b).st[1]; \
        if (nloc == 0u) { xcd_barrier_complete(bar_, (b).x, nloc, nx); (b).st[0] = nloc; (b).st[1] = nx; } \
        const unsigned old = xb_add(&bar_[XB_XSUB((b).x)], 1u); \
        gen = old / nloc; \
        if (old + 1u == (gen + 1u) * nloc) { \
            __builtin_amdgcn_fence(__ATOMIC_RELEASE, "agent"); \
            asm volatile("s_waitcnt vmcnt(0)" ::: "memory"); \
            const unsigned og = xb_add(&bar_[XB_TOP], 1u); \
            const unsigned tg = og / nx; \
            xb_add(&bar_[XB_XGEN((b).x)], 1u); \
            if (og + 1u == (tg + 1u) * nx) xb_add(&bar_[XB_TOPGEN], 1u); \
        } \
    } } while (0)
#define XB_OVERLAP_WAIT(b, gen) do { \
    if (threadIdx.x == 0) { \
        unsigned* bar_ = (b).bar; \
        XB_SPIN(xb_ld(&bar_[XB_TOPGEN]) == gen, bar_); \
        __builtin_amdgcn_fence(__ATOMIC_ACQUIRE, "agent"); \
        asm volatile("s_waitcnt vmcnt(0)" ::: "memory"); \
    } \
    __syncthreads(); } while (0)

struct Args { const float* in[41]; float* out; unsigned char* ws; int ph_lo, ph_hi, ex, pad; };
enum { I_X = 0, I_C, I_CTX, I_CCTX, I_ADAW, I_ADAB, I_MIXPRE, I_MIXPOST, I_FFNPRE, I_FFNPOST, I_EVWIN, I_HYCW, I_HYCB, I_FW1, I_FB1, I_FW2, I_FB2, I_FW3, I_FREQ, I_HYBIAS,
       I_SCW, I_SCB, I_DTB, I_ALOG, I_SSMD, I_SSMNG, I_EVWOUT, I_FFNG, I_FFNU, I_FFND, I_ODWIN, I_QNG, I_QUP, I_KVNG, I_KVUP, I_SINK, I_ODWOUT, I_ROUTER, I_MOEG, I_MOEU, I_MOED };

struct Fr {
    const float* const* in; float* out; unsigned char* ws; unsigned char* lds; int tid, lane, wave, G, bid;
    template <class T> __device__ __forceinline__ T* w(size_t off) const { return (T*)(ws + off); }
};

__device__ __forceinline__ int colmap(int mode, int perm, int r, int nsrc, int& which) {
    which = 0;
    if (mode == 1) { const int tile = r >> 8, rho = r & 255, bj = rho >> 7, wc = (rho >> 5) & 3, n = (rho >> 4) & 1, fq = (rho >> 2) & 3, i = rho & 3; which = n; return 128 * tile + 32 * wc + 8 * fq + 4 * bj + i; }
    const int c = perm ? ((r & ~255) + pg8::perm256(r & 255)) : r;
    if (mode == 0) return c < nsrc ? c : -1;
    return (c >> 6) * 128 + (c & 63) + (mode == 3 ? 64 : 0);
}
__device__ __forceinline__ void cvt_job(const Fr& F, const float* srcA, const float* srcB, const float* kscale, bf16_t* dst, int nrows, int kdst, int ksrc, int ldsrc, int nsrc, int mode, int perm, int t0, int tstride) {
    float* tile = (float*)F.lds;
    const int nrt = nrows / 256, ntiles = nrt * (kdst / 64);
    const int kk = F.tid >> 6, rq = F.tid & 63;
    float4 v[8];
#define CVT_LOAD(t) do { const int r0 = ((t) % nrt) * 256, k0 = ((t) / nrt) * 64; int which; const int col = colmap(mode, perm, r0 + rq * 4, nsrc, which); const float* src = which ? srcB : srcA; \
        _Pragma("unroll") for (int p = 0; p < 8; ++p) { const int k = k0 + p * 8 + kk; v[p] = make_float4(0.f, 0.f, 0.f, 0.f); \
            if (col >= 0 && k < ksrc) { v[p] = *(const float4*)(src + (size_t)k * ldsrc + col); if (kscale) { const float ks = kscale[k]; v[p].x *= ks; v[p].y *= ks; v[p].z *= ks; v[p].w *= ks; } } } } while (0)
    int t = t0;
    if (t < ntiles) CVT_LOAD(t);
    while (t < ntiles) {
        const int r0 = (t % nrt) * 256, k0 = (t / nrt) * 64;
        __syncthreads();
#pragma unroll
        for (int p = 0; p < 8; ++p) *(float4*)(tile + (p * 8 + kk) * 260 + rq * 4) = v[p];
        const int tn = t + tstride;
        if (tn < ntiles) CVT_LOAD(tn);
        __syncthreads();
        { const int r2 = F.tid >> 1, kq = F.tid & 1; const float* tp = tile + (kq * 32) * 260 + r2; uint4* dp = (uint4*)(dst + (size_t)(r0 + r2) * kdst + k0 + kq * 32);
#pragma unroll
          for (int q = 0; q < 4; ++q) { uint4 o; o.x = pack2(tp[(8 * q + 0) * 260], tp[(8 * q + 1) * 260]); o.y = pack2(tp[(8 * q + 2) * 260], tp[(8 * q + 3) * 260]);
              o.z = pack2(tp[(8 * q + 4) * 260], tp[(8 * q + 5) * 260]); o.w = pack2(tp[(8 * q + 6) * 260], tp[(8 * q + 7) * 260]); dp[q] = o; } }
        t = tn;
    }
#undef CVT_LOAD
    __syncthreads();
}

constexpr int CVT_T_GU = 28 * 16, CVT_T_DN = 4 * 56, CVT_T_E = CVT_T_GU + CVT_T_DN, CVT_T_ALL = NEXP * CVT_T_E;
__device__ __forceinline__ int cvt_wmap(int w) { return w < NEXP * CVT_T_GU ? (w / CVT_T_GU) * CVT_T_E + w % CVT_T_GU : ((w - NEXP * CVT_T_GU) / CVT_T_DN) * CVT_T_E + CVT_T_GU + (w - NEXP * CVT_T_GU) % CVT_T_DN; }
template <bool WMAP> __device__ __forceinline__ void cvt_moe_range(const Fr& F, int g_begin, int g_end, int rank, int stride) {
    float* tile = (float*)F.lds;
    const int kk = F.tid >> 6, rq = F.tid & 63;
    float4 va[8], vb[8];
#define CVM_DECODE(g) const int _g = WMAP ? cvt_wmap(g) : (g); const int _e = _g / CVT_T_E, _r = _g % CVT_T_E; const bool _gu = _r < CVT_T_GU; const int _rr = _gu ? _r : _r - CVT_T_GU; \
        const int _nkt = _gu ? 16 : 56; const int k0 = (_rr % _nkt) * 64, r0 = (_rr / _nkt) * 256;     const int ldsrc = _gu ? DFE : 1024, kdst = _gu ? 1024 : DFE; \
        const float* srcA = _gu ? F.in[I_MOEG] + (size_t)_e * 1024 * DFE : F.in[I_MOED] + (size_t)_e * DFE * 1024; const float* srcB = F.in[I_MOEU] + (size_t)_e * 1024 * DFE; \
        unsigned char* dst = _gu ? F.w<unsigned char>(WM_GU) + (size_t)_e * 2 * DFE * 1024 * (MOE_FP8 ? 1 : 2) : F.w<unsigned char>(WM_DN) + (size_t)_e * 1024 * DFE * (MOE_FP8 ? 1 : 2);
#define CVM_LOAD(g, v) do { CVM_DECODE(g) (void)dst; (void)kdst; int which; const int col = colmap(_gu ? 1 : 0, 1, r0 + rq * 4, _gu ? DFE : 1024, which); const float* src = which ? srcB : srcA; \
        _Pragma("unroll") for (int p = 0; p < 8; ++p) { const int k = k0 + p * 8 + kk; v[p] = *(const float4*)(src + (size_t)k * ldsrc + col); } } while (0)
#define CVM_STEP(g, v) do { __syncthreads(); \
        _Pragma("unroll") for (int p = 0; p < 8; ++p) { float4 _t; _t.x = v[p].x; _t.y = v[p].y; _t.z = v[p].z; _t.w = v[p].w; *(float4*)(tile + (p * 8 + kk) * 260 + rq * 4) = _t; } \
        if ((g) + 2 * stride < g_end) CVM_LOAD((g) + 2 * stride, v); \
        __syncthreads(); \
        { CVM_DECODE(g) (void)srcA; (void)srcB; (void)ldsrc; const int r2 = F.tid >> 1, kq = F.tid & 1; const float* tp = tile + (kq * 32) * 260 + r2; \
          if (MOE_FP8) { uint4* dp = (uint4*)(dst + (size_t)(r0 + r2) * kdst + k0 + kq * 32); \
            _Pragma("unroll") for (int q = 0; q < 2; ++q) { uint4 o; \
              o.x = pack4_fp8(tp[(16 * q + 0) * 260] * F8_WSCALE, tp[(16 * q + 1) * 260] * F8_WSCALE, tp[(16 * q + 2) * 260] * F8_WSCALE, tp[(16 * q + 3) * 260] * F8_WSCALE); \
              o.y = pack4_fp8(tp[(16 * q + 4) * 260] * F8_WSCALE, tp[(16 * q + 5) * 260] * F8_WSCALE, tp[(16 * q + 6) * 260] * F8_WSCALE, tp[(16 * q + 7) * 260] * F8_WSCALE); \
              o.z = pack4_fp8(tp[(16 * q + 8) * 260] * F8_WSCALE, tp[(16 * q + 9) * 260] * F8_WSCALE, tp[(16 * q + 10) * 260] * F8_WSCALE, tp[(16 * q + 11) * 260] * F8_WSCALE); \
              o.w = pack4_fp8(tp[(16 * q + 12) * 260] * F8_WSCALE, tp[(16 * q + 13) * 260] * F8_WSCALE, tp[(16 * q + 14) * 260] * F8_WSCALE, tp[(16 * q + 15) * 260] * F8_WSCALE); dp[q] = o; } } \
          else { uint4* dp = (uint4*)(dst + ((size_t)(r0 + r2) * kdst + k0 + kq * 32) * 2); \
          _Pragma("unroll") for (int q = 0; q < 4; ++q) { uint4 o; o.x = pack2(tp[(8 * q + 0) * 260], tp[(8 * q + 1) * 260]); o.y = pack2(tp[(8 * q + 2) * 260], tp[(8 * q + 3) * 260]); \
              o.z = pack2(tp[(8 * q + 4) * 260], tp[(8 * q + 5) * 260]); o.w = pack2(tp[(8 * q + 6) * 260], tp[(8 * q + 7) * 260]); dp[q] = o; } } } } while (0)
    int g = g_begin + rank;
    if (g < g_end) CVM_LOAD(g, va);
    if (g + stride < g_end) CVM_LOAD(g + stride, vb);
    while (g < g_end) {
        CVM_STEP(g, va);
        g += stride; if (g >= g_end) break;
        CVM_STEP(g, vb);
        g += stride;
    }
#undef CVM_STEP
#undef CVM_LOAD
#undef CVM_DECODE
    __syncthreads();
}
constexpr int CVW_Q = 2, CVW_NWIN = 11;
__device__ __forceinline__ void cvt_window(const Fr& F, int win) {
    const int w0 = win * CVW_Q * F.G, w1 = w0 + CVW_Q * F.G;
    cvt_moe_range<true>(F, w0 < CVT_T_ALL ? w0 : CVT_T_ALL, w1 < CVT_T_ALL ? w1 : CVT_T_ALL, F.bid, F.G);
}

constexpr int CVD_T_ALL = 64 + 512 + 256 + 80 + 12 + 8 + 8 + 64, CVD_NWIN = 4;
__device__ __forceinline__ void cvt_dense_tile(const Fr& F, int d) {
    if (d < 64) { cvt_job(F, F.in[I_EVWOUT], nullptr, nullptr, F.w<bf16_t>(W_OUT0), 1024, 1024, 1024, 1024, 1024, 0, 1, d, 1 << 20); return; } d -= 64;
    if (d < 512) { cvt_job(F, F.in[I_FFNG], F.in[I_FFNU], nullptr, F.w<bf16_t>(W_GU0), 2 * DFF, 1024, 1024, DFF, DFF, 1, 1, d, 1 << 20); return; } d -= 512;
    if (d < 256) { cvt_job(F, F.in[I_FFND], nullptr, nullptr, F.w<bf16_t>(W_DN0), 1024, DFF, DFF, 1024, 1024, 0, 1, d, 1 << 20); return; } d -= 256;
    if (d < 80) { cvt_job(F, F.in[I_ODWIN], nullptr, nullptr, F.w<bf16_t>(W_IN1), ODD_PAD, 1024, 1024, 1184, 1184, 0, 1, d, 1 << 20); return; } d -= 80;
    if (d < 12) { cvt_job(F, F.in[I_QUP], nullptr, F.in[I_QNG], F.w<bf16_t>(W_QUP), 768, 256, 256, 768, 768, 0, 0, d, 1 << 20); return; } d -= 12;
    if (d < 8) { cvt_job(F, F.in[I_KVUP], nullptr, F.in[I_KVNG], F.w<bf16_t>(W_KUP), 512, 256, 128, 1024, 1024, 2, 1, d, 1 << 20); return; } d -= 8;
    if (d < 8) { cvt_job(F, F.in[I_KVUP], nullptr, F.in[I_KVNG], F.w<bf16_t>(W_VUP), 512, 256, 128, 1024, 1024, 3, 0, d, 1 << 20); return; } d -= 8;
    if (d < 64) cvt_job(F, F.in[I_ODWOUT], nullptr, nullptr, F.w<bf16_t>(W_OUT1), 1024, 1024, 1024, 1024, 1024, 0, 1, d, 1 << 20);
}
__device__ __forceinline__ void cvt_dense_range(const Fr& F, int d0, int d1) { for (int d = d0 + F.bid; d < d1; d += F.G) cvt_dense_tile(F, d); }
__device__ __forceinline__ void cvt_dense_window(const Fr& F, int win) {
    const int q = (CVD_T_ALL + CVD_NWIN * F.G - 1) / (CVD_NWIN * F.G), d0 = win * q * F.G, d1 = d0 + q * F.G;
    cvt_dense_range(F, d0 < CVD_T_ALL ? d0 : CVD_T_ALL, d1 < CVD_T_ALL ? d1 : CVD_T_ALL);
}

__device__ __forceinline__ void ph_ada(const Fr& F) {
    float* sc = (float*)F.lds;
    float* part = sc + 9 * 1024;
    for (int i = F.tid; i < 9 * 1024; i += NTHR) { const int r = i >> 10, k = i & 1023; const float v = r < 8 ? F.in[I_C][r * 1024 + k] : F.in[I_CCTX][k]; sc[i] = silu_f(v); }
    __syncthreads();
    float* MOD = F.w<float>(WS_MOD);
    for (int un = F.bid; un < 2 * 6144 / 64; un += F.G) {
        const int j = un * 64 + F.lane, l = j / 6144, jj = j % 6144; const float* wp = F.in[I_ADAW] + (size_t)l * 1024 * 6144 + (size_t)(F.wave * 128) * 6144 + jj;
        float acc[9];
#pragma unroll
        for (int r = 0; r < 9; ++r) acc[r] = 0.f;
#pragma unroll 16
        for (int k = 0; k < 128; ++k) { const float wv = wp[(size_t)k * 6144];
#pragma unroll
            for (int r = 0; r < 9; ++r) acc[r] += sc[r * 1024 + F.wave * 128 + k] * wv; }
#pragma unroll
        for (int r = 0; r < 9; ++r) part[(F.wave * 9 + r) * 64 + F.lane] = acc[r];
        __syncthreads();
        for (int o = F.tid; o < 9 * 64; o += NTHR) { const int r = o >> 6, cix = o & 63; float sum = 0.f;
#pragma unroll
            for (int w2 = 0; w2 < 8; ++w2) sum += part[(w2 * 9 + r) * 64 + cix];
            const int j2 = un * 64 + cix, l2 = j2 / 6144, jj2 = j2 % 6144; MOD[(size_t)(l2 * 9 + r) * 6144 + jj2] = sum + F.in[I_ADAB][l2 * 6144 + jj2]; }
        __syncthreads();
    }
}
__device__ __forceinline__ void ph_filters(const Fr& F) {
    constexpr int NPB = 12;
    float* w1s = (float*)F.lds;
    float* w2s = w1s + 33 * 64;
    float* zs = w2s + 64 * 64;
    float* h1 = zs + NPB * 36;
    float* h2 = h1 + NPB * 64;
    const float* w3 = F.in[I_FW3]; const float* fqv = F.in[I_FREQ]; const float* hb = F.in[I_HYBIAS];
    for (int i = F.tid; i < 33 * 64; i += NTHR) w1s[i] = F.in[I_FW1][i];
    for (int i = F.tid; i < 64 * 64; i += NTHR) w2s[i] = F.in[I_FW2][i];
    const int total = SEQ + CTXL; int np = 0; for (int it = F.bid; it < total && np < NPB; it += F.G) ++np;
    for (int i = F.tid; i < np * 33; i += NTHR) { const int pi = i / 33, zi = i % 33, item = F.bid + pi * F.G; const int n = item < SEQ ? SEQ : CTXL, pos = item < SEQ ? item : item - SEQ;
        const float fpos = (float)pos, t = fpos / (float)(n - 1), omega = (6.283185307179586f * fpos) / (float)n; float v;
        if (zi == 0) v = t; else { const int bi = (zi - 1) & 15; const float band = 1e-4f + (float)bi * ((15.f - 1e-4f) / 15.f); const float a = omega * band; v = (zi <= 16) ? cosf(a) : -sinf(a); }
        zs[pi * 36 + zi] = v; }
    __syncthreads();
    for (int i = F.tid; i < np * 64; i += NTHR) { const int pi = i >> 6, j = i & 63; float a = F.in[I_FB1][j]; for (int k = 0; k < 33; ++k) a += zs[pi * 36 + k] * w1s[k * 64 + j]; h1[i] = sinf(fqv[j] * a); }
    __syncthreads();
    for (int i = F.tid; i < np * 64; i += NTHR) { const int pi = i >> 6, j = i & 63; float a = F.in[I_FB2][j]; for (int k = 0; k < 64; ++k) a += h1[pi * 64 + k] * w2s[k * 64 + j]; h2[i] = sinf(fqv[j] * a); }
    __syncthreads();
#pragma unroll 1
    for (int oo = 0; oo < 2; ++oo) { const int o = F.tid + 512 * oo; float acc[NPB];
#pragma unroll
        for (int pi = 0; pi < NPB; ++pi) acc[pi] = 0.f;
        for (int k = 0; k < 64; ++k) { const float wv = w3[k * 1024 + o];
#pragma unroll
            for (int pi = 0; pi < NPB; ++pi) acc[pi] += h2[pi * 64 + k] * wv; }
        const int dir = o >> 9, c = o & 511; const float a0 = -3.0701134573253945f, b0 = -15.350567286626973f; const float delta = fabsf(a0 + (float)c * ((b0 - a0) / 511.f));
#pragma unroll
        for (int pi = 0; pi < NPB; ++pi) if (pi < np) { const int item = F.bid + pi * F.G; const int n = item < SEQ ? SEQ : CTXL, pos = item < SEQ ? item : item - SEQ; const float t = (float)pos / (float)(n - 1);
            bf16_t* Rd = (n == SEQ) ? F.w<bf16_t>(L0_FL) : F.w<bf16_t>(L0_FC); const int n2 = 2 * n; const float val = acc[pi] * expf(-t * delta);
            if (dir == 0) Rd[(size_t)c * n2 + (n - pos)] = f2bf(val + (pos == 0 ? hb[c] : 0.f)); else if (pos > 0) Rd[(size_t)c * n2 + (n + pos)] = f2bf(val); }
    }
    __syncthreads();
}
__device__ __forceinline__ void ph_rope_tables(const Fr& F) {
    float* cm = F.w<float>(WS_ROPEM); float* sm = cm + 2048 * 16; float* cgq = F.w<float>(WS_ROPEG); float* sg = cgq + 2048 * 32;
    for (int idx = F.bid * NTHR + F.tid; idx < 2048 * 16; idx += F.G * NTHR) { const int pos = idx >> 4, i = idx & 15; const float inv = powf(10000.f, -(float)(i & 7) / 8.f);
        const float p = (i < 8) ? (float)(pos >> 6) : (float)(pos & 63); const float ang = p * inv; cm[idx] = cosf(ang); sm[idx] = sinf(ang); }
    for (int idx = F.bid * NTHR + F.tid; idx < 2048 * 32; idx += F.G * NTHR) { const int pos = idx >> 5, i = idx & 31; const float inv = powf(10000.f, -(float)(i & 15) / 16.f);
        const float p = (i < 16) ? (float)(pos >> 6) : (float)(pos & 63); const float ang = p * inv; cgq[idx] = cosf(ang); sg[idx] = sinf(ang); }
}

__device__ __forceinline__ void store_bf16x4(bf16_t* p, float4 v) { uint2 q; q.x = pack2(v.x, v.y); q.y = pack2(v.z, v.w); *(uint2*)p = q; }
__device__ __forceinline__ float4 ld4(const float* p) { return *(const float4*)p; }
__device__ __forceinline__ float sumsq4(const float4 (&v)[4]) { float s = 0.f;
#pragma unroll
    for (int i = 0; i < 4; ++i) s += v[i].x * v[i].x + v[i].y * v[i].y + v[i].z * v[i].z + v[i].w * v[i].w;
    return s; }

struct RowSched { int b, k0, WPB, NW, gw, nlat, ntot;
    __device__ __forceinline__ void init(int G, int bid, int wave, int nrows) { NW = G * 8; gw = bid * 8 + wave; WPB = NW / 8; b = gw / WPB; k0 = gw % WPB;
        nlat = (SEQ - k0 + WPB - 1) / WPB; const int nctx = (nrows > TL && gw < TC) ? (TC - gw + NW - 1) / NW : 0; ntot = nlat + nctx; }
    __device__ __forceinline__ int row_at(int s) const { return s < nlat ? b * SEQ + k0 + WPB * s : TL + gw + NW * (s - nlat); }
};
__device__ __forceinline__ void ph_norm0(const Fr& F) {
    const float* g = F.in[I_MIXPRE]; const float* MOD = F.w<float>(WS_MOD); bf16_t* A = F.w<bf16_t>(WS_ABUF);
    RowSched RS; RS.init(F.G, F.bid, F.wave, TT);
    float4 gv[4], shv[4], scv[4]; int mr_cur = -1;
#pragma unroll
    for (int i = 0; i < 4; ++i) gv[i] = ld4(g + 4 * (F.lane + 64 * i));
    for (int si = 0; si < RS.ntot; si += 2) {
        const int row0 = RS.row_at(si); const bool has1 = si + 1 < RS.ntot; const int row1 = has1 ? RS.row_at(si + 1) : row0; const int r1 = row1;
        const float* s0 = row0 < TL ? F.in[I_X] + (size_t)row0 * 1024 : F.in[I_CTX] + (size_t)(row0 - TL) * 1024; const float* s1 = r1 < TL ? F.in[I_X] + (size_t)r1 * 1024 : F.in[I_CTX] + (size_t)(r1 - TL) * 1024;
        float4 v0[4], v1[4];
#pragma unroll
        for (int i = 0; i < 4; ++i) { v0[i] = ld4(s0 + 4 * (F.lane + 64 * i)); v1[i] = ld4(s1 + 4 * (F.lane + 64 * i)); }
        const float q0 = rsqrtf(wave_sum(sumsq4(v0)) * (1.f / 1024.f) + EPS), q1 = rsqrtf(wave_sum(sumsq4(v1)) * (1.f / 1024.f) + EPS);
#pragma unroll
        for (int rr = 0; rr < 2; ++rr) { if (rr && !has1) break; const int row = rr ? row1 : row0; const int mr = row < TL ? (row >> 11) : 8; const float r = rr ? q1 : q0;
            if (mr != mr_cur) { mr_cur = mr;
#pragma unroll
                for (int i = 0; i < 4; ++i) { const int c = 4 * (F.lane + 64 * i); shv[i] = ld4(MOD + (size_t)mr * 6144 + c); scv[i] = ld4(MOD + (size_t)mr * 6144 + 1024 + c); } }
#pragma unroll
            for (int i = 0; i < 4; ++i) { const int c = 4 * (F.lane + 64 * i); const float4 gg = gv[i], sh = shv[i], sc = scv[i]; const float4 v = rr ? v1[i] : v0[i];
                float4 o; o.x = v.x * r * gg.x * (1.f + sc.x) + sh.x; o.y = v.y * r * gg.y * (1.f + sc.y) + sh.y; o.z = v.z * r * gg.z * (1.f + sc.z) + sh.z; o.w = v.w * r * gg.w * (1.f + sc.w) + sh.w;
                store_bf16x4(A + (size_t)row * 1024 + c, o); } }
    }
}
template <int MODE, bool SRCF32, bool DSTF32>
__device__ __forceinline__ void ph_thin(const Fr& F, const float* msrc, int nrows, const float* hs_lat, const float* hs_ctx, float* hd_lat, float* hd_ctx,
                        const float* postg, const float* MODg, int gate_off, const float* preg, const float* MODn, int sh_off, int sc_off, bf16_t* adst, int xNTF = 0, int xS = 1, const bf16_t* xt2 = nullptr, int xS2 = 1) {
    float* rt = (float*)F.lds;
    int* cntL = (int*)(F.lds + 32768);
    int* blkBase = cntL + 8;
    int* selInfo = cntL + 16;
    if (MODE == 1) { for (int i = F.tid; i < 1024 * 8; i += NTHR) rt[(i & 7) * 1024 + (i >> 3)] = F.in[I_ROUTER][i]; if (F.tid < 8) cntL[F.tid] = 0; __syncthreads(); }
    int li = F.wave;
#define THIN_LOAD(row, m, h) do { \
        const float* hs = SRCF32 ? ((row) < TL ? hs_lat + (size_t)(row) * 1024 : hs_ctx + (size_t)((row) - TL) * 1024) : nullptr; const bf16_t* hbs = F.w<bf16_t>(WS_HB) + (size_t)(row) * 1024; \
        int tail0 = -1, tail1 = -1; \
        if (MODE == 2 && xS > 1) { const int2 sr = *(const int2*)(F.w<int>(WS_SROW) + (size_t)(row) * 2); const int r0 = __builtin_amdgcn_readfirstlane(sr.x), r1 = __builtin_amdgcn_readfirstlane(sr.y); \
            if ((r0 >> 8) >= xNTF) tail0 = r0 - xNTF * 256; if ((r1 >> 8) >= xNTF) tail1 = r1 - xNTF * 256; } \
        _Pragma("unroll") for (int i = 0; i < 4; ++i) { const int c = 4 * (F.lane + 64 * i); \
            if (SRCF32) h[i] = ld4(hs + c); else { const uint2 hv = *(const uint2*)(hbs + c); h[i].x = bflo(hv.x); h[i].y = bfhi(hv.x); h[i].z = bflo(hv.y); h[i].w = bfhi(hv.y); } \
            if (MODE == 2) { const bf16_t* mo = (const bf16_t*)msrc; const uint2 a = *(const uint2*)(mo + (size_t)(row) * 1024 + c), b = *(const uint2*)(mo + ((size_t)TL + (row)) * 1024 + c); \
                m[i].x = bflo(a.x) + bflo(b.x); m[i].y = bfhi(a.x) + bfhi(b.x); m[i].z = bflo(a.y) + bflo(b.y); m[i].w = bfhi(a.y) + bfhi(b.y); \
                if (tail0 >= 0) { const bf16_t* xp = F.w<bf16_t>(WS_XTR) + ((size_t)((tail0 >> 8) * 4 + i) * (xS - 1) * 256 + (tail0 & 255)) * 256 + (c & 255); \
                    for (int s2 = 0; s2 < xS - 1; ++s2) { const uint2 e = *(const uint2*)(xp + (size_t)s2 * 65536); m[i].x += bflo(e.x); m[i].y += bfhi(e.x); m[i].z += bflo(e.y); m[i].w += bfhi(e.y); } } \
                if (tail1 >= 0) { const bf16_t* xp = F.w<bf16_t>(WS_XTR) + ((size_t)((tail1 >> 8) * 4 + i) * (xS - 1) * 256 + (tail1 & 255)) * 256 + (c & 255); \
                    for (int s2 = 0; s2 < xS - 1; ++s2) { const uint2 e = *(const uint2*)(xp + (size_t)s2 * 65536); m[i].x += bflo(e.x); m[i].y += bfhi(e.x); m[i].z += bflo(e.y); m[i].w += bfhi(e.y); } } } \
            else { const uint2 a = *(const uint2*)((const bf16_t*)msrc + (size_t)(row) * 1024 + c); m[i].x = bflo(a.x); m[i].y = bfhi(a.x); m[i].z = bflo(a.y); m[i].w = bfhi(a.y); \
                if (MODE == 0 && xS2 > 1 && (row) >= TL) { \
                    const bf16_t* xp = xt2 + ((size_t)(((((row) - TL) >> 8) * 4 + i) * (xS2 - 1)) * 256 + ((row) & 255)) * 256 + (c & 255); \
                    for (int s2 = 0; s2 < xS2 - 1; ++s2) { const uint2 e = *(const uint2*)(xp + (size_t)s2 * 65536); m[i].x += bflo(e.x); m[i].y += bfhi(e.x); m[i].z += bflo(e.y); m[i].w += bfhi(e.y); } } } } } while (0)
    RowSched RS; RS.init(F.G, F.bid, F.wave, nrows); const int RPW = 16;
    li = F.wave * RPW;
    float4 m[4], h[4], mN[4], hN[4], pgv[4], ggv[4], gtv[4], shv[4], scv[4]; int mr_cur = -1;
#pragma unroll
    for (int i = 0; i < 4; ++i) { const int c = 4 * (F.lane + 64 * i); pgv[i] = ld4(postg + c); if (MODE != 2) ggv[i] = ld4(preg + c); }
    if (RS.ntot > 0) { const int rw = RS.row_at(0); THIN_LOAD(rw, m, h); }
    for (int si = 0; si < RS.ntot; ++si, ++li) {
        const int row = RS.row_at(si);
        if (si + 1 < RS.ntot) { const int rown = RS.row_at(si + 1); THIN_LOAD(rown, mN, hN); }
        const int mr = row < TL ? (row >> 11) : 8;
        if (mr != mr_cur) { mr_cur = mr;
#pragma unroll
            for (int i = 0; i < 4; ++i) { const int c = 4 * (F.lane + 64 * i); gtv[i] = ld4(MODg + (size_t)mr * 6144 + gate_off + c);
                if (MODE != 2) { shv[i] = ld4(MODn + (size_t)mr * 6144 + sh_off + c); scv[i] = ld4(MODn + (size_t)mr * 6144 + sc_off + c); } } }
        float* hd = DSTF32 ? hd_lat + (size_t)row * 1024 : nullptr;
        bf16_t* hb = F.w<bf16_t>(WS_HB) + (size_t)row * 1024;
        const float r = rsqrtf(wave_sum(sumsq4(m)) * (1.f / 1024.f) + EPS);
#pragma unroll
        for (int i = 0; i < 4; ++i) { const int c = 4 * (F.lane + 64 * i); const float4 pg = pgv[i], gt = gtv[i];
            h[i].x += gt.x * (m[i].x * r * pg.x); h[i].y += gt.y * (m[i].y * r * pg.y); h[i].z += gt.z * (m[i].z * r * pg.z); h[i].w += gt.w * (m[i].w * r * pg.w);
            if (DSTF32) *(float4*)(hd + c) = h[i]; else store_bf16x4(hb + c, h[i]); }
        if (MODE != 2) {
        const float r2 = rsqrtf(wave_sum(sumsq4(h)) * (1.f / 1024.f) + EPS);
        float lg[8];
#pragma unroll
        for (int e = 0; e < 8; ++e) lg[e] = 0.f;
#pragma unroll
        for (int i = 0; i < 4; ++i) { const int c = 4 * (F.lane + 64 * i); const float4 gg = ggv[i], sh = shv[i], sc = scv[i];
            float4 o; o.x = h[i].x * r2 * gg.x * (1.f + sc.x) + sh.x; o.y = h[i].y * r2 * gg.y * (1.f + sc.y) + sh.y; o.z = h[i].z * r2 * gg.z * (1.f + sc.z) + sh.z; o.w = h[i].w * r2 * gg.w * (1.f + sc.w) + sh.w;
            store_bf16x4(adst + (size_t)row * 1024 + c, o);
            if (MODE == 1) {
#pragma unroll
                for (int e = 0; e < 8; ++e) { const float4 rv = *(const float4*)(rt + e * 1024 + c); lg[e] += o.x * rv.x + o.y * rv.y + o.z * rv.z + o.w * rv.w; } } }
        if (MODE == 1) {
#pragma unroll
            for (int e = 0; e < 8; ++e) lg[e] = wave_sum(lg[e]);
            int i1 = 0; float v1 = lg[0];
#pragma unroll
            for (int e = 1; e < 8; ++e) if (lg[e] > v1) { v1 = lg[e]; i1 = e; }
            int i2 = -1; float v2 = -3.0e38f;
#pragma unroll
            for (int e = 0; e < 8; ++e) if (e != i1 && lg[e] > v2) { v2 = lg[e]; i2 = e; }
            const float w1 = 1.f / (1.f + expf(v2 - v1)), w2 = 1.f - w1;
            if (F.lane == 0) { float* tw = F.w<float>(WS_TOPW) + (size_t)row * 2; tw[0] = w1; tw[1] = w2;
                const int r1 = atomicAdd(&cntL[i1], 1), r2i = atomicAdd(&cntL[i2], 1);
                selInfo[li * 2 + 0] = i1 | (r1 << 8); selInfo[li * 2 + 1] = i2 | (r2i << 8); }
        }
        }
#pragma unroll
        for (int i = 0; i < 4; ++i) { m[i] = mN[i]; h[i] = hN[i]; }
    }
#undef THIN_LOAD
    if (MODE == 1) {
        __syncthreads();
        if (F.tid < 8) blkBase[F.tid] = (int)__hip_atomic_fetch_add(F.w<unsigned>(WS_CNT) + F.tid, (unsigned)cntL[F.tid], __ATOMIC_RELAXED, __HIP_MEMORY_SCOPE_AGENT);
        __syncthreads();
        int* LISTE = F.w<int>(WS_LISTE);
        for (int idx = F.tid; idx < 16 * RPW; idx += NTHR) { const int l2 = idx >> 1, k = idx & 1; RowSched R2; R2.init(F.G, F.bid, l2 / RPW, nrows); const int it2 = l2 % RPW; const int row = it2 < R2.ntot ? R2.row_at(it2) : nrows;
            if (row < nrows) { const int si = selInfo[idx], e = si & 255, rk = si >> 8; LISTE[(size_t)e * TL + blkBase[e] + rk] = row * 2 + k; } }
        __syncthreads();
    }
}
__device__ __forceinline__ void ph_moe_gather(const Fr& F) {
    const unsigned* cnt = F.w<unsigned>(WS_CNT); int ts[9]; ts[0] = 0;
#pragma unroll
    for (int e = 0; e < 8; ++e) ts[e + 1] = ts[e] + (int)((__hip_atomic_load(cnt + e, __ATOMIC_RELAXED, __HIP_MEMORY_SCOPE_AGENT) + 255u) >> 8);
    const int nrows = ts[8] * 256; const int* LISTE = F.w<int>(WS_LISTE); const float* TOPW = F.w<float>(WS_TOPW);
    const bf16_t* a2 = F.w<bf16_t>(L1_A2TMP); bf16_t* AG = F.w<bf16_t>(WS_AG); uint2* RIW = F.w<uint2>(WS_ROWINFO);
    const int RPW = (nrows + F.G * 8 - 1) / (F.G * 8), rbeg = (F.bid * 8 + F.wave) * RPW, rend = (rbeg + RPW < nrows) ? rbeg + RPW : nrows;
    int my_info = -1;
    { const int r = rbeg + F.lane;
      if (F.lane < RPW && r < rend) { const int j = r >> 8; int e = 0;
#pragma unroll
          for (int k = 1; k < 8; ++k) e += (j >= ts[k]) ? 1 : 0;
          int tse = ts[0];
#pragma unroll
          for (int k = 1; k < 8; ++k) tse = (e == k) ? ts[k] : tse;
          const int i = r - tse * 256; const int ce = (int)__hip_atomic_load(cnt + e, __ATOMIC_RELAXED, __HIP_MEMORY_SCOPE_AGENT); float w = 0.f;
          if (i < ce) { my_info = LISTE[(size_t)e * TL + i]; w = TOPW[my_info]; F.w<int>(WS_SROW)[my_info] = r; }
          RIW[r] = make_uint2((unsigned)my_info, __float_as_uint(w)); } }
    static_assert(MOE_FP8, "the gather below writes e4m3 rows");
    uint4 v0 = make_uint4(0u, 0u, 0u, 0u), v1 = v0, n0 = v0, n1 = v0;
    if (rbeg < rend) { const int info = __builtin_amdgcn_readlane(my_info, 0); if (info >= 0) { const uint4* src = (const uint4*)(a2 + (size_t)(info >> 1) * 1024 + F.lane * 16); v0 = src[0]; v1 = src[1]; } }
    for (int r = rbeg; r < rend; ++r) {
        n0 = make_uint4(0u, 0u, 0u, 0u); n1 = n0;
        if (r + 1 < rend) { const int info = __builtin_amdgcn_readlane(my_info, r + 1 - rbeg); if (info >= 0) { const uint4* src = (const uint4*)(a2 + (size_t)(info >> 1) * 1024 + F.lane * 16); n0 = src[0]; n1 = src[1]; } }
        uint4 o; o.x = pack4_fp8(bflo(v0.x), bfhi(v0.x), bflo(v0.y), bfhi(v0.y)); o.y = pack4_fp8(bflo(v0.z), bfhi(v0.z), bflo(v0.w), bfhi(v0.w));
        o.z = pack4_fp8(bflo(v1.x), bfhi(v1.x), bflo(v1.y), bfhi(v1.y)); o.w = pack4_fp8(bflo(v1.z), bfhi(v1.z), bflo(v1.w), bfhi(v1.w));
        *(uint4*)((unsigned char*)AG + (size_t)r * 1024 + F.lane * 16) = o;
        v0 = n0; v1 = n1;
    }
}
__device__ __forceinline__ void ld8bf(const bf16_t* p, float (&o)[8]) { const uint4 q = *(const uint4*)p; o[0] = bflo(q.x); o[1] = bfhi(q.x); o[2] = bflo(q.y); o[3] = bfhi(q.y); o[4] = bflo(q.z); o[5] = bfhi(q.z); o[6] = bflo(q.w); o[7] = bfhi(q.w); }
__device__ __forceinline__ void st8bf(bf16_t* p, const float (&v)[8]) { uint4 q; q.x = pack2(v[0], v[1]); q.y = pack2(v[2], v[3]); q.z = pack2(v[4], v[5]); q.w = pack2(v[6], v[7]); *(uint4*)p = q; }
struct CW { float w0[8], w1[8], w2[8], bb[8]; };
__device__ __forceinline__ void cw_load(CW& c, const float* w, const float* b, int wc, int wld) {
    const float4 a0 = ld4(w + wc), a1 = ld4(w + wc + 4), b0 = ld4(w + wld + wc), b1 = ld4(w + wld + wc + 4), c0 = ld4(w + 2 * wld + wc), c1 = ld4(w + 2 * wld + wc + 4), d0 = ld4(b + wc), d1 = ld4(b + wc + 4);
    c.w0[0] = a0.x; c.w0[1] = a0.y; c.w0[2] = a0.z; c.w0[3] = a0.w; c.w0[4] = a1.x; c.w0[5] = a1.y; c.w0[6] = a1.z; c.w0[7] = a1.w;
    c.w1[0] = b0.x; c.w1[1] = b0.y; c.w1[2] = b0.z; c.w1[3] = b0.w; c.w1[4] = b1.x; c.w1[5] = b1.y; c.w1[6] = b1.z; c.w1[7] = b1.w;
    c.w2[0] = c0.x; c.w2[1] = c0.y; c.w2[2] = c0.z; c.w2[3] = c0.w; c.w2[4] = c1.x; c.w2[5] = c1.y; c.w2[6] = c1.z; c.w2[7] = c1.w;
    c.bb[0] = d0.x; c.bb[1] = d0.y; c.bb[2] = d0.z; c.bb[3] = d0.w; c.bb[4] = d1.x; c.bb[5] = d1.y; c.bb[6] = d1.z; c.bb[7] = d1.w;
}
__device__ __forceinline__ void conv8(const bf16_t* prow, bool hasp, bool hasn, int pc, const CW& c, float (&o)[8]) {
    float xm[8], x0[8], xp[8]; ld8bf(prow + pc, x0);
    if (hasp) ld8bf(prow - EVEN_PAD + pc, xm); else {
#pragma unroll
        for (int j = 0; j < 8; ++j) xm[j] = 0.f; }
    if (hasn) ld8bf(prow + EVEN_PAD + pc, xp); else {
#pragma unroll
        for (int j = 0; j < 8; ++j) xp[j] = 0.f; }
#pragma unroll
    for (int j = 0; j < 8; ++j) o[j] = c.w0[j] * xm[j] + c.w1[j] * x0[j] + c.w2[j] * xp[j] + c.bb[j];
}
__device__ __forceinline__ void ph_convpass(const Fr& F) {
    const bf16_t* PROJ = F.w<bf16_t>(L0_PROJ); bf16_t* U = F.w<bf16_t>(L0_U); bf16_t* X0 = F.w<bf16_t>(L0_X0); bf16_t* XBC = F.w<bf16_t>(L0_XBC); float* DT = F.w<float>(L0_DT);
    const float* hw = F.in[I_HYCW]; const float* hb = F.in[I_HYCB]; const float* sw = F.in[I_SCW]; const float* sb = F.in[I_SCB]; const float* dtb = F.in[I_DTB];
    {
        const int c = F.lane * 8; CW cx0, cb0, cb1; cw_load(cx0, hw, hb, c, 1536); cw_load(cb0, sw, sb, c, 1024); cw_load(cb1, sw, sb, c + 512, 1024);
        const float dtbv = F.lane < 16 ? dtb[F.lane] : 0.f;
        for (int row = F.bid * 8 + F.wave; row < TT; row += F.G * 8) {
            const int t = row < TL ? (row & (SEQ - 1)) : ((row - TL) & (CTXL - 1)), n = row < TL ? SEQ : CTXL; const bool hasp = t > 0, hasn = t < n - 1;
            const bf16_t* prow = PROJ + (size_t)row * EVEN_PAD;
            float a0[8];
            conv8(prow, hasp, hasn, c, cx0, a0);
            st8bf(X0 + (size_t)row * 512 + c, a0);
            conv8(prow, hasp, hasn, 2048 + c, cb0, a0);
#pragma unroll
            for (int j = 0; j < 8; ++j) a0[j] = silu_f(a0[j]);
            st8bf(XBC + (size_t)row * 1024 + c, a0);
            conv8(prow, hasp, hasn, 2048 + 512 + c, cb1, a0);
#pragma unroll
            for (int j = 0; j < 8; ++j) a0[j] = silu_f(a0[j]);
            st8bf(XBC + (size_t)row * 1024 + 512 + c, a0);
            if (F.lane < 16) DT[(size_t)row * 16 + F.lane] = softplus_f(bf2f(prow[3072 + F.lane]) + dtbv);
        }
    }
    bf16_t* ut = (bf16_t*)F.lds;
    {   const int tok = F.tid >> 3, cq = F.tid & 7; const int cgp = F.bid & 3;
        CW c1a, c1b, cva, cvb; { const int ch = cgp * 128 + cq * 16; cw_load(c1a, hw, hb, 512 + ch, 1536); cw_load(c1b, hw, hb, 512 + ch + 8, 1536); cw_load(cva, hw, hb, 1024 + ch, 1536); cw_load(cvb, hw, hb, 1024 + ch + 8, 1536); }
        for (int un = F.bid; un < (TT / 64) * 4; un += F.G) {
            const int tile = un >> 2, row0 = tile * 64; const int row = row0 + tok;
            const int t = row < TL ? (row & (SEQ - 1)) : ((row - TL) & (CTXL - 1)), n = row < TL ? SEQ : CTXL; const bool hasp = t > 0, hasn = t < n - 1;
            const bf16_t* prow = PROJ + (size_t)row * EVEN_PAD; const int ch = cgp * 128 + cq * 16;
            { float a1[8], a2[8]; conv8(prow, hasp, hasn, 512 + ch, c1a, a1); conv8(prow, hasp, hasn, 1024 + ch, cva, a2);
#pragma unroll
              for (int j = 0; j < 8; ++j) ut[(cq * 16 + j) * 66 + tok] = f2bf(a1[j] * a2[j]);
              conv8(prow, hasp, hasn, 512 + ch + 8, c1b, a1); conv8(prow, hasp, hasn, 1024 + ch + 8, cvb, a2);
#pragma unroll
              for (int j = 0; j < 8; ++j) ut[(cq * 16 + 8 + j) * 66 + tok] = f2bf(a1[j] * a2[j]); }
            __syncthreads();
            { const int ch2 = F.tid >> 2, part = F.tid & 3; const int b = row0 < TL ? (row0 >> 11) : ((row0 - TL) >> 8), off = row0 < TL ? CTXL + (row0 & (SEQ - 1)) : ((row0 - TL) & (CTXL - 1));
              const unsigned* src = (const unsigned*)(ut + ch2 * 66 + part * 16); uint4 v0, v1; v0.x = src[0]; v0.y = src[1]; v0.z = src[2]; v0.w = src[3]; v1.x = src[4]; v1.y = src[5]; v1.z = src[6]; v1.w = src[7];
              uint4* dst = (uint4*)(U + ((size_t)(cgp * 128 + ch2) * 8 + b) * NKEY + off + part * 16); dst[0] = v0; dst[1] = v1; }
            __syncthreads();
        }
    }
}

__device__ __forceinline__ unsigned alignhalf(unsigned hi, unsigned lo) { return (lo >> 16) | (hi << 16); }
template <int RHO> __device__ __forceinline__ uint4 shift_copy(const uint4 prev, const uint4 cur) {
    const unsigned cc[8] = {prev.x, prev.y, prev.z, prev.w, cur.x, cur.y, cur.z, cur.w};
    constexpr int o = 16 - 2 * RHO, d0 = o / 4; uint4 r;
    if constexpr ((o & 3) == 0) { r.x = cc[d0]; r.y = cc[d0 + 1]; r.z = cc[d0 + 2]; r.w = cc[d0 + 3]; }
    else { r.x = alignhalf(cc[d0 + 1], cc[d0]); r.y = alignhalf(cc[d0 + 2], cc[d0 + 1]); r.z = alignhalf(cc[d0 + 3], cc[d0 + 2]); r.w = alignhalf(cc[d0 + 4], cc[d0 + 3]); }
    return r;
}
__device__ __forceinline__ void build_copies(unsigned char* cp, int cs, const bf16_t* R, int nch, int i) {
    if (i < nch) { const uint4 cur = *(const uint4*)(R + 8 * i); const uint4 prev = i > 0 ? *(const uint4*)(R + 8 * i - 8) : make_uint4(0u, 0u, 0u, 0u);
        *(uint4*)(cp + 0 * cs + i * 16) = cur;
        *(uint4*)(cp + 1 * cs + i * 16) = shift_copy<1>(prev, cur); *(uint4*)(cp + 2 * cs + i * 16) = shift_copy<2>(prev, cur); *(uint4*)(cp + 3 * cs + i * 16) = shift_copy<3>(prev, cur);
        *(uint4*)(cp + 4 * cs + i * 16) = shift_copy<4>(prev, cur); *(uint4*)(cp + 5 * cs + i * 16) = shift_copy<5>(prev, cur); *(uint4*)(cp + 6 * cs + i * 16) = shift_copy<6>(prev, cur);
        *(uint4*)(cp + 7 * cs + i * 16) = shift_copy<7>(prev, cur); }
}
__device__ __forceinline__ void ph_hyena_mfma(const Fr& F) {
    const bf16_t* U = F.w<bf16_t>(L0_U); bf16_t* YT = F.w<bf16_t>(L0_YT);
    const int w = F.wave, rr = F.lane & 15, g = F.lane >> 4;
    {   constexpr int CS = 8224, US = 4128;
        unsigned char* Cp = F.lds; unsigned char* Ub = F.lds + 8 * CS;
        const int p = w & 1, q = w >> 1;
        for (int c = F.bid; c < 512; c += F.G) {
            __syncthreads();
            build_copies(Cp, CS, F.w<bf16_t>(L0_FL) + (size_t)c * 4096, 512, F.tid);
#pragma unroll
            for (int k = 0; k < 4; ++k) { const int id = F.tid + 512 * k, b = id >> 8, ch = id & 255; *(uint4*)(Ub + b * US + ch * 16) = *(const uint4*)(U + ((size_t)c * 8 + b) * NKEY + CTXL + ch * 8); }
            __syncthreads();
            const unsigned char* abase = Cp + (rr & 7) * CS + (2048 - 16 * (32 * q + p) - 8 * (rr >> 3) + 8 * g) * 2;
            const unsigned char* ubase = Ub + (rr & 7) * US + 16 * g;
            f32x4 acc[16]; bf16x8 af[16];
#pragma unroll
            for (int i = 0; i < 16; ++i) { acc[i] = (f32x4){0.f, 0.f, 0.f, 0.f}; af[i] = *(const bf16x8*)(abase - 64 * i); }
            for (int jj = 0; jj < 4; ++jj) {
#pragma unroll
                for (int js = 0; js < 16; ++js) { const int J = 16 * jj + js;
                    af[(16 - js) & 15] = *(const bf16x8*)(abase + 64 * J);
                    const bf16x8 bfr = *(const bf16x8*)(ubase + 64 * J);
#pragma unroll
                    for (int i = 0; i < 16; ++i) acc[i] = __builtin_amdgcn_mfma_f32_16x16x32_bf16(af[(i - js) & 15], bfr, acc[i], 0, 0, 0);
                }
            }
            if (rr < 8) {
#pragma unroll
                for (int i = 0; i < 16; ++i) { const int t = 16 * (32 * q + p + 2 * i) + 4 * g; uint2 pk; pk.x = pack2(acc[i][0], acc[i][1]); pk.y = pack2(acc[i][2], acc[i][3]);
                    *(uint2*)(YT + ((size_t)c * 8 + rr) * NKEY + CTXL + t) = pk; }
            }
        }
    }
    {   constexpr int CS = 1056, US = 544;
        unsigned char* Cp = F.lds; unsigned char* Ub = F.lds + 8 * CS;
        for (int c = F.bid; c < 512; c += F.G) {
            __syncthreads();
            build_copies(Cp, CS, F.w<bf16_t>(L0_FC) + (size_t)c * 512, 64, F.tid);
            if (F.tid < 256) { const int b = F.tid >> 5, ch = F.tid & 31; *(uint4*)(Ub + b * US + ch * 16) = *(const uint4*)(U + ((size_t)c * 8 + b) * NKEY + ch * 8); }
            __syncthreads();
            f32x4 acc[2];
#pragma unroll
            for (int ii = 0; ii < 2; ++ii) acc[ii] = (f32x4){0.f, 0.f, 0.f, 0.f};
#pragma unroll
            for (int J = 0; J < 8; ++J) { const bf16x8 bfr = *(const bf16x8*)(Ub + (rr & 7) * US + 16 * g + 64 * J);
#pragma unroll
                for (int ii = 0; ii < 2; ++ii) { const int d = 2 * w + ii - 2 * J; const bf16x8 a = *(const bf16x8*)(Cp + (rr & 7) * CS + (256 - 16 * d - 8 * (rr >> 3) + 8 * g) * 2);
                    acc[ii] = __builtin_amdgcn_mfma_f32_16x16x32_bf16(a, bfr, acc[ii], 0, 0, 0); } }
            if (rr < 8) {
#pragma unroll
                for (int ii = 0; ii < 2; ++ii) { const int t = 16 * (2 * w + ii) + 4 * g; uint2 pk; pk.x = pack2(acc[ii][0], acc[ii][1]); pk.y = pack2(acc[ii][2], acc[ii][3]);
                    *(uint2*)(YT + ((size_t)c * 8 + rr) * NKEY + t) = pk; }
            }
        }
    }
    __syncthreads();
}
__device__ __forceinline__ void ph_hyena_post(const Fr& F) {
    const bf16_t* YT = F.w<bf16_t>(L0_YT); const bf16_t* X0 = F.w<bf16_t>(L0_X0); bf16_t* A = F.w<bf16_t>(WS_ABUF);
    bf16_t* yt = (bf16_t*)F.lds;
    for (int un = F.bid; un < (TT / 64) * 4; un += F.G) {
        const int tile = un >> 2, cgp = un & 3, row0 = tile * 64;
        { const int ch = F.tid >> 2, part = F.tid & 3; const int b = row0 < TL ? (row0 >> 11) : ((row0 - TL) >> 8), off = row0 < TL ? CTXL + (row0 & (SEQ - 1)) : ((row0 - TL) & (CTXL - 1));
          const uint4* src = (const uint4*)(YT + ((size_t)(cgp * 128 + ch) * 8 + b) * NKEY + off + part * 16); const uint4 v0 = src[0], v1 = src[1];
          unsigned* dst = (unsigned*)(yt + ch * 66 + part * 16); dst[0] = v0.x; dst[1] = v0.y; dst[2] = v0.z; dst[3] = v0.w; dst[4] = v1.x; dst[5] = v1.y; dst[6] = v1.z; dst[7] = v1.w; }
        __syncthreads();
        { const int tok = F.tid >> 3, cq = F.tid & 7, row = row0 + tok;
#pragma unroll
          for (int hf = 0; hf < 2; ++hf) { const int ch = cgp * 128 + cq * 16 + hf * 8; float x0[8], o[8]; ld8bf(X0 + (size_t)row * 512 + ch, x0);
#pragma unroll
              for (int j = 0; j < 8; ++j) o[j] = x0[j] * bf2f(yt[(cq * 16 + hf * 8 + j) * 66 + tok]);
              st8bf(A + (size_t)row * 1024 + ch, o); } }
        __syncthreads();
    }
}

__device__ __forceinline__ int ssd_rowbase(int b, int cpos) { return cpos < 2 ? TL + b * CTXL + cpos * 128 : b * SEQ + (cpos - 2) * 128; }
typedef short s16x4 __attribute__((ext_vector_type(4)));
__device__ __forceinline__ s16x4 tr_read16(const unsigned char* img, int P, int row0, int col0, int lane) {
    const int q4 = (lane & 15) >> 2, p4 = lane & 3;
    return __builtin_amdgcn_ds_read_tr16_b64_v4i16((LAS s16x4*)(LAS unsigned char*)(img + (row0 + q4) * P + (col0 + 4 * p4) * 2));
}
__device__ __forceinline__ bf16x8 tr_pair(const unsigned char* img, int P, int rowa, int rowb, int col0, int lane) {
    union { bf16x8 v; s16x4 h[2]; } u; u.h[0] = tr_read16(img, P, rowa, col0, lane); u.h[1] = tr_read16(img, P, rowb, col0, lane); return u.v;
}
__device__ __forceinline__ void ph_ssd_a(const Fr& F) {
    constexpr int PT = 272, PX = 144;
    unsigned char* XD = F.lds;
    unsigned char* Bn = XD + 128 * PX;
    unsigned char* Bd = Bn + 128 * PT;
    unsigned char* Cn = Bd + 128 * PT;
    float* acs = (float*)(Cn + 128 * PT);
    float* dts = acs + 128;
    const bf16_t* XBC = F.w<bf16_t>(L0_XBC); const float* DT = F.w<float>(L0_DT);
    const int w = F.wave, cl = F.lane & 15, g = F.lane >> 4;
    for (int u = F.bid; u < NB * 18 * 16; u += F.G) {
        const int b = u / 288, rem = u % 288, cpos = rem >> 4, h = (rem >> 1) & 7, dir = rem & 1, grp = h >> 2;
        const int rowbase = ssd_rowbase(b, cpos), su = ((b * 2 + dir) * 8 + h) * 18 + cpos;
        const float Aneg = -expf(F.in[I_ALOG][dir * 8 + h]);
        __syncthreads();
        if (w == 0) { const int q0 = 2 * F.lane, p0 = dir ? 127 - q0 : q0, p1 = dir ? 126 - q0 : q0 + 1;
            const float d0 = DT[(size_t)(rowbase + p0) * 16 + dir * 8 + h], d1 = DT[(size_t)(rowbase + p1) * 16 + dir * 8 + h]; const float a0 = d0 * Aneg, a1 = d1 * Aneg;
            float sc = a0 + a1;
#pragma unroll
            for (int o = 1; o < 64; o <<= 1) { const float t = __shfl_up(sc, o); if (F.lane >= o) sc += t; }
            const float ex = sc - (a0 + a1); acs[q0] = ex + a0; acs[q0 + 1] = ex + a0 + a1; dts[q0] = d0; dts[q0 + 1] = d1;
            float* ACS = F.w<float>(L0_ACS) + (size_t)su * 128; ACS[p0] = ex + a0; ACS[p1] = ex + a0 + a1;
            if (F.lane == 63) F.w<float>(L0_ATOT)[su] = ex + a0 + a1; }
        __syncthreads();
        const float atot = acs[127];
#pragma unroll
        for (int k = 0; k < 2; ++k) { const int id = F.tid + 512 * k, q = id >> 3, pc = id & 7, pos = dir ? 127 - q : q; float v[8]; ld8bf(XBC + (size_t)(rowbase + pos) * 1024 + h * 64 + pc * 8, v); const float dv = dts[q];
            uint4 o; o.x = pack2(v[0] * dv, v[1] * dv); o.y = pack2(v[2] * dv, v[3] * dv); o.z = pack2(v[4] * dv, v[5] * dv); o.w = pack2(v[6] * dv, v[7] * dv);
            *(uint4*)(XD + q * PX + pc * 16) = o; }
#pragma unroll
        for (int k = 0; k < 4; ++k) { const int id = F.tid + 512 * k, q = id >> 4, nc = id & 15, pos = dir ? 127 - q : q; const bf16_t* src = XBC + (size_t)(rowbase + pos) * 1024 + 512 + grp * 128 + nc * 8;
            const uint4 bv = *(const uint4*)src, cv = *(const uint4*)(src + 256);
            *(uint4*)(Bn + q * PT + nc * 16) = bv; *(uint4*)(Cn + q * PT + nc * 16) = cv;
            const float dec = __expf(atot - acs[q]); uint4 o;
            o.x = pack2(bflo(bv.x) * dec, bfhi(bv.x) * dec); o.y = pack2(bflo(bv.y) * dec, bfhi(bv.y) * dec); o.z = pack2(bflo(bv.z) * dec, bfhi(bv.z) * dec); o.w = pack2(bflo(bv.w) * dec, bfhi(bv.w) * dec);
            *(uint4*)(Bd + q * PT + nc * 16) = o; }
        __syncthreads();
        const int q = 16 * w + cl; const float aq = acs[q];
        bf16x8 cf[4];
#pragma unroll
        for (int ks = 0; ks < 4; ++ks) cf[ks] = *(const bf16x8*)(Cn + q * PT + (32 * ks + 8 * g) * 2);
        unsigned pk[8][2];
#pragma unroll
        for (int sb = 0; sb < 8; ++sb) { pk[sb][0] = 0u; pk[sb][1] = 0u;
            if (sb <= w) { f32x4 gacc = (f32x4){0.f, 0.f, 0.f, 0.f};
#pragma unroll
                for (int ks = 0; ks < 4; ++ks) { const bf16x8 bf = *(const bf16x8*)(Bn + (16 * sb + cl) * PT + (32 * ks + 8 * g) * 2); gacc = __builtin_amdgcn_mfma_f32_16x16x32_bf16(bf, cf[ks], gacc, 0, 0, 0); }
                const f32x4 as = *(const f32x4*)(acs + 16 * sb + 4 * g); float sv[4];
#pragma unroll
                for (int e = 0; e < 4; ++e) { const int sI = 16 * sb + 4 * g + e; sv[e] = (sI <= q) ? gacc[e] * __expf(aq - as[e]) : 0.f; }
                pk[sb][0] = pack2(sv[0], sv[1]); pk[sb][1] = pack2(sv[2], sv[3]); } }
        f32x4 yacc[4];
#pragma unroll
        for (int pb = 0; pb < 4; ++pb) yacc[pb] = (f32x4){0.f, 0.f, 0.f, 0.f};
#pragma unroll
        for (int k2 = 0; k2 < 4; ++k2) if (2 * k2 <= w) {
            union { bf16x8 v; unsigned wd[4]; } pf; pf.wd[0] = pk[2 * k2][0]; pf.wd[1] = pk[2 * k2][1]; pf.wd[2] = pk[2 * k2 + 1][0]; pf.wd[3] = pk[2 * k2 + 1][1];
#pragma unroll
            for (int pb = 0; pb < 4; ++pb) { const bf16x8 xa = tr_pair(XD, PX, 32 * k2 + 4 * g, 32 * k2 + 16 + 4 * g, 16 * pb, F.lane);
                yacc[pb] = __builtin_amdgcn_mfma_f32_16x16x32_bf16(xa, pf.v, yacc[pb], 0, 0, 0); } }
        { bf16_t* Y = (dir ? F.w<bf16_t>(L0_YB) : F.w<bf16_t>(L0_YF)) + (size_t)(rowbase + (dir ? 127 - q : q)) * 512 + h * 64 + 4 * g;
#pragma unroll
          for (int pb = 0; pb < 4; ++pb) { uint2 o; o.x = pack2(yacc[pb][0], yacc[pb][1]); o.y = pack2(yacc[pb][2], yacc[pb][3]); *(uint2*)(Y + 16 * pb) = o; } }
        { float* ST = F.w<float>(L0_ST) + (size_t)su * 8192;
          bf16x8 af[4];
#pragma unroll
          for (int ks = 0; ks < 4; ++ks) af[ks] = tr_pair(Bd, PT, 32 * ks + 8 * g, 32 * ks + 8 * g + 4, 16 * w, F.lane);
#pragma unroll
          for (int pb = 0; pb < 4; ++pb) { f32x4 sacc = (f32x4){0.f, 0.f, 0.f, 0.f};
#pragma unroll
              for (int ks = 0; ks < 4; ++ks) { const bf16x8 xb = tr_pair(XD, PX, 32 * ks + 8 * g, 32 * ks + 8 * g + 4, 16 * pb, F.lane); sacc = __builtin_amdgcn_mfma_f32_16x16x32_bf16(af[ks], xb, sacc, 0, 0, 0); }
              *(f32x4*)(ST + (size_t)(16 * pb + cl) * 128 + 16 * w + 4 * g) = sacc; } }
    }
    __syncthreads();
}
__device__ __forceinline__ void ph_ssd_b(const Fr& F) {
    const float* ST = F.w<float>(L0_ST); const float* ATOT = F.w<float>(L0_ATOT); bf16_t* STIN = F.w<bf16_t>(L0_STIN);
    for (int idx = F.bid * NTHR + F.tid; idx < 128 * 2048; idx += F.G * NTHR) {
        const int chain = idx >> 11, e4 = idx & 2047, dir = (chain >> 3) & 1;
        f32x4 run = (f32x4){0.f, 0.f, 0.f, 0.f};
        for (int k = 0; k < 18; ++k) { const int cpos = dir ? (k < 2 ? 1 - k : 19 - k) : k; const size_t su = (size_t)chain * 18 + cpos;
            uint2 o; o.x = pack2(run[0], run[1]); o.y = pack2(run[2], run[3]); *(uint2*)(STIN + su * 8192 + e4 * 4) = o;
            const f32x4 st = *(const f32x4*)(ST + su * 8192 + e4 * 4); const float dc = __expf(ATOT[su]); run = run * dc + st; }
    }
}
__device__ __forceinline__ void ph_ssd_c(const Fr& F) {
    constexpr int PT = 272;
    unsigned char* Cn = F.lds;
    unsigned char* Sin = Cn + 64 * PT;
    float* ssx = (float*)(Sin + 4 * 64 * PT);
    const bf16_t* XBC = F.w<bf16_t>(L0_XBC); const bf16_t* PROJ = F.w<bf16_t>(L0_PROJ); const bf16_t* STIN = F.w<bf16_t>(L0_STIN); const float* ACS = F.w<float>(L0_ACS);
    const bf16_t* YF = F.w<bf16_t>(L0_YF); const bf16_t* YB = F.w<bf16_t>(L0_YB); bf16_t* A = F.w<bf16_t>(WS_ABUF);
    const float* dsk = F.in[I_SSMD]; const float* ng = F.in[I_SSMNG];
    const int w = F.wave, pw = w & 3, hp = w >> 2;
    for (int u = F.bid; u < NB * 18 * 4; u += F.G) {
        int tz = threadIdx.x; asm volatile("" : "+v"(tz));
        const int cl = tz & 15, g = (tz >> 4) & 3;
        const int b = u / 72, rem = u % 72, cpos = rem >> 2, grp = (rem >> 1) & 1, ph = rem & 1; const int rowbase = ssd_rowbase(b, cpos);
        const int lpos = 16 * pw + cl, pos = ph * 64 + lpos; const size_t row = (size_t)(rowbase + pos);
        __syncthreads();
#pragma unroll
        for (int k = 0; k < 2; ++k) { const int id = tz + 512 * k, q = id >> 4, nc = id & 15; *(uint4*)(Cn + q * PT + nc * 16) = *(const uint4*)(XBC + (size_t)(rowbase + ph * 64 + q) * 1024 + 768 + grp * 128 + nc * 8); }
        float ss = 0.f;
        uint4 sreg0, sreg1, sreg2, sreg3, sreg4, sreg5, sreg6, sreg7;
#define SSDC_SRC(k, it) (STIN + ((size_t)(b * 16 + (((tz + 512 * (k)) >> 10) & 1) * 8 + grp * 4 + 2 * ((tz + 512 * (k)) >> 11) + (it)) * 18 + cpos) * 8192 + (((tz + 512 * (k)) >> 4) & 63) * 128 + ((tz + 512 * (k)) & 15) * 8)
#define SSDC_SLOAD(it) do { sreg0 = *(const uint4*)SSDC_SRC(0, it); sreg1 = *(const uint4*)SSDC_SRC(1, it); sreg2 = *(const uint4*)SSDC_SRC(2, it); sreg3 = *(const uint4*)SSDC_SRC(3, it); \
            sreg4 = *(const uint4*)SSDC_SRC(4, it); sreg5 = *(const uint4*)SSDC_SRC(5, it); sreg6 = *(const uint4*)SSDC_SRC(6, it); sreg7 = *(const uint4*)SSDC_SRC(7, it); } while (0)
#define SSDC_LDSW(k, v) *(uint4*)(Sin + ((tz + 512 * (k)) >> 10) * 64 * PT + (((tz + 512 * (k)) >> 4) & 63) * PT + ((tz + 512 * (k)) & 15) * 16) = v
        SSDC_SLOAD(0);
#pragma unroll 1
        for (int it = 0; it < 2; ++it) {
            const int h = grp * 4 + 2 * hp + it; const size_t su0 = (size_t)(b * 16 + h) * 18 + cpos, su1 = (size_t)(b * 16 + 8 + h) * 18 + cpos;
            uint2 eyf[4], eyb[4], exv[4], ezv[4];
#pragma unroll
            for (int pb = 0; pb < 4; ++pb) { const int ch = h * 64 + 16 * pb + 4 * g;
                eyf[pb] = *(const uint2*)(YF + row * 512 + ch); eyb[pb] = *(const uint2*)(YB + row * 512 + ch); exv[pb] = *(const uint2*)(XBC + row * 1024 + ch); ezv[pb] = *(const uint2*)(PROJ + row * EVEN_PAD + 1536 + ch); }
            const float a0 = ACS[su0 * 128 + pos], a1 = ACS[su1 * 128 + pos];
            __syncthreads();
            SSDC_LDSW(0, sreg0); SSDC_LDSW(1, sreg1); SSDC_LDSW(2, sreg2); SSDC_LDSW(3, sreg3); SSDC_LDSW(4, sreg4); SSDC_LDSW(5, sreg5); SSDC_LDSW(6, sreg6); SSDC_LDSW(7, sreg7);
            if (it < 1) SSDC_SLOAD(it + 1);
            __syncthreads();
            const float sc0 = __expf(a0), sc1 = __expf(a1);
            const unsigned char* S0 = Sin + (hp * 2) * 64 * PT; const unsigned char* S1 = S0 + 64 * PT;
            f32x4 t0[4], t1[4];
#pragma unroll
            for (int pb = 0; pb < 4; ++pb) { t0[pb] = (f32x4){0.f, 0.f, 0.f, 0.f}; t1[pb] = (f32x4){0.f, 0.f, 0.f, 0.f}; }
#pragma unroll
            for (int ks = 0; ks < 4; ++ks) { const bf16x8 cf = *(const bf16x8*)(Cn + lpos * PT + (32 * ks + 8 * g) * 2);
#pragma unroll
                for (int pb = 0; pb < 4; ++pb) { const bf16x8 s0 = *(const bf16x8*)(S0 + (16 * pb + cl) * PT + (32 * ks + 8 * g) * 2), s1 = *(const bf16x8*)(S1 + (16 * pb + cl) * PT + (32 * ks + 8 * g) * 2);
                    t0[pb] = __builtin_amdgcn_mfma_f32_16x16x32_bf16(s0, cf, t0[pb], 0, 0, 0); t1[pb] = __builtin_amdgcn_mfma_f32_16x16x32_bf16(s1, cf, t1[pb], 0, 0, 0); } }
            const float dd = dsk[h];
#pragma unroll
            for (int pb = 0; pb < 4; ++pb) { const int ch = h * 64 + 16 * pb + 4 * g;
                const uint2 yf = eyf[pb], yb = eyb[pb], xv = exv[pb], zv = ezv[pb];
                f32x4 y = t0[pb] * sc0 + t1[pb] * sc1;
                y[0] = (y[0] + bflo(yf.x) + bflo(yb.x) + bflo(xv.x) * dd) * silu_f(bflo(zv.x)); y[1] = (y[1] + bfhi(yf.x) + bfhi(yb.x) + bfhi(xv.x) * dd) * silu_f(bfhi(zv.x));
                y[2] = (y[2] + bflo(yf.y) + bflo(yb.y) + bflo(xv.y) * dd) * silu_f(bflo(zv.y)); y[3] = (y[3] + bfhi(yf.y) + bfhi(yb.y) + bfhi(xv.y) * dd) * silu_f(bfhi(zv.y));
                uint2 o; o.x = pack2(y[0], y[1]); o.y = pack2(y[2], y[3]);
                const float r0 = bflo(o.x), r1 = bfhi(o.x), r2 = bflo(o.y), r3 = bfhi(o.y); ss += r0 * r0 + r1 * r1 + r2 * r2 + r3 * r3;
                *(uint2*)(A + row * 1024 + 512 + ch) = o; }
        }
#undef SSDC_SLOAD
#undef SSDC_SRC
#undef SSDC_LDSW
        ss += __shfl_xor(ss, 16); ss += __shfl_xor(ss, 32);
        if (g == 0) ssx[hp * 64 + lpos] = ss;
        __syncthreads();
        const float rn = rsqrtf((ssx[lpos] + ssx[64 + lpos]) * (1.f / 256.f) + EPS);
#pragma unroll 4
        for (int i = 0; i < 8; ++i) { const int ch = grp * 256 + (2 * hp + (i >> 2)) * 64 + 16 * (i & 3) + 4 * g; bf16_t* ap = A + row * 1024 + 512 + ch; const uint2 v = *(const uint2*)ap; const f32x4 gg = *(const f32x4*)(ng + ch);
            uint2 o; o.x = pack2(bflo(v.x) * rn * gg[0], bfhi(v.x) * rn * gg[1]); o.y = pack2(bflo(v.y) * rn * gg[2], bfhi(v.y) * rn * gg[3]); *(uint2*)ap = o; }
    }
    __syncthreads();
}

__device__ __forceinline__ uint4 rope8(const uint4 mine, const uint4 other, const float* ct, const float* st, bool upper, bool apply, float scale) {
    float m[8], o[8], r[8]; const unsigned mw[4] = {mine.x, mine.y, mine.z, mine.w}, ow[4] = {other.x, other.y, other.z, other.w};
#pragma unroll
    for (int j = 0; j < 4; ++j) { m[2 * j] = bflo(mw[j]); m[2 * j + 1] = bfhi(mw[j]); o[2 * j] = bflo(ow[j]); o[2 * j + 1] = bfhi(ow[j]); }
    if (apply) { const float4 c0 = ld4(ct), c1 = ld4(ct + 4), s0 = ld4(st), s1 = ld4(st + 4); const float c[8] = {c0.x, c0.y, c0.z, c0.w, c1.x, c1.y, c1.z, c1.w}, sn[8] = {s0.x, s0.y, s0.z, s0.w, s1.x, s1.y, s1.z, s1.w};
#pragma unroll
        for (int j = 0; j < 8; ++j) r[j] = (upper ? (m[j] * c[j] + o[j] * sn[j]) : (m[j] * c[j] - o[j] * sn[j])) * scale; }
    else {
#pragma unroll
        for (int j = 0; j < 8; ++j) r[j] = m[j] * scale; }
    uint4 q; q.x = pack2(r[0], r[1]); q.y = pack2(r[2], r[3]); q.z = pack2(r[4], r[5]); q.w = pack2(r[6], r[7]); return q;
}
__device__ __forceinline__ uint4 shfl_xor_u4(const uint4 v, int m) { uint4 r; r.x = __shfl_xor(v.x, m); r.y = __shfl_xor(v.y, m); r.z = __shfl_xor(v.z, m); r.w = __shfl_xor(v.w, m); return r; }
__device__ __forceinline__ void ph_attn_prep(const Fr& F) {
    const bf16_t* P = F.w<bf16_t>(L1_PROJ); float* SQ = F.w<float>(WS_SQ); float* SKV = F.w<float>(WS_SKV);
    bf16_t* KM = F.w<bf16_t>(L1_KM); bf16_t* QG = F.w<bf16_t>(L1_QG); bf16_t* KG = F.w<bf16_t>(L1_KG); bf16_t* VGT = F.w<bf16_t>(L1_VGT);
    const float* cm = F.w<float>(WS_ROPEM); const float* sm = cm + 2048 * 16; const float* cg = F.w<float>(WS_ROPEG); const float* sg = cg + 2048 * 32;
    const float gscale = 0.125f * LOG2E;
    for (int row = F.bid * 8 + F.wave; row < TT; row += F.G * 8) {
        const bf16_t* pr = P + (size_t)row * ODD_PAD; const bool lat = row < TL; const int pos = row & (SEQ - 1), l = F.lane;
        const int b = lat ? (row >> 11) : ((row - TL) >> 8), key = lat ? CTXL + pos : ((row - TL) & (CTXL - 1));
        { float s = 0.f; if (l < 48) { float v[8]; ld8bf(pr + l * 8, v);
#pragma unroll
              for (int j = 0; j < 8; ++j) s += v[j] * v[j]; }
          const float sq = wave_sum(l < 32 ? s : 0.f), skv = wave_sum(l >= 32 ? s : 0.f);
          if (l == 0) { SQ[row] = rsqrtf(sq * (1.f / 256.f) + EPS); SKV[row] = rsqrtf(skv * (1.f / 128.f) + EPS); } }
        { const uint4 mine = *(const uint4*)(pr + 416 + l * 8); const uint4 other = shfl_xor_u4(mine, 4); const int sub = l & 7, i0 = (sub & 3) * 8;
          if (lat) *(uint4*)(QG + (size_t)row * 512 + l * 8) = rope8(mine, other, cg + pos * 32 + i0, sg + pos * 32 + i0, sub >= 4, true, gscale); }
        { const int lk = l & 15; const uint4 mine = *(const uint4*)(pr + 928 + lk * 8); const uint4 other = shfl_xor_u4(mine, 4); const int sub = lk & 7, i0 = (sub & 3) * 8;
          const uint4 r = rope8(mine, other, cg + pos * 32 + i0, sg + pos * 32 + i0, sub >= 4, lat, 1.f);
          if (l < 16) *(uint4*)(KG + ((size_t)b * NKEY + key) * 128 + lk * 8) = r; }
        { const int lr = l & 3; const uint4 mine = *(const uint4*)(pr + 384 + lr * 8); const uint4 other = shfl_xor_u4(mine, 2); const int i0 = (lr & 1) * 8;
          const uint4 r = rope8(mine, other, cm + pos * 16 + i0, sm + pos * 16 + i0, lr >= 2, lat, 1.f);
          if (l < 4) { bf16_t* kb = KM + ((size_t)b * NKEY + key) * 768 + 64 + lr * 8;
#pragma unroll
              for (int h = 0; h < 8; ++h) *(uint4*)(kb + h * 96) = r; } }
    }
    bf16_t* vt = (bf16_t*)F.lds;
    for (int un = F.bid; un < TT / 64; un += F.G) {
        const int row0 = un * 64; const int b = row0 < TL ? (row0 >> 11) : ((row0 - TL) >> 8), key0 = row0 < TL ? CTXL + (row0 & (SEQ - 1)) : ((row0 - TL) & (CTXL - 1));
        { const int tok = F.tid >> 3, cq = F.tid & 7; const uint4 a = *(const uint4*)(P + (size_t)(row0 + tok) * ODD_PAD + 1056 + cq * 16), c2 = *(const uint4*)(P + (size_t)(row0 + tok) * ODD_PAD + 1056 + cq * 16 + 8);
          const unsigned wv[8] = {a.x, a.y, a.z, a.w, c2.x, c2.y, c2.z, c2.w};
#pragma unroll
          for (int j = 0; j < 8; ++j) { vt[(cq * 16 + 2 * j) * 66 + tok] = (bf16_t)(wv[j] & 0xFFFFu); vt[(cq * 16 + 2 * j + 1) * 66 + tok] = (bf16_t)(wv[j] >> 16); } }
        __syncthreads();
        { const int ch = F.tid >> 2, part = F.tid & 3; const unsigned* src = (const unsigned*)(vt + ch * 66 + part * 16); uint4 v0, v1; v0.x = src[0]; v0.y = src[1]; v0.z = src[2]; v0.w = src[3]; v1.x = src[4]; v1.y = src[5]; v1.z = src[6]; v1.w = src[7];
          uint4* dst = (uint4*)(VGT + ((size_t)(b * 2 + (ch >> 6)) * 64 + (ch & 63)) * NKEY + key0 + part * 16); dst[0] = v0; dst[1] = v1; }
        __syncthreads();
    }
}

typedef float f32x16 __attribute__((ext_vector_type(16)));
template <bool GQA>
__device__ __forceinline__ void ph_attn_mfma(const Fr& F) {
    constexpr int DQK = GQA ? 64 : 96, NKS = DQK / 16, KP = GQA ? 144 : 208, VP = 136, KCH = DQK / 8, NKCH = 64 * KCH;
    constexpr int KBYTES = 64 * KP, VBYTES = 64 * VP;
    unsigned char* Kb = F.lds; unsigned char* Vb = F.lds + 2 * KBYTES;
    bf16_t* A = F.w<bf16_t>(WS_ABUF);
    const int r = F.lane & 31, hh = F.lane >> 5;
    for (int u = F.bid; u < 512; u += F.G) {
        int b, ntile, lat_lo = 0, qpos, ocol; const bf16_t* qp; const bf16_t* kbase; const bf16_t* vtb; int kstride; float m_run, l_run;
        if (!GQA) { b = u >> 6; const int h = (u >> 3) & 7, qb = u & 7; qpos = qb * 256 + F.wave * 32 + r; ntile = NKEY / 64;
            qp = F.w<bf16_t>(L1_QM) + (size_t)(b * SEQ + qpos) * 768 + h * 96; kbase = F.w<bf16_t>(L1_KM) + (size_t)b * NKEY * 768 + h * 96; kstride = 768;
            vtb = F.w<bf16_t>(L1_VT) + (size_t)(b * 8 + h) * 64 * NKEY; m_run = 0.f; l_run = 0.f; ocol = h * 64; }
        else { b = u >> 6; const int kv = (u >> 5) & 1, qb = (u >> 1) & 15, pr = u & 1; const int head = kv * 4 + pr * 2 + (F.wave >> 2); qpos = qb * 128 + (F.wave & 3) * 32 + r;
            lat_lo = qb * 128 - 128 > 0 ? qb * 128 - 128 : 0; const int lat_hi = qb * 128 + 256 < SEQ ? qb * 128 + 256 : SEQ; ntile = 4 + (lat_hi - lat_lo) / 64;
            qp = F.w<bf16_t>(L1_QG) + (size_t)(b * SEQ + qpos) * 512 + head * 64; kbase = F.w<bf16_t>(L1_KG) + (size_t)b * NKEY * 128 + kv * 64; kstride = 128;
            vtb = F.w<bf16_t>(L1_VGT) + (size_t)(b * 2 + kv) * 64 * NKEY; m_run = F.in[I_SINK][head] * LOG2E; l_run = hh ? 0.f : 1.f; ocol = 512 + head * 64; }
        bf16x8 qf[NKS];
#pragma unroll
        for (int ks = 0; ks < NKS; ++ks) qf[ks] = *(const bf16x8*)(qp + 16 * ks + 8 * hh);
        f32x16 o0, o1;
#pragma unroll
        for (int i = 0; i < 16; ++i) { o0[i] = 0.f; o1[i] = 0.f; }
        const int kr0 = F.tid / KCH, kc0 = F.tid % KCH, kr1 = (F.tid + 512) / KCH, kc1 = (F.tid + 512) % KCH; const bool has2 = (F.tid + 512) < NKCH;
        const int vr = F.tid >> 3, vc = F.tid & 7;
        uint4 kreg0, kreg1 = make_uint4(0u, 0u, 0u, 0u), vreg;
        bf16x8 kf[NKS][2];
#define ATT_KIDX(t) ((!GQA || (t) < 4) ? (t) * 64 : CTXL + lat_lo + ((t) - 4) * 64)
#define ATT_LOAD(t) do { const int _k0 = ATT_KIDX(t); kreg0 = *(const uint4*)(kbase + (size_t)(_k0 + kr0) * kstride + kc0 * 8); \
            if (has2) kreg1 = *(const uint4*)(kbase + (size_t)(_k0 + kr1) * kstride + kc1 * 8); vreg = *(const uint4*)(vtb + (size_t)vr * NKEY + _k0 + vc * 8); } while (0)
#define ATT_WRITE(buf) do { *(uint4*)(Kb + (buf) * KBYTES + kr0 * KP + kc0 * 16) = kreg0; if (has2) *(uint4*)(Kb + (buf) * KBYTES + kr1 * KP + kc1 * 16) = kreg1; \
            *(uint2*)(Vb + (buf) * VBYTES + vr * VP + vc * 16) = make_uint2(vreg.x, vreg.y); *(uint2*)(Vb + (buf) * VBYTES + vr * VP + vc * 16 + 8) = make_uint2(vreg.z, vreg.w); } while (0)
#define ATT_KFRAGS(buf) do { const unsigned char* kb = Kb + (buf) * KBYTES; \
            _Pragma("unroll") for (int ks = 0; ks < NKS; ++ks) { kf[ks][0] = *(const bf16x8*)(kb + r * KP + (16 * ks + 8 * hh) * 2); kf[ks][1] = *(const bf16x8*)(kb + (32 + r) * KP + (16 * ks + 8 * hh) * 2); } } while (0)
        __syncthreads();
        ATT_LOAD(0); ATT_WRITE(0);
        __syncthreads();
        ATT_KFRAGS(0);
        for (int t = 0; t < ntile; ++t) {
            const int buf = t & 1; const bool more = (t + 1) < ntile;
            if (more) ATT_LOAD(t + 1);
            const unsigned char* vb = Vb + buf * VBYTES;
            f32x16 s0, s1;
#pragma unroll
            for (int i = 0; i < 16; ++i) { s0[i] = -m_run; s1[i] = -m_run; }
#pragma unroll
            for (int ks = 0; ks < NKS; ++ks) { s0 = __builtin_amdgcn_mfma_f32_32x32x16_bf16(kf[ks][0], qf[ks], s0, 0, 0, 0); s1 = __builtin_amdgcn_mfma_f32_32x32x16_bf16(kf[ks][1], qf[ks], s1, 0, 0, 0); }
            union { bf16x8 v; uint2 h2[2]; } vf[4][2];
#pragma unroll
            for (int s2 = 0; s2 < 4; ++s2) { vf[s2][0].h2[0] = *(const uint2*)(vb + r * VP + (16 * s2 + 4 * hh) * 2); vf[s2][0].h2[1] = *(const uint2*)(vb + r * VP + (16 * s2 + 8 + 4 * hh) * 2);
                vf[s2][1].h2[0] = *(const uint2*)(vb + (32 + r) * VP + (16 * s2 + 4 * hh) * 2); vf[s2][1].h2[1] = *(const uint2*)(vb + (32 + r) * VP + (16 * s2 + 8 + 4 * hh) * 2); }
            __builtin_amdgcn_sched_barrier(0);
            if (GQA && t >= 4) { const int kp0 = lat_lo + (t - 4) * 64 + 4 * hh - qpos;
#pragma unroll
                for (int i = 0; i < 16; ++i) { const int rel = kp0 + (i & 3) + 8 * (i >> 2); if (rel > 128 || rel < -128) s0[i] = -1.0e30f; if (rel + 32 > 128 || rel + 32 < -128) s1[i] = -1.0e30f; } }
            float tmax = s0[0];
#pragma unroll
            for (int i = 1; i < 16; ++i) tmax = fmaxf(tmax, s0[i]);
#pragma unroll
            for (int i = 0; i < 16; ++i) tmax = fmaxf(tmax, s1[i]);
            tmax = fmaxf(tmax, __shfl_xor(tmax, 32));
            const float dm = fmaxf(tmax, 0.f); const bool grow = __any(tmax > 0.f) != 0; float alpha = 1.f;
            float ls = 0.f;
            if (grow) { alpha = __builtin_amdgcn_exp2f(-dm); m_run += dm;
#pragma unroll
                for (int i = 0; i < 16; ++i) { s0[i] = __builtin_amdgcn_exp2f(s0[i] - dm); s1[i] = __builtin_amdgcn_exp2f(s1[i] - dm); ls += s0[i] + s1[i]; } }
            else {
#pragma unroll
                for (int i = 0; i < 16; ++i) { s0[i] = __builtin_amdgcn_exp2f(s0[i]); s1[i] = __builtin_amdgcn_exp2f(s1[i]); ls += s0[i] + s1[i]; } }
            l_run = l_run * alpha + ls;
            if (grow) {
#pragma unroll
                for (int i = 0; i < 16; ++i) { o0[i] *= alpha; o1[i] *= alpha; } }
#pragma unroll
            for (int s2 = 0; s2 < 4; ++s2) {
                union { bf16x8 v; unsigned w[4]; } pf;
#pragma unroll
                for (int j = 0; j < 4; ++j) { const int ri = 8 * (s2 & 1) + 2 * j; pf.w[j] = (s2 < 2) ? pack2(s0[ri], s0[ri + 1]) : pack2(s1[ri], s1[ri + 1]); }
                o0 = __builtin_amdgcn_mfma_f32_32x32x16_bf16(vf[s2][0].v, pf.v, o0, 0, 0, 0); o1 = __builtin_amdgcn_mfma_f32_32x32x16_bf16(vf[s2][1].v, pf.v, o1, 0, 0, 0);
            }
            if (more) ATT_WRITE(buf ^ 1);
            __syncthreads();
            if (more) ATT_KFRAGS(buf ^ 1);
        }
#undef ATT_KFRAGS
#undef ATT_KIDX
#undef ATT_LOAD
#undef ATT_WRITE
        const float inv = 1.f / (l_run + __shfl_xor(l_run, 32));
        bf16_t* op = A + (size_t)(b * SEQ + qpos) * 1024 + ocol + 4 * hh;
#pragma unroll
        for (int t4 = 0; t4 < 4; ++t4) { uint2 p;
            p.x = pack2(o0[4 * t4] * inv, o0[4 * t4 + 1] * inv); p.y = pack2(o0[4 * t4 + 2] * inv, o0[4 * t4 + 3] * inv); *(uint2*)(op + 8 * t4) = p;
            p.x = pack2(o1[4 * t4] * inv, o1[4 * t4 + 1] * inv); p.y = pack2(o1[4 * t4 + 2] * inv, o1[4 * t4 + 3] * inv); *(uint2*)(op + 32 + 8 * t4) = p; }
    }
    __syncthreads();
}

template <class Epi>
__device__ __forceinline__ void run_gemm(const Fr& F, const bf16_t* A, int lda, const bf16_t* Bt, int ldb, int M, int N, int K, const Epi& E) {
    pg8::Gemm g{A, Bt, M, N, K, lda, ldb, 0}; pg8::StaticOrder S; S.init(M, N, F.G, F.bid);
    pg8::gemm_phase<Epi, pg8::StaticOrder>((LAS unsigned char*)F.lds, g, S, E);
}

__global__ void __launch_bounds__(NTHR, 2) fwd(Args args) {
    extern __shared__ __attribute__((aligned(16))) unsigned char lds[];
    Fr F; F.in = args.in; F.out = args.out; F.ws = args.ws; F.lds = lds; F.tid = threadIdx.x; F.lane = F.tid & 63; F.wave = __builtin_amdgcn_readfirstlane(F.tid >> 6); F.G = gridDim.x; F.bid = blockIdx.x;
    const int lo = args.ph_lo, hi = args.ph_hi;
#ifndef PHMASK
#define PHMASK 0xFFFFFFFFu
#endif
#define IN(k) (((PHMASK >> (k)) & 1u) && lo <= (k) && (k) < hi)
    const float* MOD0 = F.w<float>(WS_MOD); const float* MOD1 = MOD0 + 9 * 6144;
    const bool multi_phase = (hi - lo) > 1;
    if (F.tid == 0) *(uint4*)(lds + LDS_BYTES - 16) = make_uint4(0u, 0u, 0u, 0u);
    __syncthreads();
    XcdBarrier bar; bar.bar = F.w<unsigned>(WS_CTL); bar.x = 0; bar.st = (volatile LAS unsigned*)(LAS unsigned char*)(lds + LDS_BYTES - 16);
    if (multi_phase) bar = xcd_barrier_post(F.w<unsigned>(WS_CTL), (volatile LAS unsigned*)(LAS unsigned char*)(lds + LDS_BYTES - 16));
#define SEAM(k) do { if (IN(k) && IN((k) + 1)) xcd_barrier(bar); } while (0)
    bf16_t* ABUF = F.w<bf16_t>(WS_ABUF);

#ifndef DUPMASK
#define DUPMASK 0u
#endif
#define PHASE(k, ...) if (IN(k)) { __VA_ARGS__ } if (IN(k) && ((DUPMASK >> (k)) & 1u)) { xcd_barrier(bar); __VA_ARGS__ } SEAM(k);
#define PHASED(k, ...) if (IN(k)) { __VA_ARGS__ } if (IN(k) && ((DUPMASK >> (k)) & 1u)) { xcd_barrier(bar); __VA_ARGS__ } \
    if (IN(k) && IN((k) + 1)) { unsigned gen_ = 0u; XB_OVERLAP_ARRIVE(bar, gen_); cvt_dense_window(F, (k) - 1); XB_OVERLAP_WAIT(bar, gen_); }
#define PHASEW(k, ...) if (IN(k)) { __VA_ARGS__ } if (IN(k) && ((DUPMASK >> (k)) & 1u)) { xcd_barrier(bar); __VA_ARGS__ } \
    if (IN(k) && IN((k) + 1)) { unsigned gen_ = 0u; XB_OVERLAP_ARRIVE(bar, gen_); cvt_window(F, (k) - 8); XB_OVERLAP_WAIT(bar, gen_); }
    PHASE(0,
        ph_ada(F);
        cvt_job(F, F.in[I_EVWIN], nullptr, nullptr, F.w<bf16_t>(W_IN0), EVEN_PAD, 1024, 1024, EVEN_IN, EVEN_IN, 0, 1, (F.bid + 64) % F.G, F.G);
        if (!multi_phase) cvt_dense_range(F, 0, CVD_T_ALL);
        ph_filters(F); ph_rope_tables(F);)
    PHASED(1, ph_norm0(F);)
    PHASED(2, run_gemm(F, ABUF, 1024, F.w<bf16_t>(W_IN0), 1024, TT, EVEN_PAD, 1024, pg8::EpiBf16Plain{F.w<bf16_t>(L0_PROJ), EVEN_PAD});)
    PHASED(3, ph_convpass(F);)
    PHASED(4, ph_ssd_a(F); ph_hyena_mfma(F);)
    PHASE(6, ph_ssd_b(F);)
    PHASE(7, ph_ssd_c(F); ph_hyena_post(F);)
    PHASEW(8,
        run_gemm(F, ABUF, 1024, F.w<bf16_t>(W_OUT0), 1024, TL, 1024, 1024, pg8::EpiBf16Plain{F.w<bf16_t>(L0_MBUF), 1024});
        { pg8::Gemm g{ABUF, F.w<bf16_t>(W_OUT0), TT, 1024, 1024, 1024, 1024, 0}; pg8::DenseTailOrder<8> S; S.init(TL / 256, TC / 256, 1024 / 64, F.G, F.bid);
          pg8::gemm_phase<pg8::EpiTailBf16, pg8::DenseTailOrder<8>>((LAS unsigned char*)F.lds, g, S, pg8::EpiTailBf16{F.w<bf16_t>(L0_MBUF), 1024, F.w<bf16_t>(L0_XT), TL / 256, 8}); }
        )
    PHASEW(9, ph_thin<0, true, false>(F, (const float*)F.w<bf16_t>(L0_MBUF), TT, F.in[I_X], F.in[I_CTX], nullptr, nullptr, F.in[I_MIXPOST], MOD0, 2048, F.in[I_FFNPRE], MOD0, 3072, 4096, ABUF, 0, 1, F.w<bf16_t>(L0_XT), 8);)
    PHASEW(10, run_gemm(F, ABUF, 1024, F.w<bf16_t>(W_GU0), 1024, TT, 2 * DFF, 1024, pg8::EpiSwiglu{F.w<bf16_t>(L0_HMID), DFF});)
    PHASEW(11,
        run_gemm(F, F.w<bf16_t>(L0_HMID), DFF, F.w<bf16_t>(W_DN0), DFF, TL, 1024, DFF, pg8::EpiBf16Plain{F.w<bf16_t>(L0_MBUF), 1024});
        { pg8::Gemm g{F.w<bf16_t>(L0_HMID), F.w<bf16_t>(W_DN0), TT, 1024, DFF, DFF, DFF, 0}; pg8::DenseTailOrder<11> S; S.init(TL / 256, TC / 256, DFF / 64, F.G, F.bid);
          pg8::gemm_phase<pg8::EpiTailBf16, pg8::DenseTailOrder<11>>((LAS unsigned char*)F.lds, g, S, pg8::EpiTailBf16{F.w<bf16_t>(L0_MBUF), 1024, F.w<bf16_t>(L0_XT), TL / 256, 11}); }
        )
    PHASEW(12, ph_thin<0, false, false>(F, (const float*)F.w<bf16_t>(L0_MBUF), TT, nullptr, nullptr, nullptr, nullptr, F.in[I_FFNPOST], MOD0, 5120, F.in[I_MIXPRE] + 1024, MOD1, 0, 1024, ABUF, 0, 1, F.w<bf16_t>(L0_XT), 11);)
    PHASEW(13, run_gemm(F, ABUF, 1024, F.w<bf16_t>(W_IN1), 1024, TT, ODD_PAD, 1024, pg8::EpiBf16Plain{F.w<bf16_t>(L1_PROJ), ODD_PAD});)
    PHASEW(14, ph_attn_prep(F);)
    PHASEW(15,
        run_gemm(F, F.w<bf16_t>(L1_PROJ), ODD_PAD, F.w<bf16_t>(W_QUP), 256, TL, 768, 256, pg8::EpiQ{F.w<bf16_t>(L1_QM), F.w<float>(WS_SQ), F.w<float>(WS_ROPEM), F.w<float>(WS_ROPEM) + 2048 * 16, 0.10206207261596575f * LOG2E});
        run_gemm(F, F.w<bf16_t>(L1_PROJ) + 256, ODD_PAD, F.w<bf16_t>(W_KUP), 256, TT, 512, 256, pg8::EpiK{F.w<bf16_t>(L1_KM), F.w<float>(WS_SKV)});
        run_gemm(F, F.w<bf16_t>(W_VUP), 256, F.w<bf16_t>(L1_PROJ) + 256, ODD_PAD, 512, TT, 256, pg8::EpiVT{F.w<bf16_t>(L1_VT), F.w<float>(WS_SKV)});)
    PHASEW(16, ph_attn_mfma<false>(F); ph_attn_mfma<true>(F);)
    PHASEW(17, run_gemm(F, ABUF, 1024, F.w<bf16_t>(W_OUT1), 1024, TL, 1024, 1024, pg8::EpiBf16Plain{F.w<bf16_t>(L1_MBUF), 1024});)
    PHASEW(18, ph_thin<1, false, false>(F, (const float*)F.w<bf16_t>(L1_MBUF), TL, nullptr, nullptr, nullptr, nullptr, F.in[I_MIXPOST] + 1024, MOD1, 2048, F.in[I_FFNPRE] + 1024, MOD1, 3072, 4096, F.w<bf16_t>(L1_A2TMP));)
    PHASE(19,
        ph_moe_gather(F);
        { const int w0 = multi_phase ? CVW_NWIN * CVW_Q * F.G : 0; cvt_moe_range<true>(F, w0 < CVT_T_ALL ? w0 : CVT_T_ALL, CVT_T_ALL, F.bid, F.G); })
    PHASE(20,
        if (MOE_FP8) { pg8::Gemm g{F.w<bf16_t>(WS_AG), F.w<bf16_t>(WM_GU), 0, 2 * DFE, 512, 512, 512, (size_t)2 * DFE * 1024}; pg8::GroupedOrder S; S.init(F.w<unsigned>(WS_CNT), 2 * DFE / 256, F.G, F.bid);
            pg8::gemm_phase<pg8::EpiSwigluF8, pg8::GroupedOrder, true>((LAS unsigned char*)F.lds, g, S, pg8::EpiSwigluF8{F.w<unsigned char>(L1_HMID), DFE}); }
        else { pg8::Gemm g{F.w<bf16_t>(WS_AG), F.w<bf16_t>(WM_GU), 0, 2 * DFE, 1024, 1024, 1024, (size_t)2 * DFE * 1024 * 2}; pg8::GroupedOrder S; S.init(F.w<unsigned>(WS_CNT), 2 * DFE / 256, F.G, F.bid);
            pg8::gemm_phase<pg8::EpiSwiglu, pg8::GroupedOrder>((LAS unsigned char*)F.lds, g, S, pg8::EpiSwiglu{F.w<bf16_t>(L1_HMID), DFE}); })
    PHASE(21,
        constexpr int KE = MOE_FP8 ? DFE / 2 : DFE;
        constexpr float osc = MOE_FP8 ? 1.f / (F8_WSCALE * F8_HSCALE) : 1.f;
        pg8::Gemm g{F.w<bf16_t>(L1_HMID), F.w<bf16_t>(WM_DN), 0, 1024, KE, KE, KE, (size_t)1024 * KE * 2};
        { pg8::GroupedOrder S; S.init(F.w<unsigned>(WS_CNT), 4, F.G, F.bid, KE / 64, true);
          pg8::gemm_phase<pg8::EpiMoeOut, pg8::GroupedOrder, MOE_FP8 != 0>((LAS unsigned char*)F.lds, g, S, pg8::EpiMoeOut{F.w<bf16_t>(WS_MOUT), F.w<uint2>(WS_ROWINFO), osc}); }
        { pg8::TailOrder S; S.init(F.w<unsigned>(WS_CNT), F.G, F.bid, KE / 64);
          pg8::gemm_phase<pg8::EpiXtr, pg8::TailOrder, MOE_FP8 != 0>((LAS unsigned char*)F.lds, g, S, pg8::EpiXtr{F.w<bf16_t>(WS_MOUT), F.w<uint2>(WS_ROWINFO), F.w<bf16_t>(WS_XTR), S.NTF, 7, osc}); })
    PHASE(22,
        pg8::TailOrder S; S.init(F.w<unsigned>(WS_CNT), F.G, F.bid, (MOE_FP8 ? DFE / 2 : DFE) / 64);
        ph_thin<2, false, true>(F, (const float*)F.w<bf16_t>(WS_MOUT), TL, nullptr, nullptr, F.out, nullptr, F.in[I_FFNPOST] + 1024, MOD1, 5120, nullptr, nullptr, 0, 0, nullptr, S.NTF, S.nsub > 0 ? 7 : 1);)
#undef IN
}

extern "C" void kernel_launch(void* const* d_in, const int* in_sizes, int n_in, void* d_out, int out_size, void* d_ws, size_t ws_size, hipStream_t stream) {
    static int grid = 0;
    if (grid == 0) {
        if (n_in != 41 || out_size != TL * DM || ws_size < WS_END) { fprintf(stderr, "kernel_launch: unexpected shapes (n_in %d, out %d, ws %zu < %zu)\n", n_in, out_size, ws_size, (size_t)WS_END); grid = -1; return; }
        int dev = 0, cus = 0;
        if (hipGetDevice(&dev) != hipSuccess || hipDeviceGetAttribute(&cus, hipDeviceAttributeMultiprocessorCount, dev) != hipSuccess) { grid = -1; return; }
        if (hipFuncSetAttribute((const void*)fwd, hipFuncAttributeMaxDynamicSharedMemorySize, LDS_BYTES) != hipSuccess) { fprintf(stderr, "kernel_launch: hipFuncSetAttribute failed\n"); grid = -1; return; }
        int per_cu = 0;
        if (hipOccupancyMaxActiveBlocksPerMultiprocessor(&per_cu, (const void*)fwd, NTHR, LDS_BYTES) != hipSuccess || per_cu < 1) fprintf(stderr, "kernel_launch: occupancy query says %d\n", per_cu);
        (void)hipGetLastError();
        grid = cus;
        if (grid % 4 != 0) { fprintf(stderr, "kernel_launch: the kernel needs a grid size that is a multiple of 4 (got %d CUs)\n", grid); grid = -1; return; }
    }
    if (grid < 0) return;
    (void)hipMemsetAsync((char*)d_ws + WS_CTL, 0, 65536, stream);
    Args a{};
    for (int i = 0; i < 41; ++i) a.in[i] = (const float*)d_in[i];
    a.out = (float*)d_out; a.ws = (unsigned char*)d_ws;
    auto launch = [&](int lo, int hi, int ex) { a.ph_lo = lo; a.ph_hi = hi; a.ex = ex; hipLaunchKernelGGL(fwd, dim3(grid), dim3(NTHR), LDS_BYTES, stream, a); };
#if defined(MULTI)
    for (int p = 0; p <= 22; ++p) launch(p, p + 1, 0);
#else
    launch(0, 23, 0);
#endif
}
```

```cpp
#include <hip/hip_runtime.h>
#include <cstdio>
#include <cstdint>

typedef unsigned short bf16_t;
typedef short bf16x8 __attribute__((ext_vector_type(8)));
typedef float f32x4 __attribute__((ext_vector_type(4)));
#define LAS __attribute__((address_space(3)))

constexpr int NB = 8, SEQ = 2048, DM = 1024, CTXL = 256;
constexpr int TL = NB * SEQ, TC = NB * CTXL, TT = TL + TC, NKEY = SEQ + CTXL;
constexpr int EVEN_IN = 3088, EVEN_PAD = 3328, ODD_PAD = 1280, DFF = 2816, DFE = 3584, NEXP = 8;
constexpr float EPS = 1e-6f;
constexpr float LOG2E = 1.4426950408889634f;
constexpr int NTHR = 512;
constexpr int LDS_BYTES = 147456;

constexpr size_t al256(size_t x) { return (x + 255) & ~(size_t)255; }
constexpr size_t WS_CTL = 0;
constexpr size_t WS_CNT = 16384;
constexpr size_t WS_MOD = 65536;
constexpr size_t WS_ROPEM = WS_MOD + al256((size_t)2 * 9 * 6144 * 4);
constexpr size_t WS_ROPEG = WS_ROPEM + (size_t)2 * 2048 * 16 * 4;
constexpr size_t WS_SQ = WS_ROPEG + (size_t)2 * 2048 * 32 * 4;
constexpr size_t WS_SKV = WS_SQ + al256((size_t)TT * 4);
constexpr size_t WS_TOPW = WS_SKV + al256((size_t)TT * 4);
constexpr size_t WS_LISTE = WS_TOPW + (size_t)TL * 2 * 4;
constexpr int MAXROWS = 34816;
constexpr size_t WS_ROWINFO = WS_LISTE + (size_t)NEXP * TL * 4;
constexpr size_t WS_ROWW = WS_ROWINFO + (size_t)MAXROWS * 4;
constexpr size_t WS_SROW = WS_ROWW + (size_t)MAXROWS * 4;
constexpr size_t WS_W0 = WS_SROW + (size_t)TL * 2 * 4;
constexpr size_t W_IN0 = WS_W0;
constexpr size_t W_OUT0 = W_IN0 + (size_t)EVEN_PAD * 1024 * 2;
constexpr size_t W_GU0 = W_OUT0 + (size_t)1024 * 1024 * 2;
constexpr size_t W_DN0 = W_GU0 + (size_t)2 * DFF * 1024 * 2;
constexpr size_t W_IN1 = W_DN0 + (size_t)1024 * DFF * 2;
constexpr size_t W_QUP = W_IN1 + (size_t)ODD_PAD * 1024 * 2;
constexpr size_t W_KUP = W_QUP + (size_t)768 * 256 * 2;
constexpr size_t W_VUP = W_KUP + (size_t)512 * 256 * 2;
constexpr size_t W_OUT1 = W_VUP + (size_t)512 * 256 * 2;
constexpr size_t WS_ABUF = W_OUT1 + (size_t)1024 * 1024 * 2;
constexpr size_t WS_AG = WS_W0;
constexpr size_t WS_MOUT = WS_W0;
constexpr size_t XG_END0 = WS_ABUF + (size_t)TT * DM * 2, XG_END1 = WS_AG + (size_t)MAXROWS * DM * 2;
constexpr size_t WS_R1 = al256(XG_END0 > XG_END1 ? XG_END0 : XG_END1);
constexpr size_t R1_BYTES = (size_t)MAXROWS * DFE * 2;
constexpr size_t WS_R2 = WS_R1 + R1_BYTES;
constexpr size_t R2_BYTES = (size_t)132 * 1024 * 1024;
constexpr size_t WS_XTR = WS_R2 + R2_BYTES;
constexpr size_t WS_HB = WS_XTR + (size_t)32 * 6 * 65536 * 2;
constexpr size_t WS_END = WS_HB + (size_t)TT * DM * 2;
static_assert(WS_END <= (size_t)536000000, "workspace budget");
constexpr size_t L0_PROJ = WS_R1;
constexpr size_t L0_HMID = WS_R1;
constexpr size_t L0_XBC = L0_PROJ + (size_t)TT * EVEN_PAD * 2;
constexpr size_t L0_U = L0_XBC + (size_t)TT * 1024 * 2;
constexpr size_t L0_X0 = L0_U + (size_t)TT * 512 * 2;
constexpr size_t L0_DT = L0_X0 + (size_t)TT * 512 * 2;
constexpr size_t L0_YF = L0_DT + (size_t)TT * 16 * 4;
constexpr size_t L0_YB = L0_YF + (size_t)TT * 512 * 2;
static_assert(L0_YB + (size_t)TT * 512 * 2 <= WS_R1 + R1_BYTES, "R1 layer 0");
constexpr size_t L0_MBUF = WS_R1 + (size_t)128 * 1024 * 1024;
static_assert(L0_MBUF >= L0_HMID + (size_t)TT * DFF * 2 && L0_MBUF + (size_t)TT * DM * 2 <= WS_R1 + R1_BYTES, "MBUF0 placement");
constexpr size_t L0_XT = WS_R1 + (size_t)176 * 1024 * 1024;
static_assert(L0_XT >= L0_MBUF + (size_t)TT * DM * 2 && L0_XT + (size_t)32 * 10 * 65536 * 2 <= WS_R1 + R1_BYTES, "XT0 placement");
constexpr size_t L0_FL = WS_R2 + (size_t)TT * DM * 2;
constexpr size_t L0_FC = L0_FL + (size_t)512 * 4096 * 2;
constexpr size_t L0_YT = L0_FC + (size_t)512 * 512 * 2;
constexpr size_t L0_ST = L0_YT + (size_t)512 * 8 * NKEY * 2;
constexpr size_t L0_ACS = L0_ST + (size_t)2304 * 8192 * 4;
constexpr size_t L0_ATOT = L0_ACS + (size_t)2304 * 128 * 4;
constexpr size_t L0_STIN = WS_R2;
static_assert(L0_ATOT + (size_t)2304 * 4 <= WS_R2 + R2_BYTES, "R2 layer 0");
constexpr size_t L1_HMID = WS_R1;
constexpr size_t L1_A2TMP = WS_R1;
constexpr size_t L1_PROJ = WS_R1;
constexpr size_t L1_QM = L1_PROJ + (size_t)TT * ODD_PAD * 2;
constexpr size_t L1_KM = L1_QM + (size_t)TL * 768 * 2;
constexpr size_t L1_VT = L1_KM + (size_t)NB * NKEY * 768 * 2;
constexpr size_t L1_QG = L1_VT + (size_t)NB * 512 * NKEY * 2;
constexpr size_t L1_KG = L1_QG + (size_t)TL * 512 * 2;
constexpr size_t L1_VGT = L1_KG + (size_t)NB * NKEY * 128 * 2;
constexpr size_t L1_MBUF = L1_VGT + (size_t)NB * 128 * NKEY * 2;
static_assert(L1_MBUF + (size_t)TL * DM * 4 <= WS_R1 + R1_BYTES, "R1 layer 1");
static_assert(L1_A2TMP + (size_t)TL * DM * 2 <= L1_MBUF, "a2tmp vs mbuf1");
constexpr size_t WM_GU = WS_R2;
constexpr size_t WM_DN = WM_GU + (size_t)NEXP * 2 * DFE * 1024;
static_assert(WM_DN + (size_t)NEXP * 1024 * DFE <= WS_R2 + R2_BYTES, "fp8 expert weights vs R2");

typedef __bf16 bf16v2 __attribute__((ext_vector_type(2)));
typedef float f32v2 __attribute__((ext_vector_type(2)));
__device__ __forceinline__ bf16_t f2bf(float f) { return __builtin_bit_cast(unsigned short, (__bf16)f); }
__device__ __forceinline__ float bf2f(bf16_t b) { return __uint_as_float(((unsigned)b) << 16); }
__device__ __forceinline__ unsigned pack2(float lo, float hi) { f32v2 v = {lo, hi}; return __builtin_bit_cast(unsigned, __builtin_convertvector(v, bf16v2)); }
#ifndef MOE_FP8
#define MOE_FP8 1
#endif
constexpr float F8_WSCALE = 64.f, F8_HSCALE = 8.f;
__device__ __forceinline__ unsigned pack4_fp8(float a, float b, float c, float d) { unsigned r = 0u; r = __builtin_amdgcn_cvt_pk_fp8_f32(a, b, r, false); r = __builtin_amdgcn_cvt_pk_fp8_f32(c, d, r, true); return r; }
__device__ __forceinline__ float bflo(unsigned u) { return __uint_as_float(u << 16); }
__device__ __forceinline__ float bfhi(unsigned u) { return __uint_as_float(u & 0xFFFF0000u); }
__device__ __forceinline__ float wave_sum(float v) {
#pragma unroll
    for (int o = 32; o > 0; o >>= 1) v += __shfl_xor(v, o);
    return v;
}
__device__ __forceinline__ float silu_f(float x) { return x * __builtin_amdgcn_rcpf(1.f + __builtin_amdgcn_exp2f(-x * LOG2E)); }
__device__ __forceinline__ float softplus_f(float x) { return x > 20.f ? x : log1pf(expf(x)); }

namespace pg8 {
constexpr int BM = 256, BK = 64, HALF = 128, HTB = HALF * BK * 2, STAGE_BYTES = 8 * HTB, NXCD = 8, WGM = 8;
__host__ __device__ __forceinline__ int lds_byte(int r, int c) { const int st = (r >> 4) * 2 + (c >> 5), rr = r & 15, cc = c & 31, ob = rr * 64 + cc * 2; return st * 1024 + (ob ^ (((ob >> 9) & 1) << 5)); }
__host__ __device__ __forceinline__ void stage_rc(int b, int& R, int& C) { const int st = b / 1024, sb = b % 1024, swz = sb ^ (((sb >> 9) & 1) << 5); R = (st >> 1) * 16 + swz / 64; C = (st & 1) * 32 + (swz % 64) / 2; }

struct Unit { int pm, pn, e, kt0, nkt, ks; };
struct Gemm { const bf16_t* A; const bf16_t* Bt; int M, N, K, lda, ldb; size_t bstride; };

struct StaticOrder {
    int nM, nN, nwg, G, c;
    __device__ __forceinline__ void init(int M, int N, int G_, int c_) { nM = M / BM; nN = N / BM; nwg = nM * nN; G = G_; c = c_; }
    __device__ __forceinline__ bool next(int i, Unit& u) const {
        const long L = (long)i * G + c; if (L >= nwg) return false;
        int wgid = (int)L; { const int q = nwg / NXCD, r = nwg % NXCD, xcd = wgid % NXCD, off = wgid / NXCD; wgid = (xcd < r ? xcd * (q + 1) : r * (q + 1) + (xcd - r) * q) + off; }
        const int nig = WGM * nN, gid = wgid / nig, fm = gid * WGM, gsz = (nM - fm) < WGM ? (nM - fm) : WGM;
        u.pm = fm + ((wgid % nig) % gsz); u.pn = (wgid % nig) / gsz; u.e = 0; u.kt0 = 0; u.nkt = 0; u.ks = 0; return true;
    }
};


struct GroupedOrder {
    int ts1, ts2, ts3, ts4, ts5, ts6, ts7, NT, nrow, nN, G, c;
    __device__ __forceinline__ static void tail_of(int NT, int nN, int G, int nkt_full, int& NTF, int& S) {
        NTF = NT; S = 1;
        if (nN == 4 && (G % 4) == 0) { const int ntf = ((NT * 4) / G) * (G / 4); const int R = (NT - ntf) * 4; if (R > 0 && ntf > 0 && R * 7 <= G && nkt_full % 14 == 0) { NTF = ntf; S = 7; } }
    }
    __device__ __forceinline__ void init(const unsigned* cnt, int nN_, int G_, int c_, int nkt_full = 0, bool head_only = false) {
        int t[9]; t[0] = 0;
#pragma unroll
        for (int e = 0; e < 8; ++e) t[e + 1] = t[e] + __builtin_amdgcn_readfirstlane((int)((__hip_atomic_load(cnt + e, __ATOMIC_RELAXED, __HIP_MEMORY_SCOPE_AGENT) + 255u) >> 8));
        ts1 = t[1]; ts2 = t[2]; ts3 = t[3]; ts4 = t[4]; ts5 = t[5]; ts6 = t[6]; ts7 = t[7]; NT = t[8]; nN = nN_; G = G_; c = c_; nrow = NT;
        if (head_only) { int ntf, s; tail_of(NT, nN, G, nkt_full, ntf, s); nrow = ntf; }
    }
    __device__ __forceinline__ int expert_of(int j) const { return (j >= ts1) + (j >= ts2) + (j >= ts3) + (j >= ts4) + (j >= ts5) + (j >= ts6) + (j >= ts7); }
    __device__ __forceinline__ bool next(int i, Unit& u) const {
        const int nwg = nrow * nN; const long L = (long)i * G + c; u.kt0 = 0; u.nkt = 0; u.ks = 0; if (L >= nwg) return false;
        int wgid = (int)L; { const int q = nwg / NXCD, r = nwg % NXCD, xcd = wgid % NXCD, off = wgid / NXCD; wgid = (xcd < r ? xcd * (q + 1) : r * (q + 1) + (xcd - r) * q) + off; }
        const int nig = WGM * nN, gid = wgid / nig, fm = gid * WGM, gsz = (nrow - fm) < WGM ? (nrow - fm) : WGM;
        const int j = fm + ((wgid % nig) % gsz); u.pm = j; u.pn = (wgid % nig) / gsz; u.e = expert_of(j); return true;
    }
};
struct TailOrder {
    int ts1, ts2, ts3, ts4, ts5, ts6, ts7, nsub, NTF, nkt, c;
    __device__ __forceinline__ void init(const unsigned* cnt, int G, int c_, int nkt_full) {
        int t[9]; t[0] = 0;
#pragma unroll
        for (int e = 0; e < 8; ++e) t[e + 1] = t[e] + __builtin_amdgcn_readfirstlane((int)((__hip_atomic_load(cnt + e, __ATOMIC_RELAXED, __HIP_MEMORY_SCOPE_AGENT) + 255u) >> 8));
        ts1 = t[1]; ts2 = t[2]; ts3 = t[3]; ts4 = t[4]; ts5 = t[5]; ts6 = t[6]; ts7 = t[7]; int s; GroupedOrder::tail_of(t[8], 4, G, nkt_full, NTF, s);
        nsub = (s == 7) ? (t[8] - NTF) * 28 : 0; nkt = nkt_full / 7; c = c_;
    }
    __device__ __forceinline__ bool next(int i, Unit& u) const {
        if (i > 0 || c >= nsub) return false;
        const int tu = c / 7, ks = c - tu * 7, j = NTF + (tu >> 2); u.pm = j; u.pn = tu & 3; u.e = (j >= ts1) + (j >= ts2) + (j >= ts3) + (j >= ts4) + (j >= ts5) + (j >= ts6) + (j >= ts7);
        u.nkt = nkt; u.kt0 = ks * nkt; u.ks = ks; return true;
    }
};

typedef int i32x4v __attribute__((ext_vector_type(4)));
typedef int i32x8v __attribute__((ext_vector_type(8)));
template <class Epi, class Sched, bool FP8 = false>
__device__ __forceinline__ void gemm_phase(LAS unsigned char* lds, const Gemm g, const Sched& S, const Epi& E) {
    const int tid = threadIdx.x, wid = __builtin_amdgcn_readfirstlane(tid >> 6), lane = tid & 63, wr = wid >> 2, wc = wid & 3, fr = lane & 15, fq = lane >> 4;
    int Kop = g.K; asm volatile("" : "+s"(Kop));
    const int K = Kop, nt = K / BK;
    unsigned voffA[2], voffB[2];
#pragma unroll
    for (int i = 0; i < 2; ++i) { int R, C; stage_rc(tid * 16 + i * 8192, R, C); voffA[i] = (unsigned)(R * g.lda + C) * 2u; voffB[i] = (unsigned)(R * g.ldb + C) * 2u; }
    const size_t kstep = (size_t)(BK * 2);
    const size_t hstepA = (size_t)HALF * g.lda * 2, hstepB = (size_t)HALF * g.ldb * 2;
    const size_t tstepA = 2 * hstepA, tstepB = 2 * hstepB;
    const unsigned ldsw = (unsigned)wid * 1024u;
    const int aoff = lds_byte(wr * 64 + fr, fq * 8), boff = lds_byte(wc * 32 + fr, fq * 8);
#define PG8_SA(b, h) (((b) * 2 + (h)) * HTB)
#define PG8_SB(b, h) ((4 + (b) * 2 + (h)) * HTB)
#define PG8_STAGE(bufoff, gbase, voff) do { _Pragma("unroll") for (int _i = 0; _i < 2; ++_i) \
        __builtin_amdgcn_global_load_lds((const unsigned*)((const char*)(gbase) + (voff)[_i]), (LAS unsigned*)(lds + (bufoff) + ldsw + _i * 8192), 16, 0, 0); } while (0)
#define PG8_LDA(dst, b, h) do { if constexpr (FP8) { _Pragma("unroll") for (int m = 0; m < 4; ++m) dst##8[m] = __builtin_shufflevector(*(const LAS i32x4v*)(lds + PG8_SA(b, h) + aoff + m * 2048), *(const LAS i32x4v*)(lds + PG8_SA(b, h) + aoff + m * 2048 + 1024), 0, 1, 2, 3, 4, 5, 6, 7); } \
        else { _Pragma("unroll") for (int m = 0; m < 4; ++m) _Pragma("unroll") for (int k = 0; k < 2; ++k) dst[m][k] = *(const LAS bf16x8*)(lds + PG8_SA(b, h) + aoff + m * 2048 + k * 1024); } } while (0)
#define PG8_LDB(dst, b, h) do { if constexpr (FP8) { _Pragma("unroll") for (int n = 0; n < 2; ++n) dst##8[n] = __builtin_shufflevector(*(const LAS i32x4v*)(lds + PG8_SB(b, h) + boff + n * 2048), *(const LAS i32x4v*)(lds + PG8_SB(b, h) + boff + n * 2048 + 1024), 0, 1, 2, 3, 4, 5, 6, 7); } \
        else { _Pragma("unroll") for (int n = 0; n < 2; ++n) _Pragma("unroll") for (int k = 0; k < 2; ++k) dst[n][k] = *(const LAS bf16x8*)(lds + PG8_SB(b, h) + boff + n * 2048 + k * 1024); } } while (0)
#define PG8_MMA(ai, bj, At, Bt) do { __builtin_amdgcn_s_setprio(1); \
        if constexpr (FP8) { _Pragma("unroll") for (int m = 0; m < 4; ++m) _Pragma("unroll") for (int n = 0; n < 2; ++n) \
            asm volatile("v_mfma_scale_f32_16x16x128_f8f6f4 %0, %1, %2, %0, %3, %3 op_sel_hi:[0,0,0]" : "+v"(acc[ai][bj][m][n]) : "v"(Bt##8[n]), "v"(At##8[m]), "v"(f8one)); } \
        else { _Pragma("unroll") for (int m = 0; m < 4; ++m) _Pragma("unroll") for (int n = 0; n < 2; ++n) _Pragma("unroll") for (int k = 0; k < 2; ++k) \
            acc[ai][bj][m][n] = __builtin_amdgcn_mfma_f32_16x16x32_bf16(Bt[n][k], At[m][k], acc[ai][bj][m][n], 0, 0, 0); } \
        __builtin_amdgcn_s_setprio(0); } while (0)
#define PG8_WAIT_V(n) asm volatile("s_waitcnt vmcnt(" #n ")" ::: "memory")
#define PG8_WAIT_L(n) asm volatile("s_waitcnt lgkmcnt(" #n ")" ::: "memory")
#define PG8_BAR __builtin_amdgcn_s_barrier()
#define PG8_SCHED __builtin_amdgcn_sched_barrier(0)
    Unit cur, nxt; int ui = 0;
    if (!S.next(0, cur)) return;
    f32x4 acc[2][2][4][2];
#pragma unroll
    for (int a = 0; a < 2; ++a)
#pragma unroll
        for (int b = 0; b < 2; ++b)
#pragma unroll
            for (int m = 0; m < 4; ++m)
#pragma unroll
                for (int n = 0; n < 2; ++n) acc[a][b][m][n] = (f32x4){0.f, 0.f, 0.f, 0.f};
    bf16x8 At[4][2], B0[2][2], B1[2][2];
    i32x8v At8[4], B08[2], B18[2];
    const int f8one = 0x7f7f7f7f;
    const char* cA = (const char*)g.A + (size_t)cur.pm * tstepA + (size_t)cur.kt0 * kstep; const char* cB = (const char*)g.Bt + (size_t)cur.e * g.bstride + (size_t)cur.pn * tstepB + (size_t)cur.kt0 * kstep;
    PG8_STAGE(PG8_SB(0, 0), cB, voffB); PG8_STAGE(PG8_SA(0, 0), cA, voffA); PG8_STAGE(PG8_SB(0, 1), cB + hstepB, voffB); PG8_STAGE(PG8_SA(0, 1), cA + hstepA, voffA);
    if (wr == 1) PG8_BAR;
    PG8_WAIT_V(4); PG8_BAR;
    PG8_STAGE(PG8_SB(1, 0), cB + kstep, voffB); PG8_STAGE(PG8_SA(1, 0), cA + kstep, voffA); PG8_STAGE(PG8_SB(1, 1), cB + hstepB + kstep, voffB);
    PG8_WAIT_V(6); PG8_BAR;
    for (;;) {
        const bool has_next = S.next(ui + 1, nxt);
        const char* nA = has_next ? (const char*)g.A + (size_t)nxt.pm * tstepA + (size_t)nxt.kt0 * kstep : cA; const char* nB = has_next ? (const char*)g.Bt + (size_t)nxt.e * g.bstride + (size_t)nxt.pn * tstepB + (size_t)nxt.kt0 * kstep : cB;
        const int ntc = cur.nkt ? cur.nkt : nt;
        for (int t = 0; t < ntc; t += 2) {
            const bool last = (t == ntc - 2);
            const char* a1 = cA + (size_t)(t + 1) * kstep;
            const char* a2 = last ? nA : cA + (size_t)(t + 2) * kstep; const char* b2 = last ? nB : cB + (size_t)(t + 2) * kstep;
            const char* a3 = a2 + kstep; const char* b3 = b2 + kstep;
            PG8_LDB(B0, 0, 0); PG8_SCHED; PG8_LDA(At, 0, 0); PG8_STAGE(PG8_SA(1, 1), a1 + hstepA, voffA);
            PG8_WAIT_L(8); PG8_BAR; PG8_WAIT_L(0); PG8_MMA(0, 0, At, B0); PG8_BAR; PG8_SCHED;
            PG8_LDB(B1, 0, 1); PG8_STAGE(PG8_SB(0, 0), b2, voffB);
            PG8_BAR; PG8_WAIT_L(0); PG8_MMA(0, 1, At, B1); PG8_BAR;
            PG8_LDA(At, 0, 1); PG8_STAGE(PG8_SA(0, 0), a2, voffA);
            PG8_BAR; PG8_WAIT_L(0); PG8_MMA(1, 0, At, B0); PG8_BAR; PG8_SCHED;
            PG8_STAGE(PG8_SB(0, 1), b2 + hstepB, voffB);
            PG8_WAIT_V(6); PG8_BAR; PG8_MMA(1, 1, At, B1); PG8_BAR;
            PG8_LDB(B0, 1, 0); PG8_SCHED; PG8_LDA(At, 1, 0); PG8_STAGE(PG8_SA(0, 1), a2 + hstepA, voffA);
            PG8_WAIT_L(8); PG8_BAR; PG8_WAIT_L(0); PG8_MMA(0, 0, At, B0); PG8_BAR; PG8_SCHED;
            PG8_LDB(B1, 1, 1); PG8_STAGE(PG8_SB(1, 0), b3, voffB);
            PG8_BAR; PG8_WAIT_L(0); PG8_MMA(0, 1, At, B1); PG8_BAR;
            PG8_LDA(At, 1, 1); PG8_STAGE(PG8_SA(1, 0), a3, voffA);
            PG8_BAR; PG8_WAIT_L(0); PG8_MMA(1, 0, At, B0); PG8_BAR; PG8_SCHED;
            PG8_STAGE(PG8_SB(1, 1), b3 + hstepB, voffB);
            PG8_WAIT_V(6); PG8_BAR; PG8_MMA(1, 1, At, B1); PG8_BAR;
        }
        if constexpr (FP8) asm volatile("s_nop 15\n\ts_nop 15\n\ts_nop 15\n\ts_nop 15" ::: "memory");
        E(acc, cur, wr, wc, fr, fq);
        if (!has_next) break;
#pragma unroll
        for (int a = 0; a < 2; ++a)
#pragma unroll
            for (int b = 0; b < 2; ++b)
#pragma unroll
                for (int m = 0; m < 4; ++m)
#pragma unroll
                    for (int n = 0; n < 2; ++n) acc[a][b][m][n] = (f32x4){0.f, 0.f, 0.f, 0.f};
        cur = nxt; cA = nA; cB = nB; ++ui;
    }
    PG8_WAIT_V(0);
    if (wr == 0) PG8_BAR;
    PG8_BAR;
#undef PG8_SA
#undef PG8_SB
#undef PG8_STAGE
#undef PG8_LDA
#undef PG8_LDB
#undef PG8_MMA
#undef PG8_WAIT_V
#undef PG8_WAIT_L
#undef PG8_BAR
#undef PG8_SCHED
}

__host__ __device__ __forceinline__ int perm256(int rho) { return 64 * ((rho >> 5) & 3) + 16 * ((rho >> 2) & 3) + 8 * (rho >> 7) + 4 * ((rho >> 4) & 1) + (rho & 3); }
#define EPI_ROWS_BEGIN _Pragma("unroll") for (int ai = 0; ai < 2; ++ai) _Pragma("unroll") for (int m = 0; m < 4; ++m) { asm volatile("" ::: "memory"); const int row = u.pm * BM + ai * HALF + wr * 64 + m * 16 + fr;
#define EPI_ROWS_END }
#define EPI_LOOP_BEGIN EPI_ROWS_BEGIN _Pragma("unroll") for (int bj = 0; bj < 2; ++bj) { const int cg = u.pn * BM + bj * HALF + wc * 32;
#define EPI_LOOP_END } }
__device__ __forceinline__ uint4 pack8(const f32x4 a, const f32x4 b) { uint4 p; p.x = pack2(a[0], a[1]); p.y = pack2(a[2], a[3]); p.z = pack2(b[0], b[1]); p.w = pack2(b[2], b[3]); return p; }

struct EpiBf16Plain {
    bf16_t* O; int ldo;
    __device__ __forceinline__ void operator()(const f32x4 (&acc)[2][2][4][2], const Unit& u, int wr, int wc, int fr, int fq) const {
        EPI_ROWS_BEGIN
            uint4* p = (uint4*)(O + (size_t)row * ldo + u.pn * BM + 64 * wc + 16 * fq);
            p[0] = pack8(acc[ai][0][m][0], acc[ai][0][m][1]); p[1] = pack8(acc[ai][1][m][0], acc[ai][1][m][1]);
        EPI_ROWS_END
    }
};
__device__ __forceinline__ f32x4 swiglu4(const f32x4 g, const f32x4 u, const float ke, const float kc) {
    const f32x4 a = g * ke; f32x4 e, r;
#pragma unroll
    for (int i = 0; i < 4; ++i) e[i] = __builtin_amdgcn_exp2f(a[i]);
    const f32x4 d = e * kc + kc;
#pragma unroll
    for (int i = 0; i < 4; ++i) r[i] = __builtin_amdgcn_rcpf(d[i]);
    return (g * r) * u;
}
struct EpiSwiglu {
    bf16_t* O; int ldo;
    __device__ __forceinline__ void operator()(const f32x4 (&acc)[2][2][4][2], const Unit& u, int wr, int wc, int fr, int fq) const {
        EPI_ROWS_BEGIN
            const f32x4 h0 = swiglu4(acc[ai][0][m][0], acc[ai][0][m][1], -LOG2E, 1.f), h1 = swiglu4(acc[ai][1][m][0], acc[ai][1][m][1], -LOG2E, 1.f);
            *(uint4*)(O + (size_t)row * ldo + u.pn * 128 + 32 * wc + 8 * fq) = pack8(h0, h1);
        EPI_ROWS_END
    }
};
struct EpiSwigluF8 {
    unsigned char* O; int ldo;
    __device__ __forceinline__ void operator()(const f32x4 (&acc)[2][2][4][2], const Unit& u, int wr, int wc, int fr, int fq) const {
        constexpr float ke = -LOG2E / F8_WSCALE, kc = F8_WSCALE * F8_WSCALE / F8_HSCALE;
        EPI_ROWS_BEGIN
            f32x4 h0 = swiglu4(acc[ai][0][m][0], acc[ai][0][m][1], ke, kc), h1 = swiglu4(acc[ai][1][m][0], acc[ai][1][m][1], ke, kc);
#pragma unroll
            for (int i = 0; i < 4; ++i) { h0[i] = __builtin_amdgcn_fmed3f(h0[i], -448.f, 448.f); h1[i] = __builtin_amdgcn_fmed3f(h1[i], -448.f, 448.f); }
            uint2 p; p.x = pack4_fp8(h0[0], h0[1], h0[2], h0[3]); p.y = pack4_fp8(h1[0], h1[1], h1[2], h1[3]);
            *(uint2*)(O + (size_t)row * ldo + u.pn * 128 + 32 * wc + 8 * fq) = p;
        EPI_ROWS_END
    }
};
struct EpiMoeOut {
    bf16_t* MOUT; const uint2* RIW; float oscale;
    __device__ __forceinline__ void operator()(const f32x4 (&acc)[2][2][4][2], const Unit& u, int wr, int wc, int fr, int fq) const {
        EPI_ROWS_BEGIN
            const uint2 iw = RIW[row]; const int info = (int)iw.x; const float gw = __uint_as_float(iw.y) * oscale;
            if (info >= 0) { uint4* p = (uint4*)(MOUT + ((size_t)(info & 1) * TL + (size_t)(info >> 1)) * 1024 + u.pn * BM + 64 * wc + 16 * fq);
                p[0] = pack8(acc[ai][0][m][0] * gw, acc[ai][0][m][1] * gw); p[1] = pack8(acc[ai][1][m][0] * gw, acc[ai][1][m][1] * gw); }
        EPI_ROWS_END
    }
};
struct EpiXtr {
    bf16_t* MOUT; const uint2* RIW; bf16_t* XTR; int NTF, S; float oscale;
    __device__ __forceinline__ void operator()(const f32x4 (&acc)[2][2][4][2], const Unit& u, int wr, int wc, int fr, int fq) const {
        const bool k0 = (u.ks == 0); const int stride = k0 ? 1024 : 256;
        bf16_t* base = (k0 ? MOUT + u.pn * BM : XTR + (size_t)(((u.pm - NTF) * 4 + u.pn) * (S - 1) + (u.ks - 1)) * 65536) + 64 * wc + 16 * fq;
        EPI_ROWS_BEGIN
            const uint2 iw = RIW[row]; const int info = (int)iw.x; const float gw = __uint_as_float(iw.y) * oscale;
            const int ridx = k0 ? ((info & 1) * TL + (info >> 1)) : (row & 255);
            if (info >= 0 || !k0) { uint4* p = (uint4*)(base + (size_t)ridx * stride); p[0] = pack8(acc[ai][0][m][0] * gw, acc[ai][0][m][1] * gw); p[1] = pack8(acc[ai][1][m][0] * gw, acc[ai][1][m][1] * gw); }
        EPI_ROWS_END
    }
};
struct EpiTailBf16 {
    bf16_t* O; int ldo; bf16_t* XT; int NTF, S;
    __device__ __forceinline__ void operator()(const f32x4 (&acc)[2][2][4][2], const Unit& u, int wr, int wc, int fr, int fq) const {
        const bool k0 = (u.ks == 0); const int stride = k0 ? ldo : 256;
        bf16_t* base = (k0 ? O + u.pn * BM : XT + (size_t)(((u.pm - NTF) * 4 + u.pn) * (S - 1) + (u.ks - 1)) * 65536) + 64 * wc + 16 * fq;
        EPI_ROWS_BEGIN
            uint4* p = (uint4*)(base + (size_t)(k0 ? row : (row & 255)) * stride);
            p[0] = pack8(acc[ai][0][m][0], acc[ai][0][m][1]); p[1] = pack8(acc[ai][1][m][0], acc[ai][1][m][1]);
        EPI_ROWS_END
    }
};
template <int S> struct DenseTailOrder {
    int NTF, nsub, nkt, G, c;
    __device__ __forceinline__ void init(int NTF_, int NTT, int nkt_full, int G_, int c_) { NTF = NTF_; nsub = NTT * 4 * S; int k = nkt_full / S; asm volatile("" : "+s"(k)); nkt = k; G = G_; c = c_; }
    __device__ __forceinline__ bool next(int i, Unit& u) const {
        const int L = i * G + c; if (L >= nsub) return false;
        const int tu = L / S, ks = L - tu * S; u.pm = NTF + (tu >> 2); u.pn = tu & 3; u.e = 0; u.nkt = nkt; u.kt0 = ks * nkt; u.ks = ks; return true;
    }
};
struct EpiQ {
    bf16_t* QM; const float* SQ; const float* cosT; const float* sinT; float qscale;
    __device__ __forceinline__ void operator()(const f32x4 (&acc)[2][2][4][2], const Unit& u, int wr, int wc, int fr, int fq) const {
        EPI_LOOP_BEGIN
            const float s = SQ[row] * qscale; f32x4 v0 = acc[ai][bj][m][0] * s, v1 = acc[ai][bj][m][1] * s;
            if ((cg % 96) == 64) { const int pos = row & (SEQ - 1); const f32x4 c = *(const f32x4*)(cosT + pos * 16 + 4 * fq), sn = *(const f32x4*)(sinT + pos * 16 + 4 * fq);
                const f32x4 o0 = v0 * c - v1 * sn, o1 = v1 * c + v0 * sn; v0 = o0; v1 = o1; }
            uint2 p; p.x = pack2(v0[0], v0[1]); p.y = pack2(v0[2], v0[3]); *(uint2*)(QM + (size_t)row * 768 + cg + 4 * fq) = p;
            p.x = pack2(v1[0], v1[1]); p.y = pack2(v1[2], v1[3]); *(uint2*)(QM + (size_t)row * 768 + cg + 16 + 4 * fq) = p;
        EPI_LOOP_END
    }
};
struct EpiK {
    bf16_t* KM; const float* SKV;
    __device__ __forceinline__ void operator()(const f32x4 (&acc)[2][2][4][2], const Unit& u, int wr, int wc, int fr, int fq) const {
        EPI_ROWS_BEGIN
            const float s = SKV[row]; const int b = row < TL ? (row >> 11) : ((row - TL) >> 8), key = row < TL ? CTXL + (row & (SEQ - 1)) : ((row - TL) & (CTXL - 1));
            const int c = u.pn * BM + 64 * wc + 16 * fq, h = c >> 6, d = c & 63;
            uint4* p = (uint4*)(KM + ((size_t)b * NKEY + key) * 768 + h * 96 + d);
            p[0] = pack8(acc[ai][0][m][0] * s, acc[ai][0][m][1] * s); p[1] = pack8(acc[ai][1][m][0] * s, acc[ai][1][m][1] * s);
        EPI_ROWS_END
    }
};
struct EpiVT {
    bf16_t* VT; const float* SKV;
    __device__ __forceinline__ void operator()(const f32x4 (&acc)[2][2][4][2], const Unit& u, int wr, int wc, int fr, int fq) const {
        EPI_LOOP_BEGIN
#pragma unroll
            for (int n = 0; n < 2; ++n) { const int tok = cg + 16 * n + 4 * fq; const f32x4 s = *(const f32x4*)(SKV + tok); const f32x4 v = acc[ai][bj][m][n] * s;
                const int b = tok < TL ? (tok >> 11) : ((tok - TL) >> 8), key = tok < TL ? CTXL + (tok & (SEQ - 1)) : ((tok - TL) & (CTXL - 1));
                uint2 p; p.x = pack2(v[0], v[1]); p.y = pack2(v[2], v[3]); *(uint2*)(VT + ((size_t)b * 512 + row) * NKEY + key) = p; }
        EPI_LOOP_END
    }
};
}


#define XB_TMO      128
#define XB_XCNT(j)  (256  + 64 * (j))
#define XB_XSUB(j)  (1280 + 64 * (j))
#define XB_XGEN(j)  (2304 + 64 * (j))
#define XB_TOP      3328
#define XB_TOPGEN   3392
#define XCD_BAR_WORDS 3456
#define XB_SPIN_CAP (1u << 18)
__device__ __forceinline__ unsigned xb_ld(unsigned* p)              { return __hip_atomic_load(p, __ATOMIC_RELAXED, __HIP_MEMORY_SCOPE_AGENT); }
__device__ __forceinline__ unsigned xb_add(unsigned* p, unsigned v) { return __hip_atomic_fetch_add(p, v, __ATOMIC_RELAXED, __HIP_MEMORY_SCOPE_AGENT); }
__device__ __forceinline__ unsigned xb_xcc_id() { return (unsigned)__builtin_amdgcn_s_getreg((3 << 11) | 20) & 0xFu; }
#define XB_SPIN(cond, bar) do { unsigned _sp = 0; while (cond) { __builtin_amdgcn_s_sleep(1); \
    if ((++_sp & 255u) == 0u) { if (xb_ld(&(bar)[XB_TMO])) break; if (_sp > XB_SPIN_CAP) { atomicAdd(&(bar)[XB_TMO], 1u); break; } } } } while (0)
struct XcdBarrier { unsigned* bar; unsigned x; volatile LAS unsigned* st; };
__device__ __forceinline__ XcdBarrier xcd_barrier_post(unsigned* bar, volatile LAS unsigned* st) {
    XcdBarrier b; b.bar = bar; b.x = xb_xcc_id(); b.st = st;
    if (threadIdx.x == 0) (void)xb_add(&bar[XB_XCNT(b.x)], 1u);
    return b;
}
__device__ __forceinline__ void xcd_barrier_complete(unsigned* bar, unsigned x, unsigned& nloc, unsigned& nx) {
    const unsigned G = gridDim.x * gridDim.y * gridDim.z;
    unsigned sum, cnt, mine, sp = 0u;
    for (;;) {
        sum = 0u; cnt = 0u; mine = 0u;
#pragma unroll
        for (unsigned j = 0; j < 16; ++j) { const unsigned c = xb_ld(&bar[XB_XCNT(j)]); sum += c; cnt += (c > 0u) ? 1u : 0u; mine = (j == x) ? c : mine; }
        if (sum == G) break;
        __builtin_amdgcn_s_sleep(1);
        if ((++sp & 255u) == 0u) { if (xb_ld(&bar[XB_TMO])) break; if (sp > XB_SPIN_CAP) { atomicAdd(&bar[XB_TMO], 1u); break; } }
    }
    nloc = mine > 0u ? mine : 1u; nx = cnt > 0u ? cnt : 1u;
}
__device__ __forceinline__ void xcd_barrier(const XcdBarrier& b) {
    asm volatile("s_waitcnt vmcnt(0)" ::: "memory");
    __syncthreads();
    if (threadIdx.x == 0) {
        unsigned* bar = b.bar;
        __builtin_amdgcn_s_waitcnt(0);
        unsigned nloc = b.st[0], nx = b.st[1];
        if (nloc == 0u) { xcd_barrier_complete(bar, b.x, nloc, nx); b.st[0] = nloc; b.st[1] = nx; }
        const unsigned old = xb_add(&bar[XB_XSUB(b.x)], 1u);
        const unsigned gen = old / nloc;
        if (old + 1u == (gen + 1u) * nloc) {
            __builtin_amdgcn_fence(__ATOMIC_RELEASE, "agent");
            asm volatile("s_waitcnt vmcnt(0)" ::: "memory");
            const unsigned og = xb_add(&bar[XB_TOP], 1u);
            const unsigned tg = og / nx;
            if (og + 1u == (tg + 1u) * nx) xb_add(&bar[XB_TOPGEN], 1u);
            else XB_SPIN(xb_ld(&bar[XB_TOPGEN]) == tg, bar);
            __builtin_amdgcn_fence(__ATOMIC_ACQUIRE, "agent");
            xb_add(&bar[XB_XGEN(b.x)], 1u);
            asm volatile("s_waitcnt vmcnt(0)" ::: "memory");
        } else {
            XB_SPIN(xb_ld(&bar[XB_XGEN(b.x)]) == gen, bar);
            __builtin_amdgcn_fence(__ATOMIC_ACQUIRE, "agent");
            asm volatile("s_waitcnt vmcnt(0)" ::: "memory");
        }
    }
    __syncthreads();
}
#define XB_OVERLAP_ARRIVE(b, gen) do { \
    asm volatile("s_waitcnt vmcnt(0)" ::: "memory"); \
    __syncthreads(); \
    if (threadIdx.x == 0) { \
        unsigned* bar_ = (b).bar; \
        __builtin_amdgcn_s_waitcnt(0); \
        unsigned nloc = (b).st[0], nx = (b).st[1]; \
        if (nloc == 0u) { xcd_barrier_complete(bar_, (b).x, nloc, nx); (b).st[0] = nloc; (b).st[1] = nx; } \
        const unsigned old = xb_add(&bar_[XB_XSUB((b).x)], 1u); \
        gen = old / nloc; \
        if (old + 1u == (gen + 1u) * nloc) { \
            __builtin_amdgcn_fence(__ATOMIC_RELEASE, "agent"); \
            asm volatile("s_waitcnt vmcnt(0)" ::: "memory"); \
            const unsigned og = xb_add(&bar_[XB_TOP], 1u); \
            const unsigned tg = og / nx; \
            xb_add(&bar_[XB_XGEN((b).x)], 1u); \
            if (og + 1u == (tg + 1u) * nx) xb_add(&bar_[XB_TOPGEN], 1u); \
        } \
    } } while (0)
#define XB_OVERLAP_WAIT(b, gen) do { \
    if (threadIdx.x == 0) { \
        unsigned* bar_ = (b).bar; \
        XB_SPIN(xb_ld(&bar_[XB_TOPGEN]) == gen, bar_); \
        __builtin_amdgcn_fence(__ATOMIC_ACQUIRE, "agent"); \
        asm volatile("s_waitcnt vmcnt(0)" ::: "memory"); \
    } \
    __syncthreads(); } while (0)

struct Args { const float* in[41]; float* out; unsigned char* ws; int ph_lo, ph_hi, ex, pad; };
enum { I_X = 0, I_C, I_CTX, I_CCTX, I_ADAW, I_ADAB, I_MIXPRE, I_MIXPOST, I_FFNPRE, I_FFNPOST, I_EVWIN, I_HYCW, I_HYCB, I_FW1, I_FB1, I_FW2, I_FB2, I_FW3, I_FREQ, I_HYBIAS,
       I_SCW, I_SCB, I_DTB, I_ALOG, I_SSMD, I_SSMNG, I_EVWOUT, I_FFNG, I_FFNU, I_FFND, I_ODWIN, I_QNG, I_QUP, I_KVNG, I_KVUP, I_SINK, I_ODWOUT, I_ROUTER, I_MOEG, I_MOEU, I_MOED };

struct Fr {
    const float* const* in; float* out; unsigned char* ws; unsigned char* lds; int tid, lane, wave, G, bid;
    template <class T> __device__ __forceinline__ T* w(size_t off) const { return (T*)(ws + off); }
};

__device__ __forceinline__ int colmap(int mode, int perm, int r, int nsrc, int& which) {
    which = 0;
    if (mode == 1) { const int tile = r >> 8, rho = r & 255, bj = rho >> 7, wc = (rho >> 5) & 3, n = (rho >> 4) & 1, fq = (rho >> 2) & 3, i = rho & 3; which = n; return 128 * tile + 32 * wc + 8 * fq + 4 * bj + i; }
    const int c = perm ? ((r & ~255) + pg8::perm256(r & 255)) : r;
    if (mode == 0) return c < nsrc ? c : -1;
    return (c >> 6) * 128 + (c & 63) + (mode == 3 ? 64 : 0);
}
__device__ __forceinline__ void cvt_job(const Fr& F, const float* srcA, const float* srcB, const float* kscale, bf16_t* dst, int nrows, int kdst, int ksrc, int ldsrc, int nsrc, int mode, int perm, int t0, int tstride) {
    float* tile = (float*)F.lds;
    const int nrt = nrows / 256, ntiles = nrt * (kdst / 64);
    const int kk = F.tid >> 6, rq = F.tid & 63;
    float4 v[8];
#define CVT_LOAD(t) do { const int r0 = ((t) % nrt) * 256, k0 = ((t) / nrt) * 64; int which; const int col = colmap(mode, perm, r0 + rq * 4, nsrc, which); const float* src = which ? srcB : srcA; \
        _Pragma("unroll") for (int p = 0; p < 8; ++p) { const int k = k0 + p * 8 + kk; v[p] = make_float4(0.f, 0.f, 0.f, 0.f); \
            if (col >= 0 && k < ksrc) { v[p] = *(const float4*)(src + (size_t)k * ldsrc + col); if (kscale) { const float ks = kscale[k]; v[p].x *= ks; v[p].y *= ks; v[p].z *= ks; v[p].w *= ks; } } } } while (0)
    int t = t0;
    if (t < ntiles) CVT_LOAD(t);
    while (t < ntiles) {
        const int r0 = (t % nrt) * 256, k0 = (t / nrt) * 64;
        __syncthreads();
#pragma unroll
        for (int p = 0; p < 8; ++p) *(float4*)(tile + (p * 8 + kk) * 260 + rq * 4) = v[p];
        const int tn = t + tstride;
        if (tn < ntiles) CVT_LOAD(tn);
        __syncthreads();
        { const int r2 = F.tid >> 1, kq = F.tid & 1; const float* tp = tile + (kq * 32) * 260 + r2; uint4* dp = (uint4*)(dst + (size_t)(r0 + r2) * kdst + k0 + kq * 32);
#pragma unroll
          for (int q = 0; q < 4; ++q) { uint4 o; o.x = pack2(tp[(8 * q + 0) * 260], tp[(8 * q + 1) * 260]); o.y = pack2(tp[(8 * q + 2) * 260], tp[(8 * q + 3) * 260]);
              o.z = pack2(tp[(8 * q + 4) * 260], tp[(8 * q + 5) * 260]); o.w = pack2(tp[(8 * q + 6) * 260], tp[(8 * q + 7) * 260]); dp[q] = o; } }
        t = tn;
    }
#undef CVT_LOAD
    __syncthreads();
}

constexpr int CVT_T_GU = 28 * 16, CVT_T_DN = 4 * 56, CVT_T_E = CVT_T_GU + CVT_T_DN, CVT_T_ALL = NEXP * CVT_T_E;
__device__ __forceinline__ int cvt_wmap(int w) { return w < NEXP * CVT_T_GU ? (w / CVT_T_GU) * CVT_T_E + w % CVT_T_GU : ((w - NEXP * CVT_T_GU) / CVT_T_DN) * CVT_T_E + CVT_T_GU + (w - NEXP * CVT_T_GU) % CVT_T_DN; }
template <bool WMAP> __device__ __forceinline__ void cvt_moe_range(const Fr& F, int g_begin, int g_end, int rank, int stride) {
    float* tile = (float*)F.lds;
    const int kk = F.tid >> 6, rq = F.tid & 63;
    float4 va[8], vb[8];
#define CVM_DECODE(g) const int _g = WMAP ? cvt_wmap(g) : (g); const int _e = _g / CVT_T_E, _r = _g % CVT_T_E; const bool _gu = _r < CVT_T_GU; const int _rr = _gu ? _r : _r - CVT_T_GU; \
        const int _nkt = _gu ? 16 : 56; const int k0 = (_rr % _nkt) * 64, r0 = (_rr / _nkt) * 256;     const int ldsrc = _gu ? DFE : 1024, kdst = _gu ? 1024 : DFE; \
        const float* srcA = _gu ? F.in[I_MOEG] + (size_t)_e * 1024 * DFE : F.in[I_MOED] + (size_t)_e * DFE * 1024; const float* srcB = F.in[I_MOEU] + (size_t)_e * 1024 * DFE; \
        unsigned char* dst = _gu ? F.w<unsigned char>(WM_GU) + (size_t)_e * 2 * DFE * 1024 * (MOE_FP8 ? 1 : 2) : F.w<unsigned char>(WM_DN) + (size_t)_e * 1024 * DFE * (MOE_FP8 ? 1 : 2);
#define CVM_LOAD(g, v) do { CVM_DECODE(g) (void)dst; (void)kdst; int which; const int col = colmap(_gu ? 1 : 0, 1, r0 + rq * 4, _gu ? DFE : 1024, which); const float* src = which ? srcB : srcA; \
        _Pragma("unroll") for (int p = 0; p < 8; ++p) { const int k = k0 + p * 8 + kk; v[p] = *(const float4*)(src + (size_t)k * ldsrc + col); } } while (0)
#define CVM_STEP(g, v) do { __syncthreads(); \
        _Pragma("unroll") for (int p = 0; p < 8; ++p) { float4 _t; _t.x = v[p].x; _t.y = v[p].y; _t.z = v[p].z; _t.w = v[p].w; *(float4*)(tile + (p * 8 + kk) * 260 + rq * 4) = _t; } \
        if ((g) + 2 * stride < g_end) CVM_LOAD((g) + 2 * stride, v); \
        __syncthreads(); \
        { CVM_DECODE(g) (void)srcA; (void)srcB; (void)ldsrc; const int r2 = F.tid >> 1, kq = F.tid & 1; const float* tp = tile + (kq * 32) * 260 + r2; \
          if (MOE_FP8) { uint4* dp = (uint4*)(dst + (size_t)(r0 + r2) * kdst + k0 + kq * 32); \
            _Pragma("unroll") for (int q = 0; q < 2; ++q) { uint4 o; \
              o.x = pack4_fp8(tp[(16 * q + 0) * 260] * F8_WSCALE, tp[(16 * q + 1) * 260] * F8_WSCALE, tp[(16 * q + 2) * 260] * F8_WSCALE, tp[(16 * q + 3) * 260] * F8_WSCALE); \
              o.y = pack4_fp8(tp[(16 * q + 4) * 260] * F8_WSCALE, tp[(16 * q + 5) * 260] * F8_WSCALE, tp[(16 * q + 6) * 260] * F8_WSCALE, tp[(16 * q + 7) * 260] * F8_WSCALE); \
              o.z = pack4_fp8(tp[(16 * q + 8) * 260] * F8_WSCALE, tp[(16 * q + 9) * 260] * F8_WSCALE, tp[(16 * q + 10) * 260] * F8_WSCALE, tp[(16 * q + 11) * 260] * F8_WSCALE); \
              o.w = pack4_fp8(tp[(16 * q + 12) * 260] * F8_WSCALE, tp[(16 * q + 13) * 260] * F8_WSCALE, tp[(16 * q + 14) * 260] * F8_WSCALE, tp[(16 * q + 15) * 260] * F8_WSCALE); dp[q] = o; } } \
          else { uint4* dp = (uint4*)(dst + ((size_t)(r0 + r2) * kdst + k0 + kq * 32) * 2); \
          _Pragma("unroll") for (int q = 0; q < 4; ++q) { uint4 o; o.x = pack2(tp[(8 * q + 0) * 260], tp[(8 * q + 1) * 260]); o.y = pack2(tp[(8 * q + 2) * 260], tp[(8 * q + 3) * 260]); \
              o.z = pack2(tp[(8 * q + 4) * 260], tp[(8 * q + 5) * 260]); o.w = pack2(tp[(8 * q + 6) * 260], tp[(8 * q + 7) * 260]); dp[q] = o; } } } } while (0)
    int g = g_begin + rank;
    if (g < g_end) CVM_LOAD(g, va);
    if (g + stride < g_end) CVM_LOAD(g + stride, vb);
    while (g < g_end) {
        CVM_STEP(g, va);
        g += stride; if (g >= g_end) break;
        CVM_STEP(g, vb);
        g += stride;
    }
#undef CVM_STEP
#undef CVM_LOAD
#undef CVM_DECODE
    __syncthreads();
}
constexpr int CVW_Q = 2, CVW_NWIN = 11;
__device__ __forceinline__ void cvt_window(const Fr& F, int win) {
    const int w0 = win * CVW_Q * F.G, w1 = w0 + CVW_Q * F.G;
    cvt_moe_range<true>(F, w0 < CVT_T_ALL ? w0 : CVT_T_ALL, w1 < CVT_T_ALL ? w1 : CVT_T_ALL, F.bid, F.G);
}

constexpr int CVD_T_ALL = 64 + 512 + 256 + 80 + 12 + 8 + 8 + 64, CVD_NWIN = 4;
__device__ __forceinline__ void cvt_dense_tile(const Fr& F, int d) {
    if (d < 64) { cvt_job(F, F.in[I_EVWOUT], nullptr, nullptr, F.w<bf16_t>(W_OUT0), 1024, 1024, 1024, 1024, 1024, 0, 1, d, 1 << 20); return; } d -= 64;
    if (d < 512) { cvt_job(F, F.in[I_FFNG], F.in[I_FFNU], nullptr, F.w<bf16_t>(W_GU0), 2 * DFF, 1024, 1024, DFF, DFF, 1, 1, d, 1 << 20); return; } d -= 512;
    if (d < 256) { cvt_job(F, F.in[I_FFND], nullptr, nullptr, F.w<bf16_t>(W_DN0), 1024, DFF, DFF, 1024, 1024, 0, 1, d, 1 << 20); return; } d -= 256;
    if (d < 80) { cvt_job(F, F.in[I_ODWIN], nullptr, nullptr, F.w<bf16_t>(W_IN1), ODD_PAD, 1024, 1024, 1184, 1184, 0, 1, d, 1 << 20); return; } d -= 80;
    if (d < 12) { cvt_job(F, F.in[I_QUP], nullptr, F.in[I_QNG], F.w<bf16_t>(W_QUP), 768, 256, 256, 768, 768, 0, 0, d, 1 << 20); return; } d -= 12;
    if (d < 8) { cvt_job(F, F.in[I_KVUP], nullptr, F.in[I_KVNG], F.w<bf16_t>(W_KUP), 512, 256, 128, 1024, 1024, 2, 1, d, 1 << 20); return; } d -= 8;
    if (d < 8) { cvt_job(F, F.in[I_KVUP], nullptr, F.in[I_KVNG], F.w<bf16_t>(W_VUP), 512, 256, 128, 1024, 1024, 3, 0, d, 1 << 20); return; } d -= 8;
    if (d < 64) cvt_job(F, F.in[I_ODWOUT], nullptr, nullptr, F.w<bf16_t>(W_OUT1), 1024, 1024, 1024, 1024, 1024, 0, 1, d, 1 << 20);
}
__device__ __forceinline__ void cvt_dense_range(const Fr& F, int d0, int d1) { for (int d = d0 + F.bid; d < d1; d += F.G) cvt_dense_tile(F, d); }
__device__ __forceinline__ void cvt_dense_window(const Fr& F, int win) {
    const int q = (CVD_T_ALL + CVD_NWIN * F.G - 1) / (CVD_NWIN * F.G), d0 = win * q * F.G, d1 = d0 + q * F.G;
    cvt_dense_range(F, d0 < CVD_T_ALL ? d0 : CVD_T_ALL, d1 < CVD_T_ALL ? d1 : CVD_T_ALL);
}

__device__ __forceinline__ void ph_ada(const Fr& F) {
    float* sc = (float*)F.lds;
    float* part = sc + 9 * 1024;
    for (int i = F.tid; i < 9 * 1024; i += NTHR) { const int r = i >> 10, k = i & 1023; const float v = r < 8 ? F.in[I_C][r * 1024 + k] : F.in[I_CCTX][k]; sc[i] = silu_f(v); }
    __syncthreads();
    float* MOD = F.w<float>(WS_MOD);
    for (int un = F.bid; un < 2 * 6144 / 64; un += F.G) {
        const int j = un * 64 + F.lane, l = j / 6144, jj = j % 6144; const float* wp = F.in[I_ADAW] + (size_t)l * 1024 * 6144 + (size_t)(F.wave * 128) * 6144 + jj;
        float acc[9];
#pragma unroll
        for (int r = 0; r < 9; ++r) acc[r] = 0.f;
#pragma unroll 16
        for (int k = 0; k < 128; ++k) { const float wv = wp[(size_t)k * 6144];
#pragma unroll
            for (int r = 0; r < 9; ++r) acc[r] += sc[r * 1024 + F.wave * 128 + k] * wv; }
#pragma unroll
        for (int r = 0; r < 9; ++r) part[(F.wave * 9 + r) * 64 + F.lane] = acc[r];
        __syncthreads();
        for (int o = F.tid; o < 9 * 64; o += NTHR) { const int r = o >> 6, cix = o & 63; float sum = 0.f;
#pragma unroll
            for (int w2 = 0; w2 < 8; ++w2) sum += part[(w2 * 9 + r) * 64 + cix];
            const int j2 = un * 64 + cix, l2 = j2 / 6144, jj2 = j2 % 6144; MOD[(size_t)(l2 * 9 + r) * 6144 + jj2] = sum + F.in[I_ADAB][l2 * 6144 + jj2]; }
        __syncthreads();
    }
}
__device__ __forceinline__ void ph_filters(const Fr& F) {
    constexpr int NPB = 12;
    float* w1s = (float*)F.lds;
    float* w2s = w1s + 33 * 64;
    float* zs = w2s + 64 * 64;
    float* h1 = zs + NPB * 36;
    float* h2 = h1 + NPB * 64;
    const float* w3 = F.in[I_FW3]; const float* fqv = F.in[I_FREQ]; const float* hb = F.in[I_HYBIAS];
    for (int i = F.tid; i < 33 * 64; i += NTHR) w1s[i] = F.in[I_FW1][i];
    for (int i = F.tid; i < 64 * 64; i += NTHR) w2s[i] = F.in[I_FW2][i];
    const int total = SEQ + CTXL; int np = 0; for (int it = F.bid; it < total && np < NPB; it += F.G) ++np;
    for (int i = F.tid; i < np * 33; i += NTHR) { const int pi = i / 33, zi = i % 33, item = F.bid + pi * F.G; const int n = item < SEQ ? SEQ : CTXL, pos = item < SEQ ? item : item - SEQ;
        const float fpos = (float)pos, t = fpos / (float)(n - 1), omega = (6.283185307179586f * fpos) / (float)n; float v;
        if (zi == 0) v = t; else { const int bi = (zi - 1) & 15; const float band = 1e-4f + (float)bi * ((15.f - 1e-4f) / 15.f); const float a = omega * band; v = (zi <= 16) ? cosf(a) : -sinf(a); }
        zs[pi * 36 + zi] = v; }
    __syncthreads();
    for (int i = F.tid; i < np * 64; i += NTHR) { const int pi = i >> 6, j = i & 63; float a = F.in[I_FB1][j]; for (int k = 0; k < 33; ++k) a += zs[pi * 36 + k] * w1s[k * 64 + j]; h1[i] = sinf(fqv[j] * a); }
    __syncthreads();
    for (int i = F.tid; i < np * 64; i += NTHR) { const int pi = i >> 6, j = i & 63; float a = F.in[I_FB2][j]; for (int k = 0; k < 64; ++k) a += h1[pi * 64 + k] * w2s[k * 64 + j]; h2[i] = sinf(fqv[j] * a); }
    __syncthreads();
#pragma unroll 1
    for (int oo = 0; oo < 2; ++oo) { const int o = F.tid + 512 * oo; float acc[NPB];
#pragma unroll
        for (int pi = 0; pi < NPB; ++pi) acc[pi] = 0.f;
        for (int k = 0; k < 64; ++k) { const float wv = w3[k * 1024 + o];
#pragma unroll
            for (int pi = 0; pi < NPB; ++pi) acc[pi] += h2[pi * 64 + k] * wv; }
        const int dir = o >> 9, c = o & 511; const float a0 = -3.0701134573253945f, b0 = -15.350567286626973f; const float delta = fabsf(a0 + (float)c * ((b0 - a0) / 511.f));
#pragma unroll
        for (int pi = 0; pi < NPB; ++pi) if (pi < np) { const int item = F.bid + pi * F.G; const int n = item < SEQ ? SEQ : CTXL, pos = item < SEQ ? item : item - SEQ; const float t = (float)pos / (float)(n - 1);
            bf16_t* Rd = (n == SEQ) ? F.w<bf16_t>(L0_FL) : F.w<bf16_t>(L0_FC); const int n2 = 2 * n; const float val = acc[pi] * expf(-t * delta);
            if (dir == 0) Rd[(size_t)c * n2 + (n - pos)] = f2bf(val + (pos == 0 ? hb[c] : 0.f)); else if (pos > 0) Rd[(size_t)c * n2 + (n + pos)] = f2bf(val); }
    }
    __syncthreads();
}
__device__ __forceinline__ void ph_rope_tables(const Fr& F) {
    float* cm = F.w<float>(WS_ROPEM); float* sm = cm + 2048 * 16; float* cgq = F.w<float>(WS_ROPEG); float* sg = cgq + 2048 * 32;
    for (int idx = F.bid * NTHR + F.tid; idx < 2048 * 16; idx += F.G * NTHR) { const int pos = idx >> 4, i = idx & 15; const float inv = powf(10000.f, -(float)(i & 7) / 8.f);
        const float p = (i < 8) ? (float)(pos >> 6) : (float)(pos & 63); const float ang = p * inv; cm[idx] = cosf(ang); sm[idx] = sinf(ang); }
    for (int idx = F.bid * NTHR + F.tid; idx < 2048 * 32; idx += F.G * NTHR) { const int pos = idx >> 5, i = idx & 31; const float inv = powf(10000.f, -(float)(i & 15) / 16.f);
        const float p = (i < 16) ? (float)(pos >> 6) : (float)(pos & 63); const float ang = p * inv; cgq[idx] = cosf(ang); sg[idx] = sinf(ang); }
}

__device__ __forceinline__ void store_bf16x4(bf16_t* p, float4 v) { uint2 q; q.x = pack2(v.x, v.y); q.y = pack2(v.z, v.w); *(uint2*)p = q; }
__device__ __forceinline__ float4 ld4(const float* p) { return *(const float4*)p; }
__device__ __forceinline__ float sumsq4(const float4 (&v)[4]) { float s = 0.f;
#pragma unroll
    for (int i = 0; i < 4; ++i) s += v[i].x * v[i].x + v[i].y * v[i].y + v[i].z * v[i].z + v[i].w * v[i].w;
    return s; }

struct RowSched { int b, k0, WPB, NW, gw, nlat, ntot;
    __device__ __forceinline__ void init(int G, int bid, int wave, int nrows) { NW = G * 8; gw = bid * 8 + wave; WPB = NW / 8; b = gw / WPB; k0 = gw % WPB;
        nlat = (SEQ - k0 + WPB - 1) / WPB; const int nctx = (nrows > TL && gw < TC) ? (TC - gw + NW - 1) / NW : 0; ntot = nlat + nctx; }
    __device__ __forceinline__ int row_at(int s) const { return s < nlat ? b * SEQ + k0 + WPB * s : TL + gw + NW * (s - nlat); }
};
__device__ __forceinline__ void ph_norm0(const Fr& F) {
    const float* g = F.in[I_MIXPRE]; const float* MOD = F.w<float>(WS_MOD); bf16_t* A = F.w<bf16_t>(WS_ABUF);
    RowSched RS; RS.init(F.G, F.bid, F.wave, TT);
    float4 gv[4], shv[4], scv[4]; int mr_cur = -1;
#pragma unroll
    for (int i = 0; i < 4; ++i) gv[i] = ld4(g + 4 * (F.lane + 64 * i));
    for (int si = 0; si < RS.ntot; si += 2) {
        const int row0 = RS.row_at(si); const bool has1 = si + 1 < RS.ntot; const int row1 = has1 ? RS.row_at(si + 1) : row0; const int r1 = row1;
        const float* s0 = row0 < TL ? F.in[I_X] + (size_t)row0 * 1024 : F.in[I_CTX] + (size_t)(row0 - TL) * 1024; const float* s1 = r1 < TL ? F.in[I_X] + (size_t)r1 * 1024 : F.in[I_CTX] + (size_t)(r1 - TL) * 1024;
        float4 v0[4], v1[4];
#pragma unroll
        for (int i = 0; i < 4; ++i) { v0[i] = ld4(s0 + 4 * (F.lane + 64 * i)); v1[i] = ld4(s1 + 4 * (F.lane + 64 * i)); }
        const float q0 = rsqrtf(wave_sum(sumsq4(v0)) * (1.f / 1024.f) + EPS), q1 = rsqrtf(wave_sum(sumsq4(v1)) * (1.f / 1024.f) + EPS);
#pragma unroll
        for (int rr = 0; rr < 2; ++rr) { if (rr && !has1) break; const int row = rr ? row1 : row0; const int mr = row < TL ? (row >> 11) : 8; const float r = rr ? q1 : q0;
            if (mr != mr_cur) { mr_cur = mr;
#pragma unroll
                for (int i = 0; i < 4; ++i) { const int c = 4 * (F.lane + 64 * i); shv[i] = ld4(MOD + (size_t)mr * 6144 + c); scv[i] = ld4(MOD + (size_t)mr * 6144 + 1024 + c); } }
#pragma unroll
            for (int i = 0; i < 4; ++i) { const int c = 4 * (F.lane + 64 * i); const float4 gg = gv[i], sh = shv[i], sc = scv[i]; const float4 v = rr ? v1[i] : v0[i];
                float4 o; o.x = v.x * r * gg.x * (1.f + sc.x) + sh.x; o.y = v.y * r * gg.y * (1.f + sc.y) + sh.y; o.z = v.z * r * gg.z * (1.f + sc.z) + sh.z; o.w = v.w * r * gg.w * (1.f + sc.w) + sh.w;
                store_bf16x4(A + (size_t)row * 1024 + c, o); } }
    }
}
template <int MODE, bool SRCF32, bool DSTF32>
__device__ __forceinline__ void ph_thin(const Fr& F, const float* msrc, int nrows, const float* hs_lat, const float* hs_ctx, float* hd_lat, float* hd_ctx,
                        const float* postg, const float* MODg, int gate_off, const float* preg, const float* MODn, int sh_off, int sc_off, bf16_t* adst, int xNTF = 0, int xS = 1, const bf16_t* xt2 = nullptr, int xS2 = 1) {
    float* rt = (float*)F.lds;
    int* cntL = (int*)(F.lds + 32768);
    int* blkBase = cntL + 8;
    int* selInfo = cntL + 16;
    if (MODE == 1) { for (int i = F.tid; i < 1024 * 8; i += NTHR) rt[(i & 7) * 1024 + (i >> 3)] = F.in[I_ROUTER][i]; if (F.tid < 8) cntL[F.tid] = 0; __syncthreads(); }
    int li = F.wave;
#define THIN_LOAD(row, m, h) do { \
        const float* hs = SRCF32 ? ((row) < TL ? hs_lat + (size_t)(row) * 1024 : hs_ctx + (size_t)((row) - TL) * 1024) : nullptr; const bf16_t* hbs = F.w<bf16_t>(WS_HB) + (size_t)(row) * 1024; \
        int tail0 = -1, tail1 = -1; \
        if (MODE == 2 && xS > 1) { const int2 sr = *(const int2*)(F.w<int>(WS_SROW) + (size_t)(row) * 2); const int r0 = __builtin_amdgcn_readfirstlane(sr.x), r1 = __builtin_amdgcn_readfirstlane(sr.y); \
            if ((r0 >> 8) >= xNTF) tail0 = r0 - xNTF * 256; if ((r1 >> 8) >= xNTF) tail1 = r1 - xNTF * 256; } \
        _Pragma("unroll") for (int i = 0; i < 4; ++i) { const int c = 4 * (F.lane + 64 * i); \
            if (SRCF32) h[i] = ld4(hs + c); else { const uint2 hv = *(const uint2*)(hbs + c); h[i].x = bflo(hv.x); h[i].y = bfhi(hv.x); h[i].z = bflo(hv.y); h[i].w = bfhi(hv.y); } \
            if (MODE == 2) { const bf16_t* mo = (const bf16_t*)msrc; const uint2 a = *(const uint2*)(mo + (size_t)(row) * 1024 + c), b = *(const uint2*)(mo + ((size_t)TL + (row)) * 1024 + c); \
                m[i].x = bflo(a.x) + bflo(b.x); m[i].y = bfhi(a.x) + bfhi(b.x); m[i].z = bflo(a.y) + bflo(b.y); m[i].w = bfhi(a.y) + bfhi(b.y); \
                if (tail0 >= 0) { const bf16_t* xp = F.w<bf16_t>(WS_XTR) + ((size_t)((tail0 >> 8) * 4 + i) * (xS - 1) * 256 + (tail0 & 255)) * 256 + (c & 255); \
                    for (int s2 = 0; s2 < xS - 1; ++s2) { const uint2 e = *(const uint2*)(xp + (size_t)s2 * 65536); m[i].x += bflo(e.x); m[i].y += bfhi(e.x); m[i].z += bflo(e.y); m[i].w += bfhi(e.y); } } \
                if (tail1 >= 0) { const bf16_t* xp = F.w<bf16_t>(WS_XTR) + ((size_t)((tail1 >> 8) * 4 + i) * (xS - 1) * 256 + (tail1 & 255)) * 256 + (c & 255); \
                    for (int s2 = 0; s2 < xS - 1; ++s2) { const uint2 e = *(const uint2*)(xp + (size_t)s2 * 65536); m[i].x += bflo(e.x); m[i].y += bfhi(e.x); m[i].z += bflo(e.y); m[i].w += bfhi(e.y); } } } \
            else { const uint2 a = *(const uint2*)((const bf16_t*)msrc + (size_t)(row) * 1024 + c); m[i].x = bflo(a.x); m[i].y = bfhi(a.x); m[i].z = bflo(a.y); m[i].w = bfhi(a.y); \
                if (MODE == 0 && xS2 > 1 && (row) >= TL) { \
                    const bf16_t* xp = xt2 + ((size_t)(((((row) - TL) >> 8) * 4 + i) * (xS2 - 1)) * 256 + ((row) & 255)) * 256 + (c & 255); \
                    for (int s2 = 0; s2 < xS2 - 1; ++s2) { const uint2 e = *(const uint2*)(xp + (size_t)s2 * 65536); m[i].x += bflo(e.x); m[i].y += bfhi(e.x); m[i].z += bflo(e.y); m[i].w += bfhi(e.y); } } } } } while (0)
    RowSched RS; RS.init(F.G, F.bid, F.wave, nrows); const int RPW = 16;
    li = F.wave * RPW;
    float4 m[4], h[4], mN[4], hN[4], pgv[4], ggv[4], gtv[4], shv[4], scv[4]; int mr_cur = -1;
#pragma unroll
    for (int i = 0; i < 4; ++i) { const int c = 4 * (F.lane + 64 * i); pgv[i] = ld4(postg + c); if (MODE != 2) ggv[i] = ld4(preg + c); }
    if (RS.ntot > 0) { const int rw = RS.row_at(0); THIN_LOAD(rw, m, h); }
    for (int si = 0; si < RS.ntot; ++si, ++li) {
        const int row = RS.row_at(si);
        if (si + 1 < RS.ntot) { const int rown = RS.row_at(si + 1); THIN_LOAD(rown, mN, hN); }
        const int mr = row < TL ? (row >> 11) : 8;
        if (mr != mr_cur) { mr_cur = mr;
#pragma unroll
            for (int i = 0; i < 4; ++i) { const int c = 4 * (F.lane + 64 * i); gtv[i] = ld4(MODg + (size_t)mr * 6144 + gate_off + c);
                if (MODE != 2) { shv[i] = ld4(MODn + (size_t)mr * 6144 + sh_off + c); scv[i] = ld4(MODn + (size_t)mr * 6144 + sc_off + c); } } }
        float* hd = DSTF32 ? hd_lat + (size_t)row * 1024 : nullptr;
        bf16_t* hb = F.w<bf16_t>(WS_HB) + (size_t)row * 1024;
        const float r = rsqrtf(wave_sum(sumsq4(m)) * (1.f / 1024.f) + EPS);
#pragma unroll
        for (int i = 0; i < 4; ++i) { const int c = 4 * (F.lane + 64 * i); const float4 pg = pgv[i], gt = gtv[i];
            h[i].x += gt.x * (m[i].x * r * pg.x); h[i].y += gt.y * (m[i].y * r * pg.y); h[i].z += gt.z * (m[i].z * r * pg.z); h[i].w += gt.w * (m[i].w * r * pg.w);
            if (DSTF32) *(float4*)(hd + c) = h[i]; else store_bf16x4(hb + c, h[i]); }
        if (MODE != 2) {
        const float r2 = rsqrtf(wave_sum(sumsq4(h)) * (1.f / 1024.f) + EPS);
        float lg[8];
#pragma unroll
        for (int e = 0; e < 8; ++e) lg[e] = 0.f;
#pragma unroll
        for (int i = 0; i < 4; ++i) { const int c = 4 * (F.lane + 64 * i); const float4 gg = ggv[i], sh = shv[i], sc = scv[i];
            float4 o; o.x = h[i].x * r2 * gg.x * (1.f + sc.x) + sh.x; o.y = h[i].y * r2 * gg.y * (1.f + sc.y) + sh.y; o.z = h[i].z * r2 * gg.z * (1.f + sc.z) + sh.z; o.w = h[i].w * r2 * gg.w * (1.f + sc.w) + sh.w;
            if (MODE == 1) *(unsigned*)((unsigned char*)adst + (size_t)row * 1024 + c) = pack4_fp8(o.x, o.y, o.z, o.w);
            else store_bf16x4(adst + (size_t)row * 1024 + c, o);
            if (MODE == 1) {
#pragma unroll
                for (int e = 0; e < 8; ++e) { const float4 rv = *(const float4*)(rt + e * 1024 + c); lg[e] += o.x * rv.x + o.y * rv.y + o.z * rv.z + o.w * rv.w; } } }
        if (MODE == 1) {
#pragma unroll
            for (int e = 0; e < 8; ++e) lg[e] = wave_sum(lg[e]);
            int i1 = 0; float v1 = lg[0];
#pragma unroll
            for (int e = 1; e < 8; ++e) if (lg[e] > v1) { v1 = lg[e]; i1 = e; }
            int i2 = -1; float v2 = -3.0e38f;
#pragma unroll
            for (int e = 0; e < 8; ++e) if (e != i1 && lg[e] > v2) { v2 = lg[e]; i2 = e; }
            const float w1 = 1.f / (1.f + expf(v2 - v1)), w2 = 1.f - w1;
            if (F.lane == 0) { float* tw = F.w<float>(WS_TOPW) + (size_t)row * 2; tw[0] = w1; tw[1] = w2;
                const int r1 = atomicAdd(&cntL[i1], 1), r2i = atomicAdd(&cntL[i2], 1);
                selInfo[li * 2 + 0] = i1 | (r1 << 8); selInfo[li * 2 + 1] = i2 | (r2i << 8); }
        }
        }
#pragma unroll
        for (int i = 0; i < 4; ++i) { m[i] = mN[i]; h[i] = hN[i]; }
    }
#undef THIN_LOAD
    if (MODE == 1) {
        __syncthreads();
        if (F.tid < 8) blkBase[F.tid] = (int)__hip_atomic_fetch_add(F.w<unsigned>(WS_CNT) + F.tid, (unsigned)cntL[F.tid], __ATOMIC_RELAXED, __HIP_MEMORY_SCOPE_AGENT);
        __syncthreads();
        int* LISTE = F.w<int>(WS_LISTE);
        for (int idx = F.tid; idx < 16 * RPW; idx += NTHR) { const int l2 = idx >> 1, k = idx & 1; RowSched R2; R2.init(F.G, F.bid, l2 / RPW, nrows); const int it2 = l2 % RPW; const int row = it2 < R2.ntot ? R2.row_at(it2) : nrows;
            if (row < nrows) { const int si = selInfo[idx], e = si & 255, rk = si >> 8; LISTE[(size_t)e * TL + blkBase[e] + rk] = row * 2 + k; } }
        __syncthreads();
    }
}
__device__ __forceinline__ void ph_moe_gather(const Fr& F) {
    const unsigned* cnt = F.w<unsigned>(WS_CNT); int ts[9]; ts[0] = 0;
#pragma unroll
    for (int e = 0; e < 8; ++e) ts[e + 1] = ts[e] + (int)((__hip_atomic_load(cnt + e, __ATOMIC_RELAXED, __HIP_MEMORY_SCOPE_AGENT) + 255u) >> 8);
    const int nrows = ts[8] * 256; const int* LISTE = F.w<int>(WS_LISTE); const float* TOPW = F.w<float>(WS_TOPW);
    const bf16_t* a2 = F.w<bf16_t>(L1_A2TMP); bf16_t* AG = F.w<bf16_t>(WS_AG); uint2* RIW = F.w<uint2>(WS_ROWINFO);
    const int RPW = (nrows + F.G * 8 - 1) / (F.G * 8), rbeg = (F.bid * 8 + F.wave) * RPW, rend = (rbeg + RPW < nrows) ? rbeg + RPW : nrows;
    int my_info = -1;
    { const int r = rbeg + F.lane;
      if (F.lane < RPW && r < rend) { const int j = r >> 8; int e = 0;
#pragma unroll
          for (int k = 1; k < 8; ++k) e += (j >= ts[k]) ? 1 : 0;
          int tse = ts[0];
#pragma unroll
          for (int k = 1; k < 8; ++k) tse = (e == k) ? ts[k] : tse;
          const int i = r - tse * 256; const int ce = (int)__hip_atomic_load(cnt + e, __ATOMIC_RELAXED, __HIP_MEMORY_SCOPE_AGENT); float w = 0.f;
          if (i < ce) { my_info = LISTE[(size_t)e * TL + i]; w = TOPW[my_info]; F.w<int>(WS_SROW)[my_info] = r; }
          RIW[r] = make_uint2((unsigned)my_info, __float_as_uint(w)); } }
    static_assert(MOE_FP8, "the gather below writes e4m3 rows");
    uint4 v0 = make_uint4(0u, 0u, 0u, 0u), n0 = v0;
    const unsigned char* a8 = (const unsigned char*)a2;
    if (rbeg < rend) { const int info = __builtin_amdgcn_readlane(my_info, 0); if (info >= 0) v0 = *(const uint4*)(a8 + (size_t)(info >> 1) * 1024 + F.lane * 16); }
    for (int r = rbeg; r < rend; ++r) {
        n0 = make_uint4(0u, 0u, 0u, 0u);
        if (r + 1 < rend) { const int info = __builtin_amdgcn_readlane(my_info, r + 1 - rbeg); if (info >= 0) n0 = *(const uint4*)(a8 + (size_t)(info >> 1) * 1024 + F.lane * 16); }
        *(uint4*)((unsigned char*)AG + (size_t)r * 1024 + F.lane * 16) = v0;
        v0 = n0;
    }
}
__device__ __forceinline__ void ld8bf(const bf16_t* p, float (&o)[8]) { const uint4 q = *(const uint4*)p; o[0] = bflo(q.x); o[1] = bfhi(q.x); o[2] = bflo(q.y); o[3] = bfhi(q.y); o[4] = bflo(q.z); o[5] = bfhi(q.z); o[6] = bflo(q.w); o[7] = bfhi(q.w); }
__device__ __forceinline__ void st8bf(bf16_t* p, const float (&v)[8]) { uint4 q; q.x = pack2(v[0], v[1]); q.y = pack2(v[2], v[3]); q.z = pack2(v[4], v[5]); q.w = pack2(v[6], v[7]); *(uint4*)p = q; }
struct CW { float w0[8], w1[8], w2[8], bb[8]; };
__device__ __forceinline__ void cw_load(CW& c, const float* w, const float* b, int wc, int wld) {
    const float4 a0 = ld4(w + wc), a1 = ld4(w + wc + 4), b0 = ld4(w + wld + wc), b1 = ld4(w + wld + wc + 4), c0 = ld4(w + 2 * wld + wc), c1 = ld4(w + 2 * wld + wc + 4), d0 = ld4(b + wc), d1 = ld4(b + wc + 4);
    c.w0[0] = a0.x; c.w0[1] = a0.y; c.w0[2] = a0.z; c.w0[3] = a0.w; c.w0[4] = a1.x; c.w0[5] = a1.y; c.w0[6] = a1.z; c.w0[7] = a1.w;
    c.w1[0] = b0.x; c.w1[1] = b0.y; c.w1[2] = b0.z; c.w1[3] = b0.w; c.w1[4] = b1.x; c.w1[5] = b1.y; c.w1[6] = b1.z; c.w1[7] = b1.w;
    c.w2[0] = c0.x; c.w2[1] = c0.y; c.w2[2] = c0.z; c.w2[3] = c0.w; c.w2[4] = c1.x; c.w2[5] = c1.y; c.w2[6] = c1.z; c.w2[7] = c1.w;
    c.bb[0] = d0.x; c.bb[1] = d0.y; c.bb[2] = d0.z; c.bb[3] = d0.w; c.bb[4] = d1.x; c.bb[5] = d1.y; c.bb[6] = d1.z; c.bb[7] = d1.w;
}
__device__ __forceinline__ void conv8(const bf16_t* prow, bool hasp, bool hasn, int pc, const CW& c, float (&o)[8]) {
    float xm[8], x0[8], xp[8]; ld8bf(prow + pc, x0);
    if (hasp) ld8bf(prow - EVEN_PAD + pc, xm); else {
#pragma unroll
        for (int j = 0; j < 8; ++j) xm[j] = 0.f; }
    if (hasn) ld8bf(prow + EVEN_PAD + pc, xp); else {
#pragma unroll
        for (int j = 0; j < 8; ++j) xp[j] = 0.f; }
#pragma unroll
    for (int j = 0; j < 8; ++j) o[j] = c.w0[j] * xm[j] + c.w1[j] * x0[j] + c.w2[j] * xp[j] + c.bb[j];
}
__device__ __forceinline__ void ph_convpass(const Fr& F) {
    const bf16_t* PROJ = F.w<bf16_t>(L0_PROJ); bf16_t* U = F.w<bf16_t>(L0_U); bf16_t* X0 = F.w<bf16_t>(L0_X0); bf16_t* XBC = F.w<bf16_t>(L0_XBC); float* DT = F.w<float>(L0_DT);
    const float* hw = F.in[I_HYCW]; const float* hb = F.in[I_HYCB]; const float* sw = F.in[I_SCW]; const float* sb = F.in[I_SCB]; const float* dtb = F.in[I_DTB];
    {
        const int c = F.lane * 8; CW cx0, cb0, cb1; cw_load(cx0, hw, hb, c, 1536); cw_load(cb0, sw, sb, c, 1024); cw_load(cb1, sw, sb, c + 512, 1024);
        const float dtbv = F.lane < 16 ? dtb[F.lane] : 0.f;
        for (int row = F.bid * 8 + F.wave; row < TT; row += F.G * 8) {
            const int t = row < TL ? (row & (SEQ - 1)) : ((row - TL) & (CTXL - 1)), n = row < TL ? SEQ : CTXL; const bool hasp = t > 0, hasn = t < n - 1;
            const bf16_t* prow = PROJ + (size_t)row * EVEN_PAD;
            float a0[8];
            conv8(prow, hasp, hasn, c, cx0, a0);
            st8bf(X0 + (size_t)row * 512 + c, a0);
            conv8(prow, hasp, hasn, 2048 + c, cb0, a0);
#pragma unroll
            for (int j = 0; j < 8; ++j) a0[j] = silu_f(a0[j]);
            st8bf(XBC + (size_t)row * 1024 + c, a0);
            conv8(prow, hasp, hasn, 2048 + 512 + c, cb1, a0);
#pragma unroll
            for (int j = 0; j < 8; ++j) a0[j] = silu_f(a0[j]);
            st8bf(XBC + (size_t)row * 1024 + 512 + c, a0);
            if (F.lane < 16) DT[(size_t)row * 16 + F.lane] = softplus_f(bf2f(prow[3072 + F.lane]) + dtbv);
        }
    }
    bf16_t* ut = (bf16_t*)F.lds;
    {   const int tok = F.tid >> 3, cq = F.tid & 7; const int cgp = F.bid & 3;
        CW c1a, c1b, cva, cvb; { const int ch = cgp * 128 + cq * 16; cw_load(c1a, hw, hb, 512 + ch, 1536); cw_load(c1b, hw, hb, 512 + ch + 8, 1536); cw_load(cva, hw, hb, 1024 + ch, 1536); cw_load(cvb, hw, hb, 1024 + ch + 8, 1536); }
        for (int un = F.bid; un < (TT / 64) * 4; un += F.G) {
            const int tile = un >> 2, row0 = tile * 64; const int row = row0 + tok;
            const int t = row < TL ? (row & (SEQ - 1)) : ((row - TL) & (CTXL - 1)), n = row < TL ? SEQ : CTXL; const bool hasp = t > 0, hasn = t < n - 1;
            const bf16_t* prow = PROJ + (size_t)row * EVEN_PAD; const int ch = cgp * 128 + cq * 16;
            { float a1[8], a2[8]; conv8(prow, hasp, hasn, 512 + ch, c1a, a1); conv8(prow, hasp, hasn, 1024 + ch, cva, a2);
#pragma unroll
              for (int j = 0; j < 8; ++j) ut[(cq * 16 + j) * 66 + tok] = f2bf(a1[j] * a2[j]);
              conv8(prow, hasp, hasn, 512 + ch + 8, c1b, a1); conv8(prow, hasp, hasn, 1024 + ch + 8, cvb, a2);
#pragma unroll
              for (int j = 0; j < 8; ++j) ut[(cq * 16 + 8 + j) * 66 + tok] = f2bf(a1[j] * a2[j]); }
            __syncthreads();
            { const int ch2 = F.tid >> 2, part = F.tid & 3; const int b = row0 < TL ? (row0 >> 11) : ((row0 - TL) >> 8), off = row0 < TL ? CTXL + (row0 & (SEQ - 1)) : ((row0 - TL) & (CTXL - 1));
              const unsigned* src = (const unsigned*)(ut + ch2 * 66 + part * 16); uint4 v0, v1; v0.x = src[0]; v0.y = src[1]; v0.z = src[2]; v0.w = src[3]; v1.x = src[4]; v1.y = src[5]; v1.z = src[6]; v1.w = src[7];
              uint4* dst = (uint4*)(U + ((size_t)(cgp * 128 + ch2) * 8 + b) * NKEY + off + part * 16); dst[0] = v0; dst[1] = v1; }
            __syncthreads();
        }
    }
}

__device__ __forceinline__ unsigned alignhalf(unsigned hi, unsigned lo) { return (lo >> 16) | (hi << 16); }
template <int RHO> __device__ __forceinline__ uint4 shift_copy(const uint4 prev, const uint4 cur) {
    const unsigned cc[8] = {prev.x, prev.y, prev.z, prev.w, cur.x, cur.y, cur.z, cur.w};
    constexpr int o = 16 - 2 * RHO, d0 = o / 4; uint4 r;
    if constexpr ((o & 3) == 0) { r.x = cc[d0]; r.y = cc[d0 + 1]; r.z = cc[d0 + 2]; r.w = cc[d0 + 3]; }
    else { r.x = alignhalf(cc[d0 + 1], cc[d0]); r.y = alignhalf(cc[d0 + 2], cc[d0 + 1]); r.z = alignhalf(cc[d0 + 3], cc[d0 + 2]); r.w = alignhalf(cc[d0 + 4], cc[d0 + 3]); }
    return r;
}
__device__ __forceinline__ void build_copies(unsigned char* cp, int cs, const bf16_t* R, int nch, int i) {
    if (i < nch) { const uint4 cur = *(const uint4*)(R + 8 * i); const uint4 prev = i > 0 ? *(const uint4*)(R + 8 * i - 8) : make_uint4(0u, 0u, 0u, 0u);
        *(uint4*)(cp + 0 * cs + i * 16) = cur;
        *(uint4*)(cp + 1 * cs + i * 16) = shift_copy<1>(prev, cur); *(uint4*)(cp + 2 * cs + i * 16) = shift_copy<2>(prev, cur); *(uint4*)(cp + 3 * cs + i * 16) = shift_copy<3>(prev, cur);
        *(uint4*)(cp + 4 * cs + i * 16) = shift_copy<4>(prev, cur); *(uint4*)(cp + 5 * cs + i * 16) = shift_copy<5>(prev, cur); *(uint4*)(cp + 6 * cs + i * 16) = shift_copy<6>(prev, cur);
        *(uint4*)(cp + 7 * cs + i * 16) = shift_copy<7>(prev, cur); }
}
__device__ __forceinline__ void ph_hyena_mfma(const Fr& F) {
    const bf16_t* U = F.w<bf16_t>(L0_U); bf16_t* YT = F.w<bf16_t>(L0_YT);
    const int w = F.wave, rr = F.lane & 15, g = F.lane >> 4;
    {   constexpr int CS = 8224, US = 4128;
        unsigned char* Cp = F.lds; unsigned char* Ub = F.lds + 8 * CS;
        const int p = w & 1, q = w >> 1;
        for (int c = F.bid; c < 512; c += F.G) {
            __syncthreads();
            build_copies(Cp, CS, F.w<bf16_t>(L0_FL) + (size_t)c * 4096, 512, F.tid);
#pragma unroll
            for (int k = 0; k < 4; ++k) { const int id = F.tid + 512 * k, b = id >> 8, ch = id & 255; *(uint4*)(Ub + b * US + ch * 16) = *(const uint4*)(U + ((size_t)c * 8 + b) * NKEY + CTXL + ch * 8); }
            __syncthreads();
            const unsigned char* abase = Cp + (rr & 7) * CS + (2048 - 16 * (32 * q + p) - 8 * (rr >> 3) + 8 * g) * 2;
            const unsigned char* ubase = Ub + (rr & 7) * US + 16 * g;
            f32x4 acc[16]; bf16x8 af[16];
#pragma unroll
            for (int i = 0; i < 16; ++i) { acc[i] = (f32x4){0.f, 0.f, 0.f, 0.f}; af[i] = *(const bf16x8*)(abase - 64 * i); }
            for (int jj = 0; jj < 4; ++jj) {
#pragma unroll
                for (int js = 0; js < 16; ++js) { const int J = 16 * jj + js;
                    af[(16 - js) & 15] = *(const bf16x8*)(abase + 64 * J);
                    const bf16x8 bfr = *(const bf16x8*)(ubase + 64 * J);
#pragma unroll
                    for (int i = 0; i < 16; ++i) acc[i] = __builtin_amdgcn_mfma_f32_16x16x32_bf16(af[(i - js) & 15], bfr, acc[i], 0, 0, 0);
                }
            }
            if (rr < 8) {
#pragma unroll
                for (int i = 0; i < 16; ++i) { const int t = 16 * (32 * q + p + 2 * i) + 4 * g; uint2 pk; pk.x = pack2(acc[i][0], acc[i][1]); pk.y = pack2(acc[i][2], acc[i][3]);
                    *(uint2*)(YT + ((size_t)c * 8 + rr) * NKEY + CTXL + t) = pk; }
            }
        }
    }
    {   constexpr int CS = 1056, US = 544;
        unsigned char* Cp = F.lds; unsigned char* Ub = F.lds + 8 * CS;
        for (int c = F.bid; c < 512; c += F.G) {
            __syncthreads();
            build_copies(Cp, CS, F.w<bf16_t>(L0_FC) + (size_t)c * 512, 64, F.tid);
            if (F.tid < 256) { const int b = F.tid >> 5, ch = F.tid & 31; *(uint4*)(Ub + b * US + ch * 16) = *(const uint4*)(U + ((size_t)c * 8 + b) * NKEY + ch * 8); }
            __syncthreads();
            f32x4 acc[2];
#pragma unroll
            for (int ii = 0; ii < 2; ++ii) acc[ii] = (f32x4){0.f, 0.f, 0.f, 0.f};
#pragma unroll
            for (int J = 0; J < 8; ++J) { const bf16x8 bfr = *(const bf16x8*)(Ub + (rr & 7) * US + 16 * g + 64 * J);
#pragma unroll
                for (int ii = 0; ii < 2; ++ii) { const int d = 2 * w + ii - 2 * J; const bf16x8 a = *(const bf16x8*)(Cp + (rr & 7) * CS + (256 - 16 * d - 8 * (rr >> 3) + 8 * g) * 2);
                    acc[ii] = __builtin_amdgcn_mfma_f32_16x16x32_bf16(a, bfr, acc[ii], 0, 0, 0); } }
            if (rr < 8) {
#pragma unroll
                for (int ii = 0; ii < 2; ++ii) { const int t = 16 * (2 * w + ii) + 4 * g; uint2 pk; pk.x = pack2(acc[ii][0], acc[ii][1]); pk.y = pack2(acc[ii][2], acc[ii][3]);
                    *(uint2*)(YT + ((size_t)c * 8 + rr) * NKEY + t) = pk; }
            }
        }
    }
    __syncthreads();
}
__device__ __forceinline__ void ph_hyena_post(const Fr& F) {
    const bf16_t* YT = F.w<bf16_t>(L0_YT); const bf16_t* X0 = F.w<bf16_t>(L0_X0); bf16_t* A = F.w<bf16_t>(WS_ABUF);
    bf16_t* yt = (bf16_t*)F.lds;
    for (int un = F.bid; un < (TT / 64) * 4; un += F.G) {
        const int tile = un >> 2, cgp = un & 3, row0 = tile * 64;
        { const int ch = F.tid >> 2, part = F.tid & 3; const int b = row0 < TL ? (row0 >> 11) : ((row0 - TL) >> 8), off = row0 < TL ? CTXL + (row0 & (SEQ - 1)) : ((row0 - TL) & (CTXL - 1));
          const uint4* src = (const uint4*)(YT + ((size_t)(cgp * 128 + ch) * 8 + b) * NKEY + off + part * 16); const uint4 v0 = src[0], v1 = src[1];
          unsigned* dst = (unsigned*)(yt + ch * 66 + part * 16); dst[0] = v0.x; dst[1] = v0.y; dst[2] = v0.z; dst[3] = v0.w; dst[4] = v1.x; dst[5] = v1.y; dst[6] = v1.z; dst[7] = v1.w; }
        __syncthreads();
        { const int tok = F.tid >> 3, cq = F.tid & 7, row = row0 + tok;
#pragma unroll
          for (int hf = 0; hf < 2; ++hf) { const int ch = cgp * 128 + cq * 16 + hf * 8; float x0[8], o[8]; ld8bf(X0 + (size_t)row * 512 + ch, x0);
#pragma unroll
              for (int j = 0; j < 8; ++j) o[j] = x0[j] * bf2f(yt[(cq * 16 + hf * 8 + j) * 66 + tok]);
              st8bf(A + (size_t)row * 1024 + ch, o); } }
        __syncthreads();
    }
}

__device__ __forceinline__ int ssd_rowbase(int b, int cpos) { return cpos < 2 ? TL + b * CTXL + cpos * 128 : b * SEQ + (cpos - 2) * 128; }
typedef short s16x4 __attribute__((ext_vector_type(4)));
__device__ __forceinline__ s16x4 tr_read16(const unsigned char* img, int P, int row0, int col0, int lane) {
    const int q4 = (lane & 15) >> 2, p4 = lane & 3;
    return __builtin_amdgcn_ds_read_tr16_b64_v4i16((LAS s16x4*)(LAS unsigned char*)(img + (row0 + q4) * P + (col0 + 4 * p4) * 2));
}
__device__ __forceinline__ bf16x8 tr_pair(const unsigned char* img, int P, int rowa, int rowb, int col0, int lane) {
    union { bf16x8 v; s16x4 h[2]; } u; u.h[0] = tr_read16(img, P, rowa, col0, lane); u.h[1] = tr_read16(img, P, rowb, col0, lane); return u.v;
}
__device__ __forceinline__ void ph_ssd_a(const Fr& F) {
    constexpr int PT = 272, PX = 144;
    unsigned char* XD = F.lds;
    unsigned char* Bn = XD + 128 * PX;
    unsigned char* Bd = Bn + 128 * PT;
    unsigned char* Cn = Bd + 128 * PT;
    float* acs = (float*)(Cn + 128 * PT);
    float* dts = acs + 128;
    const bf16_t* XBC = F.w<bf16_t>(L0_XBC); const float* DT = F.w<float>(L0_DT);
    const int w = F.wave, cl = F.lane & 15, g = F.lane >> 4;
    for (int u = F.bid; u < NB * 18 * 16; u += F.G) {
        const int b = u / 288, rem = u % 288, cpos = rem >> 4, h = (rem >> 1) & 7, dir = rem & 1, grp = h >> 2;
        const int rowbase = ssd_rowbase(b, cpos), su = ((b * 2 + dir) * 8 + h) * 18 + cpos;
        const float Aneg = -expf(F.in[I_ALOG][dir * 8 + h]);
        __syncthreads();
        if (w == 0) { const int q0 = 2 * F.lane, p0 = dir ? 127 - q0 : q0, p1 = dir ? 126 - q0 : q0 + 1;
            const float d0 = DT[(size_t)(rowbase + p0) * 16 + dir * 8 + h], d1 = DT[(size_t)(rowbase + p1) * 16 + dir * 8 + h]; const float a0 = d0 * Aneg, a1 = d1 * Aneg;
            float sc = a0 + a1;
#pragma unroll
            for (int o = 1; o < 64; o <<= 1) { const float t = __shfl_up(sc, o); if (F.lane >= o) sc += t; }
            const float ex = sc - (a0 + a1); acs[q0] = ex + a0; acs[q0 + 1] = ex + a0 + a1; dts[q0] = d0; dts[q0 + 1] = d1;
            float* ACS = F.w<float>(L0_ACS) + (size_t)su * 128; ACS[p0] = ex + a0; ACS[p1] = ex + a0 + a1;
            if (F.lane == 63) F.w<float>(L0_ATOT)[su] = ex + a0 + a1; }
        __syncthreads();
        const float atot = acs[127];
#pragma unroll
        for (int k = 0; k < 2; ++k) { const int id = F.tid + 512 * k, q = id >> 3, pc = id & 7, pos = dir ? 127 - q : q; float v[8]; ld8bf(XBC + (size_t)(rowbase + pos) * 1024 + h * 64 + pc * 8, v); const float dv = dts[q];
            uint4 o; o.x = pack2(v[0] * dv, v[1] * dv); o.y = pack2(v[2] * dv, v[3] * dv); o.z = pack2(v[4] * dv, v[5] * dv); o.w = pack2(v[6] * dv, v[7] * dv);
            *(uint4*)(XD + q * PX + pc * 16) = o; }
#pragma unroll
        for (int k = 0; k < 4; ++k) { const int id = F.tid + 512 * k, q = id >> 4, nc = id & 15, pos = dir ? 127 - q : q; const bf16_t* src = XBC + (size_t)(rowbase + pos) * 1024 + 512 + grp * 128 + nc * 8;
            const uint4 bv = *(const uint4*)src, cv = *(const uint4*)(src + 256);
            *(uint4*)(Bn + q * PT + nc * 16) = bv; *(uint4*)(Cn + q * PT + nc * 16) = cv;
            const float dec = __expf(atot - acs[q]); uint4 o;
            o.x = pack2(bflo(bv.x) * dec, bfhi(bv.x) * dec); o.y = pack2(bflo(bv.y) * dec, bfhi(bv.y) * dec); o.z = pack2(bflo(bv.z) * dec, bfhi(bv.z) * dec); o.w = pack2(bflo(bv.w) * dec, bfhi(bv.w) * dec);
            *(uint4*)(Bd + q * PT + nc * 16) = o; }
        __syncthreads();
        const int q = 16 * w + cl; const float aq = acs[q];
        bf16x8 cf[4];
#pragma unroll
        for (int ks = 0; ks < 4; ++ks) cf[ks] = *(const bf16x8*)(Cn + q * PT + (32 * ks + 8 * g) * 2);
        unsigned pk[8][2];
#pragma unroll
        for (int sb = 0; sb < 8; ++sb) { pk[sb][0] = 0u; pk[sb][1] = 0u;
            if (sb <= w) { f32x4 gacc = (f32x4){0.f, 0.f, 0.f, 0.f};
#pragma unroll
                for (int ks = 0; ks < 4; ++ks) { const bf16x8 bf = *(const bf16x8*)(Bn + (16 * sb + cl) * PT + (32 * ks + 8 * g) * 2); gacc = __builtin_amdgcn_mfma_f32_16x16x32_bf16(bf, cf[ks], gacc, 0, 0, 0); }
                const f32x4 as = *(const f32x4*)(acs + 16 * sb + 4 * g); float sv[4];
#pragma unroll
                for (int e = 0; e < 4; ++e) { const int sI = 16 * sb + 4 * g + e; sv[e] = (sI <= q) ? gacc[e] * __expf(aq - as[e]) : 0.f; }
                pk[sb][0] = pack2(sv[0], sv[1]); pk[sb][1] = pack2(sv[2], sv[3]); } }
        f32x4 yacc[4];
#pragma unroll
        for (int pb = 0; pb < 4; ++pb) yacc[pb] = (f32x4){0.f, 0.f, 0.f, 0.f};
#pragma unroll
        for (int k2 = 0; k2 < 4; ++k2) if (2 * k2 <= w) {
            union { bf16x8 v; unsigned wd[4]; } pf; pf.wd[0] = pk[2 * k2][0]; pf.wd[1] = pk[2 * k2][1]; pf.wd[2] = pk[2 * k2 + 1][0]; pf.wd[3] = pk[2 * k2 + 1][1];
#pragma unroll
            for (int pb = 0; pb < 4; ++pb) { const bf16x8 xa = tr_pair(XD, PX, 32 * k2 + 4 * g, 32 * k2 + 16 + 4 * g, 16 * pb, F.lane);
                yacc[pb] = __builtin_amdgcn_mfma_f32_16x16x32_bf16(xa, pf.v, yacc[pb], 0, 0, 0); } }
        { bf16_t* Y = (dir ? F.w<bf16_t>(L0_YB) : F.w<bf16_t>(L0_YF)) + (size_t)(rowbase + (dir ? 127 - q : q)) * 512 + h * 64 + 4 * g;
#pragma unroll
          for (int pb = 0; pb < 4; ++pb) { uint2 o; o.x = pack2(yacc[pb][0], yacc[pb][1]); o.y = pack2(yacc[pb][2], yacc[pb][3]); *(uint2*)(Y + 16 * pb) = o; } }
        { float* ST = F.w<float>(L0_ST) + (size_t)su * 8192;
          bf16x8 af[4];
#pragma unroll
          for (int ks = 0; ks < 4; ++ks) af[ks] = tr_pair(Bd, PT, 32 * ks + 8 * g, 32 * ks + 8 * g + 4, 16 * w, F.lane);
#pragma unroll
          for (int pb = 0; pb < 4; ++pb) { f32x4 sacc = (f32x4){0.f, 0.f, 0.f, 0.f};
#pragma unroll
              for (int ks = 0; ks < 4; ++ks) { const bf16x8 xb = tr_pair(XD, PX, 32 * ks + 8 * g, 32 * ks + 8 * g + 4, 16 * pb, F.lane); sacc = __builtin_amdgcn_mfma_f32_16x16x32_bf16(af[ks], xb, sacc, 0, 0, 0); }
              *(f32x4*)(ST + (size_t)(16 * pb + cl) * 128 + 16 * w + 4 * g) = sacc; } }
    }
    __syncthreads();
}
__device__ __forceinline__ void ph_ssd_b(const Fr& F) {
    const float* ST = F.w<float>(L0_ST); const float* ATOT = F.w<float>(L0_ATOT); bf16_t* STIN = F.w<bf16_t>(L0_STIN);
    for (int idx = F.bid * NTHR + F.tid; idx < 128 * 2048; idx += F.G * NTHR) {
        const int chain = idx >> 11, e4 = idx & 2047, dir = (chain >> 3) & 1;
        f32x4 run = (f32x4){0.f, 0.f, 0.f, 0.f};
        for (int k = 0; k < 18; ++k) { const int cpos = dir ? (k < 2 ? 1 - k : 19 - k) : k; const size_t su = (size_t)chain * 18 + cpos;
            uint2 o; o.x = pack2(run[0], run[1]); o.y = pack2(run[2], run[3]); *(uint2*)(STIN + su * 8192 + e4 * 4) = o;
            const f32x4 st = *(const f32x4*)(ST + su * 8192 + e4 * 4); const float dc = __expf(ATOT[su]); run = run * dc + st; }
    }
}
__device__ __forceinline__ void ph_ssd_c(const Fr& F) {
    constexpr int PT = 272;
    unsigned char* Cn = F.lds;
    unsigned char* Sin = Cn + 64 * PT;
    float* ssx = (float*)(Sin + 4 * 64 * PT);
    const bf16_t* XBC = F.w<bf16_t>(L0_XBC); const bf16_t* PROJ = F.w<bf16_t>(L0_PROJ); const bf16_t* STIN = F.w<bf16_t>(L0_STIN); const float* ACS = F.w<float>(L0_ACS);
    const bf16_t* YF = F.w<bf16_t>(L0_YF); const bf16_t* YB = F.w<bf16_t>(L0_YB); bf16_t* A = F.w<bf16_t>(WS_ABUF);
    const float* dsk = F.in[I_SSMD]; const float* ng = F.in[I_SSMNG];
    const int w = F.wave, pw = w & 3, hp = w >> 2;
    for (int u = F.bid; u < NB * 18 * 4; u += F.G) {
        int tz = threadIdx.x; asm volatile("" : "+v"(tz));
        const int cl = tz & 15, g = (tz >> 4) & 3;
        const int b = u / 72, rem = u % 72, cpos = rem >> 2, grp = (rem >> 1) & 1, ph = rem & 1; const int rowbase = ssd_rowbase(b, cpos);
        const int lpos = 16 * pw + cl, pos = ph * 64 + lpos; const size_t row = (size_t)(rowbase + pos);
        __syncthreads();
#pragma unroll
        for (int k = 0; k < 2; ++k) { const int id = tz + 512 * k, q = id >> 4, nc = id & 15; *(uint4*)(Cn + q * PT + nc * 16) = *(const uint4*)(XBC + (size_t)(rowbase + ph * 64 + q) * 1024 + 768 + grp * 128 + nc * 8); }
        float ss = 0.f;
        uint4 sreg0, sreg1, sreg2, sreg3, sreg4, sreg5, sreg6, sreg7;
#define SSDC_SRC(k, it) (STIN + ((size_t)(b * 16 + (((tz + 512 * (k)) >> 10) & 1) * 8 + grp * 4 + 2 * ((tz + 512 * (k)) >> 11) + (it)) * 18 + cpos) * 8192 + (((tz + 512 * (k)) >> 4) & 63) * 128 + ((tz + 512 * (k)) & 15) * 8)
#define SSDC_SLOAD(it) do { sreg0 = *(const uint4*)SSDC_SRC(0, it); sreg1 = *(const uint4*)SSDC_SRC(1, it); sreg2 = *(const uint4*)SSDC_SRC(2, it); sreg3 = *(const uint4*)SSDC_SRC(3, it); \
            sreg4 = *(const uint4*)SSDC_SRC(4, it); sreg5 = *(const uint4*)SSDC_SRC(5, it); sreg6 = *(const uint4*)SSDC_SRC(6, it); sreg7 = *(const uint4*)SSDC_SRC(7, it); } while (0)
#define SSDC_LDSW(k, v) *(uint4*)(Sin + ((tz + 512 * (k)) >> 10) * 64 * PT + (((tz + 512 * (k)) >> 4) & 63) * PT + ((tz + 512 * (k)) & 15) * 16) = v
        SSDC_SLOAD(0);
#pragma unroll 1
        for (int it = 0; it < 2; ++it) {
            const int h = grp * 4 + 2 * hp + it; const size_t su0 = (size_t)(b * 16 + h) * 18 + cpos, su1 = (size_t)(b * 16 + 8 + h) * 18 + cpos;
            uint2 eyf[4], eyb[4], exv[4], ezv[4];
#pragma unroll
            for (int pb = 0; pb < 4; ++pb) { const int ch = h * 64 + 16 * pb + 4 * g;
                eyf[pb] = *(const uint2*)(YF + row * 512 + ch); eyb[pb] = *(const uint2*)(YB + row * 512 + ch); exv[pb] = *(const uint2*)(XBC + row * 1024 + ch); ezv[pb] = *(const uint2*)(PROJ + row * EVEN_PAD + 1536 + ch); }
            const float a0 = ACS[su0 * 128 + pos], a1 = ACS[su1 * 128 + pos];
            __syncthreads();
            SSDC_LDSW(0, sreg0); SSDC_LDSW(1, sreg1); SSDC_LDSW(2, sreg2); SSDC_LDSW(3, sreg3); SSDC_LDSW(4, sreg4); SSDC_LDSW(5, sreg5); SSDC_LDSW(6, sreg6); SSDC_LDSW(7, sreg7);
            if (it < 1) SSDC_SLOAD(it + 1);
            __syncthreads();
            const float sc0 = __expf(a0), sc1 = __expf(a1);
            const unsigned char* S0 = Sin + (hp * 2) * 64 * PT; const unsigned char* S1 = S0 + 64 * PT;
            f32x4 t0[4], t1[4];
#pragma unroll
            for (int pb = 0; pb < 4; ++pb) { t0[pb] = (f32x4){0.f, 0.f, 0.f, 0.f}; t1[pb] = (f32x4){0.f, 0.f, 0.f, 0.f}; }
#pragma unroll
            for (int ks = 0; ks < 4; ++ks) { const bf16x8 cf = *(const bf16x8*)(Cn + lpos * PT + (32 * ks + 8 * g) * 2);
#pragma unroll
                for (int pb = 0; pb < 4; ++pb) { const bf16x8 s0 = *(const bf16x8*)(S0 + (16 * pb + cl) * PT + (32 * ks + 8 * g) * 2), s1 = *(const bf16x8*)(S1 + (16 * pb + cl) * PT + (32 * ks + 8 * g) * 2);
                    t0[pb] = __builtin_amdgcn_mfma_f32_16x16x32_bf16(s0, cf, t0[pb], 0, 0, 0); t1[pb] = __builtin_amdgcn_mfma_f32_16x16x32_bf16(s1, cf, t1[pb], 0, 0, 0); } }
            const float dd = dsk[h];
#pragma unroll
            for (int pb = 0; pb < 4; ++pb) { const int ch = h * 64 + 16 * pb + 4 * g;
                const uint2 yf = eyf[pb], yb = eyb[pb], xv = exv[pb], zv = ezv[pb];
                f32x4 y = t0[pb] * sc0 + t1[pb] * sc1;
                y[0] = (y[0] + bflo(yf.x) + bflo(yb.x) + bflo(xv.x) * dd) * silu_f(bflo(zv.x)); y[1] = (y[1] + bfhi(yf.x) + bfhi(yb.x) + bfhi(xv.x) * dd) * silu_f(bfhi(zv.x));
                y[2] = (y[2] + bflo(yf.y) + bflo(yb.y) + bflo(xv.y) * dd) * silu_f(bflo(zv.y)); y[3] = (y[3] + bfhi(yf.y) + bfhi(yb.y) + bfhi(xv.y) * dd) * silu_f(bfhi(zv.y));
                uint2 o; o.x = pack2(y[0], y[1]); o.y = pack2(y[2], y[3]);
                const float r0 = bflo(o.x), r1 = bfhi(o.x), r2 = bflo(o.y), r3 = bfhi(o.y); ss += r0 * r0 + r1 * r1 + r2 * r2 + r3 * r3;
                *(uint2*)(A + row * 1024 + 512 + ch) = o; }
        }
#undef SSDC_SLOAD
#undef SSDC_SRC
#undef SSDC_LDSW
        ss += __shfl_xor(ss, 16); ss += __shfl_xor(ss, 32);
        if (g == 0) ssx[hp * 64 + lpos] = ss;
        __syncthreads();
        const float rn = rsqrtf((ssx[lpos] + ssx[64 + lpos]) * (1.f / 256.f) + EPS);
#pragma unroll 4
        for (int i = 0; i < 8; ++i) { const int ch = grp * 256 + (2 * hp + (i >> 2)) * 64 + 16 * (i & 3) + 4 * g; bf16_t* ap = A + row * 1024 + 512 + ch; const uint2 v = *(const uint2*)ap; const f32x4 gg = *(const f32x4*)(ng + ch);
            uint2 o; o.x = pack2(bflo(v.x) * rn * gg[0], bfhi(v.x) * rn * gg[1]); o.y = pack2(bflo(v.y) * rn * gg[2], bfhi(v.y) * rn * gg[3]); *(uint2*)ap = o; }
    }
    __syncthreads();
}

__device__ __forceinline__ uint4 rope8(const uint4 mine, const uint4 other, const float* ct, const float* st, bool upper, bool apply, float scale) {
    float m[8], o[8], r[8]; const unsigned mw[4] = {mine.x, mine.y, mine.z, mine.w}, ow[4] = {other.x, other.y, other.z, other.w};
#pragma unroll
    for (int j = 0; j < 4; ++j) { m[2 * j] = bflo(mw[j]); m[2 * j + 1] = bfhi(mw[j]); o[2 * j] = bflo(ow[j]); o[2 * j + 1] = bfhi(ow[j]); }
    if (apply) { const float4 c0 = ld4(ct), c1 = ld4(ct + 4), s0 = ld4(st), s1 = ld4(st + 4); const float c[8] = {c0.x, c0.y, c0.z, c0.w, c1.x, c1.y, c1.z, c1.w}, sn[8] = {s0.x, s0.y, s0.z, s0.w, s1.x, s1.y, s1.z, s1.w};
#pragma unroll
        for (int j = 0; j < 8; ++j) r[j] = (upper ? (m[j] * c[j] + o[j] * sn[j]) : (m[j] * c[j] - o[j] * sn[j])) * scale; }
    else {
#pragma unroll
        for (int j = 0; j < 8; ++j) r[j] = m[j] * scale; }
    uint4 q; q.x = pack2(r[0], r[1]); q.y = pack2(r[2], r[3]); q.z = pack2(r[4], r[5]); q.w = pack2(r[6], r[7]); return q;
}
__device__ __forceinline__ uint4 shfl_xor_u4(const uint4 v, int m) { uint4 r; r.x = __shfl_xor(v.x, m); r.y = __shfl_xor(v.y, m); r.z = __shfl_xor(v.z, m); r.w = __shfl_xor(v.w, m); return r; }
__device__ __forceinline__ void ph_attn_prep(const Fr& F) {
    const bf16_t* P = F.w<bf16_t>(L1_PROJ); float* SQ = F.w<float>(WS_SQ); float* SKV = F.w<float>(WS_SKV);
    bf16_t* KM = F.w<bf16_t>(L1_KM); bf16_t* QG = F.w<bf16_t>(L1_QG); bf16_t* KG = F.w<bf16_t>(L1_KG); bf16_t* VGT = F.w<bf16_t>(L1_VGT);
    const float* cm = F.w<float>(WS_ROPEM); const float* sm = cm + 2048 * 16; const float* cg = F.w<float>(WS_ROPEG); const float* sg = cg + 2048 * 32;
    const float gscale = 0.125f * LOG2E;
    for (int row = F.bid * 8 + F.wave; row < TT; row += F.G * 8) {
        const bf16_t* pr = P + (size_t)row * ODD_PAD; const bool lat = row < TL; const int pos = row & (SEQ - 1), l = F.lane;
        const int b = lat ? (row >> 11) : ((row - TL) >> 8), key = lat ? CTXL + pos : ((row - TL) & (CTXL - 1));
        { float s = 0.f; if (l < 48) { float v[8]; ld8bf(pr + l * 8, v);
#pragma unroll
              for (int j = 0; j < 8; ++j) s += v[j] * v[j]; }
          const float sq = wave_sum(l < 32 ? s : 0.f), skv = wave_sum(l >= 32 ? s : 0.f);
          if (l == 0) { SQ[row] = rsqrtf(sq * (1.f / 256.f) + EPS); SKV[row] = rsqrtf(skv * (1.f / 128.f) + EPS); } }
        { const uint4 mine = *(const uint4*)(pr + 416 + l * 8); const uint4 other = shfl_xor_u4(mine, 4); const int sub = l & 7, i0 = (sub & 3) * 8;
          if (lat) *(uint4*)(QG + (size_t)row * 512 + l * 8) = rope8(mine, other, cg + pos * 32 + i0, sg + pos * 32 + i0, sub >= 4, true, gscale); }
        { const int lk = l & 15; const uint4 mine = *(const uint4*)(pr + 928 + lk * 8); const uint4 other = shfl_xor_u4(mine, 4); const int sub = lk & 7, i0 = (sub & 3) * 8;
          const uint4 r = rope8(mine, other, cg + pos * 32 + i0, sg + pos * 32 + i0, sub >= 4, lat, 1.f);
          if (l < 16) *(uint4*)(KG + ((size_t)b * NKEY + key) * 128 + lk * 8) = r; }
        { const int lr = l & 3; const uint4 mine = *(const uint4*)(pr + 384 + lr * 8); const uint4 other = shfl_xor_u4(mine, 2); const int i0 = (lr & 1) * 8;
          const uint4 r = rope8(mine, other, cm + pos * 16 + i0, sm + pos * 16 + i0, lr >= 2, lat, 1.f);
          if (l < 4) { bf16_t* kb = KM + ((size_t)b * NKEY + key) * 768 + 64 + lr * 8;
#pragma unroll
              for (int h = 0; h < 8; ++h) *(uint4*)(kb + h * 96) = r; } }
    }
    bf16_t* vt = (bf16_t*)F.lds;
    for (int un = F.bid; un < TT / 64; un += F.G) {
        const int row0 = un * 64; const int b = row0 < TL ? (row0 >> 11) : ((row0 - TL) >> 8), key0 = row0 < TL ? CTXL + (row0 & (SEQ - 1)) : ((row0 - TL) & (CTXL - 1));
        { const int tok = F.tid >> 3, cq = F.tid & 7; const uint4 a = *(const uint4*)(P + (size_t)(row0 + tok) * ODD_PAD + 1056 + cq * 16), c2 = *(const uint4*)(P + (size_t)(row0 + tok) * ODD_PAD + 1056 + cq * 16 + 8);
          const unsigned wv[8] = {a.x, a.y, a.z, a.w, c2.x, c2.y, c2.z, c2.w};
#pragma unroll
          for (int j = 0; j < 8; ++j) { vt[(cq * 16 + 2 * j) * 66 + tok] = (bf16_t)(wv[j] & 0xFFFFu); vt[(cq * 16 + 2 * j + 1) * 66 + tok] = (bf16_t)(wv[j] >> 16); } }
        __syncthreads();
        { const int ch = F.tid >> 2, part = F.tid & 3; const unsigned* src = (const unsigned*)(vt + ch * 66 + part * 16); uint4 v0, v1; v0.x = src[0]; v0.y = src[1]; v0.z = src[2]; v0.w = src[3]; v1.x = src[4]; v1.y = src[5]; v1.z = src[6]; v1.w = src[7];
          uint4* dst = (uint4*)(VGT + ((size_t)(b * 2 + (ch >> 6)) * 64 + (ch & 63)) * NKEY + key0 + part * 16); dst[0] = v0; dst[1] = v1; }
        __syncthreads();
    }
}

typedef float f32x16 __attribute__((ext_vector_type(16)));
template <bool GQA>
__device__ __forceinline__ void ph_attn_mfma(const Fr& F) {
    constexpr int DQK = GQA ? 64 : 96, NKS = DQK / 16, KP = GQA ? 144 : 208, VP = 136, KCH = DQK / 8, NKCH = 64 * KCH;
    constexpr int KBYTES = 64 * KP, VBYTES = 64 * VP;
    unsigned char* Kb = F.lds; unsigned char* Vb = F.lds + 2 * KBYTES;
    bf16_t* A = F.w<bf16_t>(WS_ABUF);
    const int r = F.lane & 31, hh = F.lane >> 5;
    for (int u = F.bid; u < 512; u += F.G) {
        int b, ntile, lat_lo = 0, qpos, ocol; const bf16_t* qp; const bf16_t* kbase; const bf16_t* vtb; int kstride; float m_run, l_run;
        if (!GQA) { b = u >> 6; const int h = (u >> 3) & 7, qb = u & 7; qpos = qb * 256 + F.wave * 32 + r; ntile = NKEY / 64;
            qp = F.w<bf16_t>(L1_QM) + (size_t)(b * SEQ + qpos) * 768 + h * 96; kbase = F.w<bf16_t>(L1_KM) + (size_t)b * NKEY * 768 + h * 96; kstride = 768;
            vtb = F.w<bf16_t>(L1_VT) + (size_t)(b * 8 + h) * 64 * NKEY; m_run = 0.f; l_run = 0.f; ocol = h * 64; }
        else { b = u >> 6; const int kv = (u >> 5) & 1, qb = (u >> 1) & 15, pr = u & 1; const int head = kv * 4 + pr * 2 + (F.wave >> 2); qpos = qb * 128 + (F.wave & 3) * 32 + r;
            lat_lo = qb * 128 - 128 > 0 ? qb * 128 - 128 : 0; const int lat_hi = qb * 128 + 256 < SEQ ? qb * 128 + 256 : SEQ; ntile = 4 + (lat_hi - lat_lo) / 64;
            qp = F.w<bf16_t>(L1_QG) + (size_t)(b * SEQ + qpos) * 512 + head * 64; kbase = F.w<bf16_t>(L1_KG) + (size_t)b * NKEY * 128 + kv * 64; kstride = 128;
            vtb = F.w<bf16_t>(L1_VGT) + (size_t)(b * 2 + kv) * 64 * NKEY; m_run = F.in[I_SINK][head] * LOG2E; l_run = hh ? 0.f : 1.f; ocol = 512 + head * 64; }
        bf16x8 qf[NKS];
#pragma unroll
        for (int ks = 0; ks < NKS; ++ks) qf[ks] = *(const bf16x8*)(qp + 16 * ks + 8 * hh);
        f32x16 o0, o1;
#pragma unroll
        for (int i = 0; i < 16; ++i) { o0[i] = 0.f; o1[i] = 0.f; }
        const int kr0 = F.tid / KCH, kc0 = F.tid % KCH, kr1 = (F.tid + 512) / KCH, kc1 = (F.tid + 512) % KCH; const bool has2 = (F.tid + 512) < NKCH;
        const int vr = F.tid >> 3, vc = F.tid & 7;
        uint4 kreg0, kreg1 = make_uint4(0u, 0u, 0u, 0u), vreg;
        bf16x8 kf[NKS][2];
#define ATT_KIDX(t) ((!GQA || (t) < 4) ? (t) * 64 : CTXL + lat_lo + ((t) - 4) * 64)
#define ATT_LOAD(t) do { const int _k0 = ATT_KIDX(t); kreg0 = *(const uint4*)(kbase + (size_t)(_k0 + kr0) * kstride + kc0 * 8); \
            if (has2) kreg1 = *(const uint4*)(kbase + (size_t)(_k0 + kr1) * kstride + kc1 * 8); vreg = *(const uint4*)(vtb + (size_t)vr * NKEY + _k0 + vc * 8); } while (0)
#define ATT_WRITE(buf) do { *(uint4*)(Kb + (buf) * KBYTES + kr0 * KP + kc0 * 16) = kreg0; if (has2) *(uint4*)(Kb + (buf) * KBYTES + kr1 * KP + kc1 * 16) = kreg1; \
            *(uint2*)(Vb + (buf) * VBYTES + vr * VP + vc * 16) = make_uint2(vreg.x, vreg.y); *(uint2*)(Vb + (buf) * VBYTES + vr * VP + vc * 16 + 8) = make_uint2(vreg.z, vreg.w); } while (0)
#define ATT_KFRAGS(buf) do { const unsigned char* kb = Kb + (buf) * KBYTES; \
            _Pragma("unroll") for (int ks = 0; ks < NKS; ++ks) { kf[ks][0] = *(const bf16x8*)(kb + r * KP + (16 * ks + 8 * hh) * 2); kf[ks][1] = *(const bf16x8*)(kb + (32 + r) * KP + (16 * ks + 8 * hh) * 2); } } while (0)
        __syncthreads();
        ATT_LOAD(0); ATT_WRITE(0);
        __syncthreads();
        ATT_KFRAGS(0);
        for (int t = 0; t < ntile; ++t) {
            const int buf = t & 1; const bool more = (t + 1) < ntile;
            if (more) ATT_LOAD(t + 1);
            const unsigned char* vb = Vb + buf * VBYTES;
            f32x16 s0, s1;
#pragma unroll
            for (int i = 0; i < 16; ++i) { s0[i] = -m_run; s1[i] = -m_run; }
#pragma unroll
            for (int ks = 0; ks < NKS; ++ks) { s0 = __builtin_amdgcn_mfma_f32_32x32x16_bf16(kf[ks][0], qf[ks], s0, 0, 0, 0); s1 = __builtin_amdgcn_mfma_f32_32x32x16_bf16(kf[ks][1], qf[ks], s1, 0, 0, 0); }
            union { bf16x8 v; uint2 h2[2]; } vf[4][2];
#pragma unroll
            for (int s2 = 0; s2 < 4; ++s2) { vf[s2][0].h2[0] = *(const uint2*)(vb + r * VP + (16 * s2 + 4 * hh) * 2); vf[s2][0].h2[1] = *(const uint2*)(vb + r * VP + (16 * s2 + 8 + 4 * hh) * 2);
                vf[s2][1].h2[0] = *(const uint2*)(vb + (32 + r) * VP + (16 * s2 + 4 * hh) * 2); vf[s2][1].h2[1] = *(const uint2*)(vb + (32 + r) * VP + (16 * s2 + 8 + 4 * hh) * 2); }
            __builtin_amdgcn_sched_barrier(0);
            if (GQA && t >= 4) { const int kp0 = lat_lo + (t - 4) * 64 + 4 * hh - qpos;
#pragma unroll
                for (int i = 0; i < 16; ++i) { const int rel = kp0 + (i & 3) + 8 * (i >> 2); if (rel > 128 || rel < -128) s0[i] = -1.0e30f; if (rel + 32 > 128 || rel + 32 < -128) s1[i] = -1.0e30f; } }
            float tmax = s0[0];
#pragma unroll
            for (int i = 1; i < 16; ++i) tmax = fmaxf(tmax, s0[i]);
#pragma unroll
            for (int i = 0; i < 16; ++i) tmax = fmaxf(tmax, s1[i]);
            tmax = fmaxf(tmax, __shfl_xor(tmax, 32));
            const float dm = fmaxf(tmax, 0.f); const bool grow = __any(tmax > 0.f) != 0; float alpha = 1.f;
            float ls = 0.f;
            if (grow) { alpha = __builtin_amdgcn_exp2f(-dm); m_run += dm;
#pragma unroll
                for (int i = 0; i < 16; ++i) { s0[i] = __builtin_amdgcn_exp2f(s0[i] - dm); s1[i] = __builtin_amdgcn_exp2f(s1[i] - dm); ls += s0[i] + s1[i]; } }
            else {
#pragma unroll
                for (int i = 0; i < 16; ++i) { s0[i] = __builtin_amdgcn_exp2f(s0[i]); s1[i] = __builtin_amdgcn_exp2f(s1[i]); ls += s0[i] + s1[i]; } }
            l_run = l_run * alpha + ls;
            if (grow) {
#pragma unroll
                for (int i = 0; i < 16; ++i) { o0[i] *= alpha; o1[i] *= alpha; } }
#pragma unroll
            for (int s2 = 0; s2 < 4; ++s2) {
                union { bf16x8 v; unsigned w[4]; } pf;
#pragma unroll
                for (int j = 0; j < 4; ++j) { const int ri = 8 * (s2 & 1) + 2 * j; pf.w[j] = (s2 < 2) ? pack2(s0[ri], s0[ri + 1]) : pack2(s1[ri], s1[ri + 1]); }
                o0 = __builtin_amdgcn_mfma_f32_32x32x16_bf16(vf[s2][0].v, pf.v, o0, 0, 0, 0); o1 = __builtin_amdgcn_mfma_f32_32x32x16_bf16(vf[s2][1].v, pf.v, o1, 0, 0, 0);
            }
            if (more) ATT_WRITE(buf ^ 1);
            __syncthreads();
            if (more) ATT_KFRAGS(buf ^ 1);
        }
#undef ATT_KFRAGS
#undef ATT_KIDX
#undef ATT_LOAD
#undef ATT_WRITE
        const float inv = 1.f / (l_run + __shfl_xor(l_run, 32));
        bf16_t* op = A + (size_t)(b * SEQ + qpos) * 1024 + ocol + 4 * hh;
#pragma unroll
        for (int t4 = 0; t4 < 4; ++t4) { uint2 p;
            p.x = pack2(o0[4 * t4] * inv, o0[4 * t4 + 1] * inv); p.y = pack2(o0[4 * t4 + 2] * inv, o0[4 * t4 + 3] * inv); *(uint2*)(op + 8 * t4) = p;
            p.x = pack2(o1[4 * t4] * inv, o1[4 * t4 + 1] * inv); p.y = pack2(o1[4 * t4 + 2] * inv, o1[4 * t4 + 3] * inv); *(uint2*)(op + 32 + 8 * t4) = p; }
    }
    __syncthreads();
}

template <class Epi>
__device__ __forceinline__ void run_gemm(const Fr& F, const bf16_t* A, int lda, const bf16_t* Bt, int ldb, int M, int N, int K, const Epi& E) {
    pg8::Gemm g{A, Bt, M, N, K, lda, ldb, 0}; pg8::StaticOrder S; S.init(M, N, F.G, F.bid);
    pg8::gemm_phase<Epi, pg8::StaticOrder>((LAS unsigned char*)F.lds, g, S, E);
}

__global__ void __launch_bounds__(NTHR, 2) fwd(Args args) {
    extern __shared__ __attribute__((aligned(16))) unsigned char lds[];
    Fr F; F.in = args.in; F.out = args.out; F.ws = args.ws; F.lds = lds; F.tid = threadIdx.x; F.lane = F.tid & 63; F.wave = __builtin_amdgcn_readfirstlane(F.tid >> 6); F.G = gridDim.x; F.bid = blockIdx.x;
    const int lo = args.ph_lo, hi = args.ph_hi;
#ifndef PHMASK
#define PHMASK 0xFFFFFFFFu
#endif
#define IN(k) (((PHMASK >> (k)) & 1u) && lo <= (k) && (k) < hi)
    const float* MOD0 = F.w<float>(WS_MOD); const float* MOD1 = MOD0 + 9 * 6144;
    const bool multi_phase = (hi - lo) > 1;
    if (F.tid == 0) *(uint4*)(lds + LDS_BYTES - 16) = make_uint4(0u, 0u, 0u, 0u);
    __syncthreads();
    XcdBarrier bar; bar.bar = F.w<unsigned>(WS_CTL); bar.x = 0; bar.st = (volatile LAS unsigned*)(LAS unsigned char*)(lds + LDS_BYTES - 16);
    if (multi_phase) bar = xcd_barrier_post(F.w<unsigned>(WS_CTL), (volatile LAS unsigned*)(LAS unsigned char*)(lds + LDS_BYTES - 16));
#define SEAM(k) do { if (IN(k) && IN((k) + 1)) xcd_barrier(bar); } while (0)
    bf16_t* ABUF = F.w<bf16_t>(WS_ABUF);

#ifndef DUPMASK
#define DUPMASK 0u
#endif
#define PHASE(k, ...) if (IN(k)) { __VA_ARGS__ } if (IN(k) && ((DUPMASK >> (k)) & 1u)) { xcd_barrier(bar); __VA_ARGS__ } SEAM(k);
#define PHASED(k, ...) if (IN(k)) { __VA_ARGS__ } if (IN(k) && ((DUPMASK >> (k)) & 1u)) { xcd_barrier(bar); __VA_ARGS__ } \
    if (IN(k) && IN((k) + 1)) { unsigned gen_ = 0u; XB_OVERLAP_ARRIVE(bar, gen_); cvt_dense_window(F, (k) - 1); XB_OVERLAP_WAIT(bar, gen_); }
#define PHASEW(k, ...) if (IN(k)) { __VA_ARGS__ } if (IN(k) && ((DUPMASK >> (k)) & 1u)) { xcd_barrier(bar); __VA_ARGS__ } \
    if (IN(k) && IN((k) + 1)) { unsigned gen_ = 0u; XB_OVERLAP_ARRIVE(bar, gen_); cvt_window(F, (k) - 8); XB_OVERLAP_WAIT(bar, gen_); }
    PHASE(0,
        ph_ada(F);
        cvt_job(F, F.in[I_EVWIN], nullptr, nullptr, F.w<bf16_t>(W_IN0), EVEN_PAD, 1024, 1024, EVEN_IN, EVEN_IN, 0, 1, (F.bid + 64) % F.G, F.G);
        if (!multi_phase) cvt_dense_range(F, 0, CVD_T_ALL);
        ph_filters(F); ph_rope_tables(F);)
    PHASED(1, ph_norm0(F);)
    PHASED(2, run_gemm(F, ABUF, 1024, F.w<bf16_t>(W_IN0), 1024, TT, EVEN_PAD, 1024, pg8::EpiBf16Plain{F.w<bf16_t>(L0_PROJ), EVEN_PAD});)
    PHASED(3, ph_convpass(F);)
    PHASED(4, ph_ssd_a(F); ph_hyena_mfma(F);)
    PHASE(6, ph_ssd_b(F);)
    PHASE(7, ph_ssd_c(F); ph_hyena_post(F);)
    PHASEW(8,
        run_gemm(F, ABUF, 1024, F.w<bf16_t>(W_OUT0), 1024, TL, 1024, 1024, pg8::EpiBf16Plain{F.w<bf16_t>(L0_MBUF), 1024});
        { pg8::Gemm g{ABUF, F.w<bf16_t>(W_OUT0), TT, 1024, 1024, 1024, 1024, 0}; pg8::DenseTailOrder<8> S; S.init(TL / 256, TC / 256, 1024 / 64, F.G, F.bid);
          pg8::gemm_phase<pg8::EpiTailBf16, pg8::DenseTailOrder<8>>((LAS unsigned char*)F.lds, g, S, pg8::EpiTailBf16{F.w<bf16_t>(L0_MBUF), 1024, F.w<bf16_t>(L0_XT), TL / 256, 8}); }
        )
    PHASEW(9, ph_thin<0, true, false>(F, (const float*)F.w<bf16_t>(L0_MBUF), TT, F.in[I_X], F.in[I_CTX], nullptr, nullptr, F.in[I_MIXPOST], MOD0, 2048, F.in[I_FFNPRE], MOD0, 3072, 4096, ABUF, 0, 1, F.w<bf16_t>(L0_XT), 8);)
    PHASEW(10, run_gemm(F, ABUF, 1024, F.w<bf16_t>(W_GU0), 1024, TT, 2 * DFF, 1024, pg8::EpiSwiglu{F.w<bf16_t>(L0_HMID), DFF});)
    PHASEW(11,
        run_gemm(F, F.w<bf16_t>(L0_HMID), DFF, F.w<bf16_t>(W_DN0), DFF, TL, 1024, DFF, pg8::EpiBf16Plain{F.w<bf16_t>(L0_MBUF), 1024});
        { pg8::Gemm g{F.w<bf16_t>(L0_HMID), F.w<bf16_t>(W_DN0), TT, 1024, DFF, DFF, DFF, 0}; pg8::DenseTailOrder<11> S; S.init(TL / 256, TC / 256, DFF / 64, F.G, F.bid);
          pg8::gemm_phase<pg8::EpiTailBf16, pg8::DenseTailOrder<11>>((LAS unsigned char*)F.lds, g, S, pg8::EpiTailBf16{F.w<bf16_t>(L0_MBUF), 1024, F.w<bf16_t>(L0_XT), TL / 256, 11}); }
        )
    PHASEW(12, ph_thin<0, false, false>(F, (const float*)F.w<bf16_t>(L0_MBUF), TT, nullptr, nullptr, nullptr, nullptr, F.in[I_FFNPOST], MOD0, 5120, F.in[I_MIXPRE] + 1024, MOD1, 0, 1024, ABUF, 0, 1, F.w<bf16_t>(L0_XT), 11);)
    PHASEW(13, run_gemm(F, ABUF, 1024, F.w<bf16_t>(W_IN1), 1024, TT, ODD_PAD, 1024, pg8::EpiBf16Plain{F.w<bf16_t>(L1_PROJ), ODD_PAD});)
    PHASEW(14, ph_attn_prep(F);)
    PHASEW(15,
        run_gemm(F, F.w<bf16_t>(L1_PROJ), ODD_PAD, F.w<bf16_t>(W_QUP), 256, TL, 768, 256, pg8::EpiQ{F.w<bf16_t>(L1_QM), F.w<float>(WS_SQ), F.w<float>(WS_ROPEM), F.w<float>(WS_ROPEM) + 2048 * 16, 0.10206207261596575f * LOG2E});
        run_gemm(F, F.w<bf16_t>(L1_PROJ) + 256, ODD_PAD, F.w<bf16_t>(W_KUP), 256, TT, 512, 256, pg8::EpiK{F.w<bf16_t>(L1_KM), F.w<float>(WS_SKV)});
        run_gemm(F, F.w<bf16_t>(W_VUP), 256, F.w<bf16_t>(L1_PROJ) + 256, ODD_PAD, 512, TT, 256, pg8::EpiVT{F.w<bf16_t>(L1_VT), F.w<float>(WS_SKV)});)
    PHASEW(16, ph_attn_mfma<false>(F); ph_attn_mfma<true>(F);)
    PHASEW(17, run_gemm(F, ABUF, 1024, F.w<bf16_t>(W_OUT1), 1024, TL, 1024, 1024, pg8::EpiBf16Plain{F.w<bf16_t>(L1_MBUF), 1024});)
    PHASEW(18, ph_thin<1, false, false>(F, (const float*)F.w<bf16_t>(L1_MBUF), TL, nullptr, nullptr, nullptr, nullptr, F.in[I_MIXPOST] + 1024, MOD1, 2048, F.in[I_FFNPRE] + 1024, MOD1, 3072, 4096, F.w<bf16_t>(L1_A2TMP));)
    PHASE(19,
        ph_moe_gather(F);
        { const int w0 = multi_phase ? CVW_NWIN * CVW_Q * F.G : 0; cvt_moe_range<true>(F, w0 < CVT_T_ALL ? w0 : CVT_T_ALL, CVT_T_ALL, F.bid, F.G); })
    PHASE(20,
        if (MOE_FP8) { pg8::Gemm g{F.w<bf16_t>(WS_AG), F.w<bf16_t>(WM_GU), 0, 2 * DFE, 512, 512, 512, (size_t)2 * DFE * 1024}; pg8::GroupedOrder S; S.init(F.w<unsigned>(WS_CNT), 2 * DFE / 256, F.G, F.bid);
            pg8::gemm_phase<pg8::EpiSwigluF8, pg8::GroupedOrder, true>((LAS unsigned char*)F.lds, g, S, pg8::EpiSwigluF8{F.w<unsigned char>(L1_HMID), DFE}); }
        else { pg8::Gemm g{F.w<bf16_t>(WS_AG), F.w<bf16_t>(WM_GU), 0, 2 * DFE, 1024, 1024, 1024, (size_t)2 * DFE * 1024 * 2}; pg8::GroupedOrder S; S.init(F.w<unsigned>(WS_CNT), 2 * DFE / 256, F.G, F.bid);
            pg8::gemm_phase<pg8::EpiSwiglu, pg8::GroupedOrder>((LAS unsigned char*)F.lds, g, S, pg8::EpiSwiglu{F.w<bf16_t>(L1_HMID), DFE}); })
    PHASE(21,
        constexpr int KE = MOE_FP8 ? DFE / 2 : DFE;
        constexpr float osc = MOE_FP8 ? 1.f / (F8_WSCALE * F8_HSCALE) : 1.f;
        pg8::Gemm g{F.w<bf16_t>(L1_HMID), F.w<bf16_t>(WM_DN), 0, 1024, KE, KE, KE, (size_t)1024 * KE * 2};
        { pg8::GroupedOrder S; S.init(F.w<unsigned>(WS_CNT), 4, F.G, F.bid, KE / 64, true);
          pg8::gemm_phase<pg8::EpiMoeOut, pg8::GroupedOrder, MOE_FP8 != 0>((LAS unsigned char*)F.lds, g, S, pg8::EpiMoeOut{F.w<bf16_t>(WS_MOUT), F.w<uint2>(WS_ROWINFO), osc}); }
        { pg8::TailOrder S; S.init(F.w<unsigned>(WS_CNT), F.G, F.bid, KE / 64);
          pg8::gemm_phase<pg8::EpiXtr, pg8::TailOrder, MOE_FP8 != 0>((LAS unsigned char*)F.lds, g, S, pg8::EpiXtr{F.w<bf16_t>(WS_MOUT), F.w<uint2>(WS_ROWINFO), F.w<bf16_t>(WS_XTR), S.NTF, 7, osc}); })
    PHASE(22,
        pg8::TailOrder S; S.init(F.w<unsigned>(WS_CNT), F.G, F.bid, (MOE_FP8 ? DFE / 2 : DFE) / 64);
        ph_thin<2, false, true>(F, (const float*)F.w<bf16_t>(WS_MOUT), TL, nullptr, nullptr, F.out, nullptr, F.in[I_FFNPOST] + 1024, MOD1, 5120, nullptr, nullptr, 0, 0, nullptr, S.NTF, S.nsub > 0 ? 7 : 1);)
#undef IN
}

extern "C" void kernel_launch(void* const* d_in, const int* in_sizes, int n_in, void* d_out, int out_size, void* d_ws, size_t ws_size, hipStream_t stream) {
    static int grid = 0;
    if (grid == 0) {
        if (n_in != 41 || out_size != TL * DM || ws_size < WS_END) { fprintf(stderr, "kernel_launch: unexpected shapes (n_in %d, out %d, ws %zu < %zu)\n", n_in, out_size, ws_size, (size_t)WS_END); grid = -1; return; }
        int dev = 0, cus = 0;
        if (hipGetDevice(&dev) != hipSuccess || hipDeviceGetAttribute(&cus, hipDeviceAttributeMultiprocessorCount, dev) != hipSuccess) { grid = -1; return; }
        if (hipFuncSetAttribute((const void*)fwd, hipFuncAttributeMaxDynamicSharedMemorySize, LDS_BYTES) != hipSuccess) { fprintf(stderr, "kernel_launch: hipFuncSetAttribute failed\n"); grid = -1; return; }
        int per_cu = 0;
        if (hipOccupancyMaxActiveBlocksPerMultiprocessor(&per_cu, (const void*)fwd, NTHR, LDS_BYTES) != hipSuccess || per_cu < 1) fprintf(stderr, "kernel_launch: occupancy query says %d\n", per_cu);
        (void)hipGetLastError();
        grid = cus;
        if (grid % 4 != 0) { fprintf(stderr, "kernel_launch: the kernel needs a grid size that is a multiple of 4 (got %d CUs)\n", grid); grid = -1; return; }
    }
    if (grid < 0) return;
    (void)hipMemsetAsync((char*)d_ws + WS_CTL, 0, 65536, stream);
    Args a{};
    for (int i = 0; i < 41; ++i) a.in[i] = (const float*)d_in[i];
    a.out = (float*)d_out; a.ws = (unsigned char*)d_ws;
    auto launch = [&](int lo, int hi, int ex) { a.ph_lo = lo; a.ph_hi = hi; a.ex = ex; hipLaunchKernelGGL(fwd, dim3(grid), dim3(NTHR), LDS_BYTES, stream, a); };
#if defined(MULTI)
    for (int p = 0; p <= 22; ++p) launch(p, p + 1, 0);
#else
    launch(0, 23, 0);
#endif
}
```
